# Optimizing an MI355X kernel written in HIP

```python
import jax, jax.numpy as jnp
from jax import lax
import numpy as np

D_MODEL = 1024
BATCH = 8
SEQ = 2048
DEPTH = 1

ATTN_Q_HEADS = 8
ATTN_KV_HEADS = 2
ATTN_HEAD_DIM = 64
ATTN_GROUP = ATTN_Q_HEADS // ATTN_KV_HEADS
ATTN_WIDTH = ATTN_Q_HEADS * ATTN_HEAD_DIM
ATTN_KV_WIDTH = ATTN_KV_HEADS * ATTN_HEAD_DIM
WINDOW = 128
HGRN_HEADS = 4
HGRN_KEY_DIM = 128
HGRN_VAL_DIM = 128
HGRN_KEY_WIDTH = HGRN_HEADS * HGRN_KEY_DIM
HGRN_WIDTH = HGRN_HEADS * HGRN_VAL_DIM
HGRN_CHUNK = 64
MIX_WIDTH = ATTN_WIDTH + HGRN_WIDTH
IN_WIDTH = ATTN_WIDTH + 2 * ATTN_KV_WIDTH + 2 * HGRN_KEY_WIDTH + 2 * HGRN_WIDTH
N_EXPERTS = 32
TOP_K = 4
EXPERT_FF = D_MODEL
SWIGLU_LIMIT = 7.0
SWIGLU_ALPHA = 1.702
EXPERT_BLOCK = 128
NORM_EPS = 1e-5

kernel_name = "hymba_swa_sink_hgrn2_moe_block"


def rmsnorm(x, g):
    x32 = x.astype(jnp.float32)
    y = x32 * lax.rsqrt(jnp.mean(x32 * x32, axis=-1, keepdims=True) + NORM_EPS)
    return (y * g.astype(jnp.float32)).astype(x.dtype)


def alibi_slopes(n):
    return (2.0 ** (-8.0 * np.arange(1, n + 1) / n)).astype(np.float32)


def sliding_window_attention(q, k, v, sinks):
    B, S = q.shape[:2]
    nb = S // WINDOW
    dt = q.dtype
    qb = q.reshape(B, nb, WINDOW, ATTN_KV_HEADS, ATTN_GROUP, ATTN_HEAD_DIM)

    def band(t):
        cur = t.reshape(B, nb, WINDOW, ATTN_KV_HEADS, ATTN_HEAD_DIM)
        prev = jnp.concatenate([jnp.zeros_like(cur[:, :1]), cur[:, :-1]], axis=1)
        return jnp.concatenate([prev, cur], axis=2)

    kb, vb = band(k), band(v)
    scores = jnp.einsum('bnqhgd,bnkhd->bhgnqk', qb, kb,
                        preferred_element_type=jnp.float32) * (ATTN_HEAD_DIM ** -0.5)
    qi = jnp.arange(WINDOW)[:, None]
    ki = jnp.arange(2 * WINDOW)[None, :]
    dist = WINDOW + qi - ki
    blk = jnp.arange(nb)[:, None, None]
    valid = (dist >= 0) & (dist < WINDOW) & (blk * WINDOW - WINDOW + ki >= 0)
    slopes = jnp.asarray(alibi_slopes(ATTN_Q_HEADS)).reshape(ATTN_KV_HEADS, ATTN_GROUP)
    scores = scores - slopes[:, :, None, None, None] * dist.astype(jnp.float32)
    scores = jnp.where(valid, scores, -jnp.inf)
    sink = sinks.astype(jnp.float32).reshape(ATTN_KV_HEADS, ATTN_GROUP)[:, :, None, None, None]
    m = jnp.maximum(scores.max(axis=-1, keepdims=True), sink)
    p = jnp.exp(scores - m)
    probs = p / (p.sum(axis=-1, keepdims=True) + jnp.exp(sink - m))
    out = jnp.einsum('bhgnqk,bnkhd->bnqhgd', probs.astype(dt), vb)
    return out.reshape(B, S, ATTN_WIDTH)


def hgrn2_recurrence(q, f_logit, i, lb):
    B, S = q.shape[:2]
    f32 = jnp.float32
    nc = S // HGRN_CHUNK
    q = jax.nn.silu(q.astype(f32))
    lb = lb.astype(f32)
    f = lb + (1.0 - lb) * jax.nn.sigmoid(f_logit.astype(f32))
    logf = jnp.log(f)
    k = 1.0 - f

    def chunks(t, d):
        return t.reshape(B, nc, HGRN_CHUNK, HGRN_HEADS, d).transpose(1, 0, 3, 2, 4)

    qc = chunks(q, HGRN_KEY_DIM)
    kc = chunks(k, HGRN_KEY_DIM)
    vc = chunks(i.astype(f32), HGRN_VAL_DIM)
    bc = jnp.cumsum(chunks(logf, HGRN_KEY_DIM), axis=3)
    causal = jnp.tril(jnp.ones((HGRN_CHUNK, HGRN_CHUNK), bool))

    def step(state, inp):
        q_, k_, v_, b_ = inp
        inter = jnp.einsum('bhtk,bhkv->bhtv', q_ * jnp.exp(b_), state)
        rel = jnp.where(causal[:, :, None], b_[:, :, :, None, :] - b_[:, :, None, :, :], -jnp.inf)
        att = jnp.einsum('bhtk,bhtsk,bhsk->bhts', q_, jnp.exp(rel), k_)
        intra = jnp.einsum('bhts,bhsv->bhtv', att, v_)
        b_last = b_[:, :, -1:, :]
        new_state = (jnp.exp(b_last[:, :, 0, :, None]) * state
                     + jnp.einsum('bhsk,bhsv->bhkv', k_ * jnp.exp(b_last - b_), v_))
        return new_state, inter + intra

    s0 = jnp.zeros((B, HGRN_HEADS, HGRN_KEY_DIM, HGRN_VAL_DIM), f32)
    _, o = lax.scan(step, s0, (qc, kc, vc, bc))
    return o.transpose(1, 0, 3, 2, 4).reshape(B, S, HGRN_HEADS, HGRN_VAL_DIM)


def moe_ffn(h, router_w, router_b, w1, b1, w2, b2):
    T, D = h.shape
    f32 = jnp.float32
    logits = jnp.dot(h.astype(f32), router_w.astype(f32)) + router_b.astype(f32)
    top_v, top_e = lax.top_k(logits, TOP_K)
    gates = jax.nn.softmax(top_v, axis=-1)
    TK = T * TOP_K
    flat_e = top_e.reshape(TK)
    flat_tok = jnp.arange(TK, dtype=jnp.int32) // TOP_K
    flat_g = gates.reshape(TK)
    order = jnp.argsort(flat_e)
    se = flat_e[order]
    counts = jnp.bincount(flat_e, length=N_EXPERTS)
    padded = (counts + EXPERT_BLOCK - 1) // EXPERT_BLOCK * EXPERT_BLOCK
    start = jnp.cumsum(counts) - counts
    ends = jnp.cumsum(padded)
    pstart = ends - padded
    dest = pstart[se] + jnp.arange(TK, dtype=jnp.int32) - start[se]
    n_rows = -(-TK // EXPERT_BLOCK) * EXPERT_BLOCK + N_EXPERTS * EXPERT_BLOCK
    n_blocks = n_rows // EXPERT_BLOCK
    row_tok = jnp.zeros((n_rows,), jnp.int32).at[dest].set(flat_tok[order])
    row_gate = jnp.zeros((n_rows,), f32).at[dest].set(flat_g[order])
    block_e = jnp.clip(jnp.searchsorted(ends, jnp.arange(n_blocks) * EXPERT_BLOCK, side='right'),
                       0, N_EXPERTS - 1)
    xb = h[row_tok].reshape(n_blocks, EXPERT_BLOCK, D)

    def expert_block(args):
        xblk, e = args
        hid = jnp.dot(xblk, w1[e]) + b1[e]
        glu = jnp.minimum(hid[:, 0::2], SWIGLU_LIMIT)
        lin = jnp.clip(hid[:, 1::2], -SWIGLU_LIMIT, SWIGLU_LIMIT)
        act = glu * jax.nn.sigmoid(SWIGLU_ALPHA * glu) * (lin + 1.0)
        return jnp.dot(act, w2[e]) + b2[e]

    yb = lax.map(expert_block, (xb, block_e))
    y = jnp.zeros((T, D), f32).at[row_tok].add(
        yb.reshape(n_rows, D).astype(f32) * row_gate[:, None])
    return y.astype(h.dtype)


def setup_inputs(seed: int = 0) -> dict:
    key = jax.random.key(seed)
    ks = jax.random.split(key, 18)

    def nrm(k, shape, scale):
        return jax.random.normal(k, shape, jnp.float32) * scale

    return {
        "x": nrm(ks[0], (BATCH, SEQ, D_MODEL), 1.0),
        "norm1_g": 1.0 + nrm(ks[1], (DEPTH, D_MODEL), 0.02),
        "w_in": nrm(ks[2], (DEPTH, D_MODEL, IN_WIDTH), D_MODEL ** -0.5),
        "b_in": nrm(ks[3], (DEPTH, IN_WIDTH), 0.02),
        "attn_sinks": nrm(ks[4], (DEPTH, ATTN_Q_HEADS), 0.5),
        "attn_out_g": 1.0 + nrm(ks[5], (DEPTH, ATTN_WIDTH), 0.02),
        "hgrn_lb_logits": nrm(ks[6], (DEPTH + 1, HGRN_KEY_WIDTH), 1.0),
        "hgrn_out_g": 1.0 + nrm(ks[7], (DEPTH, HGRN_WIDTH), 0.02),
        "w_out": nrm(ks[8], (DEPTH, MIX_WIDTH, D_MODEL), MIX_WIDTH ** -0.5),
        "b_out": nrm(ks[9], (DEPTH, D_MODEL), 0.02),
        "norm2_g": 1.0 + nrm(ks[10], (DEPTH, D_MODEL), 0.02),
        "router_w": nrm(ks[11], (DEPTH, D_MODEL, N_EXPERTS), D_MODEL ** -0.5),
        "router_b": nrm(ks[12], (DEPTH, N_EXPERTS), 0.01),
        "w1": nrm(ks[13], (DEPTH, N_EXPERTS, D_MODEL, 2 * EXPERT_FF), D_MODEL ** -0.5),
        "b1": nrm(ks[14], (DEPTH, N_EXPERTS, 2 * EXPERT_FF), 0.02),
        "w2": nrm(ks[15], (DEPTH, N_EXPERTS, EXPERT_FF, D_MODEL), EXPERT_FF ** -0.5),
        "b2": nrm(ks[16], (DEPTH, N_EXPERTS, D_MODEL), 0.02),
        "final_g": 1.0 + nrm(ks[17], (D_MODEL,), 0.02),
    }


def reference(x, norm1_g, w_in, b_in, attn_sinks, attn_out_g, hgrn_lb_logits, hgrn_out_g,
              w_out, b_out, norm2_g, router_w, router_b, w1, b1, w2, b2, final_g):
    B, S, D = x.shape
    lower_bounds = jnp.cumsum(jax.nn.softmax(hgrn_lb_logits.astype(jnp.float32), axis=0), axis=0)
    split_at = list(np.cumsum([ATTN_WIDTH, ATTN_KV_WIDTH, ATTN_KV_WIDTH,
                               HGRN_KEY_WIDTH, HGRN_KEY_WIDTH, HGRN_WIDTH]))
    for l in range(DEPTH):
        h = rmsnorm(x, norm1_g[l])
        proj = jnp.dot(h, w_in[l]) + b_in[l]
        aq, ak, av, hq, hf, hi, hg = jnp.split(proj, split_at, axis=-1)
        attn = sliding_window_attention(aq, ak, av, attn_sinks[l])
        attn = rmsnorm(attn, attn_out_g[l])
        o = hgrn2_recurrence(hq, hf, hi, lower_bounds[l])
        o = o * lax.rsqrt(jnp.mean(o * o, axis=-1, keepdims=True) + NORM_EPS)
        o = o * hgrn_out_g[l].astype(jnp.float32).reshape(HGRN_HEADS, HGRN_VAL_DIM)
        o = o.reshape(B, S, HGRN_WIDTH) * jax.nn.silu(hg.astype(jnp.float32))
        mixed = jnp.concatenate([attn, o.astype(x.dtype)], axis=-1)
        x = x + jnp.dot(mixed, w_out[l]) + b_out[l]
        h2 = rmsnorm(x, norm2_g[l]).reshape(B * S, D)
        x = x + moe_ffn(h2, router_w[l], router_b[l], w1[l], b1[l], w2[l], b2[l]).reshape(B, S, D)
    return rmsnorm(x, final_g)
```

```cpp
#include <hip/hip_runtime.h>
#include <stdint.h>

typedef unsigned short bf16_t;
typedef short bf16x8 __attribute__((ext_vector_type(8)));
typedef float f32x4 __attribute__((ext_vector_type(4)));

constexpr int BATCH = 8, SEQ = 2048, DM = 1024, T = BATCH * SEQ;
constexpr int AW = 512, AKW = 128, HKW = 512, HW = 512, INW = 2816, MIXW = 1024;
constexpr int NE = 32, TOPK = 4, FF = 1024;
constexpr int C_AQ = 0, C_AK = 512, C_AV = 640, C_HQ = 768, C_HF = 1280, C_HI = 1792, C_HG = 2304;
constexpr float EPS = 1e-5f;
constexpr int ACT_ROWS = T * TOPK + NE * 256;

constexpr size_t MiB = 1u << 20;
constexpr size_t al(size_t x) { return (x + 255) & ~(size_t)255; }
constexpr size_t WS_CTL = 0;
constexpr size_t WS_LB = 1 * MiB;
constexpr size_t WS_WINT = 2 * MiB;
constexpr size_t WS_WOUTT = WS_WINT + al((size_t)INW * DM * 2);
constexpr size_t WS_W1T = WS_WOUTT + al((size_t)DM * MIXW * 2);
constexpr size_t WS_W2T = WS_W1T + al((size_t)NE * 2 * FF * DM * 2);
constexpr size_t WS_XN = WS_W2T + al((size_t)NE * DM * FF * 2);
constexpr size_t WS_AQ = WS_XN + al((size_t)T * DM * 2);
constexpr size_t WS_AK = WS_AQ + al((size_t)T * AW * 2);
constexpr size_t WS_AV = WS_AK + al((size_t)T * AKW * 2);
constexpr size_t WS_HQ = WS_AV + al((size_t)T * AKW * 2);
constexpr size_t WS_G = WS_HQ + al((size_t)T * HKW * 2);
constexpr size_t WS_KK = WS_G + al((size_t)T * HKW * 4);
constexpr size_t WS_HI = WS_KK + al((size_t)T * HKW * 2);
constexpr size_t WS_HG = WS_HI + al((size_t)T * HW * 2);
constexpr size_t WS_ATT = WS_HG + al((size_t)T * HW * 2);
constexpr size_t WS_ORAW = WS_ATT + al((size_t)T * AW * 4);
constexpr size_t WS_MIX = WS_ORAW + al((size_t)T * HW * 4);
constexpr size_t WS_X1 = WS_MIX + al((size_t)T * MIXW * 2);
constexpr size_t WS_H2 = WS_X1 + al((size_t)T * DM * 4);
constexpr size_t WS_GATE = WS_H2 + al((size_t)T * DM * 2);
constexpr size_t WS_LIST = WS_GATE + al((size_t)T * TOPK * 4);
constexpr size_t WS_ACT = WS_LIST + al((size_t)NE * T * 4);
constexpr size_t WS_Y = WS_ACT + al((size_t)ACT_ROWS * FF * 2);
constexpr size_t WS_END = WS_Y + al((size_t)T * TOPK * DM * 2);
constexpr int CW_CNT = 64;
constexpr int CW_OFF = 128;

__device__ __forceinline__ bf16_t f2bf(float f) { unsigned u = __builtin_bit_cast(unsigned, f); return (bf16_t)((u + 0x7fffu + ((u >> 16) & 1u)) >> 16); }
__device__ __forceinline__ float bf2f(bf16_t b) { return __builtin_bit_cast(float, (unsigned)b << 16); }
__device__ __forceinline__ float wave_sum(float v) {
#pragma unroll
    for (int o = 1; o < 64; o <<= 1) v += __shfl_xor(v, o);
    return v;
}
__device__ __forceinline__ float wave_max(float v) {
#pragma unroll
    for (int o = 1; o < 64; o <<= 1) v = fmaxf(v, __shfl_xor(v, o));
    return v;
}
__device__ __forceinline__ float sigmoidf_(float x) { return 1.f / (1.f + __expf(-x)); }
__device__ __forceinline__ float siluf_(float x) { return x / (1.f + __expf(-x)); }

__global__ __launch_bounds__(256) void nk_transpose(const float* __restrict__ W, bf16_t* __restrict__ WT, int K, int N) {
    __shared__ float tile[32][33];
    const size_t eoff = (size_t)blockIdx.z * K * N;
    const int n0 = blockIdx.x * 32, k0 = blockIdx.y * 32, tx = threadIdx.x & 31, ty = threadIdx.x >> 5;
    for (int i = ty; i < 32; i += 8) tile[i][tx] = W[eoff + (size_t)(k0 + i) * N + n0 + tx];
    __syncthreads();
    for (int i = ty; i < 32; i += 8) WT[eoff + (size_t)(n0 + i) * K + k0 + tx] = f2bf(tile[tx][i]);
}
__global__ void nk_lb(const float* __restrict__ lg, float* __restrict__ lb) {
    const int c = blockIdx.x * blockDim.x + threadIdx.x;
    if (c < HKW) { const float a = lg[c], b = lg[HKW + c]; lb[c] = 1.f / (1.f + __expf(b - a)); }
}
__global__ __launch_bounds__(256) void nk_rmsnorm1(const float* __restrict__ x, const float* __restrict__ g, bf16_t* __restrict__ out) {
    const int row = blockIdx.x * 4 + (threadIdx.x >> 6), lane = threadIdx.x & 63;
    const float* xr = x + (size_t)row * DM;
    float v[16]; float ss = 0.f;
#pragma unroll
    for (int j = 0; j < 16; ++j) { v[j] = xr[lane + 64 * j]; ss += v[j] * v[j]; }
    const float r = rsqrtf(wave_sum(ss) * (1.f / DM) + EPS);
#pragma unroll
    for (int j = 0; j < 16; ++j) out[(size_t)row * DM + lane + 64 * j] = f2bf(v[j] * r * g[lane + 64 * j]);
}

struct GemmArgs { const bf16_t* A; const bf16_t* Bt; int M, N, K, mode; const int* cnt; const int* off; const int* list; };
template <class Epi>
__global__ __launch_bounds__(256) void nk_gemm(GemmArgs g, Epi epi) {
    const int e = blockIdx.z, lane = threadIdx.x & 63, w = threadIdx.x >> 6, wm = w >> 1, wn = w & 1;
    const int Me = g.mode ? g.cnt[e] : g.M;
    const int m0 = blockIdx.y * 64, n0 = blockIdx.x * 64;
    if (m0 >= Me) return;
    const bf16_t* Bt = g.Bt + (g.mode ? (size_t)e * g.N * g.K : 0);
    const int K = g.K, fr = lane & 15, fq = lane >> 4;
    const bf16_t* ap[2]; const bf16_t* bp[2];
#pragma unroll
    for (int i = 0; i < 2; ++i) {
        int r = m0 + wm * 32 + i * 16 + fr; if (r >= Me) r = Me - 1;
        size_t arow;
        if (g.mode == 0) arow = (size_t)r;
        else if (g.mode == 1) arow = (size_t)(g.list[(size_t)e * T + r] >> 2);
        else arow = (size_t)(g.off[e] + r);
        ap[i] = g.A + arow * K + fq * 8;
        bp[i] = Bt + (size_t)(n0 + wn * 32 + i * 16 + fr) * K + fq * 8;
    }
    f32x4 acc[2][2];
#pragma unroll
    for (int i = 0; i < 2; ++i)
#pragma unroll
        for (int j = 0; j < 2; ++j) acc[i][j] = (f32x4){0.f, 0.f, 0.f, 0.f};
    for (int k = 0; k < K; k += 32) {
        bf16x8 a[2], b[2];
#pragma unroll
        for (int i = 0; i < 2; ++i) { a[i] = *(const bf16x8*)(ap[i] + k); b[i] = *(const bf16x8*)(bp[i] + k); }
#pragma unroll
        for (int i = 0; i < 2; ++i)
#pragma unroll
            for (int j = 0; j < 2; ++j) acc[i][j] = __builtin_amdgcn_mfma_f32_16x16x32_bf16(b[j], a[i], acc[i][j], 0, 0, 0);
    }
#pragma unroll
    for (int i = 0; i < 2; ++i) {
        const int r = m0 + wm * 32 + i * 16 + fr;
        if (r < Me) {
#pragma unroll
            for (int j = 0; j < 2; ++j) epi(e, r, n0 + wn * 32 + j * 16 + 4 * fq, acc[i][j]);
        }
    }
}

struct EpiInProj {
    const float* bias; const float* lb; bf16_t *AQ, *AK, *AV, *HQ, *KK, *HI, *HG; float* G;
    __device__ __forceinline__ void operator()(int, int r, int c, f32x4 v) const {
        const f32x4 bv = *(const f32x4*)(bias + c); v = v + bv;
        if (c < C_AK) { bf16_t* o = AQ + (size_t)r * AW + (c - C_AQ); for (int i = 0; i < 4; ++i) o[i] = f2bf(v[i]); }
        else if (c < C_AV) { bf16_t* o = AK + (size_t)r * AKW + (c - C_AK); for (int i = 0; i < 4; ++i) o[i] = f2bf(v[i]); }
        else if (c < C_HQ) { bf16_t* o = AV + (size_t)r * AKW + (c - C_AV); for (int i = 0; i < 4; ++i) o[i] = f2bf(v[i]); }
        else if (c < C_HF) { bf16_t* o = HQ + (size_t)r * HKW + (c - C_HQ); for (int i = 0; i < 4; ++i) o[i] = f2bf(siluf_(v[i])); }
        else if (c < C_HI) { const int cc = c - C_HF; float* og = G + (size_t)r * HKW + cc; bf16_t* ok = KK + (size_t)r * HKW + cc;
            for (int i = 0; i < 4; ++i) { const float l = lb[cc + i], f = l + (1.f - l) * sigmoidf_(v[i]); og[i] = __logf(f); ok[i] = f2bf(1.f - f); } }
        else if (c < C_HG) { bf16_t* o = HI + (size_t)r * HW + (c - C_HI); for (int i = 0; i < 4; ++i) o[i] = f2bf(v[i]); }
        else { bf16_t* o = HG + (size_t)r * HW + (c - C_HG); for (int i = 0; i < 4; ++i) o[i] = f2bf(siluf_(v[i])); }
    }
};
struct EpiOutProj {
    const float* bias; const float* x; float* X1;
    __device__ __forceinline__ void operator()(int, int r, int c, f32x4 v) const {
        const f32x4 bv = *(const f32x4*)(bias + c), xv = *(const f32x4*)(x + (size_t)r * DM + c);
        *(f32x4*)(X1 + (size_t)r * DM + c) = v + bv + xv;
    }
};
struct EpiMoe1 {
    const float* b1; const int* off; bf16_t* ACT;
    __device__ __forceinline__ void operator()(int e, int r, int c, f32x4 v) const {
        const f32x4 bv = *(const f32x4*)(b1 + (size_t)e * 2 * FF + c); v = v + bv;
        bf16_t* o = ACT + (size_t)(off[e] + r) * FF + (c >> 1);
#pragma unroll
        for (int i = 0; i < 2; ++i) {
            const float glu = fminf(v[2 * i], 7.f), lin = fminf(fmaxf(v[2 * i + 1], -7.f), 7.f);
            o[i] = f2bf(glu * sigmoidf_(1.702f * glu) * (lin + 1.f));
        }
    }
};
struct EpiMoe2 {
    const float* b2; const int* list; const float* gate; bf16_t* Y;
    __device__ __forceinline__ void operator()(int e, int r, int c, f32x4 v) const {
        const f32x4 bv = *(const f32x4*)(b2 + (size_t)e * DM + c); v = v + bv;
        const int slot = list[(size_t)e * T + r]; const float gt = gate[slot];
        bf16_t* o = Y + (size_t)slot * DM + c;
#pragma unroll
        for (int i = 0; i < 4; ++i) o[i] = f2bf(v[i] * gt);
    }
};

__global__ __launch_bounds__(256) void nk_attn(const bf16_t* __restrict__ AQ, const bf16_t* __restrict__ AK, const bf16_t* __restrict__ AV, const float* __restrict__ sinks, float* __restrict__ ATT) {
    const int gw = blockIdx.x * 4 + (threadIdx.x >> 6), lane = threadIdx.x & 63;
    const int t = gw >> 3, hq = gw & 7, kvh = hq >> 2, b = t / SEQ, tp = t % SEQ;
    const float slope = exp2f(-(float)(hq + 1)), sink = sinks[hq];
    const float qd = bf2f(AQ[(size_t)t * AW + hq * 64 + lane]);
    const int s0 = tp >= 127 ? tp - 127 : 0, nk = tp - s0 + 1;
    const bf16_t* kb = AK + ((size_t)b * SEQ + s0) * AKW + kvh * 64 + lane;
    const bf16_t* vb = AV + ((size_t)b * SEQ + s0) * AKW + kvh * 64 + lane;
    float slo = -INFINITY, shi = -INFINITY;
    for (int i = 0; i < nk; ++i) {
        const float d = wave_sum(qd * bf2f(kb[(size_t)i * AKW]));
        const float sc = d * 0.125f - slope * (float)(tp - (s0 + i));
        if ((i & 63) == lane) { if (i < 64) slo = sc; else shi = sc; }
    }
    const float m = fmaxf(wave_max(fmaxf(slo, shi)), sink);
    const float plo = __expf(slo - m), phi = __expf(shi - m);
    const float den = wave_sum(plo + phi) + __expf(sink - m);
    float o = 0.f;
    for (int i = 0; i < nk; ++i) {
        const float p = __shfl(i < 64 ? plo : phi, i & 63);
        o += p * bf2f(vb[(size_t)i * AKW]);
    }
    ATT[(size_t)t * AW + hq * 64 + lane] = o / den;
}

__global__ __launch_bounds__(128) void nk_hgrn(const bf16_t* __restrict__ HQ, const float* __restrict__ G, const bf16_t* __restrict__ KK, const bf16_t* __restrict__ HI, float* __restrict__ ORAW) {
    constexpr int TT = 16;
    __shared__ float sf[TT][128], sk[TT][128], sq[TT][128];
    const int b = blockIdx.x >> 2, h = blockIdx.x & 3, v = threadIdx.x;
    float S[128];
#pragma unroll
    for (int k = 0; k < 128; ++k) S[k] = 0.f;
    for (int t0 = 0; t0 < SEQ; t0 += TT) {
        __syncthreads();
        for (int tt = 0; tt < TT; ++tt) {
            const size_t idx = ((size_t)b * SEQ + t0 + tt) * HKW + h * 128 + v;
            sf[tt][v] = __expf(G[idx]); sk[tt][v] = bf2f(KK[idx]); sq[tt][v] = bf2f(HQ[idx]);
        }
        __syncthreads();
        for (int tt = 0; tt < TT; ++tt) {
            const size_t row = (size_t)b * SEQ + t0 + tt;
            const float vv = bf2f(HI[row * HW + h * 128 + v]);
            float o = 0.f;
#pragma unroll
            for (int k = 0; k < 128; ++k) { S[k] = sf[tt][k] * S[k] + sk[tt][k] * vv; o += sq[tt][k] * S[k]; }
            ORAW[row * HW + h * 128 + v] = o;
        }
    }
}

__global__ __launch_bounds__(256) void nk_mix(const float* __restrict__ ATT, const float* __restrict__ ORAW, const bf16_t* __restrict__ HG, const float* __restrict__ ga, const float* __restrict__ gh, bf16_t* __restrict__ MIX) {
    const int t = blockIdx.x * 4 + (threadIdx.x >> 6), lane = threadIdx.x & 63;
    float a[8]; float ss = 0.f;
#pragma unroll
    for (int j = 0; j < 8; ++j) { a[j] = ATT[(size_t)t * AW + lane + 64 * j]; ss += a[j] * a[j]; }
    const float r = rsqrtf(wave_sum(ss) * (1.f / AW) + EPS);
#pragma unroll
    for (int j = 0; j < 8; ++j) MIX[(size_t)t * MIXW + lane + 64 * j] = f2bf(a[j] * r * ga[lane + 64 * j]);
#pragma unroll
    for (int h = 0; h < 4; ++h) {
        const int c0 = h * 128 + lane, c1 = c0 + 64;
        const float o0 = ORAW[(size_t)t * HW + c0], o1 = ORAW[(size_t)t * HW + c1];
        const float rr = rsqrtf(wave_sum(o0 * o0 + o1 * o1) * (1.f / 128.f) + EPS);
        MIX[(size_t)t * MIXW + AW + c0] = f2bf(o0 * rr * gh[c0] * bf2f(HG[(size_t)t * HW + c0]));
        MIX[(size_t)t * MIXW + AW + c1] = f2bf(o1 * rr * gh[c1] * bf2f(HG[(size_t)t * HW + c1]));
    }
}

__global__ __launch_bounds__(256) void nk_router(const float* __restrict__ X1, const float* __restrict__ g2, const float* __restrict__ rw, const float* __restrict__ rb,
                                                 bf16_t* __restrict__ H2, float* __restrict__ GATE, int* __restrict__ LIST, int* __restrict__ cnt) {
    const int t = blockIdx.x * 4 + (threadIdx.x >> 6), lane = threadIdx.x & 63;
    float v[16]; float ss = 0.f;
#pragma unroll
    for (int j = 0; j < 16; ++j) { v[j] = X1[(size_t)t * DM + lane + 64 * j]; ss += v[j] * v[j]; }
    const float r = rsqrtf(wave_sum(ss) * (1.f / DM) + EPS);
#pragma unroll
    for (int j = 0; j < 16; ++j) { const int c = lane + 64 * j; v[j] = v[j] * r * g2[c]; H2[(size_t)t * DM + c] = f2bf(v[j]); }
    float mine = -INFINITY;
#pragma unroll 1
    for (int eg = 0; eg < NE; eg += 8) {
        float lg[8];
#pragma unroll
        for (int i = 0; i < 8; ++i) lg[i] = 0.f;
#pragma unroll
        for (int j = 0; j < 16; ++j) {
            const float* w = rw + (size_t)(lane + 64 * j) * NE + eg;
            const f32x4 w0 = *(const f32x4*)w, w1 = *(const f32x4*)(w + 4);
#pragma unroll
            for (int i = 0; i < 4; ++i) { lg[i] += v[j] * w0[i]; lg[4 + i] += v[j] * w1[i]; }
        }
#pragma unroll
        for (int i = 0; i < 8; ++i) { const float s = wave_sum(lg[i]) + rb[eg + i]; if (lane == eg + i) mine = s; }
    }
    float tv[TOPK]; int te[TOPK];
#pragma unroll
    for (int k = 0; k < TOPK; ++k) {
        float bv = mine; int bi = lane;
#pragma unroll
        for (int o = 1; o < 64; o <<= 1) { const float ov = __shfl_xor(bv, o); const int oi = __shfl_xor(bi, o); if (ov > bv || (ov == bv && oi < bi)) { bv = ov; bi = oi; } }
        tv[k] = bv; te[k] = bi; if (lane == bi) mine = -INFINITY;
    }
    const float e1 = __expf(tv[1] - tv[0]), e2 = __expf(tv[2] - tv[0]), e3 = __expf(tv[3] - tv[0]), inv = 1.f / (1.f + e1 + e2 + e3);
    if (lane < TOPK) {
        const float gk = (lane == 0 ? 1.f : lane == 1 ? e1 : lane == 2 ? e2 : e3) * inv;
        const int ek = lane == 0 ? te[0] : lane == 1 ? te[1] : lane == 2 ? te[2] : te[3];
        GATE[t * TOPK + lane] = gk;
        const int pos = atomicAdd(&cnt[ek], 1);
        LIST[(size_t)ek * T + pos] = t * TOPK + lane;
    }
}
__global__ void nk_offsets(const int* __restrict__ cnt, int* __restrict__ off) {
    if (threadIdx.x == 0) { int a = 0; for (int e = 0; e < NE; ++e) { off[e] = a; a += (cnt[e] + 255) & ~255; } off[NE] = a; }
}
__global__ __launch_bounds__(256) void nk_final(const float* __restrict__ X1, const bf16_t* __restrict__ Y, const float* __restrict__ gf, float* __restrict__ out) {
    const int t = blockIdx.x * 4 + (threadIdx.x >> 6), lane = threadIdx.x & 63;
    float v[16]; float ss = 0.f;
#pragma unroll
    for (int j = 0; j < 16; ++j) {
        const int c = lane + 64 * j; float a = X1[(size_t)t * DM + c];
#pragma unroll
        for (int k = 0; k < TOPK; ++k) a += bf2f(Y[((size_t)t * TOPK + k) * DM + c]);
        v[j] = a; ss += a * a;
    }
    const float r = rsqrtf(wave_sum(ss) * (1.f / DM) + EPS);
#pragma unroll
    for (int j = 0; j < 16; ++j) out[(size_t)t * DM + lane + 64 * j] = v[j] * r * gf[lane + 64 * j];
}

extern "C" void kernel_launch(void* const* d_in, const int* in_sizes, int n_in, void* d_out, int out_size, void* d_ws, size_t ws_size, hipStream_t stream) {
    if (n_in != 18 || ws_size < WS_END) return;
    const float* x = (const float*)d_in[0]; const float* norm1_g = (const float*)d_in[1]; const float* w_in = (const float*)d_in[2]; const float* b_in = (const float*)d_in[3];
    const float* sinks = (const float*)d_in[4]; const float* attn_g = (const float*)d_in[5]; const float* lb_logits = (const float*)d_in[6]; const float* hgrn_g = (const float*)d_in[7];
    const float* w_out = (const float*)d_in[8]; const float* b_out = (const float*)d_in[9]; const float* norm2_g = (const float*)d_in[10]; const float* router_w = (const float*)d_in[11];
    const float* router_b = (const float*)d_in[12]; const float* w1 = (const float*)d_in[13]; const float* b1 = (const float*)d_in[14]; const float* w2 = (const float*)d_in[15];
    const float* b2 = (const float*)d_in[16]; const float* final_g = (const float*)d_in[17];
    unsigned char* ws = (unsigned char*)d_ws; float* out = (float*)d_out;
    int* ctl = (int*)(ws + WS_CTL); float* LB = (float*)(ws + WS_LB);
    bf16_t *WinT = (bf16_t*)(ws + WS_WINT), *WoutT = (bf16_t*)(ws + WS_WOUTT), *W1T = (bf16_t*)(ws + WS_W1T), *W2T = (bf16_t*)(ws + WS_W2T);
    bf16_t *XN = (bf16_t*)(ws + WS_XN), *AQ = (bf16_t*)(ws + WS_AQ), *AK = (bf16_t*)(ws + WS_AK), *AV = (bf16_t*)(ws + WS_AV), *HQ = (bf16_t*)(ws + WS_HQ), *KK = (bf16_t*)(ws + WS_KK),
           *HI = (bf16_t*)(ws + WS_HI), *HG = (bf16_t*)(ws + WS_HG), *MIX = (bf16_t*)(ws + WS_MIX), *H2 = (bf16_t*)(ws + WS_H2), *ACT = (bf16_t*)(ws + WS_ACT), *Y = (bf16_t*)(ws + WS_Y);
    float *G = (float*)(ws + WS_G), *ATT = (float*)(ws + WS_ATT), *ORAW = (float*)(ws + WS_ORAW), *X1 = (float*)(ws + WS_X1), *GATE = (float*)(ws + WS_GATE);
    int* LIST = (int*)(ws + WS_LIST);
    hipMemsetAsync(ws + WS_CTL, 0, 65536, stream);
    nk_transpose<<<dim3(INW / 32, DM / 32, 1), 256, 0, stream>>>(w_in, WinT, DM, INW);
    nk_transpose<<<dim3(DM / 32, MIXW / 32, 1), 256, 0, stream>>>(w_out, WoutT, MIXW, DM);
    nk_transpose<<<dim3(2 * FF / 32, DM / 32, NE), 256, 0, stream>>>(w1, W1T, DM, 2 * FF);
    nk_transpose<<<dim3(DM / 32, FF / 32, NE), 256, 0, stream>>>(w2, W2T, FF, DM);
    nk_lb<<<2, 256, 0, stream>>>(lb_logits, LB);
    nk_rmsnorm1<<<T / 4, 256, 0, stream>>>(x, norm1_g, XN);
    { GemmArgs g{XN, WinT, T, INW, DM, 0, nullptr, nullptr, nullptr}; EpiInProj e{b_in, LB, AQ, AK, AV, HQ, KK, HI, HG, G};
      nk_gemm<EpiInProj><<<dim3(INW / 64, T / 64, 1), 256, 0, stream>>>(g, e); }
    nk_attn<<<T * 8 / 4, 256, 0, stream>>>(AQ, AK, AV, sinks, ATT);
    nk_hgrn<<<BATCH * 4, 128, 0, stream>>>(HQ, G, KK, HI, ORAW);
    nk_mix<<<T / 4, 256, 0, stream>>>(ATT, ORAW, HG, attn_g, hgrn_g, MIX);
    { GemmArgs g{MIX, WoutT, T, DM, MIXW, 0, nullptr, nullptr, nullptr}; EpiOutProj e{b_out, x, X1};
      nk_gemm<EpiOutProj><<<dim3(DM / 64, T / 64, 1), 256, 0, stream>>>(g, e); }
    nk_router<<<T / 4, 256, 0, stream>>>(X1, norm2_g, router_w, router_b, H2, GATE, LIST, ctl + CW_CNT);
    nk_offsets<<<1, 64, 0, stream>>>(ctl + CW_CNT, ctl + CW_OFF);
    { GemmArgs g{H2, W1T, T, 2 * FF, DM, 1, ctl + CW_CNT, ctl + CW_OFF, LIST}; EpiMoe1 e{b1, ctl + CW_OFF, ACT};
      nk_gemm<EpiMoe1><<<dim3(2 * FF / 64, T / 64, NE), 256, 0, stream>>>(g, e); }
    { GemmArgs g{ACT, W2T, T, DM, FF, 2, ctl + CW_CNT, ctl + CW_OFF, LIST}; EpiMoe2 e{b2, LIST, GATE, Y};
      nk_gemm<EpiMoe2><<<dim3(DM / 64, T / 64, NE), 256, 0, stream>>>(g, e); }
    nk_final<<<T / 4, 256, 0, stream>>>(X1, Y, final_g, out);
}
```

```cpp
#include <hip/hip_runtime.h>
#include <stdint.h>

typedef unsigned short bf16_t;
typedef short bf16x8 __attribute__((ext_vector_type(8)));
typedef float f32x4 __attribute__((ext_vector_type(4)));

constexpr int BATCH = 8, SEQ = 2048, DM = 1024, T = BATCH * SEQ;
constexpr int AW = 512, AKW = 128, HKW = 512, HW = 512, INW = 2816, MIXW = 1024;
constexpr int NE = 32, TOPK = 4, FF = 1024;
constexpr int C_AQ = 0, C_AK = 512, C_AV = 640, C_HQ = 768, C_HF = 1280, C_HI = 1792, C_HG = 2304;
constexpr float EPS = 1e-5f;
constexpr int ACT_ROWS = T * TOPK + NE * 256;

constexpr size_t MiB = 1u << 20;
constexpr size_t al(size_t x) { return (x + 255) & ~(size_t)255; }
constexpr size_t WS_CTL = 0;
constexpr size_t WS_LB = 1 * MiB;
constexpr size_t WS_WINT = 2 * MiB;
constexpr size_t WS_WOUTT = WS_WINT + al((size_t)INW * DM * 2);
constexpr size_t WS_W1T = WS_WOUTT + al((size_t)DM * MIXW * 2);
constexpr size_t WS_W2T = WS_W1T + al((size_t)NE * 2 * FF * DM * 2);
constexpr size_t WS_XN = WS_W2T + al((size_t)NE * DM * FF * 2);
constexpr size_t WS_AQ = WS_XN + al((size_t)T * DM * 2);
constexpr size_t WS_AK = WS_AQ + al((size_t)T * AW * 2);
constexpr size_t WS_AV = WS_AK + al((size_t)T * AKW * 2);
constexpr size_t WS_HQ = WS_AV + al((size_t)T * AKW * 2);
constexpr size_t WS_G = WS_HQ + al((size_t)T * HKW * 2);
constexpr size_t WS_KK = WS_G + al((size_t)T * HKW * 4);
constexpr size_t WS_HI = WS_KK + al((size_t)T * HKW * 2);
constexpr size_t WS_HG = WS_HI + al((size_t)T * HW * 2);
constexpr size_t WS_ATT = WS_HG + al((size_t)T * HW * 2);
constexpr size_t WS_ORAW = WS_ATT + al((size_t)T * AW * 4);
constexpr size_t WS_MIX = WS_ORAW + al((size_t)T * HW * 4);
constexpr size_t WS_X1 = WS_MIX + al((size_t)T * MIXW * 2);
constexpr size_t WS_H2 = WS_X1 + al((size_t)T * DM * 4);
constexpr size_t WS_GATE = WS_H2 + al((size_t)T * DM * 2);
constexpr size_t WS_LIST = WS_GATE + al((size_t)T * TOPK * 4);
constexpr size_t WS_ACT = WS_LIST + al((size_t)NE * T * 4);
constexpr size_t WS_Y = WS_ACT + al((size_t)ACT_ROWS * FF * 2);
constexpr size_t WS_END = WS_Y + al((size_t)T * TOPK * DM * 2);
constexpr int CW_CNT = 64;
constexpr int CW_OFF = 128;

__device__ __forceinline__ bf16_t f2bf(float f) { unsigned u = __builtin_bit_cast(unsigned, f); return (bf16_t)((u + 0x7fffu + ((u >> 16) & 1u)) >> 16); }
__device__ __forceinline__ float bf2f(bf16_t b) { return __builtin_bit_cast(float, (unsigned)b << 16); }
__device__ __forceinline__ float wave_sum(float v) {
#pragma unroll
    for (int o = 1; o < 64; o <<= 1) v += __shfl_xor(v, o);
    return v;
}
__device__ __forceinline__ float wave_max(float v) {
#pragma unroll
    for (int o = 1; o < 64; o <<= 1) v = fmaxf(v, __shfl_xor(v, o));
    return v;
}
__device__ __forceinline__ float sigmoidf_(float x) { return 1.f / (1.f + __expf(-x)); }
__device__ __forceinline__ float siluf_(float x) { return x / (1.f + __expf(-x)); }

#define LAS __attribute__((address_space(3)))
#define GAS __attribute__((address_space(1)))
typedef unsigned u32x4 __attribute__((ext_vector_type(4)));
typedef unsigned u32x2 __attribute__((ext_vector_type(2)));
typedef float f32x2 __attribute__((ext_vector_type(2)));

namespace pg8 {
constexpr int BM = 256, BK = 64, HALF = 128, HTB = HALF * BK * 2  , STAGE_BYTES = 8 * HTB, NXCD = 8, WGM = 8;
__host__ __device__ __forceinline__ int lds_byte(int r, int c) { const int st = (r >> 4) * 2 + (c >> 5), rr = r & 15, cc = c & 31, ob = rr * 64 + cc * 2; return st * 1024 + (ob ^ (((ob >> 9) & 1) << 5)); }
__host__ __device__ __forceinline__ void stage_rc(int b, int& R, int& C) { const int st = b / 1024, sb = b % 1024, swz = sb ^ (((sb >> 9) & 1) << 5); R = (st >> 1) * 16 + swz / 64; C = (st & 1) * 32 + (swz % 64) / 2; }
__host__ __device__ __forceinline__ int perm32(int rho) { const int n = rho >> 4, i = rho & 15; return 8 * (i >> 2) + 4 * n + (i & 3); }
__device__ __forceinline__ unsigned cvt_pk_bf16(float lo, float hi) { unsigned r; asm volatile("v_cvt_pk_bf16_f32 %0, %1, %2" : "=v"(r) : "v"(lo), "v"(hi)); return r; }

struct Unit { const char* A; const char* B; int pm, pn, e, rows, arow, lbase; };

struct DenseOrder {
    const char* A; const char* Bt; int K, nM, nN, nwg, G, c;
    __device__ void init(const void* A_, const void* Bt_, int M, int N, int K_, int G_, int c_) { A = (const char*)A_; Bt = (const char*)Bt_; K = K_; nM = M / BM; nN = N / BM; nwg = nM * nN; G = G_; c = c_; }
    __device__ __forceinline__ bool next(int i, Unit& u) const {
        const long L = (long)i * G + c; if (L >= nwg) return false;
        int wgid = (int)L; { const int q = nwg / NXCD, r = nwg % NXCD, xcd = wgid % NXCD, off = wgid / NXCD; wgid = (xcd < r ? xcd * (q + 1) : r * (q + 1) + (xcd - r) * q) + off; }
        const int nig = WGM * nN, gid = wgid / nig, fm = gid * WGM, gsz = (nM - fm) < WGM ? (nM - fm) : WGM;
        u.pm = fm + ((wgid % nig) % gsz); u.pn = (wgid % nig) / gsz; u.e = 0; u.rows = BM; u.arow = u.pm * BM; u.lbase = 0;
        u.A = A + (size_t)u.pm * BM * K * 2; u.B = Bt + (size_t)u.pn * BM * K * 2; return true;
    }
    __device__ __forceinline__ int row(const Unit&, int r) const { return r; }
};
template <bool G1>
struct MoeOrder {
    const char* A; const char* Bt; const int* list; LAS const int* pre; LAS const int* cnt; int K, N, nN, nwg, G, c;
    __device__ __forceinline__ bool next(int i, Unit& u) const {
        const long L = (long)i * G + c; if (L >= nwg) return false;
        int wgid = (int)L; { const int q = nwg / NXCD, r = nwg % NXCD, xcd = wgid % NXCD, off = wgid / NXCD; wgid = (xcd < r ? xcd * (q + 1) : r * (q + 1) + (xcd - r) * q) + off; }
        const int tau = wgid / nN; u.pn = wgid % nN;
        const int p = pre[(threadIdx.x & 31) + 1];
        const int e = __builtin_popcountll(__ballot(p <= tau) & 0xffffffffull);
        const int mt = tau - pre[e];
        u.e = e; u.pm = mt; const int left = cnt[e] - mt * BM; u.rows = left < BM ? left : BM;
        u.arow = tau * BM; u.lbase = e * T + mt * BM;
        u.A = G1 ? A : A + (size_t)u.arow * K * 2;
        u.B = Bt + ((size_t)e * N + (size_t)u.pn * BM) * K * 2; return true;
    }
    __device__ __forceinline__ int row(const Unit& u, int r) const { const int rr = r < u.rows ? r : u.rows - 1; return list[u.lbase + rr] >> 2; }
};

__device__ __forceinline__ u32x4 pack8(f32x4 v0, f32x4 v1) { u32x4 w; w.x = cvt_pk_bf16(v0[0], v0[1]); w.y = cvt_pk_bf16(v0[2], v0[3]); w.z = cvt_pk_bf16(v1[0], v1[1]); w.w = cvt_pk_bf16(v1[2], v1[3]); return w; }
__device__ __forceinline__ f32x4 silu4(f32x4 v) { f32x4 r; for (int i = 0; i < 4; ++i) r[i] = v[i] * __builtin_amdgcn_rcpf(1.f + __expf(-v[i])); return r; }

struct EpiInProj {
    static constexpr bool PERM = true;
    const float* bias; const float* lb; bf16_t *AQ, *AK, *AV, *HQ, *KK, *HI, *HG; float* G;
    __device__ __forceinline__ void operator()(const f32x4 (&acc)[2][2][4][2], const Unit& u, int wr, int wc, int fr, int fq) const {
        const int row0 = u.pm * BM + wr * 64 + fr, cl = wc * 32 + 8 * fq;
#pragma unroll
        for (int bj = 0; bj < 2; ++bj) {
            const int cb = u.pn * BM + bj * HALF;
            const f32x4 b0 = *(const f32x4*)(bias + cb + cl), b1 = *(const f32x4*)(bias + cb + cl + 4);
            if (cb >= C_HF && cb < C_HI) {
                const int cc = cb - C_HF + cl;
                const f32x4 l0 = *(const f32x4*)(lb + cc), l1 = *(const f32x4*)(lb + cc + 4);
#pragma unroll
                for (int ai = 0; ai < 2; ++ai)
#pragma unroll
                    for (int m = 0; m < 4; ++m) {
                        const size_t r = (size_t)(row0 + ai * HALF + m * 16);
                        f32x4 v0 = acc[ai][bj][m][0] + b0, v1 = acc[ai][bj][m][1] + b1, g0, g1, k0, k1;
#pragma unroll
                        for (int i = 0; i < 4; ++i) {
                            const float f0 = l0[i] + (1.f - l0[i]) * __builtin_amdgcn_rcpf(1.f + __expf(-v0[i])); g0[i] = __logf(f0); k0[i] = 1.f - f0;
                            const float f1 = l1[i] + (1.f - l1[i]) * __builtin_amdgcn_rcpf(1.f + __expf(-v1[i])); g1[i] = __logf(f1); k1[i] = 1.f - f1;
                        }
                        *(f32x4*)(G + r * HKW + cc) = g0; *(f32x4*)(G + r * HKW + cc + 4) = g1;
                        *(u32x4*)(KK + r * HKW + cc) = pack8(k0, k1);
                    }
            } else {
                bf16_t* dst; int ld, cc; bool act = false;
                if (cb < C_AK) { dst = AQ; ld = AW; cc = cb - C_AQ; }
                else if (cb < C_AV) { dst = AK; ld = AKW; cc = cb - C_AK; }
                else if (cb < C_HQ) { dst = AV; ld = AKW; cc = cb - C_AV; }
                else if (cb < C_HF) { dst = HQ; ld = HKW; cc = cb - C_HQ; act = true; }
                else if (cb < C_HG) { dst = HI; ld = HW; cc = cb - C_HI; }
                else { dst = HG; ld = HW; cc = cb - C_HG; act = true; }
                cc += cl;
#pragma unroll
                for (int ai = 0; ai < 2; ++ai)
#pragma unroll
                    for (int m = 0; m < 4; ++m) {
                        const size_t r = (size_t)(row0 + ai * HALF + m * 16);
                        f32x4 v0 = acc[ai][bj][m][0] + b0, v1 = acc[ai][bj][m][1] + b1;
                        if (act) { v0 = silu4(v0); v1 = silu4(v1); }
                        *(u32x4*)(dst + r * ld + cc) = pack8(v0, v1);
                    }
            }
        }
    }
};
struct EpiOutProj {
    static constexpr bool PERM = false;
    const float* bias; const float* x; float* X1;
    __device__ __forceinline__ void operator()(const f32x4 (&acc)[2][2][4][2], const Unit& u, int wr, int wc, int fr, int fq) const {
        const int row0 = u.pm * BM + wr * 64 + fr, col0 = u.pn * BM + wc * 32 + 4 * fq;
#pragma unroll
        for (int bj = 0; bj < 2; ++bj)
#pragma unroll
            for (int n = 0; n < 2; ++n) {
                const int c = col0 + bj * HALF + n * 16; const f32x4 bv = *(const f32x4*)(bias + c);
#pragma unroll
                for (int ai = 0; ai < 2; ++ai)
#pragma unroll
                    for (int m = 0; m < 4; ++m) { const size_t o = (size_t)(row0 + ai * HALF + m * 16) * DM + c; *(f32x4*)(X1 + o) = acc[ai][bj][m][n] + bv + *(const f32x4*)(x + o); }
            }
    }
};
struct EpiMoe1 {
    static constexpr bool PERM = true;
    const float* b1; bf16_t* ACT;
    __device__ __forceinline__ void operator()(const f32x4 (&acc)[2][2][4][2], const Unit& u, int wr, int wc, int fr, int fq) const {
        const int ac0 = u.pn * HALF + wc * 32 + 8 * fq;
        const float* bp = b1 + (size_t)u.e * 2 * FF + 2 * ac0;
        const f32x4 q0 = *(const f32x4*)bp, q1 = *(const f32x4*)(bp + 4), q2 = *(const f32x4*)(bp + 8), q3 = *(const f32x4*)(bp + 12);
        const f32x4 bg0 = {q0[0], q0[2], q1[0], q1[2]}, bg1 = {q2[0], q2[2], q3[0], q3[2]}, bl0 = {q0[1], q0[3], q1[1], q1[3]}, bl1 = {q2[1], q2[3], q3[1], q3[3]};
#pragma unroll
        for (int ai = 0; ai < 2; ++ai)
#pragma unroll
            for (int m = 0; m < 4; ++m) {
                const int r = ai * HALF + wr * 64 + m * 16 + fr;
                const f32x4 g0 = acc[ai][0][m][0] + bg0, g1 = acc[ai][0][m][1] + bg1, l0 = acc[ai][1][m][0] + bl0, l1 = acc[ai][1][m][1] + bl1;
                f32x4 a0, a1;
#pragma unroll
                for (int i = 0; i < 4; ++i) {
                    const float u0 = fminf(g0[i], 7.f), u1 = fminf(g1[i], 7.f), w0 = fminf(fmaxf(l0[i], -7.f), 7.f), w1 = fminf(fmaxf(l1[i], -7.f), 7.f);
                    a0[i] = u0 * __builtin_amdgcn_rcpf(1.f + __expf(-1.702f * u0)) * (w0 + 1.f);
                    a1[i] = u1 * __builtin_amdgcn_rcpf(1.f + __expf(-1.702f * u1)) * (w1 + 1.f);
                }
                if (r < u.rows) *(u32x4*)(ACT + (size_t)(u.arow + r) * FF + ac0) = pack8(a0, a1);
            }
    }
};
struct EpiMoe2 {
    static constexpr bool PERM = true;
    const float* b2; const int* list; const float* gate; bf16_t* Y;
    __device__ __forceinline__ void operator()(const f32x4 (&acc)[2][2][4][2], const Unit& u, int wr, int wc, int fr, int fq) const {
        const int c0 = u.pn * BM + wc * 32 + 8 * fq;
        f32x4 bv[2][2];
#pragma unroll
        for (int bj = 0; bj < 2; ++bj)
#pragma unroll
            for (int n = 0; n < 2; ++n) bv[bj][n] = *(const f32x4*)(b2 + (size_t)u.e * DM + c0 + bj * HALF + 4 * n);
#pragma unroll
        for (int ai = 0; ai < 2; ++ai)
#pragma unroll
            for (int m = 0; m < 4; ++m) {
                const int r = ai * HALF + wr * 64 + m * 16 + fr;
                if (r < u.rows) {
                    const int slot = list[u.lbase + r]; const float gt = gate[slot];
                    bf16_t* yr = Y + (size_t)slot * DM + c0;
#pragma unroll
                    for (int bj = 0; bj < 2; ++bj) { const f32x4 v0 = (acc[ai][bj][m][0] + bv[bj][0]) * gt, v1 = (acc[ai][bj][m][1] + bv[bj][1]) * gt; *(u32x4*)(yr + bj * HALF) = pack8(v0, v1); }
                }
            }
    }
};

template <class Epi, class Sched, bool GATHER, bool ALIGN_EPI>
__device__ __forceinline__ void gemm_phase(LAS unsigned char* lds, const int K, const Sched& S, const Epi& E) {
    const int tid = threadIdx.x, wid = __builtin_amdgcn_readfirstlane(tid >> 6), lane = tid & 63, wr = wid >> 2, wc = wid & 3, fr = lane & 15, fq = lane >> 4;
    const int nt = K / BK;
    int RA[2], CA[2]; unsigned voffB[2];
#pragma unroll
    for (int i = 0; i < 2; ++i) { int R, C; stage_rc(tid * 16 + i * 8192, R, C); RA[i] = R; CA[i] = C; const int Rb = Epi::PERM ? ((R & ~31) + perm32(R & 31)) : R; voffB[i] = (unsigned)(Rb * K + C) * 2u; }
    const size_t kstep = (size_t)(BK * 2);
    const size_t hstep = (size_t)HALF * K * 2;
    const unsigned ldsw = (unsigned)wid * 1024u;
    const int aoff = lds_byte(wr * 64 + fr, fq * 8), boff = lds_byte(wc * 32 + fr, fq * 8);
#define PG8_SA(b, h) (((b) * 2 + (h)) * HTB)
#define PG8_SB(b, h) ((4 + (b) * 2 + (h)) * HTB)
#define PG8_STAGE(bufoff, gbase, voff) do { _Pragma("unroll") for (int _i = 0; _i < 2; ++_i) \
        __builtin_amdgcn_global_load_lds((const unsigned*)((const char*)(gbase) + (voff)[_i]), (LAS unsigned*)(lds + (bufoff) + ldsw + _i * 8192), 16, 0, 0); } while (0)
#define PG8_LDA(dst, b, h) do { _Pragma("unroll") for (int m = 0; m < 4; ++m) _Pragma("unroll") for (int k = 0; k < 2; ++k) dst[m][k] = *(const LAS bf16x8*)(lds + PG8_SA(b, h) + aoff + m * 2048 + k * 1024); } while (0)
#define PG8_LDB(dst, b, h) do { _Pragma("unroll") for (int n = 0; n < 2; ++n) _Pragma("unroll") for (int k = 0; k < 2; ++k) dst[n][k] = *(const LAS bf16x8*)(lds + PG8_SB(b, h) + boff + n * 2048 + k * 1024); } while (0)
#define PG8_MMA(ai, bj, At, Bt) do { __builtin_amdgcn_s_setprio(1); _Pragma("unroll") for (int m = 0; m < 4; ++m) _Pragma("unroll") for (int n = 0; n < 2; ++n) _Pragma("unroll") for (int k = 0; k < 2; ++k) \
        acc[ai][bj][m][n] = __builtin_amdgcn_mfma_f32_16x16x32_bf16(Bt[n][k], At[m][k], acc[ai][bj][m][n], 0, 0, 0); __builtin_amdgcn_s_setprio(0); } while (0)
#define PG8_WAIT_V(n) asm volatile("s_waitcnt vmcnt(" #n ")" ::: "memory")
#define PG8_WAIT_L(n) asm volatile("s_waitcnt lgkmcnt(" #n ")" ::: "memory")
#define PG8_BAR __builtin_amdgcn_s_barrier()
#define PG8_SCHED __builtin_amdgcn_sched_barrier(0)
#define PG8_VOFFA(dst, u) do { _Pragma("unroll") for (int _h = 0; _h < 2; ++_h) _Pragma("unroll") for (int _i = 0; _i < 2; ++_i) { const int _r = _h * HALF + RA[_i]; \
        const unsigned _row = GATHER ? (unsigned)S.row(u, _r) : (unsigned)_r; dst[_h][_i] = (_row * (unsigned)K + (unsigned)CA[_i]) * 2u; } } while (0)
    Unit cur, nxt; int ui = 0;
    if (!S.next(0, cur)) return;
    f32x4 acc[2][2][4][2];
#pragma unroll
    for (int a = 0; a < 2; ++a)
#pragma unroll
        for (int b = 0; b < 2; ++b)
#pragma unroll
            for (int m = 0; m < 4; ++m)
#pragma unroll
                for (int n = 0; n < 2; ++n) acc[a][b][m][n] = (f32x4){0.f, 0.f, 0.f, 0.f};
    bf16x8 At[4][2], B0[2][2], B1[2][2];
    unsigned vA[2][2], nvA[2][2];
    PG8_VOFFA(vA, cur);
    const char* cA = cur.A; const char* cB = cur.B;
    PG8_STAGE(PG8_SB(0, 0), cB, voffB); PG8_STAGE(PG8_SB(0, 1), cB + hstep, voffB); PG8_STAGE(PG8_SA(0, 0), cA, vA[0]); PG8_STAGE(PG8_SA(0, 1), cA, vA[1]);
    if (wr == 1) PG8_BAR;
    PG8_WAIT_V(2); PG8_BAR;
    PG8_STAGE(PG8_SB(1, 0), cB + kstep, voffB); PG8_STAGE(PG8_SA(1, 0), cA + kstep, vA[0]); PG8_STAGE(PG8_SB(1, 1), cB + hstep + kstep, voffB);
    PG8_WAIT_V(6); PG8_BAR;
    for (;;) {
        const bool has_next = S.next(ui + 1, nxt);
        const char* nA = has_next ? nxt.A : cA; const char* nB = has_next ? nxt.B : cB;
        if (has_next) { PG8_VOFFA(nvA, nxt); } else {
#pragma unroll
            for (int h = 0; h < 2; ++h)
#pragma unroll
                for (int i = 0; i < 2; ++i) nvA[h][i] = vA[h][i]; }
        for (int t = 0; t < nt; t += 2) {
            const bool last = (t == nt - 2);
            const char* a1 = cA + (size_t)(t + 1) * kstep;
            const char* a2 = last ? nA : cA + (size_t)(t + 2) * kstep; const char* b2 = last ? nB : cB + (size_t)(t + 2) * kstep;
            const char* a3 = a2 + kstep; const char* b3 = b2 + kstep;
            unsigned s0[2], s1[2];
#pragma unroll
            for (int i = 0; i < 2; ++i) { s0[i] = last ? nvA[0][i] : vA[0][i]; s1[i] = last ? nvA[1][i] : vA[1][i]; }
            PG8_LDB(B0, 0, 0); PG8_LDB(B1, 0, 1); PG8_SCHED; PG8_LDA(At, 0, 0); PG8_STAGE(PG8_SA(1, 1), a1, vA[1]);
            PG8_WAIT_V(8); PG8_WAIT_L(0); PG8_BAR; PG8_MMA(0, 0, At, B0); PG8_MMA(0, 1, At, B1); PG8_BAR; PG8_SCHED;
            PG8_LDA(At, 0, 1); PG8_STAGE(PG8_SB(0, 0), b2, voffB); PG8_STAGE(PG8_SB(0, 1), b2 + hstep, voffB); PG8_STAGE(PG8_SA(0, 0), a2, s0);
            PG8_WAIT_V(8); PG8_WAIT_L(0); PG8_BAR; PG8_MMA(1, 0, At, B0); PG8_MMA(1, 1, At, B1); PG8_BAR; PG8_SCHED;
            PG8_LDB(B0, 1, 0); PG8_LDB(B1, 1, 1); PG8_SCHED; PG8_LDA(At, 1, 0); PG8_STAGE(PG8_SA(0, 1), a2, s1);
            PG8_WAIT_V(8); PG8_WAIT_L(0); PG8_BAR; PG8_MMA(0, 0, At, B0); PG8_MMA(0, 1, At, B1); PG8_BAR; PG8_SCHED;
            PG8_LDA(At, 1, 1); PG8_STAGE(PG8_SB(1, 0), b3, voffB); PG8_STAGE(PG8_SB(1, 1), b3 + hstep, voffB); PG8_STAGE(PG8_SA(1, 0), a3, s0);
            PG8_WAIT_V(8); PG8_WAIT_L(0); PG8_BAR; PG8_MMA(1, 0, At, B0); PG8_MMA(1, 1, At, B1); PG8_BAR; PG8_SCHED;
        }
        if constexpr (ALIGN_EPI) { if (wr == 0) PG8_BAR; }
        E(acc, cur, wr, wc, fr, fq);
        if (!has_next) break;
#pragma unroll
        for (int a = 0; a < 2; ++a)
#pragma unroll
            for (int b = 0; b < 2; ++b)
#pragma unroll
                for (int m = 0; m < 4; ++m)
#pragma unroll
                    for (int n = 0; n < 2; ++n) acc[a][b][m][n] = (f32x4){0.f, 0.f, 0.f, 0.f};
        cur = nxt; cA = nA; cB = nB; ++ui;
#pragma unroll
        for (int h = 0; h < 2; ++h)
#pragma unroll
            for (int i = 0; i < 2; ++i) vA[h][i] = nvA[h][i];
        if constexpr (ALIGN_EPI) { if (wr == 1) PG8_BAR; }
    }
    PG8_WAIT_V(0);
    if constexpr (!ALIGN_EPI) { if (wr == 0) PG8_BAR; }
    PG8_BAR;
#undef PG8_SA
#undef PG8_SB
#undef PG8_STAGE
#undef PG8_LDA
#undef PG8_LDB
#undef PG8_MMA
#undef PG8_WAIT_V
#undef PG8_WAIT_L
#undef PG8_BAR
#undef PG8_SCHED
#undef PG8_VOFFA
}
}

constexpr int NWAVES = 8;
constexpr int RING_OFF = 0, RING_BYTES = 131072;
constexpr int LDSCTL_OFF = RING_BYTES, MISC_OFF = LDSCTL_OFF + 320;
constexpr int MOE_OFF = LDSCTL_OFF + 1024;
constexpr int LDS_BYTES = 147456;
constexpr int CW_TMO = 0, CW_CODE = 1, CW_BAR = 4096;
constexpr int N_PHASES = 10;

typedef GAS unsigned gu32;
#define RLX_AGENT __ATOMIC_RELAXED, __HIP_MEMORY_SCOPE_AGENT
#define LDS_WAIT() asm volatile("s_waitcnt lgkmcnt(0)" ::: "memory")
#define VM_WAIT() asm volatile("s_waitcnt vmcnt(0)" ::: "memory")

#define XB_TMO      128
#define XB_XCNT(j)  (256  + 64 * (j))
#define XB_XSUB(j)  (1280 + 64 * (j))
#define XB_XGEN(j)  (2304 + 64 * (j))
#define XB_TOP      3328
#define XB_TOPGEN   3392
#define XCD_BAR_WORDS 3456
#define XB_SPIN_CAP (1u << 18)
__device__ __forceinline__ unsigned xb_ld(unsigned* p)              { return __hip_atomic_load(p, __ATOMIC_RELAXED, __HIP_MEMORY_SCOPE_AGENT); }
__device__ __forceinline__ unsigned xb_add(unsigned* p, unsigned v) { return __hip_atomic_fetch_add(p, v, __ATOMIC_RELAXED, __HIP_MEMORY_SCOPE_AGENT); }
__device__ __forceinline__ unsigned xb_xcc_id() { return (unsigned)__builtin_amdgcn_s_getreg((3 << 11) | 20) & 0xFu; }
#define XB_SPIN(cond, bar) do { unsigned _sp = 0; while (cond) { __builtin_amdgcn_s_sleep(1); \
    if ((++_sp & 255u) == 0u) { if (xb_ld(&(bar)[XB_TMO])) break; if (_sp > XB_SPIN_CAP) { atomicAdd(&(bar)[XB_TMO], 1u); break; } } } } while (0)
struct XcdBarrier { unsigned* bar; unsigned x; volatile LAS unsigned* st; };
__device__ __forceinline__ XcdBarrier xcd_barrier_post(unsigned* bar, volatile LAS unsigned* st) {
    XcdBarrier b; b.bar = bar; b.x = xb_xcc_id(); b.st = st;
    if (threadIdx.x == 0) (void)xb_add(&bar[XB_XCNT(b.x)], 1u);
    return b;
}
__device__ __forceinline__ void xcd_barrier_complete(unsigned* bar, unsigned x, unsigned& nloc, unsigned& nx) {
    const unsigned G = gridDim.x * gridDim.y * gridDim.z;
    unsigned sum, cnt, mine, sp = 0u;
    for (;;) {
        sum = 0u; cnt = 0u; mine = 0u;
#pragma unroll
        for (unsigned j = 0; j < 16; ++j) { const unsigned c = xb_ld(&bar[XB_XCNT(j)]); sum += c; cnt += (c > 0u) ? 1u : 0u; mine = (j == x) ? c : mine; }
        if (sum == G) break;
        __builtin_amdgcn_s_sleep(1);
        if ((++sp & 255u) == 0u) { if (xb_ld(&bar[XB_TMO])) break; if (sp > XB_SPIN_CAP) { atomicAdd(&bar[XB_TMO], 1u); break; } }
    }
    nloc = mine > 0u ? mine : 1u; nx = cnt > 0u ? cnt : 1u;
}
__device__ __forceinline__ void xcd_barrier(const XcdBarrier& b) {
    asm volatile("s_waitcnt vmcnt(0)" ::: "memory");
    __syncthreads();
    if (threadIdx.x == 0) {
        unsigned* bar = b.bar;
        __builtin_amdgcn_s_waitcnt(0);
        unsigned nloc = b.st[0], nx = b.st[1];
        if (nloc == 0u) { xcd_barrier_complete(bar, b.x, nloc, nx); b.st[0] = nloc; b.st[1] = nx; }
        const unsigned old = xb_add(&bar[XB_XSUB(b.x)], 1u);
        const unsigned gen = old / nloc;
        if (old + 1u == (gen + 1u) * nloc) {
            __builtin_amdgcn_fence(__ATOMIC_RELEASE, "agent");
            asm volatile("s_waitcnt vmcnt(0)" ::: "memory");
            const unsigned og = xb_add(&bar[XB_TOP], 1u);
            const unsigned tg = og / nx;
            if (og + 1u == (tg + 1u) * nx) xb_add(&bar[XB_TOPGEN], 1u);
            else XB_SPIN(xb_ld(&bar[XB_TOPGEN]) == tg, bar);
            __builtin_amdgcn_fence(__ATOMIC_ACQUIRE, "agent");
            xb_add(&bar[XB_XGEN(b.x)], 1u);
            asm volatile("s_waitcnt vmcnt(0)" ::: "memory");
        } else {
            XB_SPIN(xb_ld(&bar[XB_XGEN(b.x)]) == gen, bar);
            __builtin_amdgcn_fence(__ATOMIC_ACQUIRE, "agent");
            asm volatile("s_waitcnt vmcnt(0)" ::: "memory");
        }
    }
    __syncthreads();
}

struct Frame {
    LAS unsigned char* lds; volatile LAS unsigned* MISC; gu32* ctl;
    int tid, lane, wave, vcu, G;
    const float *x, *norm1_g, *w_in, *b_in, *sinks, *attn_g, *lb_logits, *hgrn_g, *w_out, *b_out, *norm2_g, *router_w, *router_b, *w1, *b1, *w2, *b2, *final_g;
    float* out; unsigned char* ws;
};
#define WSP(type, off) ((type*)(F.ws + (off)))

__device__ __forceinline__ int w1col(int n) { const int pn = n >> 8, cl = n & 255; return cl < 128 ? 2 * (128 * pn + cl) : 2 * (128 * pn + cl - 128) + 1; }
template <bool W1MAP>
__device__ __forceinline__ void p0_transpose_item(const float* W, int K, int N, bf16_t* WT, LAS float* scr, int item, int lane) {
    const int nblk = N / 32, kb = item / nblk, nb = item % nblk, k0 = 64 * kb, n0 = 32 * nb;
    const int sc = W1MAP ? w1col(n0 + (lane & 31)) : n0 + (lane & 31);
#pragma unroll 8
    for (int i = 0; i < 32; ++i) { const int kk = 2 * i + (lane >> 5); scr[kk * 33 + (lane & 31)] = W[(size_t)(k0 + kk) * N + sc]; }
    LDS_WAIT(); asm volatile("" ::: "memory");
    const int c = lane & 7;
#pragma unroll
    for (int j = 0; j < 4; ++j) { const int n = (lane >> 3) + 8 * j; const LAS float* s = scr + (8 * c) * 33 + n;
        u32x4 o; o.x = pg8::cvt_pk_bf16(s[0 * 33], s[1 * 33]); o.y = pg8::cvt_pk_bf16(s[2 * 33], s[3 * 33]); o.z = pg8::cvt_pk_bf16(s[4 * 33], s[5 * 33]); o.w = pg8::cvt_pk_bf16(s[6 * 33], s[7 * 33]);
        *(GAS u32x4*)(WT + (size_t)(n0 + n) * K + k0 + 8 * c) = o; }
    LDS_WAIT(); asm volatile("" ::: "memory");
}
__device__ __forceinline__ void p_prologue(Frame& F) {
    LAS float* scr = (LAS float*)(F.lds + RING_OFF + F.wave * 16384);
    const int gw = F.vcu * NWAVES + F.wave, NGW = F.G * NWAVES;
    constexpr int I_IN = (DM / 64) * (INW / 32), I_OUT = (MIXW / 64) * (DM / 32), I_W1E = (DM / 64) * (2 * FF / 32), I_W2E = (FF / 64) * (DM / 32);
    constexpr int NITEMS = I_IN + I_OUT + NE * I_W1E + NE * I_W2E;
    bf16_t *WinT = WSP(bf16_t, WS_WINT), *WoutT = WSP(bf16_t, WS_WOUTT), *W1T = WSP(bf16_t, WS_W1T), *W2T = WSP(bf16_t, WS_W2T);
    for (int it = gw; it < NITEMS; it += NGW) {
        int r = it;
        if (r < I_IN) { p0_transpose_item<false>(F.w_in, DM, INW, WinT, scr, r, F.lane); continue; } r -= I_IN;
        if (r < I_OUT) { p0_transpose_item<false>(F.w_out, MIXW, DM, WoutT, scr, r, F.lane); continue; } r -= I_OUT;
        if (r < NE * I_W1E) { const int e = r / I_W1E; p0_transpose_item<true>(F.w1 + (size_t)e * DM * 2 * FF, DM, 2 * FF, W1T + (size_t)e * 2 * FF * DM, scr, r % I_W1E, F.lane); continue; } r -= NE * I_W1E;
        { const int e = r / I_W2E; p0_transpose_item<false>(F.w2 + (size_t)e * FF * DM, FF, DM, W2T + (size_t)e * DM * FF, scr, r % I_W2E, F.lane); }
    }
    bf16_t* XN = WSP(bf16_t, WS_XN);
    for (int m = gw; m < T; m += NGW) {
        const GAS f32x4* xr = (const GAS f32x4*)(F.x + (size_t)m * DM) + F.lane;
        f32x4 v[4]; float s = 0.f;
#pragma unroll
        for (int j = 0; j < 4; ++j) { v[j] = xr[64 * j]; s += (v[j].x * v[j].x + v[j].y * v[j].y) + (v[j].z * v[j].z + v[j].w * v[j].w); }
        const float r = rsqrtf(wave_sum(s) * (1.f / DM) + EPS);
        GAS u32x2* o8 = (GAS u32x2*)(XN + (size_t)m * DM) + F.lane;
#pragma unroll
        for (int j = 0; j < 4; ++j) { const f32x4 g = *((const f32x4*)F.norm1_g + F.lane + 64 * j); u32x2 w; w.x = pg8::cvt_pk_bf16(v[j].x * r * g.x, v[j].y * r * g.y); w.y = pg8::cvt_pk_bf16(v[j].z * r * g.z, v[j].w * r * g.w); o8[64 * j] = w; }
    }
    if (blockIdx.x == 0) { float* LB = WSP(float, WS_LB); for (int c = F.tid; c < HKW; c += NWAVES * 64) { const float a = F.lb_logits[c], b = F.lb_logits[HKW + c]; LB[c] = 1.f / (1.f + __expf(b - a)); } }
}

__device__ __forceinline__ void p_router(Frame& F) {
    LAS int* lcnt = (LAS int*)(F.lds + MOE_OFF + 512); LAS int* lbase = (LAS int*)(F.lds + MOE_OFF + 768);
    const float* X1 = WSP(float, WS_X1); bf16_t* H2 = WSP(bf16_t, WS_H2); float* GATE = WSP(float, WS_GATE); int* LIST = WSP(int, WS_LIST);
    int* cnt = (int*)(F.ctl + CW_CNT);
    for (int tb = blockIdx.x; tb < T / 64; tb += F.G) {
        if (F.tid < NE) lcnt[F.tid] = 0;
        __syncthreads();
        int my_e[8], my_p[8];
#pragma unroll
        for (int i = 0; i < 8; ++i) {
            const int t = tb * 64 + F.wave * 8 + i;
            const GAS f32x4* xr = (const GAS f32x4*)(X1 + (size_t)t * DM) + F.lane;
            f32x4 v[4]; float s = 0.f;
#pragma unroll
            for (int j = 0; j < 4; ++j) { v[j] = xr[64 * j]; s += (v[j].x * v[j].x + v[j].y * v[j].y) + (v[j].z * v[j].z + v[j].w * v[j].w); }
            const float r = rsqrtf(wave_sum(s) * (1.f / DM) + EPS);
            GAS u32x2* o8 = (GAS u32x2*)(H2 + (size_t)t * DM) + F.lane;
#pragma unroll
            for (int j = 0; j < 4; ++j) { const f32x4 g = *((const f32x4*)F.norm2_g + F.lane + 64 * j); v[j].x *= r * g.x; v[j].y *= r * g.y; v[j].z *= r * g.z; v[j].w *= r * g.w;
                u32x2 w; w.x = pg8::cvt_pk_bf16(v[j].x, v[j].y); w.y = pg8::cvt_pk_bf16(v[j].z, v[j].w); o8[64 * j] = w; }
            float mine = -INFINITY;
#pragma unroll 1
            for (int eg = 0; eg < NE; eg += 8) {
                float lg[8];
#pragma unroll
                for (int q = 0; q < 8; ++q) lg[q] = 0.f;
#pragma unroll
                for (int j = 0; j < 4; ++j)
#pragma unroll
                    for (int cidx = 0; cidx < 4; ++cidx) {
                        const float* w = F.router_w + (size_t)(4 * F.lane + 256 * j + cidx) * NE + eg;
                        const f32x4 w0 = *(const f32x4*)w, w1 = *(const f32x4*)(w + 4); const float h = v[j][cidx];
#pragma unroll
                        for (int q = 0; q < 4; ++q) { lg[q] += h * w0[q]; lg[4 + q] += h * w1[q]; }
                    }
#pragma unroll
                for (int q = 0; q < 8; ++q) { const float sm = wave_sum(lg[q]) + F.router_b[eg + q]; if (F.lane == eg + q) mine = sm; }
            }
            float tv[TOPK]; int te[TOPK];
#pragma unroll
            for (int k = 0; k < TOPK; ++k) {
                float bv = mine; int bi = F.lane;
#pragma unroll
                for (int o = 1; o < 64; o <<= 1) { const float ov = __shfl_xor(bv, o); const int oi = __shfl_xor(bi, o); if (ov > bv || (ov == bv && oi < bi)) { bv = ov; bi = oi; } }
                tv[k] = bv; te[k] = bi; if (F.lane == bi) mine = -INFINITY;
            }
            const float e1 = __expf(tv[1] - tv[0]), e2 = __expf(tv[2] - tv[0]), e3 = __expf(tv[3] - tv[0]), inv = 1.f / (1.f + e1 + e2 + e3);
            my_e[i] = 0; my_p[i] = 0;
            if (F.lane < TOPK) {
                const float gk = (F.lane == 0 ? 1.f : F.lane == 1 ? e1 : F.lane == 2 ? e2 : e3) * inv;
                const int ek = F.lane == 0 ? te[0] : F.lane == 1 ? te[1] : F.lane == 2 ? te[2] : te[3];
                GATE[t * TOPK + F.lane] = gk;
                my_e[i] = ek; my_p[i] = __hip_atomic_fetch_add(&lcnt[ek], 1, __ATOMIC_RELAXED, __HIP_MEMORY_SCOPE_WORKGROUP);
            }
        }
        __syncthreads();
        if (F.tid < NE) lbase[F.tid] = atomicAdd(&cnt[F.tid], (int)lcnt[F.tid]);
        __syncthreads();
        if (F.lane < TOPK) {
#pragma unroll
            for (int i = 0; i < 8; ++i) { const int t = tb * 64 + F.wave * 8 + i; LIST[(size_t)my_e[i] * T + lbase[my_e[i]] + my_p[i]] = t * TOPK + F.lane; }
        }
        __syncthreads();
    }
}
__device__ __forceinline__ void moe_setup(Frame& F) {
    LAS int* pre = (LAS int*)(F.lds + MOE_OFF); LAS int* lc = (LAS int*)(F.lds + MOE_OFF + 256);
    if (F.tid < 64) {
        const int c = F.lane < NE ? (int)__hip_atomic_load((int*)(F.ctl + CW_CNT) + F.lane, RLX_AGENT) : 0;
        int s = (c + 255) >> 8;
#pragma unroll
        for (int o = 1; o < 32; o <<= 1) { const int v = __shfl_up(s, o); if ((F.lane & 31) >= o) s += v; }
        if (F.lane < NE) { pre[F.lane + 1] = s; lc[F.lane] = c; }
        if (F.lane == 0) pre[0] = 0;
    }
    __syncthreads();
}
__device__ __forceinline__ void p_final(Frame& F) {
    const float* X1 = WSP(float, WS_X1); const bf16_t* Y = WSP(bf16_t, WS_Y);
    const int gw = F.vcu * NWAVES + F.wave, NGW = F.G * NWAVES;
    for (int t = gw; t < T; t += NGW) {
        const GAS f32x4* xr = (const GAS f32x4*)(X1 + (size_t)t * DM) + F.lane;
        f32x4 v[4]; float s = 0.f;
#pragma unroll
        for (int j = 0; j < 4; ++j) {
            v[j] = xr[64 * j];
#pragma unroll
            for (int k = 0; k < TOPK; ++k) { const u32x2 y = *((const GAS u32x2*)(Y + ((size_t)t * TOPK + k) * DM) + F.lane + 64 * j);
                v[j].x += __builtin_bit_cast(float, y.x << 16); v[j].y += __builtin_bit_cast(float, y.x & 0xffff0000u); v[j].z += __builtin_bit_cast(float, y.y << 16); v[j].w += __builtin_bit_cast(float, y.y & 0xffff0000u); }
            s += (v[j].x * v[j].x + v[j].y * v[j].y) + (v[j].z * v[j].z + v[j].w * v[j].w);
        }
        const float r = rsqrtf(wave_sum(s) * (1.f / DM) + EPS);
        GAS f32x4* o = (GAS f32x4*)(F.out + (size_t)t * DM) + F.lane;
#pragma unroll
        for (int j = 0; j < 4; ++j) { const f32x4 g = *((const f32x4*)F.final_g + F.lane + 64 * j); o[64 * j] = (f32x4){v[j].x * r * g.x, v[j].y * r * g.y, v[j].z * r * g.z, v[j].w * r * g.w}; }
    }
}


__device__ __forceinline__ void p_attn_simple(Frame& F) {
    const bf16_t* AQ = WSP(bf16_t, WS_AQ); const bf16_t* AK = WSP(bf16_t, WS_AK); const bf16_t* AV = WSP(bf16_t, WS_AV); float* ATT = WSP(float, WS_ATT);
    const int gw0 = F.vcu * NWAVES + F.wave, NGW = F.G * NWAVES, lane = F.lane;
    for (int gw = gw0; gw < T * 8; gw += NGW) {
        const int t = gw >> 3, hq = gw & 7, kvh = hq >> 2, b = t / SEQ, tp = t % SEQ;
        const float slope = exp2f(-(float)(hq + 1)), sink = F.sinks[hq];
        const float qd = bf2f(AQ[(size_t)t * AW + hq * 64 + lane]);
        const int s0 = tp >= 127 ? tp - 127 : 0, nk = tp - s0 + 1;
        const bf16_t* kb = AK + ((size_t)b * SEQ + s0) * AKW + kvh * 64 + lane;
        const bf16_t* vb = AV + ((size_t)b * SEQ + s0) * AKW + kvh * 64 + lane;
        float slo = -INFINITY, shi = -INFINITY;
        for (int i = 0; i < nk; ++i) {
            const float d = wave_sum(qd * bf2f(kb[(size_t)i * AKW]));
            const float sc = d * 0.125f - slope * (float)(tp - (s0 + i));
            if ((i & 63) == lane) { if (i < 64) slo = sc; else shi = sc; }
        }
        const float m = fmaxf(wave_max(fmaxf(slo, shi)), sink);
        const float plo = __expf(slo - m), phi = __expf(shi - m);
        const float den = wave_sum(plo + phi) + __expf(sink - m);
        float o = 0.f;
        for (int i = 0; i < nk; ++i) { const float p = __shfl(i < 64 ? plo : phi, i & 63); o += p * bf2f(vb[(size_t)i * AKW]); }
        ATT[(size_t)t * AW + hq * 64 + lane] = o / den;
    }
}
__device__ __forceinline__ void p_hgrn_simple(Frame& F) {
    constexpr int TT = 16;
    LAS float* sf = (LAS float*)(F.lds); LAS float* sk = sf + TT * 128; LAS float* sq = sk + TT * 128; LAS float* po = sq + TT * 128;
    const bf16_t* HQ = WSP(bf16_t, WS_HQ); const float* G = WSP(float, WS_G); const bf16_t* KK = WSP(bf16_t, WS_KK); const bf16_t* HI = WSP(bf16_t, WS_HI); float* ORAW = WSP(float, WS_ORAW);
    for (int u = blockIdx.x; u < BATCH * 4; u += F.G) {
        const int b = u >> 2, h = u & 3, v = F.tid & 127, kq = F.tid >> 7;
        float S[32];
#pragma unroll
        for (int k = 0; k < 32; ++k) S[k] = 0.f;
        for (int t0 = 0; t0 < SEQ; t0 += TT) {
            __syncthreads();
            for (int i = F.tid; i < TT * 128; i += NWAVES * 64) {
                const int tt = i >> 7, k = i & 127; const size_t idx = ((size_t)b * SEQ + t0 + tt) * HKW + h * 128 + k;
                sf[i] = __expf(G[idx]); sk[i] = bf2f(KK[idx]); sq[i] = bf2f(HQ[idx]);
            }
            __syncthreads();
            for (int tt = 0; tt < TT; ++tt) {
                const float vv = bf2f(HI[((size_t)b * SEQ + t0 + tt) * HW + h * 128 + v]);
                float o = 0.f;
#pragma unroll
                for (int k = 0; k < 32; ++k) { const int kk = tt * 128 + kq * 32 + k; S[k] = sf[kk] * S[k] + sk[kk] * vv; o += sq[kk] * S[k]; }
                po[(tt * 4 + kq) * 128 + v] = o;
            }
            __syncthreads();
            for (int i = F.tid; i < TT * 128; i += NWAVES * 64) {
                const int tt = i >> 7, vv = i & 127;
                ORAW[((size_t)b * SEQ + t0 + tt) * HW + h * 128 + vv] = (po[(tt * 4 + 0) * 128 + vv] + po[(tt * 4 + 1) * 128 + vv]) + (po[(tt * 4 + 2) * 128 + vv] + po[(tt * 4 + 3) * 128 + vv]);
            }
        }
        __syncthreads();
    }
}
__device__ __forceinline__ void p_mix_simple(Frame& F) {
    const float* ATT = WSP(float, WS_ATT); const float* ORAW = WSP(float, WS_ORAW); const bf16_t* HG = WSP(bf16_t, WS_HG); bf16_t* MIX = WSP(bf16_t, WS_MIX);
    const int gw0 = F.vcu * NWAVES + F.wave, NGW = F.G * NWAVES, lane = F.lane;
    for (int t = gw0; t < T; t += NGW) {
        float a[8]; float ss = 0.f;
#pragma unroll
        for (int j = 0; j < 8; ++j) { a[j] = ATT[(size_t)t * AW + lane + 64 * j]; ss += a[j] * a[j]; }
        const float r = rsqrtf(wave_sum(ss) * (1.f / AW) + EPS);
#pragma unroll
        for (int j = 0; j < 8; ++j) MIX[(size_t)t * MIXW + lane + 64 * j] = f2bf(a[j] * r * F.attn_g[lane + 64 * j]);
#pragma unroll
        for (int h = 0; h < 4; ++h) {
            const int c0 = h * 128 + lane, c1 = c0 + 64;
            const float o0 = ORAW[(size_t)t * HW + c0], o1 = ORAW[(size_t)t * HW + c1];
            const float rr = rsqrtf(wave_sum(o0 * o0 + o1 * o1) * (1.f / 128.f) + EPS);
            MIX[(size_t)t * MIXW + AW + c0] = f2bf(o0 * rr * F.hgrn_g[c0] * bf2f(HG[(size_t)t * HW + c0]));
            MIX[(size_t)t * MIXW + AW + c1] = f2bf(o1 * rr * F.hgrn_g[c1] * bf2f(HG[(size_t)t * HW + c1]));
        }
    }
}

struct Args { const float* in[18]; float* out; unsigned char* ws; int ph_lo, ph_hi, li, pad; };
__global__ void __launch_bounds__(NWAVES * 64, 2) mega_fwd(Args args) {
    extern __shared__ __attribute__((aligned(16))) unsigned char lds[];
    Frame F;
    F.lds = (LAS unsigned char*)lds; F.MISC = (volatile LAS unsigned*)(F.lds + MISC_OFF);
    F.tid = threadIdx.x; F.lane = F.tid & 63; F.wave = __builtin_amdgcn_readfirstlane(F.tid >> 6);
    F.G = gridDim.x; { const int bx = blockIdx.x; F.vcu = (F.G % 8 == 0) ? (bx % 8) * (F.G / 8) + bx / 8 : bx; }
    F.ws = args.ws; F.ctl = (gu32*)(args.ws + WS_CTL); F.out = args.out;
    F.x = args.in[0]; F.norm1_g = args.in[1]; F.w_in = args.in[2]; F.b_in = args.in[3]; F.sinks = args.in[4]; F.attn_g = args.in[5]; F.lb_logits = args.in[6]; F.hgrn_g = args.in[7];
    F.w_out = args.in[8]; F.b_out = args.in[9]; F.norm2_g = args.in[10]; F.router_w = args.in[11]; F.router_b = args.in[12]; F.w1 = args.in[13]; F.b1 = args.in[14]; F.w2 = args.in[15];
    F.b2 = args.in[16]; F.final_g = args.in[17];
    for (int u = F.tid; u < (LDS_BYTES - LDSCTL_OFF) / 4; u += NWAVES * 64) ((LAS unsigned*)(F.lds + LDSCTL_OFF))[u] = 0u;
    __syncthreads();
    XcdBarrier bar = xcd_barrier_post((unsigned*)(F.ctl + CW_BAR) + args.li * XCD_BAR_WORDS, F.MISC + 8);
    const int lo = args.ph_lo, hi = args.ph_hi;
#define IN(k) (lo <= (k) && (k) < hi)
#define SEAM(k) do { if (IN(k) && IN((k) + 1)) xcd_barrier(bar); } while (0)

    if (IN(0)) { p_prologue(F); SEAM(0); }
    if (IN(1)) {
        pg8::DenseOrder S; S.init(WSP(bf16_t, WS_XN), WSP(bf16_t, WS_WINT), T, INW, DM, F.G, (int)blockIdx.x);
        pg8::EpiInProj E{F.b_in, WSP(float, WS_LB), WSP(bf16_t, WS_AQ), WSP(bf16_t, WS_AK), WSP(bf16_t, WS_AV), WSP(bf16_t, WS_HQ), WSP(bf16_t, WS_KK), WSP(bf16_t, WS_HI), WSP(bf16_t, WS_HG), WSP(float, WS_G)};
        pg8::gemm_phase<pg8::EpiInProj, pg8::DenseOrder, false, true>(F.lds + RING_OFF, DM, S, E);
        SEAM(1);
    }
    if (IN(2)) { p_attn_simple(F); }
    if (IN(3)) { p_hgrn_simple(F); SEAM(3); }
    if (IN(4)) { p_mix_simple(F); SEAM(4); }
    if (IN(5)) {
        pg8::DenseOrder S; S.init(WSP(bf16_t, WS_MIX), WSP(bf16_t, WS_WOUTT), T, DM, MIXW, F.G, (int)blockIdx.x);
        pg8::EpiOutProj E{F.b_out, F.x, WSP(float, WS_X1)};
        pg8::gemm_phase<pg8::EpiOutProj, pg8::DenseOrder, false, true>(F.lds + RING_OFF, MIXW, S, E);
        SEAM(5);
    }
    if (IN(6)) { p_router(F); SEAM(6); }
    if (IN(7)) {
        moe_setup(F);
        LAS const int* pre = (LAS const int*)(F.lds + MOE_OFF); LAS const int* lc = (LAS const int*)(F.lds + MOE_OFF + 256);
        pg8::MoeOrder<true> S{(const char*)WSP(bf16_t, WS_H2), (const char*)WSP(bf16_t, WS_W1T), WSP(int, WS_LIST), pre, lc, DM, 2 * FF, 2 * FF / 256, pre[NE] * (2 * FF / 256), F.G, (int)blockIdx.x};
        pg8::EpiMoe1 E{F.b1, WSP(bf16_t, WS_ACT)};
        pg8::gemm_phase<pg8::EpiMoe1, pg8::MoeOrder<true>, true, true>(F.lds + RING_OFF, DM, S, E);
        SEAM(7);
    }
    if (IN(8)) {
        if (!IN(7)) moe_setup(F);
        LAS const int* pre = (LAS const int*)(F.lds + MOE_OFF); LAS const int* lc = (LAS const int*)(F.lds + MOE_OFF + 256);
        pg8::MoeOrder<false> S{(const char*)WSP(bf16_t, WS_ACT), (const char*)WSP(bf16_t, WS_W2T), WSP(int, WS_LIST), pre, lc, FF, DM, DM / 256, pre[NE] * (DM / 256), F.G, (int)blockIdx.x};
        pg8::EpiMoe2 E{F.b2, WSP(int, WS_LIST), WSP(float, WS_GATE), WSP(bf16_t, WS_Y)};
        pg8::gemm_phase<pg8::EpiMoe2, pg8::MoeOrder<false>, false, true>(F.lds + RING_OFF, FF, S, E);
        SEAM(8);
    }
    if (IN(9)) p_final(F);
#undef IN
#undef SEAM
}

static int mega_grid() {
    static int grid = 0;
    if (grid == 0) {
        int dev = 0, cus = 0;
        if (hipGetDevice(&dev) != hipSuccess || hipDeviceGetAttribute(&cus, hipDeviceAttributeMultiprocessorCount, dev) != hipSuccess) { grid = -1; return grid; }
        if (hipFuncSetAttribute((const void*)mega_fwd, hipFuncAttributeMaxDynamicSharedMemorySize, LDS_BYTES) != hipSuccess) { grid = -1; return grid; }
        (void)hipGetLastError();
        grid = cus;
    }
    return grid;
}
extern "C" void kernel_launch(void* const* d_in, const int* in_sizes, int n_in, void* d_out, int out_size, void* d_ws, size_t ws_size, hipStream_t stream) {
    if (n_in != 18 || ws_size < WS_END) return;
    const int grid = mega_grid(); if (grid <= 0) return;
    unsigned char* ws = (unsigned char*)d_ws;
    (void)hipMemsetAsync(ws + WS_CTL, 0, 65536, stream);
    Args a{};
    for (int i = 0; i < 18; ++i) a.in[i] = (const float*)d_in[i];
    a.out = (float*)d_out; a.ws = ws;
    a.ph_lo = 0; a.ph_hi = N_PHASES; a.li = 0;
    hipLaunchKernelGGL(mega_fwd, dim3(grid), dim3(NWAVES * 64), LDS_BYTES, stream, a);
}
```

```cpp
#include <hip/hip_runtime.h>
#include <stdint.h>

typedef unsigned short bf16_t;
typedef short bf16x8 __attribute__((ext_vector_type(8)));
typedef float f32x4 __attribute__((ext_vector_type(4)));

constexpr int BATCH = 8, SEQ = 2048, DM = 1024, T = BATCH * SEQ;
constexpr int AW = 512, AKW = 128, HKW = 512, HW = 512, INW = 2816, MIXW = 1024;
constexpr int NE = 32, TOPK = 4, FF = 1024;
constexpr int C_AQ = 0, C_AK = 512, C_AV = 640, C_HQ = 768, C_HF = 1280, C_HI = 1792, C_HG = 2304;
constexpr float EPS = 1e-5f;
constexpr int ACT_ROWS = T * TOPK + NE * 256;

constexpr size_t MiB = 1u << 20;
constexpr size_t al(size_t x) { return (x + 255) & ~(size_t)255; }
constexpr size_t WS_CTL = 0;
constexpr size_t WS_LB = 1 * MiB;
constexpr size_t WS_WINT = 2 * MiB;
constexpr size_t WS_WOUTT = WS_WINT + al((size_t)INW * DM * 2);
constexpr size_t WS_W1T = WS_WOUTT + al((size_t)DM * MIXW * 2);
constexpr size_t WS_W2T = WS_W1T + al((size_t)NE * 2 * FF * DM * 2);
constexpr size_t WS_XN = WS_W2T + al((size_t)NE * DM * FF * 2);
constexpr size_t WS_AQ = WS_XN + al((size_t)T * DM * 2);
constexpr size_t WS_AK = WS_AQ + al((size_t)T * AW * 2);
constexpr size_t WS_AV = WS_AK + al((size_t)T * AKW * 2);
constexpr size_t WS_HQ = WS_AV + al((size_t)T * AKW * 2);
constexpr size_t WS_G = WS_HQ + al((size_t)T * HKW * 2);
constexpr size_t WS_KK = WS_G + al((size_t)T * HKW * 4);
constexpr size_t WS_HI = WS_KK + al((size_t)T * HKW * 2);
constexpr size_t WS_HG = WS_HI + al((size_t)T * HW * 2);
constexpr size_t WS_ATT = WS_HG + al((size_t)T * HW * 2);
constexpr size_t WS_ORAW = WS_ATT + al((size_t)T * AW * 4);
constexpr size_t WS_MIX = WS_ORAW + al((size_t)T * HW * 4);
constexpr size_t WS_X1 = WS_MIX + al((size_t)T * MIXW * 2);
constexpr size_t WS_H2 = WS_X1 + al((size_t)T * DM * 4);
constexpr size_t WS_GATE = WS_H2 + al((size_t)T * DM * 2);
constexpr size_t WS_LIST = WS_GATE + al((size_t)T * TOPK * 4);
constexpr size_t WS_ACT = WS_LIST + al((size_t)NE * T * 4);
constexpr size_t WS_Y = WS_ACT + al((size_t)ACT_ROWS * FF * 2);
constexpr size_t WS_QF = WS_Y + al((size_t)T * TOPK * DM * 2);
constexpr size_t WS_KF = WS_QF + al((size_t)1024 * 16 * 512 * 2);
constexpr size_t WS_VF = WS_KF + al((size_t)1024 * 16 * 512 * 2);
constexpr size_t WS_INTRA = WS_VF + al((size_t)1024 * 16 * 512 * 2);
constexpr size_t WS_DEC = WS_INTRA + al((size_t)T * HW * 2);
constexpr size_t WS_END = WS_DEC + al((size_t)1024 * 128 * 4);
static_assert(WS_END <= ((size_t)1 << 30), "workspace map exceeds 1 GiB");
constexpr int CW_CNT = 64;
constexpr int CW_OFF = 128;

__device__ __forceinline__ bf16_t f2bf(float f) { unsigned u = __builtin_bit_cast(unsigned, f); return (bf16_t)((u + 0x7fffu + ((u >> 16) & 1u)) >> 16); }
__device__ __forceinline__ float bf2f(bf16_t b) { return __builtin_bit_cast(float, (unsigned)b << 16); }
__device__ __forceinline__ float wave_sum(float v) {
#pragma unroll
    for (int o = 1; o < 64; o <<= 1) v += __shfl_xor(v, o);
    return v;
}
__device__ __forceinline__ float wave_max(float v) {
#pragma unroll
    for (int o = 1; o < 64; o <<= 1) v = fmaxf(v, __shfl_xor(v, o));
    return v;
}
__device__ __forceinline__ float sigmoidf_(float x) { return 1.f / (1.f + __expf(-x)); }
__device__ __forceinline__ float siluf_(float x) { return x / (1.f + __expf(-x)); }

#define LAS __attribute__((address_space(3)))
#define GAS __attribute__((address_space(1)))
typedef unsigned u32x4 __attribute__((ext_vector_type(4)));
typedef unsigned u32x2 __attribute__((ext_vector_type(2)));
typedef float f32x2 __attribute__((ext_vector_type(2)));

namespace pg8 {
constexpr int BM = 256, BK = 64, HALF = 128, HTB = HALF * BK * 2  , STAGE_BYTES = 8 * HTB, NXCD = 8, WGM = 8;
__host__ __device__ __forceinline__ int lds_byte(int r, int c) { const int st = (r >> 4) * 2 + (c >> 5), rr = r & 15, cc = c & 31, ob = rr * 64 + cc * 2; return st * 1024 + (ob ^ (((ob >> 9) & 1) << 5)); }
__host__ __device__ __forceinline__ void stage_rc(int b, int& R, int& C) { const int st = b / 1024, sb = b % 1024, swz = sb ^ (((sb >> 9) & 1) << 5); R = (st >> 1) * 16 + swz / 64; C = (st & 1) * 32 + (swz % 64) / 2; }
__host__ __device__ __forceinline__ int perm32(int rho) { const int n = rho >> 4, i = rho & 15; return 8 * (i >> 2) + 4 * n + (i & 3); }
__device__ __forceinline__ unsigned cvt_pk_bf16(float lo, float hi) { unsigned r; asm volatile("v_cvt_pk_bf16_f32 %0, %1, %2" : "=v"(r) : "v"(lo), "v"(hi)); return r; }

struct Unit { const char* A; const char* B; int pm, pn, e, rows, arow, lbase; };

struct DenseOrder {
    const char* A; const char* Bt; int K, nM, nN, nwg, G, c;
    __device__ void init(const void* A_, const void* Bt_, int M, int N, int K_, int G_, int c_) { A = (const char*)A_; Bt = (const char*)Bt_; K = K_; nM = M / BM; nN = N / BM; nwg = nM * nN; G = G_; c = c_; }
    __device__ __forceinline__ bool next(int i, Unit& u) const {
        const long L = (long)i * G + c; if (L >= nwg) return false;
        int wgid = (int)L; { const int q = nwg / NXCD, r = nwg % NXCD, xcd = wgid % NXCD, off = wgid / NXCD; wgid = (xcd < r ? xcd * (q + 1) : r * (q + 1) + (xcd - r) * q) + off; }
        const int nig = WGM * nN, gid = wgid / nig, fm = gid * WGM, gsz = (nM - fm) < WGM ? (nM - fm) : WGM;
        u.pm = fm + ((wgid % nig) % gsz); u.pn = (wgid % nig) / gsz; u.e = 0; u.rows = BM; u.arow = u.pm * BM; u.lbase = 0;
        u.A = A + (size_t)u.pm * BM * K * 2; u.B = Bt + (size_t)u.pn * BM * K * 2; return true;
    }
    __device__ __forceinline__ int row(const Unit&, int r) const { return r; }
};
template <bool G1>
struct MoeOrder {
    const char* A; const char* Bt; const int* list; LAS const int* pre; LAS const int* cnt; int K, N, nN, nwg, G, c;
    __device__ __forceinline__ bool next(int i, Unit& u) const {
        const long L = (long)i * G + c; if (L >= nwg) return false;
        int wgid = (int)L; { const int q = nwg / NXCD, r = nwg % NXCD, xcd = wgid % NXCD, off = wgid / NXCD; wgid = (xcd < r ? xcd * (q + 1) : r * (q + 1) + (xcd - r) * q) + off; }
        const int tau = wgid / nN; u.pn = wgid % nN;
        const int p = pre[(threadIdx.x & 31) + 1];
        const int e = __builtin_popcountll(__ballot(p <= tau) & 0xffffffffull);
        const int mt = tau - pre[e];
        u.e = e; u.pm = mt; const int left = cnt[e] - mt * BM; u.rows = left < BM ? left : BM;
        u.arow = tau * BM; u.lbase = e * T + mt * BM;
        u.A = G1 ? A : A + (size_t)u.arow * K * 2;
        u.B = Bt + ((size_t)e * N + (size_t)u.pn * BM) * K * 2; return true;
    }
    __device__ __forceinline__ int row(const Unit& u, int r) const { const int rr = r < u.rows ? r : u.rows - 1; return list[u.lbase + rr] >> 2; }
};

__device__ __forceinline__ u32x4 pack8(f32x4 v0, f32x4 v1) { u32x4 w; w.x = cvt_pk_bf16(v0[0], v0[1]); w.y = cvt_pk_bf16(v0[2], v0[3]); w.z = cvt_pk_bf16(v1[0], v1[1]); w.w = cvt_pk_bf16(v1[2], v1[3]); return w; }
__device__ __forceinline__ f32x4 silu4(f32x4 v) { f32x4 r; for (int i = 0; i < 4; ++i) r[i] = v[i] * __builtin_amdgcn_rcpf(1.f + __expf(-v[i])); return r; }

struct EpiInProj {
    static constexpr bool PERM = true;
    const float* bias; const float* lb; bf16_t *AQ, *AK, *AV, *HQ, *KK, *HI, *HG; float* G;
    __device__ __forceinline__ void operator()(const f32x4 (&acc)[2][2][4][2], const Unit& u, int wr, int wc, int fr, int fq) const {
        const int row0 = u.pm * BM + wr * 64 + fr, cl = wc * 32 + 8 * fq;
#pragma unroll
        for (int bj = 0; bj < 2; ++bj) {
            const int cb = u.pn * BM + bj * HALF;
            const f32x4 b0 = *(const f32x4*)(bias + cb + cl), b1 = *(const f32x4*)(bias + cb + cl + 4);
            if (cb >= C_HF && cb < C_HI) {
                const int cc = cb - C_HF + cl;
                const f32x4 l0 = *(const f32x4*)(lb + cc), l1 = *(const f32x4*)(lb + cc + 4);
#pragma unroll
                for (int ai = 0; ai < 2; ++ai)
#pragma unroll
                    for (int m = 0; m < 4; ++m) {
                        const size_t r = (size_t)(row0 + ai * HALF + m * 16);
                        f32x4 v0 = acc[ai][bj][m][0] + b0, v1 = acc[ai][bj][m][1] + b1, g0, g1, k0, k1;
#pragma unroll
                        for (int i = 0; i < 4; ++i) {
                            const float f0 = l0[i] + (1.f - l0[i]) * __builtin_amdgcn_rcpf(1.f + __expf(-v0[i])); g0[i] = __logf(f0); k0[i] = 1.f - f0;
                            const float f1 = l1[i] + (1.f - l1[i]) * __builtin_amdgcn_rcpf(1.f + __expf(-v1[i])); g1[i] = __logf(f1); k1[i] = 1.f - f1;
                        }
                        *(f32x4*)(G + r * HKW + cc) = g0; *(f32x4*)(G + r * HKW + cc + 4) = g1;
                        *(u32x4*)(KK + r * HKW + cc) = pack8(k0, k1);
                    }
            } else {
                bf16_t* dst; int ld, cc; bool act = false;
                if (cb < C_AK) { dst = AQ; ld = AW; cc = cb - C_AQ; }
                else if (cb < C_AV) { dst = AK; ld = AKW; cc = cb - C_AK; }
                else if (cb < C_HQ) { dst = AV; ld = AKW; cc = cb - C_AV; }
                else if (cb < C_HF) { dst = HQ; ld = HKW; cc = cb - C_HQ; act = true; }
                else if (cb < C_HG) { dst = HI; ld = HW; cc = cb - C_HI; }
                else { dst = HG; ld = HW; cc = cb - C_HG; act = true; }
                cc += cl;
#pragma unroll
                for (int ai = 0; ai < 2; ++ai)
#pragma unroll
                    for (int m = 0; m < 4; ++m) {
                        const size_t r = (size_t)(row0 + ai * HALF + m * 16);
                        f32x4 v0 = acc[ai][bj][m][0] + b0, v1 = acc[ai][bj][m][1] + b1;
                        if (act) { v0 = silu4(v0); v1 = silu4(v1); }
                        *(u32x4*)(dst + r * ld + cc) = pack8(v0, v1);
                    }
            }
        }
    }
};
struct EpiOutProj {
    static constexpr bool PERM = false;
    const float* bias; const float* x; float* X1;
    __device__ __forceinline__ void operator()(const f32x4 (&acc)[2][2][4][2], const Unit& u, int wr, int wc, int fr, int fq) const {
        const int row0 = u.pm * BM + wr * 64 + fr, col0 = u.pn * BM + wc * 32 + 4 * fq;
#pragma unroll
        for (int bj = 0; bj < 2; ++bj)
#pragma unroll
            for (int n = 0; n < 2; ++n) {
                const int c = col0 + bj * HALF + n * 16; const f32x4 bv = *(const f32x4*)(bias + c);
#pragma unroll
                for (int ai = 0; ai < 2; ++ai)
#pragma unroll
                    for (int m = 0; m < 4; ++m) { const size_t o = (size_t)(row0 + ai * HALF + m * 16) * DM + c; *(f32x4*)(X1 + o) = acc[ai][bj][m][n] + bv + *(const f32x4*)(x + o); }
            }
    }
};
struct EpiMoe1 {
    static constexpr bool PERM = true;
    const float* b1; bf16_t* ACT;
    __device__ __forceinline__ void operator()(const f32x4 (&acc)[2][2][4][2], const Unit& u, int wr, int wc, int fr, int fq) const {
        const int ac0 = u.pn * HALF + wc * 32 + 8 * fq;
        const float* bp = b1 + (size_t)u.e * 2 * FF + 2 * ac0;
        const f32x4 q0 = *(const f32x4*)bp, q1 = *(const f32x4*)(bp + 4), q2 = *(const f32x4*)(bp + 8), q3 = *(const f32x4*)(bp + 12);
        const f32x4 bg0 = {q0[0], q0[2], q1[0], q1[2]}, bg1 = {q2[0], q2[2], q3[0], q3[2]}, bl0 = {q0[1], q0[3], q1[1], q1[3]}, bl1 = {q2[1], q2[3], q3[1], q3[3]};
#pragma unroll
        for (int ai = 0; ai < 2; ++ai)
#pragma unroll
            for (int m = 0; m < 4; ++m) {
                const int r = ai * HALF + wr * 64 + m * 16 + fr;
                const f32x4 g0 = acc[ai][0][m][0] + bg0, g1 = acc[ai][0][m][1] + bg1, l0 = acc[ai][1][m][0] + bl0, l1 = acc[ai][1][m][1] + bl1;
                f32x4 a0, a1;
#pragma unroll
                for (int i = 0; i < 4; ++i) {
                    const float u0 = fminf(g0[i], 7.f), u1 = fminf(g1[i], 7.f), w0 = fminf(fmaxf(l0[i], -7.f), 7.f), w1 = fminf(fmaxf(l1[i], -7.f), 7.f);
                    a0[i] = u0 * __builtin_amdgcn_rcpf(1.f + __expf(-1.702f * u0)) * (w0 + 1.f);
                    a1[i] = u1 * __builtin_amdgcn_rcpf(1.f + __expf(-1.702f * u1)) * (w1 + 1.f);
                }
                if (r < u.rows) *(u32x4*)(ACT + (size_t)(u.arow + r) * FF + ac0) = pack8(a0, a1);
            }
    }
};
struct EpiMoe2 {
    static constexpr bool PERM = true;
    const float* b2; const int* list; const float* gate; bf16_t* Y;
    __device__ __forceinline__ void operator()(const f32x4 (&acc)[2][2][4][2], const Unit& u, int wr, int wc, int fr, int fq) const {
        const int c0 = u.pn * BM + wc * 32 + 8 * fq;
        f32x4 bv[2][2];
#pragma unroll
        for (int bj = 0; bj < 2; ++bj)
#pragma unroll
            for (int n = 0; n < 2; ++n) bv[bj][n] = *(const f32x4*)(b2 + (size_t)u.e * DM + c0 + bj * HALF + 4 * n);
#pragma unroll
        for (int ai = 0; ai < 2; ++ai)
#pragma unroll
            for (int m = 0; m < 4; ++m) {
                const int r = ai * HALF + wr * 64 + m * 16 + fr;
                if (r < u.rows) {
                    const int slot = list[u.lbase + r]; const float gt = gate[slot];
                    bf16_t* yr = Y + (size_t)slot * DM + c0;
#pragma unroll
                    for (int bj = 0; bj < 2; ++bj) { const f32x4 v0 = (acc[ai][bj][m][0] + bv[bj][0]) * gt, v1 = (acc[ai][bj][m][1] + bv[bj][1]) * gt; *(u32x4*)(yr + bj * HALF) = pack8(v0, v1); }
                }
            }
    }
};

template <class Epi, class Sched, bool GATHER, bool ALIGN_EPI>
__device__ __forceinline__ void gemm_phase(LAS unsigned char* lds, const int K, const Sched& S, const Epi& E) {
    const int tid = threadIdx.x, wid = __builtin_amdgcn_readfirstlane(tid >> 6), lane = tid & 63, wr = wid >> 2, wc = wid & 3, fr = lane & 15, fq = lane >> 4;
    const int nt = K / BK;
    int RA[2], CA[2]; unsigned voffB[2];
#pragma unroll
    for (int i = 0; i < 2; ++i) { int R, C; stage_rc(tid * 16 + i * 8192, R, C); RA[i] = R; CA[i] = C; const int Rb = Epi::PERM ? ((R & ~31) + perm32(R & 31)) : R; voffB[i] = (unsigned)(Rb * K + C) * 2u; }
    const size_t kstep = (size_t)(BK * 2);
    const size_t hstep = (size_t)HALF * K * 2;
    const unsigned ldsw = (unsigned)wid * 1024u;
    const int aoff = lds_byte(wr * 64 + fr, fq * 8), boff = lds_byte(wc * 32 + fr, fq * 8);
#define PG8_SA(b, h) (((b) * 2 + (h)) * HTB)
#define PG8_SB(b, h) ((4 + (b) * 2 + (h)) * HTB)
#define PG8_STAGE(bufoff, gbase, voff) do { _Pragma("unroll") for (int _i = 0; _i < 2; ++_i) \
        __builtin_amdgcn_global_load_lds((const unsigned*)((const char*)(gbase) + (voff)[_i]), (LAS unsigned*)(lds + (bufoff) + ldsw + _i * 8192), 16, 0, 0); } while (0)
#define PG8_LDA(dst, b, h) do { _Pragma("unroll") for (int m = 0; m < 4; ++m) _Pragma("unroll") for (int k = 0; k < 2; ++k) dst[m][k] = *(const LAS bf16x8*)(lds + PG8_SA(b, h) + aoff + m * 2048 + k * 1024); } while (0)
#define PG8_LDB(dst, b, h) do { _Pragma("unroll") for (int n = 0; n < 2; ++n) _Pragma("unroll") for (int k = 0; k < 2; ++k) dst[n][k] = *(const LAS bf16x8*)(lds + PG8_SB(b, h) + boff + n * 2048 + k * 1024); } while (0)
#define PG8_MMA(ai, bj, At, Bt) do { __builtin_amdgcn_s_setprio(1); _Pragma("unroll") for (int m = 0; m < 4; ++m) _Pragma("unroll") for (int n = 0; n < 2; ++n) _Pragma("unroll") for (int k = 0; k < 2; ++k) \
        acc[ai][bj][m][n] = __builtin_amdgcn_mfma_f32_16x16x32_bf16(Bt[n][k], At[m][k], acc[ai][bj][m][n], 0, 0, 0); __builtin_amdgcn_s_setprio(0); } while (0)
#define PG8_WAIT_V(n) asm volatile("s_waitcnt vmcnt(" #n ")" ::: "memory")
#define PG8_WAIT_L(n) asm volatile("s_waitcnt lgkmcnt(" #n ")" ::: "memory")
#define PG8_BAR __builtin_amdgcn_s_barrier()
#define PG8_SCHED __builtin_amdgcn_sched_barrier(0)
#define PG8_VOFFA(dst, u) do { _Pragma("unroll") for (int _h = 0; _h < 2; ++_h) _Pragma("unroll") for (int _i = 0; _i < 2; ++_i) { const int _r = _h * HALF + RA[_i]; \
        const unsigned _row = GATHER ? (unsigned)S.row(u, _r) : (unsigned)_r; dst[_h][_i] = (_row * (unsigned)K + (unsigned)CA[_i]) * 2u; } } while (0)
    Unit cur, nxt; int ui = 0;
    if (!S.next(0, cur)) return;
    f32x4 acc[2][2][4][2];
#pragma unroll
    for (int a = 0; a < 2; ++a)
#pragma unroll
        for (int b = 0; b < 2; ++b)
#pragma unroll
            for (int m = 0; m < 4; ++m)
#pragma unroll
                for (int n = 0; n < 2; ++n) acc[a][b][m][n] = (f32x4){0.f, 0.f, 0.f, 0.f};
    bf16x8 At[4][2], B0[2][2], B1[2][2];
    unsigned vA[2][2], nvA[2][2];
    PG8_VOFFA(vA, cur);
    const char* cA = cur.A; const char* cB = cur.B;
    PG8_STAGE(PG8_SB(0, 0), cB, voffB); PG8_STAGE(PG8_SB(0, 1), cB + hstep, voffB); PG8_STAGE(PG8_SA(0, 0), cA, vA[0]); PG8_STAGE(PG8_SA(0, 1), cA, vA[1]);
    if (wr == 1) PG8_BAR;
    PG8_WAIT_V(2); PG8_BAR;
    PG8_STAGE(PG8_SB(1, 0), cB + kstep, voffB); PG8_STAGE(PG8_SA(1, 0), cA + kstep, vA[0]); PG8_STAGE(PG8_SB(1, 1), cB + hstep + kstep, voffB);
    PG8_WAIT_V(6); PG8_BAR;
    for (;;) {
        const bool has_next = S.next(ui + 1, nxt);
        const char* nA = has_next ? nxt.A : cA; const char* nB = has_next ? nxt.B : cB;
        if (has_next) { PG8_VOFFA(nvA, nxt); } else {
#pragma unroll
            for (int h = 0; h < 2; ++h)
#pragma unroll
                for (int i = 0; i < 2; ++i) nvA[h][i] = vA[h][i]; }
        for (int t = 0; t < nt; t += 2) {
            const bool last = (t == nt - 2);
            const char* a1 = cA + (size_t)(t + 1) * kstep;
            const char* a2 = last ? nA : cA + (size_t)(t + 2) * kstep; const char* b2 = last ? nB : cB + (size_t)(t + 2) * kstep;
            const char* a3 = a2 + kstep; const char* b3 = b2 + kstep;
            unsigned s0[2], s1[2];
#pragma unroll
            for (int i = 0; i < 2; ++i) { s0[i] = last ? nvA[0][i] : vA[0][i]; s1[i] = last ? nvA[1][i] : vA[1][i]; }
            PG8_LDB(B0, 0, 0); PG8_LDB(B1, 0, 1); PG8_SCHED; PG8_LDA(At, 0, 0); PG8_STAGE(PG8_SA(1, 1), a1, vA[1]);
            PG8_WAIT_V(8); PG8_WAIT_L(0); PG8_BAR; PG8_MMA(0, 0, At, B0); PG8_MMA(0, 1, At, B1); PG8_BAR; PG8_SCHED;
            PG8_LDA(At, 0, 1); PG8_STAGE(PG8_SB(0, 0), b2, voffB); PG8_STAGE(PG8_SB(0, 1), b2 + hstep, voffB); PG8_STAGE(PG8_SA(0, 0), a2, s0);
            PG8_WAIT_V(8); PG8_WAIT_L(0); PG8_BAR; PG8_MMA(1, 0, At, B0); PG8_MMA(1, 1, At, B1); PG8_BAR; PG8_SCHED;
            PG8_LDB(B0, 1, 0); PG8_LDB(B1, 1, 1); PG8_SCHED; PG8_LDA(At, 1, 0); PG8_STAGE(PG8_SA(0, 1), a2, s1);
            PG8_WAIT_V(8); PG8_WAIT_L(0); PG8_BAR; PG8_MMA(0, 0, At, B0); PG8_MMA(0, 1, At, B1); PG8_BAR; PG8_SCHED;
            PG8_LDA(At, 1, 1); PG8_STAGE(PG8_SB(1, 0), b3, voffB); PG8_STAGE(PG8_SB(1, 1), b3 + hstep, voffB); PG8_STAGE(PG8_SA(1, 0), a3, s0);
            PG8_WAIT_V(8); PG8_WAIT_L(0); PG8_BAR; PG8_MMA(1, 0, At, B0); PG8_MMA(1, 1, At, B1); PG8_BAR; PG8_SCHED;
        }
        if constexpr (ALIGN_EPI) { if (wr == 0) PG8_BAR; }
        E(acc, cur, wr, wc, fr, fq);
        if (!has_next) break;
#pragma unroll
        for (int a = 0; a < 2; ++a)
#pragma unroll
            for (int b = 0; b < 2; ++b)
#pragma unroll
                for (int m = 0; m < 4; ++m)
#pragma unroll
                    for (int n = 0; n < 2; ++n) acc[a][b][m][n] = (f32x4){0.f, 0.f, 0.f, 0.f};
        cur = nxt; cA = nA; cB = nB; ++ui;
#pragma unroll
        for (int h = 0; h < 2; ++h)
#pragma unroll
            for (int i = 0; i < 2; ++i) vA[h][i] = nvA[h][i];
        if constexpr (ALIGN_EPI) { if (wr == 1) PG8_BAR; }
    }
    PG8_WAIT_V(0);
    if constexpr (!ALIGN_EPI) { if (wr == 0) PG8_BAR; }
    PG8_BAR;
#undef PG8_SA
#undef PG8_SB
#undef PG8_STAGE
#undef PG8_LDA
#undef PG8_LDB
#undef PG8_MMA
#undef PG8_WAIT_V
#undef PG8_WAIT_L
#undef PG8_BAR
#undef PG8_SCHED
#undef PG8_VOFFA
}
}

constexpr int NWAVES = 8;
constexpr int RING_OFF = 0, RING_BYTES = 139264;
constexpr int LDSCTL_OFF = RING_BYTES, MISC_OFF = LDSCTL_OFF + 320;
constexpr int MOE_OFF = LDSCTL_OFF + 1024;
constexpr int LDS_BYTES = RING_BYTES + 16384;
constexpr int CW_TMO = 0, CW_CODE = 1, CW_BAR = 4096;
constexpr int N_PHASES = 10;

typedef GAS unsigned gu32;
#define RLX_AGENT __ATOMIC_RELAXED, __HIP_MEMORY_SCOPE_AGENT
#define LDS_WAIT() asm volatile("s_waitcnt lgkmcnt(0)" ::: "memory")
#define VM_WAIT() asm volatile("s_waitcnt vmcnt(0)" ::: "memory")

#define XB_TMO      128
#define XB_XCNT(j)  (256  + 64 * (j))
#define XB_XSUB(j)  (1280 + 64 * (j))
#define XB_XGEN(j)  (2304 + 64 * (j))
#define XB_TOP      3328
#define XB_TOPGEN   3392
#define XCD_BAR_WORDS 3456
#define XB_SPIN_CAP (1u << 18)
__device__ __forceinline__ unsigned xb_ld(unsigned* p)              { return __hip_atomic_load(p, __ATOMIC_RELAXED, __HIP_MEMORY_SCOPE_AGENT); }
__device__ __forceinline__ unsigned xb_add(unsigned* p, unsigned v) { return __hip_atomic_fetch_add(p, v, __ATOMIC_RELAXED, __HIP_MEMORY_SCOPE_AGENT); }
__device__ __forceinline__ unsigned xb_xcc_id() { return (unsigned)__builtin_amdgcn_s_getreg((3 << 11) | 20) & 0xFu; }
#define XB_SPIN(cond, bar) do { unsigned _sp = 0; while (cond) { __builtin_amdgcn_s_sleep(1); \
    if ((++_sp & 255u) == 0u) { if (xb_ld(&(bar)[XB_TMO])) break; if (_sp > XB_SPIN_CAP) { atomicAdd(&(bar)[XB_TMO], 1u); break; } } } } while (0)
struct XcdBarrier { unsigned* bar; unsigned x; volatile LAS unsigned* st; };
__device__ __forceinline__ XcdBarrier xcd_barrier_post(unsigned* bar, volatile LAS unsigned* st) {
    XcdBarrier b; b.bar = bar; b.x = xb_xcc_id(); b.st = st;
    if (threadIdx.x == 0) (void)xb_add(&bar[XB_XCNT(b.x)], 1u);
    return b;
}
__device__ __forceinline__ void xcd_barrier_complete(unsigned* bar, unsigned x, unsigned& nloc, unsigned& nx) {
    const unsigned G = gridDim.x * gridDim.y * gridDim.z;
    unsigned sum, cnt, mine, sp = 0u;
    for (;;) {
        sum = 0u; cnt = 0u; mine = 0u;
#pragma unroll
        for (unsigned j = 0; j < 16; ++j) { const unsigned c = xb_ld(&bar[XB_XCNT(j)]); sum += c; cnt += (c > 0u) ? 1u : 0u; mine = (j == x) ? c : mine; }
        if (sum == G) break;
        __builtin_amdgcn_s_sleep(1);
        if ((++sp & 255u) == 0u) { if (xb_ld(&bar[XB_TMO])) break; if (sp > XB_SPIN_CAP) { atomicAdd(&bar[XB_TMO], 1u); break; } }
    }
    nloc = mine > 0u ? mine : 1u; nx = cnt > 0u ? cnt : 1u;
}
__device__ __forceinline__ void xcd_barrier(const XcdBarrier& b) {
    asm volatile("s_waitcnt vmcnt(0)" ::: "memory");
    __syncthreads();
    if (threadIdx.x == 0) {
        unsigned* bar = b.bar;
        __builtin_amdgcn_s_waitcnt(0);
        unsigned nloc = b.st[0], nx = b.st[1];
        if (nloc == 0u) { xcd_barrier_complete(bar, b.x, nloc, nx); b.st[0] = nloc; b.st[1] = nx; }
        const unsigned old = xb_add(&bar[XB_XSUB(b.x)], 1u);
        const unsigned gen = old / nloc;
        if (old + 1u == (gen + 1u) * nloc) {
            __builtin_amdgcn_fence(__ATOMIC_RELEASE, "agent");
            asm volatile("s_waitcnt vmcnt(0)" ::: "memory");
            const unsigned og = xb_add(&bar[XB_TOP], 1u);
            const unsigned tg = og / nx;
            if (og + 1u == (tg + 1u) * nx) xb_add(&bar[XB_TOPGEN], 1u);
            else XB_SPIN(xb_ld(&bar[XB_TOPGEN]) == tg, bar);
            __builtin_amdgcn_fence(__ATOMIC_ACQUIRE, "agent");
            xb_add(&bar[XB_XGEN(b.x)], 1u);
            asm volatile("s_waitcnt vmcnt(0)" ::: "memory");
        } else {
            XB_SPIN(xb_ld(&bar[XB_XGEN(b.x)]) == gen, bar);
            __builtin_amdgcn_fence(__ATOMIC_ACQUIRE, "agent");
            asm volatile("s_waitcnt vmcnt(0)" ::: "memory");
        }
    }
    __syncthreads();
}

struct Frame {
    LAS unsigned char* lds; volatile LAS unsigned* MISC; gu32* ctl;
    int tid, lane, wave, vcu, G;
    const float *x, *norm1_g, *w_in, *b_in, *sinks, *attn_g, *lb_logits, *hgrn_g, *w_out, *b_out, *norm2_g, *router_w, *router_b, *w1, *b1, *w2, *b2, *final_g;
    float* out; unsigned char* ws;
};
#define WSP(type, off) ((type*)(F.ws + (off)))

__device__ __forceinline__ int w1col(int n) { const int pn = n >> 8, cl = n & 255; return cl < 128 ? 2 * (128 * pn + cl) : 2 * (128 * pn + cl - 128) + 1; }
template <bool W1MAP>
__device__ __forceinline__ void p0_transpose_item(const float* W, int K, int N, bf16_t* WT, LAS float* scr, int item, int lane) {
    const int nblk = N / 32, kb = item / nblk, nb = item % nblk, k0 = 64 * kb, n0 = 32 * nb;
    const int sc = W1MAP ? w1col(n0 + (lane & 31)) : n0 + (lane & 31);
#pragma unroll 8
    for (int i = 0; i < 32; ++i) { const int kk = 2 * i + (lane >> 5); scr[kk * 33 + (lane & 31)] = W[(size_t)(k0 + kk) * N + sc]; }
    LDS_WAIT(); asm volatile("" ::: "memory");
    const int c = lane & 7;
#pragma unroll
    for (int j = 0; j < 4; ++j) { const int n = (lane >> 3) + 8 * j; const LAS float* s = scr + (8 * c) * 33 + n;
        u32x4 o; o.x = pg8::cvt_pk_bf16(s[0 * 33], s[1 * 33]); o.y = pg8::cvt_pk_bf16(s[2 * 33], s[3 * 33]); o.z = pg8::cvt_pk_bf16(s[4 * 33], s[5 * 33]); o.w = pg8::cvt_pk_bf16(s[6 * 33], s[7 * 33]);
        *(GAS u32x4*)(WT + (size_t)(n0 + n) * K + k0 + 8 * c) = o; }
    LDS_WAIT(); asm volatile("" ::: "memory");
}
__device__ __forceinline__ void p_prologue(Frame& F) {
    LAS float* scr = (LAS float*)(F.lds + RING_OFF + F.wave * 16384);
    const int gw = F.vcu * NWAVES + F.wave, NGW = F.G * NWAVES;
    constexpr int I_IN = (DM / 64) * (INW / 32), I_OUT = (MIXW / 64) * (DM / 32), I_W1E = (DM / 64) * (2 * FF / 32), I_W2E = (FF / 64) * (DM / 32);
    constexpr int NITEMS = I_IN + I_OUT + NE * I_W1E + NE * I_W2E;
    bf16_t *WinT = WSP(bf16_t, WS_WINT), *WoutT = WSP(bf16_t, WS_WOUTT), *W1T = WSP(bf16_t, WS_W1T), *W2T = WSP(bf16_t, WS_W2T);
    for (int it = gw; it < NITEMS; it += NGW) {
        int r = it;
        if (r < I_IN) { p0_transpose_item<false>(F.w_in, DM, INW, WinT, scr, r, F.lane); continue; } r -= I_IN;
        if (r < I_OUT) { p0_transpose_item<false>(F.w_out, MIXW, DM, WoutT, scr, r, F.lane); continue; } r -= I_OUT;
        if (r < NE * I_W1E) { const int e = r / I_W1E; p0_transpose_item<true>(F.w1 + (size_t)e * DM * 2 * FF, DM, 2 * FF, W1T + (size_t)e * 2 * FF * DM, scr, r % I_W1E, F.lane); continue; } r -= NE * I_W1E;
        { const int e = r / I_W2E; p0_transpose_item<false>(F.w2 + (size_t)e * FF * DM, FF, DM, W2T + (size_t)e * DM * FF, scr, r % I_W2E, F.lane); }
    }
    bf16_t* XN = WSP(bf16_t, WS_XN);
    for (int m = gw; m < T; m += NGW) {
        const GAS f32x4* xr = (const GAS f32x4*)(F.x + (size_t)m * DM) + F.lane;
        f32x4 v[4]; float s = 0.f;
#pragma unroll
        for (int j = 0; j < 4; ++j) { v[j] = xr[64 * j]; s += (v[j].x * v[j].x + v[j].y * v[j].y) + (v[j].z * v[j].z + v[j].w * v[j].w); }
        const float r = rsqrtf(wave_sum(s) * (1.f / DM) + EPS);
        GAS u32x2* o8 = (GAS u32x2*)(XN + (size_t)m * DM) + F.lane;
#pragma unroll
        for (int j = 0; j < 4; ++j) { const f32x4 g = *((const f32x4*)F.norm1_g + F.lane + 64 * j); u32x2 w; w.x = pg8::cvt_pk_bf16(v[j].x * r * g.x, v[j].y * r * g.y); w.y = pg8::cvt_pk_bf16(v[j].z * r * g.z, v[j].w * r * g.w); o8[64 * j] = w; }
    }
    if (blockIdx.x == 0) { float* LB = WSP(float, WS_LB); for (int c = F.tid; c < HKW; c += NWAVES * 64) { const float a = F.lb_logits[c], b = F.lb_logits[HKW + c]; LB[c] = 1.f / (1.f + __expf(b - a)); } }
}

__device__ __forceinline__ void p_router(Frame& F) {
    LAS int* lcnt = (LAS int*)(F.lds + MOE_OFF + 512); LAS int* lbase = (LAS int*)(F.lds + MOE_OFF + 768);
    const float* X1 = WSP(float, WS_X1); bf16_t* H2 = WSP(bf16_t, WS_H2); float* GATE = WSP(float, WS_GATE); int* LIST = WSP(int, WS_LIST);
    int* cnt = (int*)(F.ctl + CW_CNT);
    for (int tb = blockIdx.x; tb < T / 64; tb += F.G) {
        if (F.tid < NE) lcnt[F.tid] = 0;
        __syncthreads();
        int my_e[8], my_p[8];
#pragma unroll
        for (int i = 0; i < 8; ++i) {
            const int t = tb * 64 + F.wave * 8 + i;
            const GAS f32x4* xr = (const GAS f32x4*)(X1 + (size_t)t * DM) + F.lane;
            f32x4 v[4]; float s = 0.f;
#pragma unroll
            for (int j = 0; j < 4; ++j) { v[j] = xr[64 * j]; s += (v[j].x * v[j].x + v[j].y * v[j].y) + (v[j].z * v[j].z + v[j].w * v[j].w); }
            const float r = rsqrtf(wave_sum(s) * (1.f / DM) + EPS);
            GAS u32x2* o8 = (GAS u32x2*)(H2 + (size_t)t * DM) + F.lane;
#pragma unroll
            for (int j = 0; j < 4; ++j) { const f32x4 g = *((const f32x4*)F.norm2_g + F.lane + 64 * j); v[j].x *= r * g.x; v[j].y *= r * g.y; v[j].z *= r * g.z; v[j].w *= r * g.w;
                u32x2 w; w.x = pg8::cvt_pk_bf16(v[j].x, v[j].y); w.y = pg8::cvt_pk_bf16(v[j].z, v[j].w); o8[64 * j] = w; }
            float mine = -INFINITY;
#pragma unroll 1
            for (int eg = 0; eg < NE; eg += 8) {
                float lg[8];
#pragma unroll
                for (int q = 0; q < 8; ++q) lg[q] = 0.f;
#pragma unroll
                for (int j = 0; j < 4; ++j)
#pragma unroll
                    for (int cidx = 0; cidx < 4; ++cidx) {
                        const float* w = F.router_w + (size_t)(4 * F.lane + 256 * j + cidx) * NE + eg;
                        const f32x4 w0 = *(const f32x4*)w, w1 = *(const f32x4*)(w + 4); const float h = v[j][cidx];
#pragma unroll
                        for (int q = 0; q < 4; ++q) { lg[q] += h * w0[q]; lg[4 + q] += h * w1[q]; }
                    }
#pragma unroll
                for (int q = 0; q < 8; ++q) { const float sm = wave_sum(lg[q]) + F.router_b[eg + q]; if (F.lane == eg + q) mine = sm; }
            }
            float tv[TOPK]; int te[TOPK];
#pragma unroll
            for (int k = 0; k < TOPK; ++k) {
                float bv = mine; int bi = F.lane;
#pragma unroll
                for (int o = 1; o < 64; o <<= 1) { const float ov = __shfl_xor(bv, o); const int oi = __shfl_xor(bi, o); if (ov > bv || (ov == bv && oi < bi)) { bv = ov; bi = oi; } }
                tv[k] = bv; te[k] = bi; if (F.lane == bi) mine = -INFINITY;
            }
            const float e1 = __expf(tv[1] - tv[0]), e2 = __expf(tv[2] - tv[0]), e3 = __expf(tv[3] - tv[0]), inv = 1.f / (1.f + e1 + e2 + e3);
            my_e[i] = 0; my_p[i] = 0;
            if (F.lane < TOPK) {
                const float gk = (F.lane == 0 ? 1.f : F.lane == 1 ? e1 : F.lane == 2 ? e2 : e3) * inv;
                const int ek = F.lane == 0 ? te[0] : F.lane == 1 ? te[1] : F.lane == 2 ? te[2] : te[3];
                GATE[t * TOPK + F.lane] = gk;
                my_e[i] = ek; my_p[i] = __hip_atomic_fetch_add(&lcnt[ek], 1, __ATOMIC_RELAXED, __HIP_MEMORY_SCOPE_WORKGROUP);
            }
        }
        __syncthreads();
        if (F.tid < NE) lbase[F.tid] = atomicAdd(&cnt[F.tid], (int)lcnt[F.tid]);
        __syncthreads();
        if (F.lane < TOPK) {
#pragma unroll
            for (int i = 0; i < 8; ++i) { const int t = tb * 64 + F.wave * 8 + i; LIST[(size_t)my_e[i] * T + lbase[my_e[i]] + my_p[i]] = t * TOPK + F.lane; }
        }
        __syncthreads();
    }
}
__device__ __forceinline__ void moe_setup(Frame& F) {
    LAS int* pre = (LAS int*)(F.lds + MOE_OFF); LAS int* lc = (LAS int*)(F.lds + MOE_OFF + 256);
    if (F.tid < 64) {
        const int c = F.lane < NE ? (int)__hip_atomic_load((int*)(F.ctl + CW_CNT) + F.lane, RLX_AGENT) : 0;
        int s = (c + 255) >> 8;
#pragma unroll
        for (int o = 1; o < 32; o <<= 1) { const int v = __shfl_up(s, o); if ((F.lane & 31) >= o) s += v; }
        if (F.lane < NE) { pre[F.lane + 1] = s; lc[F.lane] = c; }
        if (F.lane == 0) pre[0] = 0;
    }
    __syncthreads();
}
__device__ __forceinline__ void p_final(Frame& F) {
    const float* X1 = WSP(float, WS_X1); const bf16_t* Y = WSP(bf16_t, WS_Y);
    const int gw = F.vcu * NWAVES + F.wave, NGW = F.G * NWAVES;
    for (int t = gw; t < T; t += NGW) {
        const GAS f32x4* xr = (const GAS f32x4*)(X1 + (size_t)t * DM) + F.lane;
        f32x4 v[4]; float s = 0.f;
#pragma unroll
        for (int j = 0; j < 4; ++j) {
            v[j] = xr[64 * j];
#pragma unroll
            for (int k = 0; k < TOPK; ++k) { const u32x2 y = *((const GAS u32x2*)(Y + ((size_t)t * TOPK + k) * DM) + F.lane + 64 * j);
                v[j].x += __builtin_bit_cast(float, y.x << 16); v[j].y += __builtin_bit_cast(float, y.x & 0xffff0000u); v[j].z += __builtin_bit_cast(float, y.y << 16); v[j].w += __builtin_bit_cast(float, y.y & 0xffff0000u); }
            s += (v[j].x * v[j].x + v[j].y * v[j].y) + (v[j].z * v[j].z + v[j].w * v[j].w);
        }
        const float r = rsqrtf(wave_sum(s) * (1.f / DM) + EPS);
        GAS f32x4* o = (GAS f32x4*)(F.out + (size_t)t * DM) + F.lane;
#pragma unroll
        for (int j = 0; j < 4; ++j) { const f32x4 g = *((const f32x4*)F.final_g + F.lane + 64 * j); o[64 * j] = (f32x4){v[j].x * r * g.x, v[j].y * r * g.y, v[j].z * r * g.z, v[j].w * r * g.w}; }
    }
}


__device__ __forceinline__ void p_attn_simple(Frame& F) {
    const bf16_t* AQ = WSP(bf16_t, WS_AQ); const bf16_t* AK = WSP(bf16_t, WS_AK); const bf16_t* AV = WSP(bf16_t, WS_AV); float* ATT = WSP(float, WS_ATT);
    const int gw0 = F.vcu * NWAVES + F.wave, NGW = F.G * NWAVES, lane = F.lane;
    for (int gw = gw0; gw < T * 8; gw += NGW) {
        const int t = gw >> 3, hq = gw & 7, kvh = hq >> 2, b = t / SEQ, tp = t % SEQ;
        const float slope = exp2f(-(float)(hq + 1)), sink = F.sinks[hq];
        const float qd = bf2f(AQ[(size_t)t * AW + hq * 64 + lane]);
        const int s0 = tp >= 127 ? tp - 127 : 0, nk = tp - s0 + 1;
        const bf16_t* kb = AK + ((size_t)b * SEQ + s0) * AKW + kvh * 64 + lane;
        const bf16_t* vb = AV + ((size_t)b * SEQ + s0) * AKW + kvh * 64 + lane;
        float slo = -INFINITY, shi = -INFINITY;
        for (int i = 0; i < nk; ++i) {
            const float d = wave_sum(qd * bf2f(kb[(size_t)i * AKW]));
            const float sc = d * 0.125f - slope * (float)(tp - (s0 + i));
            if ((i & 63) == lane) { if (i < 64) slo = sc; else shi = sc; }
        }
        const float m = fmaxf(wave_max(fmaxf(slo, shi)), sink);
        const float plo = __expf(slo - m), phi = __expf(shi - m);
        const float den = wave_sum(plo + phi) + __expf(sink - m);
        float o = 0.f;
        for (int i = 0; i < nk; ++i) { const float p = __shfl(i < 64 ? plo : phi, i & 63); o += p * bf2f(vb[(size_t)i * AKW]); }
        ATT[(size_t)t * AW + hq * 64 + lane] = o / den;
    }
}
__device__ __forceinline__ void p_hgrn_simple(Frame& F) {
    constexpr int TT = 16;
    LAS float* sf = (LAS float*)(F.lds); LAS float* sk = sf + TT * 128; LAS float* sq = sk + TT * 128; LAS float* po = sq + TT * 128;
    const bf16_t* HQ = WSP(bf16_t, WS_HQ); const float* G = WSP(float, WS_G); const bf16_t* KK = WSP(bf16_t, WS_KK); const bf16_t* HI = WSP(bf16_t, WS_HI); float* ORAW = WSP(float, WS_ORAW);
    for (int u = blockIdx.x; u < BATCH * 4; u += F.G) {
        const int b = u >> 2, h = u & 3, v = F.tid & 127, kq = F.tid >> 7;
        float S[32];
#pragma unroll
        for (int k = 0; k < 32; ++k) S[k] = 0.f;
        for (int t0 = 0; t0 < SEQ; t0 += TT) {
            __syncthreads();
            for (int i = F.tid; i < TT * 128; i += NWAVES * 64) {
                const int tt = i >> 7, k = i & 127; const size_t idx = ((size_t)b * SEQ + t0 + tt) * HKW + h * 128 + k;
                sf[i] = __expf(G[idx]); sk[i] = bf2f(KK[idx]); sq[i] = bf2f(HQ[idx]);
            }
            __syncthreads();
            for (int tt = 0; tt < TT; ++tt) {
                const float vv = bf2f(HI[((size_t)b * SEQ + t0 + tt) * HW + h * 128 + v]);
                float o = 0.f;
#pragma unroll
                for (int k = 0; k < 32; ++k) { const int kk = tt * 128 + kq * 32 + k; S[k] = sf[kk] * S[k] + sk[kk] * vv; o += sq[kk] * S[k]; }
                po[(tt * 4 + kq) * 128 + v] = o;
            }
            __syncthreads();
            for (int i = F.tid; i < TT * 128; i += NWAVES * 64) {
                const int tt = i >> 7, vv = i & 127;
                ORAW[((size_t)b * SEQ + t0 + tt) * HW + h * 128 + vv] = (po[(tt * 4 + 0) * 128 + vv] + po[(tt * 4 + 1) * 128 + vv]) + (po[(tt * 4 + 2) * 128 + vv] + po[(tt * 4 + 3) * 128 + vv]);
            }
        }
        __syncthreads();
    }
}
__device__ __forceinline__ void p_mix_simple(Frame& F, bool do_attn, bool do_hgrn) {
    const float* ATT = WSP(float, WS_ATT); const float* ORAW = WSP(float, WS_ORAW); const bf16_t* HG = WSP(bf16_t, WS_HG); bf16_t* MIX = WSP(bf16_t, WS_MIX);
    const int gw0 = F.vcu * NWAVES + F.wave, NGW = F.G * NWAVES, lane = F.lane;
    for (int t = gw0; t < T; t += NGW) {
        if (do_attn) {
        float a[8]; float ss = 0.f;
#pragma unroll
        for (int j = 0; j < 8; ++j) { a[j] = ATT[(size_t)t * AW + lane + 64 * j]; ss += a[j] * a[j]; }
        const float r = rsqrtf(wave_sum(ss) * (1.f / AW) + EPS);
#pragma unroll
        for (int j = 0; j < 8; ++j) MIX[(size_t)t * MIXW + lane + 64 * j] = f2bf(a[j] * r * F.attn_g[lane + 64 * j]);
        }
        if (do_hgrn)
#pragma unroll
        for (int h = 0; h < 4; ++h) {
            const int c0 = h * 128 + lane, c1 = c0 + 64;
            const float o0 = ORAW[(size_t)t * HW + c0], o1 = ORAW[(size_t)t * HW + c1];
            const float rr = rsqrtf(wave_sum(o0 * o0 + o1 * o1) * (1.f / 128.f) + EPS);
            MIX[(size_t)t * MIXW + AW + c0] = f2bf(o0 * rr * F.hgrn_g[c0] * bf2f(HG[(size_t)t * HW + c0]));
            MIX[(size_t)t * MIXW + AW + c1] = f2bf(o1 * rr * F.hgrn_g[c1] * bf2f(HG[(size_t)t * HW + c1]));
        }
    }
}

typedef float f32x16 __attribute__((ext_vector_type(16)));
typedef __bf16 bf16x2_t __attribute__((ext_vector_type(2)));
__device__ __forceinline__ unsigned cvtpk(float lo, float hi) { f32x2 v = {lo, hi}; bf16x2_t b = __builtin_convertvector(v, bf16x2_t); return __builtin_bit_cast(unsigned, b); }
__device__ __forceinline__ int crow(int reg, int h) { return (reg & 3) + 8 * (reg >> 2) + 4 * h; }
__device__ __forceinline__ float bflo(unsigned u) { return __builtin_bit_cast(float, u << 16); }
__device__ __forceinline__ float bfhi(unsigned u) { return __builtin_bit_cast(float, u & 0xffff0000u); }
__device__ __forceinline__ bf16x8 pack_step(const f32x16& x, int s) {
    u32x4 p; p.x = cvtpk(x[8 * s], x[8 * s + 1]); p.y = cvtpk(x[8 * s + 2], x[8 * s + 3]); p.z = cvtpk(x[8 * s + 4], x[8 * s + 5]); p.w = cvtpk(x[8 * s + 6], x[8 * s + 7]);
    return __builtin_bit_cast(bf16x8, p);
}
#define MFMA32(a, b, c) __builtin_amdgcn_mfma_f32_32x32x16_bf16((a), (b), (c), 0, 0, 0)
#define MFMA16(a, b, c) __builtin_amdgcn_mfma_f32_16x16x32_bf16((a), (b), (c), 0, 0, 0)

__device__ __forceinline__ void p_hgrn_prep(Frame& F) {
    constexpr int GP = 132, QP = 136, VP = 72, AP = 72;
    LAS float* Gs = (LAS float*)F.lds;
    LAS bf16_t* Qs = (LAS bf16_t*)(F.lds + 33792);
    LAS bf16_t* Ks = (LAS bf16_t*)(F.lds + 33792 + 17408);
    LAS bf16_t* Vt = (LAS bf16_t*)(F.lds + 33792 + 2 * 17408);
    LAS bf16_t* At = (LAS bf16_t*)(F.lds + 33792 + 2 * 17408 + 18432);
    LAS float* Tot = (LAS float*)(F.lds + 96256);
    LAS float* Bl = Tot + 8 * 128;
    const bf16_t* HQ = WSP(bf16_t, WS_HQ); const float* G = WSP(float, WS_G); const bf16_t* KK = WSP(bf16_t, WS_KK); const bf16_t* HI = WSP(bf16_t, WS_HI);
    bf16_t* QF = WSP(bf16_t, WS_QF); bf16_t* KF = WSP(bf16_t, WS_KF); bf16_t* VF = WSP(bf16_t, WS_VF); bf16_t* INTRA = WSP(bf16_t, WS_INTRA); float* DEC = WSP(float, WS_DEC);
    const int tid = F.tid, lane = F.lane, w = F.wave, r = lane & 31, h = lane >> 5, fr = lane & 15, fq = lane >> 4;
    for (int ch = blockIdx.x; ch < BATCH * 4 * 32; ch += F.G) {
        const int bh = ch >> 5, c = ch & 31, b = bh >> 2, hd = bh & 3;
        const size_t t0 = (size_t)b * SEQ + 64 * c; const int col0 = hd * 128;
#pragma unroll
        for (int i = 0; i < 4; ++i) { const int idx = tid + 512 * i, row = idx >> 5, c4 = idx & 31; *(LAS f32x4*)(Gs + row * GP + 4 * c4) = *(const f32x4*)(G + (t0 + row) * HKW + col0 + 4 * c4); }
#pragma unroll
        for (int i = 0; i < 2; ++i) { const int idx = tid + 512 * i, row = idx >> 4, c8 = idx & 15; const size_t go = (t0 + row) * HKW + col0 + 8 * c8;
            *(LAS u32x4*)(Qs + row * QP + 8 * c8) = *(const u32x4*)(HQ + go); *(LAS u32x4*)(Ks + row * QP + 8 * c8) = *(const u32x4*)(KK + go);
            const u32x4 vv = *(const u32x4*)(HI + go);
#pragma unroll
            for (int q = 0; q < 4; ++q) { Vt[(8 * c8 + 2 * q) * VP + row] = (bf16_t)(vv[q] & 0xffffu); Vt[(8 * c8 + 2 * q + 1) * VP + row] = (bf16_t)(vv[q] >> 16); } }
        for (int i = tid; i < 64 * AP / 8; i += 512) *(LAS u32x4*)(At + 8 * i) = (u32x4){0u, 0u, 0u, 0u};
        __syncthreads();
#pragma unroll
        for (int q = 0; q < 2; ++q) { const int kk = lane + 64 * q; float run = 0.f;
#pragma unroll
            for (int i = 0; i < 8; ++i) { run += Gs[(8 * w + i) * GP + kk]; Gs[(8 * w + i) * GP + kk] = run; }
            Tot[w * 128 + kk] = run; }
        __syncthreads();
#pragma unroll
        for (int q = 0; q < 2; ++q) { const int kk = lane + 64 * q; float off = 0.f, tot = 0.f;
#pragma unroll
            for (int i = 0; i < 8; ++i) { const float tv = Tot[i * 128 + kk]; tot += tv; if (i < w) off += tv; }
#pragma unroll
            for (int i = 0; i < 8; ++i) Gs[(8 * w + i) * GP + kk] += off;
            if (w == 0) Bl[kk] = tot; }
        __syncthreads();
#pragma unroll
        for (int q = 0; q < 2; ++q) {
            const int f = w + 8 * q;
            {
                const int tt = f >> 3, kt = (f >> 1) & 3, ks = f & 1, t = 32 * tt + r, kb = 32 * kt + 16 * ks + 4 * h;
                const u32x2 qa = *(const LAS u32x2*)(Qs + t * QP + kb), qb = *(const LAS u32x2*)(Qs + t * QP + kb + 8);
                const f32x4 ba = *(const LAS f32x4*)(Gs + t * GP + kb), bb = *(const LAS f32x4*)(Gs + t * GP + kb + 8);
                u32x4 o; o.x = cvtpk(bflo(qa.x) * __expf(ba[0]), bfhi(qa.x) * __expf(ba[1])); o.y = cvtpk(bflo(qa.y) * __expf(ba[2]), bfhi(qa.y) * __expf(ba[3]));
                o.z = cvtpk(bflo(qb.x) * __expf(bb[0]), bfhi(qb.x) * __expf(bb[1])); o.w = cvtpk(bflo(qb.y) * __expf(bb[2]), bfhi(qb.y) * __expf(bb[3]));
                *(u32x4*)(QF + (((size_t)ch * 16 + f) * 64 + lane) * 8) = o;
            }
            {
                const int kt = f >> 2, ss = f & 3, kc = 32 * kt + r, s0 = 16 * ss + 8 * h; const float bl = Bl[kc];
                float v[8];
#pragma unroll
                for (int j = 0; j < 8; ++j) v[j] = bf2f(Ks[(s0 + j) * QP + kc]) * __expf(bl - Gs[(s0 + j) * GP + kc]);
                u32x4 o; o.x = cvtpk(v[0], v[1]); o.y = cvtpk(v[2], v[3]); o.z = cvtpk(v[4], v[5]); o.w = cvtpk(v[6], v[7]);
                *(u32x4*)(KF + (((size_t)ch * 16 + f) * 64 + lane) * 8) = o;
            }
            {
                const int ss = f >> 2, dt = f & 3;
                *(u32x4*)(VF + (((size_t)ch * 16 + f) * 64 + lane) * 8) = *(const LAS u32x4*)(Vt + (32 * dt + r) * VP + 16 * ss + 8 * h);
            }
        }
        if (tid < 128) DEC[(size_t)ch * 128 + tid] = __expf(Bl[tid]);
        {
            const int i = w >> 1;
            for (int j = w & 1; j <= i; j += 2) {
                f32x4 acc = {0.f, 0.f, 0.f, 0.f};
                const int t = 16 * i + fr, s = 16 * j + fr;
#pragma unroll
                for (int k4 = 0; k4 < 4; ++k4) {
                    const int k0 = 32 * k4 + 8 * fq;
                    f32x4 r0 = {0.f, 0.f, 0.f, 0.f}, r1 = {0.f, 0.f, 0.f, 0.f};
                    if (i > 0) { r0 = *(const LAS f32x4*)(Gs + (16 * i - 1) * GP + k0); r1 = *(const LAS f32x4*)(Gs + (16 * i - 1) * GP + k0 + 4); }
                    const u32x4 q8 = *(const LAS u32x4*)(Qs + t * QP + k0), k8 = *(const LAS u32x4*)(Ks + s * QP + k0);
                    const f32x4 bt0 = *(const LAS f32x4*)(Gs + t * GP + k0), bt1 = *(const LAS f32x4*)(Gs + t * GP + k0 + 4);
                    const f32x4 bs0 = *(const LAS f32x4*)(Gs + s * GP + k0), bs1 = *(const LAS f32x4*)(Gs + s * GP + k0 + 4);
                    u32x4 a, bb;
                    a.x = cvtpk(bflo(q8.x) * __expf(bt0[0] - r0[0]), bfhi(q8.x) * __expf(bt0[1] - r0[1])); a.y = cvtpk(bflo(q8.y) * __expf(bt0[2] - r0[2]), bfhi(q8.y) * __expf(bt0[3] - r0[3]));
                    a.z = cvtpk(bflo(q8.z) * __expf(bt1[0] - r1[0]), bfhi(q8.z) * __expf(bt1[1] - r1[1])); a.w = cvtpk(bflo(q8.w) * __expf(bt1[2] - r1[2]), bfhi(q8.w) * __expf(bt1[3] - r1[3]));
                    bb.x = cvtpk(bflo(k8.x) * __expf(r0[0] - bs0[0]), bfhi(k8.x) * __expf(r0[1] - bs0[1])); bb.y = cvtpk(bflo(k8.y) * __expf(r0[2] - bs0[2]), bfhi(k8.y) * __expf(r0[3] - bs0[3]));
                    bb.z = cvtpk(bflo(k8.z) * __expf(r1[0] - bs1[0]), bfhi(k8.z) * __expf(r1[1] - bs1[1])); bb.w = cvtpk(bflo(k8.w) * __expf(r1[2] - bs1[2]), bfhi(k8.w) * __expf(r1[3] - bs1[3]));
                    acc = MFMA16(__builtin_bit_cast(bf16x8, a), __builtin_bit_cast(bf16x8, bb), acc);
                }
#pragma unroll
                for (int q = 0; q < 4; ++q) { const float v = (j < i || (4 * fq + q) >= fr) ? acc[q] : 0.f; At[(16 * i + 4 * fq + q) * AP + 16 * j + fr] = f2bf(v); }
            }
        }
        __syncthreads();
        {
            const int tt = w & 1, dt = w >> 1;
            f32x16 acc;
#pragma unroll
            for (int q = 0; q < 16; ++q) acc[q] = 0.f;
#pragma unroll
            for (int ss = 0; ss < 4; ++ss) if (ss < 2 * (tt + 1)) {
                const bf16x8 a = *(const LAS bf16x8*)(At + (32 * tt + r) * AP + 16 * ss + 8 * h), bv = *(const LAS bf16x8*)(Vt + (32 * dt + r) * VP + 16 * ss + 8 * h);
                acc = MFMA32(a, bv, acc);
            }
#pragma unroll
            for (int q = 0; q < 16; ++q) INTRA[(t0 + 32 * tt + crow(q, h)) * HW + col0 + 32 * dt + r] = f2bf(acc[q]);
        }
        __syncthreads();
    }
}

constexpr int SC_OPB = 0, SC_OBUF = 65536, SC_OBP = 132, SC_OBB = 64 * SC_OBP * 4, SC_DEC = SC_OBUF + 2 * SC_OBB;
__device__ __forceinline__ void scan_unit(Frame& F, int bh) {
    const bf16_t* QF = WSP(bf16_t, WS_QF); const bf16_t* KF = WSP(bf16_t, WS_KF); const bf16_t* VF = WSP(bf16_t, WS_VF); const bf16_t* INTRA = WSP(bf16_t, WS_INTRA); const float* DEC = WSP(float, WS_DEC);
    const bf16_t* HG = WSP(bf16_t, WS_HG); bf16_t* MIX = WSP(bf16_t, WS_MIX);
    const int tid = F.tid, lane = F.lane, w = F.wave, r = lane & 31, h = lane >> 5, tt = w & 1, d = w >> 1, b = bh >> 2, hd = bh & 3;
    LAS unsigned char* lds = F.lds;
    f32x16 S[4];
#pragma unroll
    for (int kt = 0; kt < 4; ++kt)
#pragma unroll
        for (int q = 0; q < 16; ++q) S[kt][q] = 0.f;
#define SC_DMA(c_) do { const size_t chn = (size_t)bh * 32 + (c_); const int slot = ((c_) & 1) * 32768; _Pragma("unroll") for (int i_ = 0; i_ < 2; ++i_) { \
        __builtin_amdgcn_global_load_lds((const unsigned*)(QF + ((chn * 16 + 2 * w + i_) * 64 + lane) * 8), (LAS unsigned*)(lds + SC_OPB + slot + (2 * w + i_) * 1024), 16, 0, 0); \
        __builtin_amdgcn_global_load_lds((const unsigned*)(KF + ((chn * 16 + 2 * w + i_) * 64 + lane) * 8), (LAS unsigned*)(lds + SC_OPB + slot + 16384 + (2 * w + i_) * 1024), 16, 0, 0); } \
        } while (0)
#define SC_DEC_LD(c_) (*(const f32x4*)(DEC + ((size_t)bh * 32 + (c_)) * 128 + (tid & 31) * 4))
#define SC_DEC_ST(c_, v_) do { if (tid < 32) *(LAS f32x4*)(lds + SC_DEC + ((c_) & 1) * 512 + tid * 16) = (v_); } while (0)
    bf16x8 Vf[4], Vn[4];
#pragma unroll
    for (int ss = 0; ss < 4; ++ss) Vf[ss] = *(const bf16x8*)(VF + ((((size_t)bh * 32) * 16 + ss * 4 + d) * 64 + lane) * 8);
    SC_DMA(0);
    { const f32x4 dv0 = SC_DEC_LD(0); SC_DEC_ST(0, dv0); }
    __syncthreads();
    const int ft = tid >> 3, fs = tid & 7;
    const int ocol = hd * 128 + 16 * fs;
    for (int c = 0; c < 32; ++c) {
        const int slot = (c & 1) * 32768;
        f32x4 dnext = {0.f, 0.f, 0.f, 0.f};
        if (c + 1 < 32) {
            SC_DMA(c + 1);
            dnext = SC_DEC_LD(c + 1);
#pragma unroll
            for (int ss = 0; ss < 4; ++ss) Vn[ss] = *(const bf16x8*)(VF + ((((size_t)bh * 32 + c + 1) * 16 + ss * 4 + d) * 64 + lane) * 8);
        }
        const size_t trow = (size_t)b * SEQ + 64 * c + ft;
        const u32x4 in0 = *(const u32x4*)(INTRA + trow * HW + ocol), in1 = *(const u32x4*)(INTRA + trow * HW + ocol + 8);
        const u32x4 hg0 = *(const u32x4*)(HG + trow * HW + ocol), hg1 = *(const u32x4*)(HG + trow * HW + ocol + 8);
        f32x16 P;
#pragma unroll
        for (int q = 0; q < 16; ++q) P[q] = 0.f;
#pragma unroll
        for (int kt = 0; kt < 4; ++kt)
#pragma unroll
            for (int ks = 0; ks < 2; ++ks) {
                const bf16x8 qf = *(const LAS bf16x8*)(lds + SC_OPB + slot + ((tt * 4 + kt) * 2 + ks) * 1024 + lane * 16);
                P = MFMA32(qf, pack_step(S[kt], ks), P);
            }
        {   LAS float* ob = (LAS float*)(lds + SC_OBUF + (c & 1) * SC_OBB);
#pragma unroll
            for (int q = 0; q < 16; ++q) ob[(32 * tt + crow(q, h)) * SC_OBP + 32 * d + r] = P[q]; }
#pragma unroll
        for (int kt = 0; kt < 4; ++kt) {
#pragma unroll
            for (int g = 0; g < 4; ++g) { const f32x4 dc = *(const LAS f32x4*)(lds + SC_DEC + (c & 1) * 512 + (32 * kt + 8 * g + 4 * h) * 4);
#pragma unroll
                for (int q = 0; q < 4; ++q) S[kt][4 * g + q] *= dc[q]; }
#pragma unroll
            for (int ss = 0; ss < 4; ++ss) {
                const bf16x8 kf = *(const LAS bf16x8*)(lds + SC_OPB + slot + 16384 + (kt * 4 + ss) * 1024 + lane * 16);
                S[kt] = MFMA32(kf, Vf[ss], S[kt]);
            }
        }
        SC_DEC_ST(c + 1, dnext);
        __syncthreads();
        {
            const LAS float* ob = (const LAS float*)(lds + SC_OBUF + (c & 1) * SC_OBB) + ft * SC_OBP + 16 * fs;
            const f32x4 p0 = *(const LAS f32x4*)ob, p1 = *(const LAS f32x4*)(ob + 4), p2 = *(const LAS f32x4*)(ob + 8), p3 = *(const LAS f32x4*)(ob + 12);
            float o[16];
            o[0] = p0[0] + bflo(in0.x); o[1] = p0[1] + bfhi(in0.x); o[2] = p0[2] + bflo(in0.y); o[3] = p0[3] + bfhi(in0.y);
            o[4] = p1[0] + bflo(in0.z); o[5] = p1[1] + bfhi(in0.z); o[6] = p1[2] + bflo(in0.w); o[7] = p1[3] + bfhi(in0.w);
            o[8] = p2[0] + bflo(in1.x); o[9] = p2[1] + bfhi(in1.x); o[10] = p2[2] + bflo(in1.y); o[11] = p2[3] + bfhi(in1.y);
            o[12] = p3[0] + bflo(in1.z); o[13] = p3[1] + bfhi(in1.z); o[14] = p3[2] + bflo(in1.w); o[15] = p3[3] + bfhi(in1.w);
            float ss2 = 0.f;
#pragma unroll
            for (int q = 0; q < 16; ++q) ss2 += o[q] * o[q];
            ss2 += __shfl_xor(ss2, 1); ss2 += __shfl_xor(ss2, 2); ss2 += __shfl_xor(ss2, 4);
            const float rs = rsqrtf(ss2 * (1.f / 128.f) + EPS);
            const float* gh = F.hgrn_g + ocol;
            const unsigned hgw[8] = {hg0.x, hg0.y, hg0.z, hg0.w, hg1.x, hg1.y, hg1.z, hg1.w};
            unsigned ow[8];
#pragma unroll
            for (int q = 0; q < 8; ++q) ow[q] = cvtpk(o[2 * q] * rs * gh[2 * q] * bflo(hgw[q]), o[2 * q + 1] * rs * gh[2 * q + 1] * bfhi(hgw[q]));
            bf16_t* mo = MIX + trow * MIXW + AW + ocol;
            *(u32x4*)mo = (u32x4){ow[0], ow[1], ow[2], ow[3]}; *(u32x4*)(mo + 8) = (u32x4){ow[4], ow[5], ow[6], ow[7]};
        }
#pragma unroll
        for (int ss = 0; ss < 4; ++ss) Vf[ss] = Vn[ss];
    }
    __syncthreads();
#undef SC_DMA
#undef SC_DEC_LD
#undef SC_DEC_ST
}

constexpr int AT_KP = 72, AT_VP = 260;
__device__ __forceinline__ void attn_stage(Frame& F, int kvh, int n, size_t t0, LAS bf16_t* Ks, LAS bf16_t* Vt) {
    const bf16_t* AK = WSP(bf16_t, WS_AK); const bf16_t* AV = WSP(bf16_t, WS_AV);
    __syncthreads();
    int tid_ = F.tid; asm volatile("" : "+v"(tid_));
#pragma unroll
    for (int i = 0; i < 4; ++i) {
        const int idx = tid_ + 512 * i, row = idx >> 3, c8 = idx & 7;
        u32x4 kv = {0u, 0u, 0u, 0u}, vv = {0u, 0u, 0u, 0u};
        if (n > 0 || row >= 128) { const size_t go = (t0 - 128 + row) * AKW + kvh * 64 + 8 * c8; kv = *(const u32x4*)(AK + go); vv = *(const u32x4*)(AV + go); }
        *(LAS u32x4*)(Ks + row * AT_KP + 8 * c8) = kv;
#pragma unroll
        for (int q = 0; q < 4; ++q) { Vt[(8 * c8 + 2 * q) * AT_VP + row] = (bf16_t)(vv[q] & 0xffffu); Vt[(8 * c8 + 2 * q + 1) * AT_VP + row] = (bf16_t)(vv[q] >> 16); }
    }
    __syncthreads();
}
__device__ __forceinline__ void attn_item(Frame& F, int hq, int rt, int n, size_t t0, const LAS bf16_t* Ks, const LAS bf16_t* Vt, LAS float* ssq, unsigned (&okp)[16]) {
    const bf16_t* AQ = WSP(bf16_t, WS_AQ);
    int lane = F.lane; asm volatile("" : "+v"(lane));
    const int r = lane & 31, h = lane >> 5;
    constexpr float L2E = 1.4426950408889634f;
    const float slope2 = exp2f(-(float)(hq + 1)) * L2E, sink2 = F.sinks[hq] * L2E;
    bf16x8 qf[4];
#pragma unroll
    for (int ds = 0; ds < 4; ++ds) qf[ds] = *(const bf16x8*)(AQ + (t0 + 32 * rt + r) * AW + hq * 64 + 16 * ds + 8 * h);
    float m = sink2;
#define AT_SCORE(SC, j) do { const int kt = rt + (j); int rq = r - 32 * (j); asm volatile("" : "+v"(rq));     \
        _Pragma("unroll") for (int q = 0; q < 16; ++q) SC[q] = 0.f; \
        _Pragma("unroll") for (int ds = 0; ds < 4; ++ds) SC = MFMA32(*(const LAS bf16x8*)(Ks + (32 * kt + r) * AT_KP + 16 * ds + 8 * h), qf[ds], SC); \
        const bool tile_ok = (n > 0) || (kt >= 4); \
        _Pragma("unroll") for (int q = 0; q < 16; ++q) { const int dist = 128 + rq - crow(q, h); const float v = SC[q] * (0.125f * L2E) - slope2 * (float)dist; \
            SC[q] = (tile_ok && dist >= 0 && dist < 128) ? v : -INFINITY; } } while (0)
#pragma unroll
    for (int j = 0; j < 5; ++j) { f32x16 sc; AT_SCORE(sc, j);
#pragma unroll
        for (int q = 0; q < 16; ++q) m = fmaxf(m, sc[q]); }
    m = fmaxf(m, __shfl_xor(m, 32));
    float l = 0.f; unsigned pp[5][8];
#pragma unroll
    for (int j = 0; j < 5; ++j) { f32x16 sc; AT_SCORE(sc, j);
#pragma unroll
        for (int q = 0; q < 16; ++q) { sc[q] = exp2f(sc[q] - m); l += sc[q]; }
#pragma unroll
        for (int q = 0; q < 8; ++q) pp[j][q] = cvtpk(sc[2 * q], sc[2 * q + 1]); }
#undef AT_SCORE
    l += __shfl_xor(l, 32); l += exp2f(sink2 - m);
    const float rl = 1.f / l;
    float sq = 0.f;
#pragma unroll
    for (int dt = 0; dt < 2; ++dt) {
        f32x16 o;
#pragma unroll
        for (int q = 0; q < 16; ++q) o[q] = 0.f;
        const LAS bf16_t* vrow = Vt + (32 * dt + r) * AT_VP + 4 * h;
#pragma unroll
        for (int j = 0; j < 5; ++j)
#pragma unroll
            for (int s = 0; s < 2; ++s) { const LAS bf16_t* vp = vrow + 32 * (rt + j) + 16 * s;
                const u32x2 va = *(const LAS u32x2*)vp, vb = *(const LAS u32x2*)(vp + 8); const u32x4 pa = {va.x, va.y, vb.x, vb.y};
                const u32x4 pb = {pp[j][4 * s], pp[j][4 * s + 1], pp[j][4 * s + 2], pp[j][4 * s + 3]};
                o = MFMA32(__builtin_bit_cast(bf16x8, pa), __builtin_bit_cast(bf16x8, pb), o); }
#pragma unroll
        for (int q = 0; q < 16; ++q) { o[q] *= rl; sq += o[q] * o[q]; }
#pragma unroll
        for (int q = 0; q < 8; ++q) okp[dt * 8 + q] = cvtpk(o[2 * q], o[2 * q + 1]);
    }
    sq += __shfl_xor(sq, 32);
    if (h == 0) __hip_atomic_fetch_add(&ssq[32 * rt + r], sq, __ATOMIC_RELAXED, __HIP_MEMORY_SCOPE_WORKGROUP);
}
__device__ __forceinline__ void attn_store(Frame& F, int hq, int rt, size_t t0, const LAS float* ssq, const unsigned (&okp)[16]) {
    bf16_t* MIX = WSP(bf16_t, WS_MIX);
    int lane = F.lane; asm volatile("" : "+v"(lane));
    const int r = lane & 31, h = lane >> 5;
    const float rs = rsqrtf(ssq[32 * rt + r] * (1.f / AW) + EPS);
    bf16_t* mo = MIX + (t0 + 32 * rt + r) * MIXW + hq * 64;
#pragma unroll
    for (int dt = 0; dt < 2; ++dt)
#pragma unroll
        for (int g4 = 0; g4 < 4; ++g4) {
            const int d0 = 32 * dt + 8 * g4 + 4 * h; const f32x4 ga = *(const f32x4*)(F.attn_g + hq * 64 + d0);
            const unsigned p0 = okp[dt * 8 + 2 * g4], p1 = okp[dt * 8 + 2 * g4 + 1];
            u32x2 ow; ow.x = cvtpk(bflo(p0) * rs * ga[0], bfhi(p0) * rs * ga[1]); ow.y = cvtpk(bflo(p1) * rs * ga[2], bfhi(p1) * rs * ga[3]);
            *(u32x2*)(mo + d0) = ow;
        }
}
__device__ __forceinline__ void attn_unit(Frame& F, int u) {
    LAS bf16_t* Ks = (LAS bf16_t*)F.lds;
    LAS bf16_t* Vt = (LAS bf16_t*)(F.lds + 36864);
    LAS float* ssq = (LAS float*)(F.lds + 36864 + 33280);
    const int w = F.wave, b = u >> 4, n = u & 15; const size_t t0 = (size_t)b * SEQ + 128 * n;
    if (F.tid < 128) ssq[F.tid] = 0.f;
    const int g0 = (2 * w) >> 2, rt0 = (2 * w) & 3, g1 = (2 * w + 1) >> 2, rt1 = (2 * w + 1) & 3;
    unsigned ok0[16], ok1[16], ok2[16], ok3[16];
    attn_stage(F, 0, n, t0, Ks, Vt);
    attn_item(F, g0, rt0, n, t0, Ks, Vt, ssq, ok0);
    attn_item(F, g1, rt1, n, t0, Ks, Vt, ssq, ok1);
    attn_stage(F, 1, n, t0, Ks, Vt);
    attn_item(F, 4 + g0, rt0, n, t0, Ks, Vt, ssq, ok2);
    attn_item(F, 4 + g1, rt1, n, t0, Ks, Vt, ssq, ok3);
    __syncthreads();
    attn_store(F, g0, rt0, t0, ssq, ok0); attn_store(F, g1, rt1, t0, ssq, ok1); attn_store(F, 4 + g0, rt0, t0, ssq, ok2); attn_store(F, 4 + g1, rt1, t0, ssq, ok3);
    __syncthreads();
}
__device__ __forceinline__ void p_scan_attn(Frame& F, bool do_scan, bool do_attn) {
    const int G = F.G, bx = blockIdx.x, nscan = (do_scan && do_attn && G >= 64) ? 32 : 0;
    if (do_scan) { if (nscan) { if (bx < nscan) scan_unit(F, bx); } else for (int u = bx; u < BATCH * 4; u += G) scan_unit(F, u); }
    if (do_attn) { if (nscan) { for (int u = bx - nscan; u >= 0 && u < BATCH * 16; u += G - nscan) attn_unit(F, u); } else for (int u = bx; u < BATCH * 16; u += G) attn_unit(F, u); }
}

struct Args { const float* in[18]; float* out; unsigned char* ws; int ph_lo, ph_hi, li, pad; };
__global__ void __launch_bounds__(NWAVES * 64, 2) mega_fwd(Args args) {
    extern __shared__ __attribute__((aligned(16))) unsigned char lds[];
    Frame F;
    F.lds = (LAS unsigned char*)lds; F.MISC = (volatile LAS unsigned*)(F.lds + MISC_OFF);
    F.tid = threadIdx.x; F.lane = F.tid & 63; F.wave = __builtin_amdgcn_readfirstlane(F.tid >> 6);
    F.G = gridDim.x; { const int bx = blockIdx.x; F.vcu = (F.G % 8 == 0) ? (bx % 8) * (F.G / 8) + bx / 8 : bx; }
    F.ws = args.ws; F.ctl = (gu32*)(args.ws + WS_CTL); F.out = args.out;
    F.x = args.in[0]; F.norm1_g = args.in[1]; F.w_in = args.in[2]; F.b_in = args.in[3]; F.sinks = args.in[4]; F.attn_g = args.in[5]; F.lb_logits = args.in[6]; F.hgrn_g = args.in[7];
    F.w_out = args.in[8]; F.b_out = args.in[9]; F.norm2_g = args.in[10]; F.router_w = args.in[11]; F.router_b = args.in[12]; F.w1 = args.in[13]; F.b1 = args.in[14]; F.w2 = args.in[15];
    F.b2 = args.in[16]; F.final_g = args.in[17];
    for (int u = F.tid; u < (LDS_BYTES - LDSCTL_OFF) / 4; u += NWAVES * 64) ((LAS unsigned*)(F.lds + LDSCTL_OFF))[u] = 0u;
    __syncthreads();
    XcdBarrier bar = xcd_barrier_post((unsigned*)(F.ctl + CW_BAR) + args.li * XCD_BAR_WORDS, F.MISC + 8);
    const int lo = args.ph_lo, hi = args.ph_hi;
#define IN(k) (lo <= (k) && (k) < hi)
#define SEAM(k) do { if (IN(k) && IN((k) + 1)) xcd_barrier(bar); } while (0)

    if (IN(0)) { p_prologue(F); SEAM(0); }
    if (IN(1)) {
        pg8::DenseOrder S; S.init(WSP(bf16_t, WS_XN), WSP(bf16_t, WS_WINT), T, INW, DM, F.G, (int)blockIdx.x);
        pg8::EpiInProj E{F.b_in, WSP(float, WS_LB), WSP(bf16_t, WS_AQ), WSP(bf16_t, WS_AK), WSP(bf16_t, WS_AV), WSP(bf16_t, WS_HQ), WSP(bf16_t, WS_KK), WSP(bf16_t, WS_HI), WSP(bf16_t, WS_HG), WSP(float, WS_G)};
        pg8::gemm_phase<pg8::EpiInProj, pg8::DenseOrder, false, true>(F.lds + RING_OFF, DM, S, E);
        SEAM(1);
    }
#ifndef NEW_ATTN
#define NEW_ATTN 1
#endif
#ifndef NEW_HGRN
#define NEW_HGRN 1
#endif
    if (IN(2)) { if (!NEW_ATTN) p_attn_simple(F); if (NEW_HGRN) p_hgrn_prep(F); SEAM(2); }
    if (IN(3)) { if (!NEW_HGRN) p_hgrn_simple(F); p_scan_attn(F, NEW_HGRN, NEW_ATTN); SEAM(3); }
    if (IN(4)) { if (!NEW_ATTN || !NEW_HGRN) p_mix_simple(F, !NEW_ATTN, !NEW_HGRN); SEAM(4); }
    if (IN(5)) {
        pg8::DenseOrder S; S.init(WSP(bf16_t, WS_MIX), WSP(bf16_t, WS_WOUTT), T, DM, MIXW, F.G, (int)blockIdx.x);
        pg8::EpiOutProj E{F.b_out, F.x, WSP(float, WS_X1)};
        pg8::gemm_phase<pg8::EpiOutProj, pg8::DenseOrder, false, true>(F.lds + RING_OFF, MIXW, S, E);
        SEAM(5);
    }
    if (IN(6)) { p_router(F); SEAM(6); }
    if (IN(7)) {
        moe_setup(F);
        LAS const int* pre = (LAS const int*)(F.lds + MOE_OFF); LAS const int* lc = (LAS const int*)(F.lds + MOE_OFF + 256);
        pg8::MoeOrder<true> S{(const char*)WSP(bf16_t, WS_H2), (const char*)WSP(bf16_t, WS_W1T), WSP(int, WS_LIST), pre, lc, DM, 2 * FF, 2 * FF / 256, pre[NE] * (2 * FF / 256), F.G, (int)blockIdx.x};
        pg8::EpiMoe1 E{F.b1, WSP(bf16_t, WS_ACT)};
        pg8::gemm_phase<pg8::EpiMoe1, pg8::MoeOrder<true>, true, true>(F.lds + RING_OFF, DM, S, E);
        SEAM(7);
    }
    if (IN(8)) {
        if (!IN(7)) moe_setup(F);
        LAS const int* pre = (LAS const int*)(F.lds + MOE_OFF); LAS const int* lc = (LAS const int*)(F.lds + MOE_OFF + 256);
        pg8::MoeOrder<false> S{(const char*)WSP(bf16_t, WS_ACT), (const char*)WSP(bf16_t, WS_W2T), WSP(int, WS_LIST), pre, lc, FF, DM, DM / 256, pre[NE] * (DM / 256), F.G, (int)blockIdx.x};
        pg8::EpiMoe2 E{F.b2, WSP(int, WS_LIST), WSP(float, WS_GATE), WSP(bf16_t, WS_Y)};
        pg8::gemm_phase<pg8::EpiMoe2, pg8::MoeOrder<false>, false, true>(F.lds + RING_OFF, FF, S, E);
        SEAM(8);
    }
    if (IN(9)) p_final(F);
#undef IN
#undef SEAM
}

static int mega_grid() {
    static int grid = 0;
    if (grid == 0) {
        int dev = 0, cus = 0;
        if (hipGetDevice(&dev) != hipSuccess || hipDeviceGetAttribute(&cus, hipDeviceAttributeMultiprocessorCount, dev) != hipSuccess) { grid = -1; return grid; }
        if (hipFuncSetAttribute((const void*)mega_fwd, hipFuncAttributeMaxDynamicSharedMemorySize, LDS_BYTES) != hipSuccess) { grid = -1; return grid; }
        (void)hipGetLastError();
        grid = cus;
    }
    return grid;
}
extern "C" void kernel_launch(void* const* d_in, const int* in_sizes, int n_in, void* d_out, int out_size, void* d_ws, size_t ws_size, hipStream_t stream) {
    if (n_in != 18 || ws_size < WS_END) return;
    const int grid = mega_grid(); if (grid <= 0) return;
    unsigned char* ws = (unsigned char*)d_ws;
    (void)hipMemsetAsync(ws + WS_CTL, 0, 262144, stream);
    Args a{};
    for (int i = 0; i < 18; ++i) a.in[i] = (const float*)d_in[i];
    a.out = (float*)d_out; a.ws = ws;
#ifndef PLAN
#define PLAN {{0, N_PHASES}}
#endif
    static const int plan[][2] = PLAN;
    for (int li = 0; li < (int)(sizeof(plan) / sizeof(plan[0])); ++li) {
        a.ph_lo = plan[li][0]; a.ph_hi = plan[li][1]; a.li = li;
        hipLaunchKernelGGL(mega_fwd, dim3(grid), dim3(NWAVES * 64), LDS_BYTES, stream, a);
    }
}
```

```cpp
#include <hip/hip_runtime.h>
#include <stdint.h>

typedef unsigned short bf16_t;
typedef short bf16x8 __attribute__((ext_vector_type(8)));
typedef float f32x4 __attribute__((ext_vector_type(4)));

constexpr int BATCH = 8, SEQ = 2048, DM = 1024, T = BATCH * SEQ;
constexpr int AW = 512, AKW = 128, HKW = 512, HW = 512, INW = 2816, MIXW = 1024;
constexpr int NE = 32, TOPK = 4, FF = 1024;
constexpr int C_AQ = 0, C_AK = 512, C_AV = 640, C_HQ = 768, C_HF = 1280, C_HI = 1792, C_HG = 2304;
constexpr float EPS = 1e-5f;
constexpr int ACT_ROWS = T * TOPK + NE * 256;

constexpr size_t MiB = 1u << 20;
constexpr size_t al(size_t x) { return (x + 255) & ~(size_t)255; }
constexpr size_t WS_CTL = 0;
constexpr size_t WS_LB = 1 * MiB;
constexpr size_t WS_WINT = 2 * MiB;
constexpr size_t WS_WOUTT = WS_WINT + al((size_t)INW * DM * 2);
constexpr size_t WS_W1T = WS_WOUTT + al((size_t)DM * MIXW * 2);
constexpr size_t WS_W2T = WS_W1T + al((size_t)NE * 2 * FF * DM * 2);
constexpr size_t WS_XN = WS_W2T + al((size_t)NE * DM * FF * 2);
constexpr size_t WS_AQ = WS_XN + al((size_t)T * DM * 2);
constexpr size_t WS_AK = WS_AQ + al((size_t)T * AW * 2);
constexpr size_t WS_AV = WS_AK + al((size_t)T * AKW * 2);
constexpr size_t WS_HQ = WS_AV + al((size_t)T * AKW * 2);
constexpr size_t WS_G = WS_HQ + al((size_t)T * HKW * 2);
constexpr size_t WS_KK = WS_G + al((size_t)T * HKW * 4);
constexpr size_t WS_HI = WS_KK + al((size_t)T * HKW * 2);
constexpr size_t WS_HG = WS_HI + al((size_t)T * HW * 2);
constexpr size_t WS_ATT = WS_HG + al((size_t)T * HW * 2);
constexpr size_t WS_ORAW = WS_ATT + al((size_t)T * AW * 4);
constexpr size_t WS_MIX = WS_ORAW + al((size_t)T * HW * 4);
constexpr size_t WS_X1 = WS_MIX + al((size_t)T * MIXW * 2);
constexpr size_t WS_H2 = WS_X1 + al((size_t)T * DM * 4);
constexpr size_t WS_GATE = WS_H2 + al((size_t)T * DM * 2);
constexpr size_t WS_LIST = WS_GATE + al((size_t)T * TOPK * 4);
constexpr size_t WS_ACT = WS_LIST + al((size_t)NE * T * 4);
constexpr size_t WS_Y = WS_ACT + al((size_t)ACT_ROWS * FF * 2);
constexpr size_t WS_QF = WS_Y + al((size_t)T * TOPK * DM * 2);
constexpr size_t WS_KF = WS_QF + al((size_t)1024 * 16 * 512 * 2);
constexpr size_t WS_VF = WS_KF + al((size_t)1024 * 16 * 512 * 2);
constexpr size_t WS_INTRA = WS_VF + al((size_t)1024 * 16 * 512 * 2);
constexpr size_t WS_DEC = WS_INTRA + al((size_t)T * HW * 2);
constexpr size_t WS_RWF = WS_DEC + al((size_t)1024 * 128 * 4);
constexpr size_t WS_RSTD = WS_RWF + al((size_t)64 * 2 * 512 * 2);
constexpr size_t WS_END = WS_RSTD + al((size_t)T * 4);
static_assert(WS_END <= ((size_t)1 << 30), "workspace map exceeds 1 GiB");
constexpr int CW_CNT = 64;
constexpr int CW_OFF = 128;

__device__ __forceinline__ bf16_t f2bf(float f) { unsigned u = __builtin_bit_cast(unsigned, f); return (bf16_t)((u + 0x7fffu + ((u >> 16) & 1u)) >> 16); }
__device__ __forceinline__ float bf2f(bf16_t b) { return __builtin_bit_cast(float, (unsigned)b << 16); }
__device__ __forceinline__ float wave_sum(float v) {
#pragma unroll
    for (int o = 1; o < 64; o <<= 1) v += __shfl_xor(v, o);
    return v;
}
__device__ __forceinline__ float wave_max(float v) {
#pragma unroll
    for (int o = 1; o < 64; o <<= 1) v = fmaxf(v, __shfl_xor(v, o));
    return v;
}
__device__ __forceinline__ float sigmoidf_(float x) { return 1.f / (1.f + __expf(-x)); }
__device__ __forceinline__ float siluf_(float x) { return x / (1.f + __expf(-x)); }

#define LAS __attribute__((address_space(3)))
#define GAS __attribute__((address_space(1)))
typedef unsigned u32x4 __attribute__((ext_vector_type(4)));
typedef unsigned u32x2 __attribute__((ext_vector_type(2)));
typedef float f32x2 __attribute__((ext_vector_type(2)));

namespace pg8 {
constexpr int BM = 256, BK = 64, HALF = 128, HTB = HALF * BK * 2  , STAGE_BYTES = 8 * HTB, NXCD = 8, WGM = 8;
__host__ __device__ __forceinline__ int lds_byte(int r, int c) { const int st = (r >> 4) * 2 + (c >> 5), rr = r & 15, cc = c & 31, ob = rr * 64 + cc * 2; return st * 1024 + (ob ^ (((ob >> 9) & 1) << 5)); }
__host__ __device__ __forceinline__ void stage_rc(int b, int& R, int& C) { const int st = b / 1024, sb = b % 1024, swz = sb ^ (((sb >> 9) & 1) << 5); R = (st >> 1) * 16 + swz / 64; C = (st & 1) * 32 + (swz % 64) / 2; }
__host__ __device__ __forceinline__ int perm32(int rho) { const int n = rho >> 4, i = rho & 15; return 8 * (i >> 2) + 4 * n + (i & 3); }
__device__ __forceinline__ unsigned cvt_pk_bf16(float lo, float hi) { unsigned r; asm volatile("v_cvt_pk_bf16_f32 %0, %1, %2" : "=v"(r) : "v"(lo), "v"(hi)); return r; }

struct Unit { const char* A; const char* B; int pm, pn, e, rows, arow, lbase; };

struct DenseOrder {
    const char* A; const char* Bt; int K, nM, nN, nwg, G, c;
    __device__ void init(const void* A_, const void* Bt_, int M, int N, int K_, int G_, int c_) { A = (const char*)A_; Bt = (const char*)Bt_; K = K_; nM = M / BM; nN = N / BM; nwg = nM * nN; G = G_; c = c_; }
    __device__ __forceinline__ bool next(int i, Unit& u) const {
        const long L = (long)i * G + c; if (L >= nwg) return false;
        int wgid = (int)L; { const int q = nwg / NXCD, r = nwg % NXCD, xcd = wgid % NXCD, off = wgid / NXCD; wgid = (xcd < r ? xcd * (q + 1) : r * (q + 1) + (xcd - r) * q) + off; }
        const int nig = WGM * nN, gid = wgid / nig, fm = gid * WGM, gsz = (nM - fm) < WGM ? (nM - fm) : WGM;
        u.pm = fm + ((wgid % nig) % gsz); u.pn = (wgid % nig) / gsz; u.e = 0; u.rows = BM; u.arow = u.pm * BM; u.lbase = 0;
        u.A = A + (size_t)u.pm * BM * K * 2; u.B = Bt + (size_t)u.pn * BM * K * 2; return true;
    }
    __device__ __forceinline__ int row(const Unit&, int r) const { return r; }
};
template <bool G1>
struct MoeOrder {
    const char* A; const char* Bt; const int* list; LAS const int* pre; LAS const int* cnt; int K, N, nN, nwg, G, c;
    __device__ __forceinline__ bool next(int i, Unit& u) const {
        const long L = (long)i * G + c; if (L >= nwg) return false;
        int wgid = (int)L; { const int q = nwg / NXCD, r = nwg % NXCD, xcd = wgid % NXCD, off = wgid / NXCD; wgid = (xcd < r ? xcd * (q + 1) : r * (q + 1) + (xcd - r) * q) + off; }
        const int tau = wgid / nN; u.pn = wgid % nN;
        const int p = pre[(threadIdx.x & 31) + 1];
        const int e = __builtin_popcountll(__ballot(p <= tau) & 0xffffffffull);
        const int mt = tau - pre[e];
        u.e = e; u.pm = mt; const int left = cnt[e] - mt * BM; u.rows = left < BM ? left : BM;
        u.arow = tau * BM; u.lbase = e * T + mt * BM;
        u.A = G1 ? A : A + (size_t)u.arow * K * 2;
        u.B = Bt + ((size_t)e * N + (size_t)u.pn * BM) * K * 2; return true;
    }
    __device__ __forceinline__ int row(const Unit& u, int r) const { const int rr = r < u.rows ? r : u.rows - 1; return list[u.lbase + rr] >> 2; }
};

__device__ __forceinline__ u32x4 pack8(f32x4 v0, f32x4 v1) { u32x4 w; w.x = cvt_pk_bf16(v0[0], v0[1]); w.y = cvt_pk_bf16(v0[2], v0[3]); w.z = cvt_pk_bf16(v1[0], v1[1]); w.w = cvt_pk_bf16(v1[2], v1[3]); return w; }
__device__ __forceinline__ f32x4 silu4(f32x4 v) { f32x4 r; for (int i = 0; i < 4; ++i) r[i] = v[i] * __builtin_amdgcn_rcpf(1.f + __expf(-v[i])); return r; }

struct EpiInProj {
    static constexpr bool PERM = true;
    const float* bias; const float* lb; bf16_t *AQ, *AK, *AV, *HQ, *KK, *HI, *HG; float* G;
    __device__ __forceinline__ void operator()(const f32x4 (&acc)[2][2][4][2], const Unit& u, int wr, int wc, int fr, int fq) const {
        const int row0 = u.pm * BM + wr * 64 + fr, cl = wc * 32 + 8 * fq;
#pragma unroll
        for (int bj = 0; bj < 2; ++bj) {
            const int cb = u.pn * BM + bj * HALF;
            const f32x4 b0 = *(const f32x4*)(bias + cb + cl), b1 = *(const f32x4*)(bias + cb + cl + 4);
            if (cb >= C_HF && cb < C_HI) {
                const int cc = cb - C_HF + cl;
                const f32x4 l0 = *(const f32x4*)(lb + cc), l1 = *(const f32x4*)(lb + cc + 4);
#pragma unroll
                for (int ai = 0; ai < 2; ++ai)
#pragma unroll
                    for (int m = 0; m < 4; ++m) {
                        const size_t r = (size_t)(row0 + ai * HALF + m * 16);
                        f32x4 v0 = acc[ai][bj][m][0] + b0, v1 = acc[ai][bj][m][1] + b1, g0, g1, k0, k1;
#pragma unroll
                        for (int i = 0; i < 4; ++i) {
                            const float f0 = l0[i] + (1.f - l0[i]) * __builtin_amdgcn_rcpf(1.f + __expf(-v0[i])); g0[i] = __logf(f0); k0[i] = 1.f - f0;
                            const float f1 = l1[i] + (1.f - l1[i]) * __builtin_amdgcn_rcpf(1.f + __expf(-v1[i])); g1[i] = __logf(f1); k1[i] = 1.f - f1;
                        }
                        *(f32x4*)(G + r * HKW + cc) = g0; *(f32x4*)(G + r * HKW + cc + 4) = g1;
                        *(u32x4*)(KK + r * HKW + cc) = pack8(k0, k1);
                    }
            } else {
                bf16_t* dst; int ld, cc; bool act = false;
                if (cb < C_AK) { dst = AQ; ld = AW; cc = cb - C_AQ; }
                else if (cb < C_AV) { dst = AK; ld = AKW; cc = cb - C_AK; }
                else if (cb < C_HQ) { dst = AV; ld = AKW; cc = cb - C_AV; }
                else if (cb < C_HF) { dst = HQ; ld = HKW; cc = cb - C_HQ; act = true; }
                else if (cb < C_HG) { dst = HI; ld = HW; cc = cb - C_HI; }
                else { dst = HG; ld = HW; cc = cb - C_HG; act = true; }
                cc += cl;
#pragma unroll
                for (int ai = 0; ai < 2; ++ai)
#pragma unroll
                    for (int m = 0; m < 4; ++m) {
                        const size_t r = (size_t)(row0 + ai * HALF + m * 16);
                        f32x4 v0 = acc[ai][bj][m][0] + b0, v1 = acc[ai][bj][m][1] + b1;
                        if (act) { v0 = silu4(v0); v1 = silu4(v1); }
                        *(u32x4*)(dst + r * ld + cc) = pack8(v0, v1);
                    }
            }
        }
    }
};
struct EpiOutProj {
    static constexpr bool PERM = false;
    const float* bias; const float* x; float* X1;
    __device__ __forceinline__ void operator()(const f32x4 (&acc)[2][2][4][2], const Unit& u, int wr, int wc, int fr, int fq) const {
        const int row0 = u.pm * BM + wr * 64 + fr, col0 = u.pn * BM + wc * 32 + 4 * fq;
#pragma unroll
        for (int bj = 0; bj < 2; ++bj)
#pragma unroll
            for (int n = 0; n < 2; ++n) {
                const int c = col0 + bj * HALF + n * 16; const f32x4 bv = *(const f32x4*)(bias + c);
#pragma unroll
                for (int ai = 0; ai < 2; ++ai)
#pragma unroll
                    for (int m = 0; m < 4; ++m) { const size_t o = (size_t)(row0 + ai * HALF + m * 16) * DM + c; *(f32x4*)(X1 + o) = acc[ai][bj][m][n] + bv + *(const f32x4*)(x + o); }
            }
    }
};
struct EpiMoe1 {
    static constexpr bool PERM = true;
    const float* b1; bf16_t* ACT; const int* list; const float* rstd;
    __device__ __forceinline__ void operator()(const f32x4 (&acc)[2][2][4][2], const Unit& u, int wr, int wc, int fr, int fq) const {
        const int ac0 = u.pn * HALF + wc * 32 + 8 * fq;
        const float* bp = b1 + (size_t)u.e * 2 * FF + 2 * ac0;
        const f32x4 q0 = *(const f32x4*)bp, q1 = *(const f32x4*)(bp + 4), q2 = *(const f32x4*)(bp + 8), q3 = *(const f32x4*)(bp + 12);
        const f32x4 bg0 = {q0[0], q0[2], q1[0], q1[2]}, bg1 = {q2[0], q2[2], q3[0], q3[2]}, bl0 = {q0[1], q0[3], q1[1], q1[3]}, bl1 = {q2[1], q2[3], q3[1], q3[3]};
#pragma unroll
        for (int ai = 0; ai < 2; ++ai)
#pragma unroll
            for (int m = 0; m < 4; ++m) {
                const int r = ai * HALF + wr * 64 + m * 16 + fr;
                const float rs = r < u.rows ? rstd[list[u.lbase + r] >> 2] : 0.f;
                const f32x4 g0 = acc[ai][0][m][0] * rs + bg0, g1 = acc[ai][0][m][1] * rs + bg1, l0 = acc[ai][1][m][0] * rs + bl0, l1 = acc[ai][1][m][1] * rs + bl1;
                f32x4 a0, a1;
#pragma unroll
                for (int i = 0; i < 4; ++i) {
                    const float u0 = fminf(g0[i], 7.f), u1 = fminf(g1[i], 7.f), w0 = fminf(fmaxf(l0[i], -7.f), 7.f), w1 = fminf(fmaxf(l1[i], -7.f), 7.f);
                    a0[i] = u0 * __builtin_amdgcn_rcpf(1.f + __expf(-1.702f * u0)) * (w0 + 1.f);
                    a1[i] = u1 * __builtin_amdgcn_rcpf(1.f + __expf(-1.702f * u1)) * (w1 + 1.f);
                }
                if (r < u.rows) *(u32x4*)(ACT + (size_t)(u.arow + r) * FF + ac0) = pack8(a0, a1);
            }
    }
};
struct EpiMoe2 {
    static constexpr bool PERM = true;
    const float* b2; const int* list; const float* gate; bf16_t* Y;
    __device__ __forceinline__ void operator()(const f32x4 (&acc)[2][2][4][2], const Unit& u, int wr, int wc, int fr, int fq) const {
        const int c0 = u.pn * BM + wc * 32 + 8 * fq;
        f32x4 bv[2][2];
#pragma unroll
        for (int bj = 0; bj < 2; ++bj)
#pragma unroll
            for (int n = 0; n < 2; ++n) bv[bj][n] = *(const f32x4*)(b2 + (size_t)u.e * DM + c0 + bj * HALF + 4 * n);
#pragma unroll
        for (int ai = 0; ai < 2; ++ai)
#pragma unroll
            for (int m = 0; m < 4; ++m) {
                const int r = ai * HALF + wr * 64 + m * 16 + fr;
                if (r < u.rows) {
                    const int slot = list[u.lbase + r]; const float gt = gate[slot];
                    bf16_t* yr = Y + (size_t)slot * DM + c0;
#pragma unroll
                    for (int bj = 0; bj < 2; ++bj) { const f32x4 v0 = (acc[ai][bj][m][0] + bv[bj][0]) * gt, v1 = (acc[ai][bj][m][1] + bv[bj][1]) * gt; *(u32x4*)(yr + bj * HALF) = pack8(v0, v1); }
                }
            }
    }
};

template <class Epi, class Sched, bool GATHER, bool ALIGN_EPI>
__device__ __forceinline__ void gemm_phase(LAS unsigned char* lds, const int K, const Sched& S, const Epi& E) {
    const int tid = threadIdx.x, wid = __builtin_amdgcn_readfirstlane(tid >> 6), lane = tid & 63, wr = wid >> 2, wc = wid & 3, fr = lane & 15, fq = lane >> 4;
    const int nt = K / BK;
    int RA[2], CA[2]; unsigned voffB[2];
#pragma unroll
    for (int i = 0; i < 2; ++i) { int R, C; stage_rc(tid * 16 + i * 8192, R, C); RA[i] = R; CA[i] = C; const int Rb = Epi::PERM ? ((R & ~31) + perm32(R & 31)) : R; voffB[i] = (unsigned)(Rb * K + C) * 2u; }
    const size_t kstep = (size_t)(BK * 2);
    const size_t hstep = (size_t)HALF * K * 2;
    const unsigned ldsw = (unsigned)wid * 1024u;
    const int aoff = lds_byte(wr * 64 + fr, fq * 8), boff = lds_byte(wc * 32 + fr, fq * 8);
#define PG8_SA(b, h) (((b) * 2 + (h)) * HTB)
#define PG8_SB(b, h) ((4 + (b) * 2 + (h)) * HTB)
#define PG8_STAGE(bufoff, gbase, voff) do { _Pragma("unroll") for (int _i = 0; _i < 2; ++_i) \
        __builtin_amdgcn_global_load_lds((const unsigned*)((const char*)(gbase) + (voff)[_i]), (LAS unsigned*)(lds + (bufoff) + ldsw + _i * 8192), 16, 0, 0); } while (0)
#define PG8_LDA(dst, b, h) do { _Pragma("unroll") for (int m = 0; m < 4; ++m) _Pragma("unroll") for (int k = 0; k < 2; ++k) dst[m][k] = *(const LAS bf16x8*)(lds + PG8_SA(b, h) + aoff + m * 2048 + k * 1024); } while (0)
#define PG8_LDB(dst, b, h) do { _Pragma("unroll") for (int n = 0; n < 2; ++n) _Pragma("unroll") for (int k = 0; k < 2; ++k) dst[n][k] = *(const LAS bf16x8*)(lds + PG8_SB(b, h) + boff + n * 2048 + k * 1024); } while (0)
#define PG8_MMA(ai, bj, At, Bt) do { __builtin_amdgcn_s_setprio(1); _Pragma("unroll") for (int m = 0; m < 4; ++m) _Pragma("unroll") for (int n = 0; n < 2; ++n) _Pragma("unroll") for (int k = 0; k < 2; ++k) \
        acc[ai][bj][m][n] = __builtin_amdgcn_mfma_f32_16x16x32_bf16(Bt[n][k], At[m][k], acc[ai][bj][m][n], 0, 0, 0); __builtin_amdgcn_s_setprio(0); } while (0)
#define PG8_WAIT_V(n) asm volatile("s_waitcnt vmcnt(" #n ")" ::: "memory")
#define PG8_WAIT_L(n) asm volatile("s_waitcnt lgkmcnt(" #n ")" ::: "memory")
#define PG8_BAR __builtin_amdgcn_s_barrier()
#define PG8_SCHED __builtin_amdgcn_sched_barrier(0)
#define PG8_VOFFA(dst, u) do { _Pragma("unroll") for (int _h = 0; _h < 2; ++_h) _Pragma("unroll") for (int _i = 0; _i < 2; ++_i) { const int _r = _h * HALF + RA[_i]; \
        const unsigned _row = GATHER ? (unsigned)S.row(u, _r) : (unsigned)_r; dst[_h][_i] = (_row * (unsigned)K + (unsigned)CA[_i]) * 2u; } } while (0)
    Unit cur, nxt; int ui = 0;
    if (!S.next(0, cur)) return;
    f32x4 acc[2][2][4][2];
#pragma unroll
    for (int a = 0; a < 2; ++a)
#pragma unroll
        for (int b = 0; b < 2; ++b)
#pragma unroll
            for (int m = 0; m < 4; ++m)
#pragma unroll
                for (int n = 0; n < 2; ++n) acc[a][b][m][n] = (f32x4){0.f, 0.f, 0.f, 0.f};
    bf16x8 At[4][2], B0[2][2], B1[2][2];
    unsigned vA[2][2], nvA[2][2];
    PG8_VOFFA(vA, cur);
    const char* cA = cur.A; const char* cB = cur.B;
    PG8_STAGE(PG8_SB(0, 0), cB, voffB); PG8_STAGE(PG8_SB(0, 1), cB + hstep, voffB); PG8_STAGE(PG8_SA(0, 0), cA, vA[0]); PG8_STAGE(PG8_SA(0, 1), cA, vA[1]);
    if (wr == 1) PG8_BAR;
    PG8_WAIT_V(2); PG8_BAR;
    PG8_STAGE(PG8_SB(1, 0), cB + kstep, voffB); PG8_STAGE(PG8_SA(1, 0), cA + kstep, vA[0]); PG8_STAGE(PG8_SB(1, 1), cB + hstep + kstep, voffB);
    PG8_WAIT_V(6); PG8_BAR;
    for (;;) {
        const bool has_next = S.next(ui + 1, nxt);
        const char* nA = has_next ? nxt.A : cA; const char* nB = has_next ? nxt.B : cB;
        if (has_next) { PG8_VOFFA(nvA, nxt); } else {
#pragma unroll
            for (int h = 0; h < 2; ++h)
#pragma unroll
                for (int i = 0; i < 2; ++i) nvA[h][i] = vA[h][i]; }
        for (int t = 0; t < nt; t += 2) {
            const bool last = (t == nt - 2);
            const char* a1 = cA + (size_t)(t + 1) * kstep;
            const char* a2 = last ? nA : cA + (size_t)(t + 2) * kstep; const char* b2 = last ? nB : cB + (size_t)(t + 2) * kstep;
            const char* a3 = a2 + kstep; const char* b3 = b2 + kstep;
            unsigned s0[2], s1[2];
#pragma unroll
            for (int i = 0; i < 2; ++i) { s0[i] = last ? nvA[0][i] : vA[0][i]; s1[i] = last ? nvA[1][i] : vA[1][i]; }
            PG8_LDB(B0, 0, 0); PG8_LDB(B1, 0, 1); PG8_SCHED; PG8_LDA(At, 0, 0); PG8_STAGE(PG8_SA(1, 1), a1, vA[1]);
            PG8_WAIT_V(8); PG8_WAIT_L(0); PG8_BAR; PG8_MMA(0, 0, At, B0); PG8_MMA(0, 1, At, B1); PG8_BAR; PG8_SCHED;
            PG8_LDA(At, 0, 1); PG8_STAGE(PG8_SB(0, 0), b2, voffB); PG8_STAGE(PG8_SB(0, 1), b2 + hstep, voffB); PG8_STAGE(PG8_SA(0, 0), a2, s0);
            PG8_WAIT_V(8); PG8_WAIT_L(0); PG8_BAR; PG8_MMA(1, 0, At, B0); PG8_MMA(1, 1, At, B1); PG8_BAR; PG8_SCHED;
            PG8_LDB(B0, 1, 0); PG8_LDB(B1, 1, 1); PG8_SCHED; PG8_LDA(At, 1, 0); PG8_STAGE(PG8_SA(0, 1), a2, s1);
            PG8_WAIT_V(8); PG8_WAIT_L(0); PG8_BAR; PG8_MMA(0, 0, At, B0); PG8_MMA(0, 1, At, B1); PG8_BAR; PG8_SCHED;
            PG8_LDA(At, 1, 1); PG8_STAGE(PG8_SB(1, 0), b3, voffB); PG8_STAGE(PG8_SB(1, 1), b3 + hstep, voffB); PG8_STAGE(PG8_SA(1, 0), a3, s0);
            PG8_WAIT_V(8); PG8_WAIT_L(0); PG8_BAR; PG8_MMA(1, 0, At, B0); PG8_MMA(1, 1, At, B1); PG8_BAR; PG8_SCHED;
        }
        if constexpr (ALIGN_EPI) { if (wr == 0) PG8_BAR; }
        E(acc, cur, wr, wc, fr, fq);
        if (!has_next) break;
#pragma unroll
        for (int a = 0; a < 2; ++a)
#pragma unroll
            for (int b = 0; b < 2; ++b)
#pragma unroll
                for (int m = 0; m < 4; ++m)
#pragma unroll
                    for (int n = 0; n < 2; ++n) acc[a][b][m][n] = (f32x4){0.f, 0.f, 0.f, 0.f};
        cur = nxt; cA = nA; cB = nB; ++ui;
#pragma unroll
        for (int h = 0; h < 2; ++h)
#pragma unroll
            for (int i = 0; i < 2; ++i) vA[h][i] = nvA[h][i];
        if constexpr (ALIGN_EPI) { if (wr == 1) PG8_BAR; }
    }
    PG8_WAIT_V(0);
    if constexpr (!ALIGN_EPI) { if (wr == 0) PG8_BAR; }
    PG8_BAR;
#undef PG8_SA
#undef PG8_SB
#undef PG8_STAGE
#undef PG8_LDA
#undef PG8_LDB
#undef PG8_MMA
#undef PG8_WAIT_V
#undef PG8_WAIT_L
#undef PG8_BAR
#undef PG8_SCHED
#undef PG8_VOFFA
}
}

constexpr int NWAVES = 8;
constexpr int RING_OFF = 0, RING_BYTES = 139264;
constexpr int LDSCTL_OFF = RING_BYTES, MISC_OFF = LDSCTL_OFF + 320;
constexpr int MOE_OFF = LDSCTL_OFF + 1024;
constexpr int LDS_BYTES = RING_BYTES + 16384;
constexpr int CW_TMO = 0, CW_CODE = 1, CW_BAR = 4096;
constexpr int N_PHASES = 10;

typedef GAS unsigned gu32;
#define RLX_AGENT __ATOMIC_RELAXED, __HIP_MEMORY_SCOPE_AGENT
#define LDS_WAIT() asm volatile("s_waitcnt lgkmcnt(0)" ::: "memory")
#define VM_WAIT() asm volatile("s_waitcnt vmcnt(0)" ::: "memory")

#define XB_TMO      128
#define XB_XCNT(j)  (256  + 64 * (j))
#define XB_XSUB(j)  (1280 + 64 * (j))
#define XB_XGEN(j)  (2304 + 64 * (j))
#define XB_TOP      3328
#define XB_TOPGEN   3392
#define XCD_BAR_WORDS 3456
#define XB_SPIN_CAP (1u << 18)
__device__ __forceinline__ unsigned xb_ld(unsigned* p)              { return __hip_atomic_load(p, __ATOMIC_RELAXED, __HIP_MEMORY_SCOPE_AGENT); }
__device__ __forceinline__ unsigned xb_add(unsigned* p, unsigned v) { return __hip_atomic_fetch_add(p, v, __ATOMIC_RELAXED, __HIP_MEMORY_SCOPE_AGENT); }
__device__ __forceinline__ unsigned xb_xcc_id() { return (unsigned)__builtin_amdgcn_s_getreg((3 << 11) | 20) & 0xFu; }
#define XB_SPIN(cond, bar) do { unsigned _sp = 0; while (cond) { __builtin_amdgcn_s_sleep(1); \
    if ((++_sp & 255u) == 0u) { if (xb_ld(&(bar)[XB_TMO])) break; if (_sp > XB_SPIN_CAP) { atomicAdd(&(bar)[XB_TMO], 1u); break; } } } } while (0)
struct XcdBarrier { unsigned* bar; unsigned x; volatile LAS unsigned* st; };
__device__ __forceinline__ XcdBarrier xcd_barrier_post(unsigned* bar, volatile LAS unsigned* st) {
    XcdBarrier b; b.bar = bar; b.x = xb_xcc_id(); b.st = st;
    if (threadIdx.x == 0) (void)xb_add(&bar[XB_XCNT(b.x)], 1u);
    return b;
}
__device__ __forceinline__ void xcd_barrier_complete(unsigned* bar, unsigned x, unsigned& nloc, unsigned& nx) {
    const unsigned G = gridDim.x * gridDim.y * gridDim.z;
    unsigned sum, cnt, mine, sp = 0u;
    for (;;) {
        sum = 0u; cnt = 0u; mine = 0u;
#pragma unroll
        for (unsigned j = 0; j < 16; ++j) { const unsigned c = xb_ld(&bar[XB_XCNT(j)]); sum += c; cnt += (c > 0u) ? 1u : 0u; mine = (j == x) ? c : mine; }
        if (sum == G) break;
        __builtin_amdgcn_s_sleep(1);
        if ((++sp & 255u) == 0u) { if (xb_ld(&bar[XB_TMO])) break; if (sp > XB_SPIN_CAP) { atomicAdd(&bar[XB_TMO], 1u); break; } }
    }
    nloc = mine > 0u ? mine : 1u; nx = cnt > 0u ? cnt : 1u;
}
__device__ __forceinline__ void xcd_barrier(const XcdBarrier& b) {
    asm volatile("s_waitcnt vmcnt(0)" ::: "memory");
    __syncthreads();
    if (threadIdx.x == 0) {
        unsigned* bar = b.bar;
        __builtin_amdgcn_s_waitcnt(0);
        unsigned nloc = b.st[0], nx = b.st[1];
        if (nloc == 0u) { xcd_barrier_complete(bar, b.x, nloc, nx); b.st[0] = nloc; b.st[1] = nx; }
        const unsigned old = xb_add(&bar[XB_XSUB(b.x)], 1u);
        const unsigned gen = old / nloc;
        if (old + 1u == (gen + 1u) * nloc) {
            __builtin_amdgcn_fence(__ATOMIC_RELEASE, "agent");
            asm volatile("s_waitcnt vmcnt(0)" ::: "memory");
            const unsigned og = xb_add(&bar[XB_TOP], 1u);
            const unsigned tg = og / nx;
            if (og + 1u == (tg + 1u) * nx) xb_add(&bar[XB_TOPGEN], 1u);
            else XB_SPIN(xb_ld(&bar[XB_TOPGEN]) == tg, bar);
            __builtin_amdgcn_fence(__ATOMIC_ACQUIRE, "agent");
            xb_add(&bar[XB_XGEN(b.x)], 1u);
            asm volatile("s_waitcnt vmcnt(0)" ::: "memory");
        } else {
            XB_SPIN(xb_ld(&bar[XB_XGEN(b.x)]) == gen, bar);
            __builtin_amdgcn_fence(__ATOMIC_ACQUIRE, "agent");
            asm volatile("s_waitcnt vmcnt(0)" ::: "memory");
        }
    }
    __syncthreads();
}

struct Frame {
    LAS unsigned char* lds; volatile LAS unsigned* MISC; gu32* ctl;
    int tid, lane, wave, vcu, G;
    const float *x, *norm1_g, *w_in, *b_in, *sinks, *attn_g, *lb_logits, *hgrn_g, *w_out, *b_out, *norm2_g, *router_w, *router_b, *w1, *b1, *w2, *b2, *final_g;
    float* out; unsigned char* ws;
};
#define WSP(type, off) ((type*)(F.ws + (off)))

typedef float f32x16 __attribute__((ext_vector_type(16)));
typedef __bf16 bf16x2_t __attribute__((ext_vector_type(2)));
__device__ __forceinline__ unsigned cvtpk(float lo, float hi) { f32x2 v = {lo, hi}; bf16x2_t b = __builtin_convertvector(v, bf16x2_t); return __builtin_bit_cast(unsigned, b); }
__device__ __forceinline__ int crow(int reg, int h) { return (reg & 3) + 8 * (reg >> 2) + 4 * h; }
__device__ __forceinline__ float bflo(unsigned u) { return __builtin_bit_cast(float, u << 16); }
__device__ __forceinline__ float bfhi(unsigned u) { return __builtin_bit_cast(float, u & 0xffff0000u); }
__device__ __forceinline__ bf16x8 pack_step(const f32x16& x, int s) {
    u32x4 p; p.x = cvtpk(x[8 * s], x[8 * s + 1]); p.y = cvtpk(x[8 * s + 2], x[8 * s + 3]); p.z = cvtpk(x[8 * s + 4], x[8 * s + 5]); p.w = cvtpk(x[8 * s + 6], x[8 * s + 7]);
    return __builtin_bit_cast(bf16x8, p);
}
#define MFMA32(a, b, c) __builtin_amdgcn_mfma_f32_32x32x16_bf16((a), (b), (c), 0, 0, 0)
#define MFMA16(a, b, c) __builtin_amdgcn_mfma_f32_16x16x32_bf16((a), (b), (c), 0, 0, 0)

__device__ __forceinline__ void p_hgrn_prep(Frame& F) {
    constexpr int GP = 132, QP = 136, VP = 72, AP = 72;
    LAS float* Gs = (LAS float*)F.lds;
    LAS bf16_t* Qs = (LAS bf16_t*)(F.lds + 33792);
    LAS bf16_t* Ks = (LAS bf16_t*)(F.lds + 33792 + 17408);
    LAS bf16_t* Vt = (LAS bf16_t*)(F.lds + 33792 + 2 * 17408);
    LAS bf16_t* At = (LAS bf16_t*)(F.lds + 33792 + 2 * 17408 + 18432);
    LAS float* Tot = (LAS float*)(F.lds + 96256);
    LAS float* Bl = Tot + 8 * 128;
    const bf16_t* HQ = WSP(bf16_t, WS_HQ); const float* G = WSP(float, WS_G); const bf16_t* KK = WSP(bf16_t, WS_KK); const bf16_t* HI = WSP(bf16_t, WS_HI);
    bf16_t* QF = WSP(bf16_t, WS_QF); bf16_t* KF = WSP(bf16_t, WS_KF); bf16_t* VF = WSP(bf16_t, WS_VF); bf16_t* INTRA = WSP(bf16_t, WS_INTRA); float* DEC = WSP(float, WS_DEC);
    const int tid = F.tid, lane = F.lane, w = F.wave, r = lane & 31, h = lane >> 5, fr = lane & 15, fq = lane >> 4;
    for (int ch = blockIdx.x; ch < BATCH * 4 * 32; ch += F.G) {
        const int bh = ch >> 5, c = ch & 31, b = bh >> 2, hd = bh & 3;
        const size_t t0 = (size_t)b * SEQ + 64 * c; const int col0 = hd * 128;
#pragma unroll
        for (int i = 0; i < 4; ++i) { const int idx = tid + 512 * i, row = idx >> 5, c4 = idx & 31; *(LAS f32x4*)(Gs + row * GP + 4 * c4) = *(const f32x4*)(G + (t0 + row) * HKW + col0 + 4 * c4); }
#pragma unroll
        for (int i = 0; i < 2; ++i) { const int idx = tid + 512 * i, row = idx >> 4, c8 = idx & 15; const size_t go = (t0 + row) * HKW + col0 + 8 * c8;
            *(LAS u32x4*)(Qs + row * QP + 8 * c8) = *(const u32x4*)(HQ + go); *(LAS u32x4*)(Ks + row * QP + 8 * c8) = *(const u32x4*)(KK + go);
            const u32x4 vv = *(const u32x4*)(HI + go);
#pragma unroll
            for (int q = 0; q < 4; ++q) { Vt[(8 * c8 + 2 * q) * VP + row] = (bf16_t)(vv[q] & 0xffffu); Vt[(8 * c8 + 2 * q + 1) * VP + row] = (bf16_t)(vv[q] >> 16); } }
        for (int i = tid; i < 64 * AP / 8; i += 512) *(LAS u32x4*)(At + 8 * i) = (u32x4){0u, 0u, 0u, 0u};
        __syncthreads();
#pragma unroll
        for (int q = 0; q < 2; ++q) { const int kk = lane + 64 * q; float run = 0.f;
#pragma unroll
            for (int i = 0; i < 8; ++i) { run += Gs[(8 * w + i) * GP + kk]; Gs[(8 * w + i) * GP + kk] = run; }
            Tot[w * 128 + kk] = run; }
        __syncthreads();
#pragma unroll
        for (int q = 0; q < 2; ++q) { const int kk = lane + 64 * q; float off = 0.f, tot = 0.f;
#pragma unroll
            for (int i = 0; i < 8; ++i) { const float tv = Tot[i * 128 + kk]; tot += tv; if (i < w) off += tv; }
#pragma unroll
            for (int i = 0; i < 8; ++i) Gs[(8 * w + i) * GP + kk] += off;
            if (w == 0) Bl[kk] = tot; }
        __syncthreads();
#pragma unroll
        for (int q = 0; q < 2; ++q) {
            const int f = w + 8 * q;
            {
                const int tt = f >> 3, kt = (f >> 1) & 3, ks = f & 1, t = 32 * tt + r, kb = 32 * kt + 16 * ks + 4 * h;
                const u32x2 qa = *(const LAS u32x2*)(Qs + t * QP + kb), qb = *(const LAS u32x2*)(Qs + t * QP + kb + 8);
                const f32x4 ba = *(const LAS f32x4*)(Gs + t * GP + kb), bb = *(const LAS f32x4*)(Gs + t * GP + kb + 8);
                u32x4 o; o.x = cvtpk(bflo(qa.x) * __expf(ba[0]), bfhi(qa.x) * __expf(ba[1])); o.y = cvtpk(bflo(qa.y) * __expf(ba[2]), bfhi(qa.y) * __expf(ba[3]));
                o.z = cvtpk(bflo(qb.x) * __expf(bb[0]), bfhi(qb.x) * __expf(bb[1])); o.w = cvtpk(bflo(qb.y) * __expf(bb[2]), bfhi(qb.y) * __expf(bb[3]));
                *(u32x4*)(QF + (((size_t)ch * 16 + f) * 64 + lane) * 8) = o;
            }
            {
                const int kt = f >> 2, ss = f & 3, kc = 32 * kt + r, s0 = 16 * ss + 8 * h; const float bl = Bl[kc];
                float v[8];
#pragma unroll
                for (int j = 0; j < 8; ++j) v[j] = bf2f(Ks[(s0 + j) * QP + kc]) * __expf(bl - Gs[(s0 + j) * GP + kc]);
                u32x4 o; o.x = cvtpk(v[0], v[1]); o.y = cvtpk(v[2], v[3]); o.z = cvtpk(v[4], v[5]); o.w = cvtpk(v[6], v[7]);
                *(u32x4*)(KF + (((size_t)ch * 16 + f) * 64 + lane) * 8) = o;
            }
            {
                const int ss = f >> 2, dt = f & 3;
                *(u32x4*)(VF + (((size_t)ch * 16 + f) * 64 + lane) * 8) = *(const LAS u32x4*)(Vt + (32 * dt + r) * VP + 16 * ss + 8 * h);
            }
        }
        if (tid < 128) DEC[(size_t)ch * 128 + tid] = __expf(Bl[tid]);
        {
            const int i = w >> 1;
            for (int j = w & 1; j <= i; j += 2) {
                f32x4 acc = {0.f, 0.f, 0.f, 0.f};
                const int t = 16 * i + fr, s = 16 * j + fr;
#pragma unroll
                for (int k4 = 0; k4 < 4; ++k4) {
                    const int k0 = 32 * k4 + 8 * fq;
                    f32x4 r0 = {0.f, 0.f, 0.f, 0.f}, r1 = {0.f, 0.f, 0.f, 0.f};
                    if (i > 0) { r0 = *(const LAS f32x4*)(Gs + (16 * i - 1) * GP + k0); r1 = *(const LAS f32x4*)(Gs + (16 * i - 1) * GP + k0 + 4); }
                    const u32x4 q8 = *(const LAS u32x4*)(Qs + t * QP + k0), k8 = *(const LAS u32x4*)(Ks + s * QP + k0);
                    const f32x4 bt0 = *(const LAS f32x4*)(Gs + t * GP + k0), bt1 = *(const LAS f32x4*)(Gs + t * GP + k0 + 4);
                    const f32x4 bs0 = *(const LAS f32x4*)(Gs + s * GP + k0), bs1 = *(const LAS f32x4*)(Gs + s * GP + k0 + 4);
                    u32x4 a, bb;
                    a.x = cvtpk(bflo(q8.x) * __expf(bt0[0] - r0[0]), bfhi(q8.x) * __expf(bt0[1] - r0[1])); a.y = cvtpk(bflo(q8.y) * __expf(bt0[2] - r0[2]), bfhi(q8.y) * __expf(bt0[3] - r0[3]));
                    a.z = cvtpk(bflo(q8.z) * __expf(bt1[0] - r1[0]), bfhi(q8.z) * __expf(bt1[1] - r1[1])); a.w = cvtpk(bflo(q8.w) * __expf(bt1[2] - r1[2]), bfhi(q8.w) * __expf(bt1[3] - r1[3]));
                    bb.x = cvtpk(bflo(k8.x) * __expf(r0[0] - bs0[0]), bfhi(k8.x) * __expf(r0[1] - bs0[1])); bb.y = cvtpk(bflo(k8.y) * __expf(r0[2] - bs0[2]), bfhi(k8.y) * __expf(r0[3] - bs0[3]));
                    bb.z = cvtpk(bflo(k8.z) * __expf(r1[0] - bs1[0]), bfhi(k8.z) * __expf(r1[1] - bs1[1])); bb.w = cvtpk(bflo(k8.w) * __expf(r1[2] - bs1[2]), bfhi(k8.w) * __expf(r1[3] - bs1[3]));
                    acc = MFMA16(__builtin_bit_cast(bf16x8, a), __builtin_bit_cast(bf16x8, bb), acc);
                }
#pragma unroll
                for (int q = 0; q < 4; ++q) { const float v = (j < i || (4 * fq + q) >= fr) ? acc[q] : 0.f; At[(16 * i + 4 * fq + q) * AP + 16 * j + fr] = f2bf(v); }
            }
        }
        __syncthreads();
        {
            const int tt = w & 1, dt = w >> 1;
            f32x16 acc;
#pragma unroll
            for (int q = 0; q < 16; ++q) acc[q] = 0.f;
#pragma unroll
            for (int ss = 0; ss < 4; ++ss) if (ss < 2 * (tt + 1)) {
                const bf16x8 a = *(const LAS bf16x8*)(At + (32 * tt + r) * AP + 16 * ss + 8 * h), bv = *(const LAS bf16x8*)(Vt + (32 * dt + r) * VP + 16 * ss + 8 * h);
                acc = MFMA32(a, bv, acc);
            }
#pragma unroll
            for (int q = 0; q < 16; ++q) INTRA[(t0 + 32 * tt + crow(q, h)) * HW + col0 + 32 * dt + r] = f2bf(acc[q]);
        }
        __syncthreads();
    }
}

constexpr int SC_OPB = 0, SC_OBUF = 65536, SC_OBP = 132, SC_OBB = 64 * SC_OBP * 4, SC_DEC = SC_OBUF + 2 * SC_OBB;
__device__ __forceinline__ void scan_unit(Frame& F, int bh) {
    const bf16_t* QF = WSP(bf16_t, WS_QF); const bf16_t* KF = WSP(bf16_t, WS_KF); const bf16_t* VF = WSP(bf16_t, WS_VF); const bf16_t* INTRA = WSP(bf16_t, WS_INTRA); const float* DEC = WSP(float, WS_DEC);
    const bf16_t* HG = WSP(bf16_t, WS_HG); bf16_t* MIX = WSP(bf16_t, WS_MIX);
    const int tid = F.tid, lane = F.lane, w = F.wave, r = lane & 31, h = lane >> 5, tt = w & 1, d = w >> 1, b = bh >> 2, hd = bh & 3;
    LAS unsigned char* lds = F.lds;
    f32x16 S[4];
#pragma unroll
    for (int kt = 0; kt < 4; ++kt)
#pragma unroll
        for (int q = 0; q < 16; ++q) S[kt][q] = 0.f;
#define SC_DMA(c_) do { const size_t chn = (size_t)bh * 32 + (c_); const int slot = ((c_) & 1) * 32768; _Pragma("unroll") for (int i_ = 0; i_ < 2; ++i_) { \
        __builtin_amdgcn_global_load_lds((const unsigned*)(QF + ((chn * 16 + 2 * w + i_) * 64 + lane) * 8), (LAS unsigned*)(lds + SC_OPB + slot + (2 * w + i_) * 1024), 16, 0, 0); \
        __builtin_amdgcn_global_load_lds((const unsigned*)(KF + ((chn * 16 + 2 * w + i_) * 64 + lane) * 8), (LAS unsigned*)(lds + SC_OPB + slot + 16384 + (2 * w + i_) * 1024), 16, 0, 0); } \
        } while (0)
#define SC_DEC_LD(c_) (*(const f32x4*)(DEC + ((size_t)bh * 32 + (c_)) * 128 + (tid & 31) * 4))
#define SC_DEC_ST(c_, v_) do { if (tid < 32) *(LAS f32x4*)(lds + SC_DEC + ((c_) & 1) * 512 + tid * 16) = (v_); } while (0)
    bf16x8 Vf[4], Vn[4];
#pragma unroll
    for (int ss = 0; ss < 4; ++ss) Vf[ss] = *(const bf16x8*)(VF + ((((size_t)bh * 32) * 16 + ss * 4 + d) * 64 + lane) * 8);
    SC_DMA(0);
    { const f32x4 dv0 = SC_DEC_LD(0); SC_DEC_ST(0, dv0); }
    __syncthreads();
    const int ft = tid >> 3, fs = tid & 7;
    const int ocol = hd * 128 + 16 * fs;
    for (int c = 0; c < 32; ++c) {
        const int slot = (c & 1) * 32768;
        f32x4 dnext = {0.f, 0.f, 0.f, 0.f};
        if (c + 1 < 32) {
            SC_DMA(c + 1);
            dnext = SC_DEC_LD(c + 1);
#pragma unroll
            for (int ss = 0; ss < 4; ++ss) Vn[ss] = *(const bf16x8*)(VF + ((((size_t)bh * 32 + c + 1) * 16 + ss * 4 + d) * 64 + lane) * 8);
        }
        const size_t trow = (size_t)b * SEQ + 64 * c + ft;
        const u32x4 in0 = *(const u32x4*)(INTRA + trow * HW + ocol), in1 = *(const u32x4*)(INTRA + trow * HW + ocol + 8);
        const u32x4 hg0 = *(const u32x4*)(HG + trow * HW + ocol), hg1 = *(const u32x4*)(HG + trow * HW + ocol + 8);
        f32x16 P;
#pragma unroll
        for (int q = 0; q < 16; ++q) P[q] = 0.f;
#pragma unroll
        for (int kt = 0; kt < 4; ++kt)
#pragma unroll
            for (int ks = 0; ks < 2; ++ks) {
                const bf16x8 qf = *(const LAS bf16x8*)(lds + SC_OPB + slot + ((tt * 4 + kt) * 2 + ks) * 1024 + lane * 16);
                P = MFMA32(qf, pack_step(S[kt], ks), P);
            }
        {   LAS float* ob = (LAS float*)(lds + SC_OBUF + (c & 1) * SC_OBB);
#pragma unroll
            for (int q = 0; q < 16; ++q) ob[(32 * tt + crow(q, h)) * SC_OBP + 32 * d + r] = P[q]; }
#pragma unroll
        for (int kt = 0; kt < 4; ++kt) {
#pragma unroll
            for (int g = 0; g < 4; ++g) { const f32x4 dc = *(const LAS f32x4*)(lds + SC_DEC + (c & 1) * 512 + (32 * kt + 8 * g + 4 * h) * 4);
#pragma unroll
                for (int q = 0; q < 4; ++q) S[kt][4 * g + q] *= dc[q]; }
#pragma unroll
            for (int ss = 0; ss < 4; ++ss) {
                const bf16x8 kf = *(const LAS bf16x8*)(lds + SC_OPB + slot + 16384 + (kt * 4 + ss) * 1024 + lane * 16);
                S[kt] = MFMA32(kf, Vf[ss], S[kt]);
            }
        }
        SC_DEC_ST(c + 1, dnext);
        __syncthreads();
        {
            const LAS float* ob = (const LAS float*)(lds + SC_OBUF + (c & 1) * SC_OBB) + ft * SC_OBP + 16 * fs;
            const f32x4 p0 = *(const LAS f32x4*)ob, p1 = *(const LAS f32x4*)(ob + 4), p2 = *(const LAS f32x4*)(ob + 8), p3 = *(const LAS f32x4*)(ob + 12);
            float o[16];
            o[0] = p0[0] + bflo(in0.x); o[1] = p0[1] + bfhi(in0.x); o[2] = p0[2] + bflo(in0.y); o[3] = p0[3] + bfhi(in0.y);
            o[4] = p1[0] + bflo(in0.z); o[5] = p1[1] + bfhi(in0.z); o[6] = p1[2] + bflo(in0.w); o[7] = p1[3] + bfhi(in0.w);
            o[8] = p2[0] + bflo(in1.x); o[9] = p2[1] + bfhi(in1.x); o[10] = p2[2] + bflo(in1.y); o[11] = p2[3] + bfhi(in1.y);
            o[12] = p3[0] + bflo(in1.z); o[13] = p3[1] + bfhi(in1.z); o[14] = p3[2] + bflo(in1.w); o[15] = p3[3] + bfhi(in1.w);
            float ss2 = 0.f;
#pragma unroll
            for (int q = 0; q < 16; ++q) ss2 += o[q] * o[q];
            ss2 += __shfl_xor(ss2, 1); ss2 += __shfl_xor(ss2, 2); ss2 += __shfl_xor(ss2, 4);
            const float rs = rsqrtf(ss2 * (1.f / 128.f) + EPS);
            const float* gh = F.hgrn_g + ocol;
            const unsigned hgw[8] = {hg0.x, hg0.y, hg0.z, hg0.w, hg1.x, hg1.y, hg1.z, hg1.w};
            unsigned ow[8];
#pragma unroll
            for (int q = 0; q < 8; ++q) ow[q] = cvtpk(o[2 * q] * rs * gh[2 * q] * bflo(hgw[q]), o[2 * q + 1] * rs * gh[2 * q + 1] * bfhi(hgw[q]));
            bf16_t* mo = MIX + trow * MIXW + AW + ocol;
            *(u32x4*)mo = (u32x4){ow[0], ow[1], ow[2], ow[3]}; *(u32x4*)(mo + 8) = (u32x4){ow[4], ow[5], ow[6], ow[7]};
        }
#pragma unroll
        for (int ss = 0; ss < 4; ++ss) Vf[ss] = Vn[ss];
    }
    __syncthreads();
#undef SC_DMA
#undef SC_DEC_LD
#undef SC_DEC_ST
}

constexpr int AT_KP = 72, AT_VP = 260;
__device__ __forceinline__ void attn_stage(Frame& F, int kvh, int n, size_t t0, LAS bf16_t* Ks, LAS bf16_t* Vt) {
    const bf16_t* AK = WSP(bf16_t, WS_AK); const bf16_t* AV = WSP(bf16_t, WS_AV);
    __syncthreads();
    int tid_ = F.tid; asm volatile("" : "+v"(tid_));
#pragma unroll
    for (int i = 0; i < 4; ++i) {
        const int idx = tid_ + 512 * i, row = idx >> 3, c8 = idx & 7;
        u32x4 kv = {0u, 0u, 0u, 0u}, vv = {0u, 0u, 0u, 0u};
        if (n > 0 || row >= 128) { const size_t go = (t0 - 128 + row) * AKW + kvh * 64 + 8 * c8; kv = *(const u32x4*)(AK + go); vv = *(const u32x4*)(AV + go); }
        *(LAS u32x4*)(Ks + row * AT_KP + 8 * c8) = kv;
#pragma unroll
        for (int q = 0; q < 4; ++q) { Vt[(8 * c8 + 2 * q) * AT_VP + row] = (bf16_t)(vv[q] & 0xffffu); Vt[(8 * c8 + 2 * q + 1) * AT_VP + row] = (bf16_t)(vv[q] >> 16); }
    }
    __syncthreads();
}
__device__ __forceinline__ void attn_item(Frame& F, int hq, int rt, int n, size_t t0, const LAS bf16_t* Ks, const LAS bf16_t* Vt, LAS float* ssq, unsigned (&okp)[16]) {
    const bf16_t* AQ = WSP(bf16_t, WS_AQ);
    int lane = F.lane; asm volatile("" : "+v"(lane));
    const int r = lane & 31, h = lane >> 5;
    constexpr float L2E = 1.4426950408889634f;
    const float slope2 = exp2f(-(float)(hq + 1)) * L2E, sink2 = F.sinks[hq] * L2E;
    bf16x8 qf[4];
#pragma unroll
    for (int ds = 0; ds < 4; ++ds) qf[ds] = *(const bf16x8*)(AQ + (t0 + 32 * rt + r) * AW + hq * 64 + 16 * ds + 8 * h);
    float m = sink2;
#define AT_SCORE(SC, j) do { const int kt = rt + (j); int rq = r - 32 * (j); asm volatile("" : "+v"(rq));     \
        _Pragma("unroll") for (int q = 0; q < 16; ++q) SC[q] = 0.f; \
        _Pragma("unroll") for (int ds = 0; ds < 4; ++ds) SC = MFMA32(*(const LAS bf16x8*)(Ks + (32 * kt + r) * AT_KP + 16 * ds + 8 * h), qf[ds], SC); \
        const bool tile_ok = (n > 0) || (kt >= 4); \
        _Pragma("unroll") for (int q = 0; q < 16; ++q) { const int dist = 128 + rq - crow(q, h); const float v = SC[q] * (0.125f * L2E) - slope2 * (float)dist; \
            SC[q] = (tile_ok && dist >= 0 && dist < 128) ? v : -INFINITY; } } while (0)
#pragma unroll
    for (int j = 0; j < 5; ++j) { f32x16 sc; AT_SCORE(sc, j);
#pragma unroll
        for (int q = 0; q < 16; ++q) m = fmaxf(m, sc[q]); }
    m = fmaxf(m, __shfl_xor(m, 32));
    float l = 0.f; unsigned pp[5][8];
#pragma unroll
    for (int j = 0; j < 5; ++j) { f32x16 sc; AT_SCORE(sc, j);
#pragma unroll
        for (int q = 0; q < 16; ++q) { sc[q] = exp2f(sc[q] - m); l += sc[q]; }
#pragma unroll
        for (int q = 0; q < 8; ++q) pp[j][q] = cvtpk(sc[2 * q], sc[2 * q + 1]); }
#undef AT_SCORE
    l += __shfl_xor(l, 32); l += exp2f(sink2 - m);
    const float rl = 1.f / l;
    float sq = 0.f;
#pragma unroll
    for (int dt = 0; dt < 2; ++dt) {
        f32x16 o;
#pragma unroll
        for (int q = 0; q < 16; ++q) o[q] = 0.f;
        const LAS bf16_t* vrow = Vt + (32 * dt + r) * AT_VP + 4 * h;
#pragma unroll
        for (int j = 0; j < 5; ++j)
#pragma unroll
            for (int s = 0; s < 2; ++s) { const LAS bf16_t* vp = vrow + 32 * (rt + j) + 16 * s;
                const u32x2 va = *(const LAS u32x2*)vp, vb = *(const LAS u32x2*)(vp + 8); const u32x4 pa = {va.x, va.y, vb.x, vb.y};
                const u32x4 pb = {pp[j][4 * s], pp[j][4 * s + 1], pp[j][4 * s + 2], pp[j][4 * s + 3]};
                o = MFMA32(__builtin_bit_cast(bf16x8, pa), __builtin_bit_cast(bf16x8, pb), o); }
#pragma unroll
        for (int q = 0; q < 16; ++q) { o[q] *= rl; sq += o[q] * o[q]; }
#pragma unroll
        for (int q = 0; q < 8; ++q) okp[dt * 8 + q] = cvtpk(o[2 * q], o[2 * q + 1]);
    }
    sq += __shfl_xor(sq, 32);
    if (h == 0) __hip_atomic_fetch_add(&ssq[32 * rt + r], sq, __ATOMIC_RELAXED, __HIP_MEMORY_SCOPE_WORKGROUP);
}
__device__ __forceinline__ void attn_store(Frame& F, int hq, int rt, size_t t0, const LAS float* ssq, const unsigned (&okp)[16]) {
    bf16_t* MIX = WSP(bf16_t, WS_MIX);
    int lane = F.lane; asm volatile("" : "+v"(lane));
    const int r = lane & 31, h = lane >> 5;
    const float rs = rsqrtf(ssq[32 * rt + r] * (1.f / AW) + EPS);
    bf16_t* mo = MIX + (t0 + 32 * rt + r) * MIXW + hq * 64;
#pragma unroll
    for (int dt = 0; dt < 2; ++dt)
#pragma unroll
        for (int g4 = 0; g4 < 4; ++g4) {
            const int d0 = 32 * dt + 8 * g4 + 4 * h; const f32x4 ga = *(const f32x4*)(F.attn_g + hq * 64 + d0);
            const unsigned p0 = okp[dt * 8 + 2 * g4], p1 = okp[dt * 8 + 2 * g4 + 1];
            u32x2 ow; ow.x = cvtpk(bflo(p0) * rs * ga[0], bfhi(p0) * rs * ga[1]); ow.y = cvtpk(bflo(p1) * rs * ga[2], bfhi(p1) * rs * ga[3]);
            *(u32x2*)(mo + d0) = ow;
        }
}
__device__ __forceinline__ void attn_unit(Frame& F, int u) {
    LAS bf16_t* Ks = (LAS bf16_t*)F.lds;
    LAS bf16_t* Vt = (LAS bf16_t*)(F.lds + 36864);
    LAS float* ssq = (LAS float*)(F.lds + 36864 + 33280);
    const int w = F.wave, b = u >> 4, n = u & 15; const size_t t0 = (size_t)b * SEQ + 128 * n;
    if (F.tid < 128) ssq[F.tid] = 0.f;
    const int g0 = (2 * w) >> 2, rt0 = (2 * w) & 3, g1 = (2 * w + 1) >> 2, rt1 = (2 * w + 1) & 3;
    unsigned ok0[16], ok1[16], ok2[16], ok3[16];
    attn_stage(F, 0, n, t0, Ks, Vt);
    attn_item(F, g0, rt0, n, t0, Ks, Vt, ssq, ok0);
    attn_item(F, g1, rt1, n, t0, Ks, Vt, ssq, ok1);
    attn_stage(F, 1, n, t0, Ks, Vt);
    attn_item(F, 4 + g0, rt0, n, t0, Ks, Vt, ssq, ok2);
    attn_item(F, 4 + g1, rt1, n, t0, Ks, Vt, ssq, ok3);
    __syncthreads();
    attn_store(F, g0, rt0, t0, ssq, ok0); attn_store(F, g1, rt1, t0, ssq, ok1); attn_store(F, 4 + g0, rt0, t0, ssq, ok2); attn_store(F, 4 + g1, rt1, t0, ssq, ok3);
    __syncthreads();
}
__device__ __forceinline__ void p_scan_attn(Frame& F, bool do_scan, bool do_attn) {
    const int G = F.G, bx = blockIdx.x, nscan = (do_scan && do_attn && G >= 64) ? 32 : 0;
    if (do_scan) { if (nscan) { if (bx < nscan) scan_unit(F, bx); } else for (int u = bx; u < BATCH * 4; u += G) scan_unit(F, u); }
    if (do_attn) { if (nscan) { for (int u = bx - nscan; u >= 0 && u < BATCH * 16; u += G - nscan) attn_unit(F, u); } else for (int u = bx; u < BATCH * 16; u += G) attn_unit(F, u); }
}

__device__ __forceinline__ int w1col(int n) { const int pn = n >> 8, cl = n & 255; return cl < 128 ? 2 * (128 * pn + cl) : 2 * (128 * pn + cl - 128) + 1; }
template <bool W1MAP>
__device__ __forceinline__ void p0_transpose_item(const float* W, int K, int N, bf16_t* WT, LAS float* scr, int item, int lane) {
    const int nblk = N / 32, kb = item / nblk, nb = item % nblk, k0 = 64 * kb, n0 = 32 * nb;
    const int sc = W1MAP ? w1col(n0 + (lane & 31)) : n0 + (lane & 31);
#pragma unroll 8
    for (int i = 0; i < 32; ++i) { const int kk = 2 * i + (lane >> 5); scr[kk * 33 + (lane & 31)] = W[(size_t)(k0 + kk) * N + sc]; }
    LDS_WAIT(); asm volatile("" ::: "memory");
    const int c = lane & 7;
#pragma unroll
    for (int j = 0; j < 4; ++j) { const int n = (lane >> 3) + 8 * j; const LAS float* s = scr + (8 * c) * 33 + n;
        u32x4 o; o.x = pg8::cvt_pk_bf16(s[0 * 33], s[1 * 33]); o.y = pg8::cvt_pk_bf16(s[2 * 33], s[3 * 33]); o.z = pg8::cvt_pk_bf16(s[4 * 33], s[5 * 33]); o.w = pg8::cvt_pk_bf16(s[6 * 33], s[7 * 33]);
        *(GAS u32x4*)(WT + (size_t)(n0 + n) * K + k0 + 8 * c) = o; }
    LDS_WAIT(); asm volatile("" ::: "memory");
}
__device__ __forceinline__ void p_prologue(Frame& F) {
    LAS float* scr = (LAS float*)(F.lds + RING_OFF + F.wave * 16384);
    const int gw = F.vcu * NWAVES + F.wave, NGW = F.G * NWAVES;
    constexpr int I_IN = (DM / 64) * (INW / 32), I_OUT = (MIXW / 64) * (DM / 32), I_W1E = (DM / 64) * (2 * FF / 32), I_W2E = (FF / 64) * (DM / 32);
    constexpr int NITEMS = I_IN + I_OUT + NE * I_W1E + NE * I_W2E;
    bf16_t *WinT = WSP(bf16_t, WS_WINT), *WoutT = WSP(bf16_t, WS_WOUTT), *W1T = WSP(bf16_t, WS_W1T), *W2T = WSP(bf16_t, WS_W2T);
    for (int it = gw; it < NITEMS; it += NGW) {
        int r = it;
        if (r < I_IN) { p0_transpose_item<false>(F.w_in, DM, INW, WinT, scr, r, F.lane); continue; } r -= I_IN;
        if (r < I_OUT) { p0_transpose_item<false>(F.w_out, MIXW, DM, WoutT, scr, r, F.lane); continue; } r -= I_OUT;
        if (r < NE * I_W1E) { const int e = r / I_W1E; p0_transpose_item<true>(F.w1 + (size_t)e * DM * 2 * FF, DM, 2 * FF, W1T + (size_t)e * 2 * FF * DM, scr, r % I_W1E, F.lane); continue; } r -= NE * I_W1E;
        { const int e = r / I_W2E; p0_transpose_item<false>(F.w2 + (size_t)e * FF * DM, FF, DM, W2T + (size_t)e * DM * FF, scr, r % I_W2E, F.lane); }
    }
    bf16_t* XN = WSP(bf16_t, WS_XN);
    for (int m = gw; m < T; m += NGW) {
        const GAS f32x4* xr = (const GAS f32x4*)(F.x + (size_t)m * DM) + F.lane;
        f32x4 v[4]; float s = 0.f;
#pragma unroll
        for (int j = 0; j < 4; ++j) { v[j] = xr[64 * j]; s += (v[j].x * v[j].x + v[j].y * v[j].y) + (v[j].z * v[j].z + v[j].w * v[j].w); }
        const float r = rsqrtf(wave_sum(s) * (1.f / DM) + EPS);
        GAS u32x2* o8 = (GAS u32x2*)(XN + (size_t)m * DM) + F.lane;
#pragma unroll
        for (int j = 0; j < 4; ++j) { const f32x4 g = *((const f32x4*)F.norm1_g + F.lane + 64 * j); u32x2 w; w.x = pg8::cvt_pk_bf16(v[j].x * r * g.x, v[j].y * r * g.y); w.y = pg8::cvt_pk_bf16(v[j].z * r * g.z, v[j].w * r * g.w); o8[64 * j] = w; }
    }
    if ((int)blockIdx.x == (F.G > 1 ? 1 : 0)) {
        bf16_t* RWF = WSP(bf16_t, WS_RWF);
        for (int i = F.tid; i < 64 * 64; i += NWAVES * 64) { const int ks = i >> 6, ln = i & 63, rr = ln & 31, hh = ln >> 5; float v[8];
#pragma unroll
            for (int j = 0; j < 8; ++j) v[j] = F.router_w[(size_t)(16 * ks + 8 * hh + j) * NE + rr];
            u32x4 hi, lo; hi.x = cvtpk(v[0], v[1]); hi.y = cvtpk(v[2], v[3]); hi.z = cvtpk(v[4], v[5]); hi.w = cvtpk(v[6], v[7]);
            lo.x = cvtpk(v[0] - bflo(hi.x), v[1] - bfhi(hi.x)); lo.y = cvtpk(v[2] - bflo(hi.y), v[3] - bfhi(hi.y)); lo.z = cvtpk(v[4] - bflo(hi.z), v[5] - bfhi(hi.z)); lo.w = cvtpk(v[6] - bflo(hi.w), v[7] - bfhi(hi.w));
            *(u32x4*)(RWF + ((size_t)(ks * 2 + 0) * 64 + ln) * 8) = hi; *(u32x4*)(RWF + ((size_t)(ks * 2 + 1) * 64 + ln) * 8) = lo; }
    }
    if (blockIdx.x == 0) { float* LB = WSP(float, WS_LB); for (int c = F.tid; c < HKW; c += NWAVES * 64) { const float a = F.lb_logits[c], b = F.lb_logits[HKW + c]; LB[c] = 1.f / (1.f + __expf(b - a)); } }
}

__device__ __forceinline__ void p_router(Frame& F) {
    LAS int* lcnt = (LAS int*)(F.lds + MOE_OFF + 512); LAS int* lbase = (LAS int*)(F.lds + MOE_OFF + 768);
    LAS float* part = (LAS float*)F.lds;
    LAS float* ssqp = (LAS float*)(F.lds + 32768);
    const float* X1 = WSP(float, WS_X1); bf16_t* H2 = WSP(bf16_t, WS_H2); float* GATE = WSP(float, WS_GATE); int* LIST = WSP(int, WS_LIST); float* RSTD = WSP(float, WS_RSTD);
    const bf16_t* RWF = WSP(bf16_t, WS_RWF);
    int* cnt = (int*)(F.ctl + CW_CNT);
    const int lane = F.lane, w = F.wave, r = lane & 31, h = lane >> 5, tile = w & 1, kq = w >> 1;
    for (int tb = blockIdx.x; tb < T / 64; tb += F.G) {
        if (F.tid < NE) lcnt[F.tid] = 0;
        const int t = tb * 64 + tile * 32 + r;
        f32x16 acc;
#pragma unroll
        for (int q = 0; q < 16; ++q) acc[q] = 0.f;
        float ssq = 0.f;
#pragma unroll 4
        for (int ks = 16 * kq; ks < 16 * kq + 16; ++ks) {
            const int k0 = 16 * ks + 8 * h;
            const f32x4 x0 = *(const f32x4*)(X1 + (size_t)t * DM + k0), x1v = *(const f32x4*)(X1 + (size_t)t * DM + k0 + 4);
            const f32x4 g0 = *(const f32x4*)(F.norm2_g + k0), g1 = *(const f32x4*)(F.norm2_g + k0 + 4);
            const u32x4 ahi = *(const u32x4*)(RWF + ((size_t)(ks * 2 + 0) * 64 + lane) * 8), alo = *(const u32x4*)(RWF + ((size_t)(ks * 2 + 1) * 64 + lane) * 8);
            float u[8];
#pragma unroll
            for (int q = 0; q < 4; ++q) { u[q] = x0[q] * g0[q]; u[4 + q] = x1v[q] * g1[q]; ssq += x0[q] * x0[q]; ssq += x1v[q] * x1v[q]; }
            u32x4 bh, bl;
            bh.x = cvtpk(u[0], u[1]); bh.y = cvtpk(u[2], u[3]); bh.z = cvtpk(u[4], u[5]); bh.w = cvtpk(u[6], u[7]);
            bl.x = cvtpk(u[0] - bflo(bh.x), u[1] - bfhi(bh.x)); bl.y = cvtpk(u[2] - bflo(bh.y), u[3] - bfhi(bh.y));
            bl.z = cvtpk(u[4] - bflo(bh.z), u[5] - bfhi(bh.z)); bl.w = cvtpk(u[6] - bflo(bh.w), u[7] - bfhi(bh.w));
            *(u32x4*)(H2 + (size_t)t * DM + k0) = bh;
            acc = MFMA32(__builtin_bit_cast(bf16x8, ahi), __builtin_bit_cast(bf16x8, bh), acc);
            acc = MFMA32(__builtin_bit_cast(bf16x8, alo), __builtin_bit_cast(bf16x8, bh), acc);
            acc = MFMA32(__builtin_bit_cast(bf16x8, ahi), __builtin_bit_cast(bf16x8, bl), acc);
        }
#pragma unroll
        for (int q = 0; q < 4; ++q) *(LAS f32x4*)(part + (w * 64 + lane) * 16 + 4 * q) = (f32x4){acc[4 * q], acc[4 * q + 1], acc[4 * q + 2], acc[4 * q + 3]};
        ssqp[w * 64 + lane] = ssq;
        __syncthreads();
        int my_e[TOPK], my_p[TOPK];
#pragma unroll
        for (int k = 0; k < TOPK; ++k) { my_e[k] = 0; my_p[k] = 0; }
        if (w < 2) {
            float lg[16];
#pragma unroll
            for (int q = 0; q < 16; ++q) lg[q] = 0.f;
            float s2 = 0.f;
#pragma unroll
            for (int k4 = 0; k4 < 4; ++k4) { const int ww = k4 * 2 + tile;
#pragma unroll
                for (int q = 0; q < 4; ++q) { const f32x4 p = *(const LAS f32x4*)(part + (ww * 64 + lane) * 16 + 4 * q); lg[4 * q] += p[0]; lg[4 * q + 1] += p[1]; lg[4 * q + 2] += p[2]; lg[4 * q + 3] += p[3]; }
                s2 += ssqp[ww * 64 + lane] + ssqp[ww * 64 + (lane ^ 32)]; }
            const float rstd = rsqrtf(s2 * (1.f / DM) + EPS);
#pragma unroll
            for (int q = 0; q < 16; ++q) lg[q] = lg[q] * rstd + F.router_b[crow(q, h)];
            float cv[8]; int ci[8];
#pragma unroll
            for (int k = 0; k < TOPK; ++k) {
                float bv = -INFINITY; int bi = 1 << 20;
#pragma unroll
                for (int q = 0; q < 16; ++q) { const int e = crow(q, h); const bool better = (lg[q] > bv) || (lg[q] == bv && e < bi); bv = better ? lg[q] : bv; bi = better ? e : bi; }
#pragma unroll
                for (int q = 0; q < 16; ++q) if (crow(q, h) == bi) lg[q] = -INFINITY;
                cv[k] = bv; ci[k] = bi;
            }
#pragma unroll
            for (int k = 0; k < TOPK; ++k) { cv[4 + k] = __shfl_xor(cv[k], 32); ci[4 + k] = __shfl_xor(ci[k], 32); }
            float tv[TOPK]; int te[TOPK];
#pragma unroll
            for (int k = 0; k < TOPK; ++k) {
                float bv = -INFINITY; int bi = 1 << 20;
#pragma unroll
                for (int q = 0; q < 8; ++q) { const bool better = (cv[q] > bv) || (cv[q] == bv && ci[q] < bi); bv = better ? cv[q] : bv; bi = better ? ci[q] : bi; }
#pragma unroll
                for (int q = 0; q < 8; ++q) if (ci[q] == bi) cv[q] = -INFINITY;
                tv[k] = bv; te[k] = bi;
            }
            const float e1 = __expf(tv[1] - tv[0]), e2 = __expf(tv[2] - tv[0]), e3 = __expf(tv[3] - tv[0]), inv = 1.f / (1.f + e1 + e2 + e3);
            if (h == 0) {
                RSTD[t] = rstd;
                *(f32x4*)(GATE + (size_t)t * TOPK) = (f32x4){inv, e1 * inv, e2 * inv, e3 * inv};
#pragma unroll
                for (int k = 0; k < TOPK; ++k) { my_e[k] = te[k]; my_p[k] = __hip_atomic_fetch_add(&lcnt[te[k]], 1, __ATOMIC_RELAXED, __HIP_MEMORY_SCOPE_WORKGROUP); }
            }
        }
        __syncthreads();
        if (F.tid < NE) lbase[F.tid] = atomicAdd(&cnt[F.tid], (int)lcnt[F.tid]);
        __syncthreads();
        if (w < 2 && h == 0) {
#pragma unroll
            for (int k = 0; k < TOPK; ++k) LIST[(size_t)my_e[k] * T + lbase[my_e[k]] + my_p[k]] = t * TOPK + k;
        }
        __syncthreads();
    }
}
__device__ __forceinline__ void moe_setup(Frame& F) {
    LAS int* pre = (LAS int*)(F.lds + MOE_OFF); LAS int* lc = (LAS int*)(F.lds + MOE_OFF + 256);
    if (F.tid < 64) {
        const int c = F.lane < NE ? (int)__hip_atomic_load((int*)(F.ctl + CW_CNT) + F.lane, RLX_AGENT) : 0;
        int s = (c + 255) >> 8;
#pragma unroll
        for (int o = 1; o < 32; o <<= 1) { const int v = __shfl_up(s, o); if ((F.lane & 31) >= o) s += v; }
        if (F.lane < NE) { pre[F.lane + 1] = s; lc[F.lane] = c; }
        if (F.lane == 0) pre[0] = 0;
    }
    __syncthreads();
}
__device__ __forceinline__ void p_final(Frame& F) {
    const float* X1 = WSP(float, WS_X1); const bf16_t* Y = WSP(bf16_t, WS_Y);
    const int gw = F.vcu * NWAVES + F.wave, NGW = F.G * NWAVES;
    for (int t = gw; t < T; t += NGW) {
        const GAS f32x4* xr = (const GAS f32x4*)(X1 + (size_t)t * DM) + F.lane;
        f32x4 v[4]; float s = 0.f;
#pragma unroll
        for (int j = 0; j < 4; ++j) {
            v[j] = xr[64 * j];
#pragma unroll
            for (int k = 0; k < TOPK; ++k) { const u32x2 y = *((const GAS u32x2*)(Y + ((size_t)t * TOPK + k) * DM) + F.lane + 64 * j);
                v[j].x += __builtin_bit_cast(float, y.x << 16); v[j].y += __builtin_bit_cast(float, y.x & 0xffff0000u); v[j].z += __builtin_bit_cast(float, y.y << 16); v[j].w += __builtin_bit_cast(float, y.y & 0xffff0000u); }
            s += (v[j].x * v[j].x + v[j].y * v[j].y) + (v[j].z * v[j].z + v[j].w * v[j].w);
        }
        const float r = rsqrtf(wave_sum(s) * (1.f / DM) + EPS);
        GAS f32x4* o = (GAS f32x4*)(F.out + (size_t)t * DM) + F.lane;
#pragma unroll
        for (int j = 0; j < 4; ++j) { const f32x4 g = *((const f32x4*)F.final_g + F.lane + 64 * j); o[64 * j] = (f32x4){v[j].x * r * g.x, v[j].y * r * g.y, v[j].z * r * g.z, v[j].w * r * g.w}; }
    }
}


__device__ __forceinline__ void p_attn_simple(Frame& F) {
    const bf16_t* AQ = WSP(bf16_t, WS_AQ); const bf16_t* AK = WSP(bf16_t, WS_AK); const bf16_t* AV = WSP(bf16_t, WS_AV); float* ATT = WSP(float, WS_ATT);
    const int gw0 = F.vcu * NWAVES + F.wave, NGW = F.G * NWAVES, lane = F.lane;
    for (int gw = gw0; gw < T * 8; gw += NGW) {
        const int t = gw >> 3, hq = gw & 7, kvh = hq >> 2, b = t / SEQ, tp = t % SEQ;
        const float slope = exp2f(-(float)(hq + 1)), sink = F.sinks[hq];
        const float qd = bf2f(AQ[(size_t)t * AW + hq * 64 + lane]);
        const int s0 = tp >= 127 ? tp - 127 : 0, nk = tp - s0 + 1;
        const bf16_t* kb = AK + ((size_t)b * SEQ + s0) * AKW + kvh * 64 + lane;
        const bf16_t* vb = AV + ((size_t)b * SEQ + s0) * AKW + kvh * 64 + lane;
        float slo = -INFINITY, shi = -INFINITY;
        for (int i = 0; i < nk; ++i) {
            const float d = wave_sum(qd * bf2f(kb[(size_t)i * AKW]));
            const float sc = d * 0.125f - slope * (float)(tp - (s0 + i));
            if ((i & 63) == lane) { if (i < 64) slo = sc; else shi = sc; }
        }
        const float m = fmaxf(wave_max(fmaxf(slo, shi)), sink);
        const float plo = __expf(slo - m), phi = __expf(shi - m);
        const float den = wave_sum(plo + phi) + __expf(sink - m);
        float o = 0.f;
        for (int i = 0; i < nk; ++i) { const float p = __shfl(i < 64 ? plo : phi, i & 63); o += p * bf2f(vb[(size_t)i * AKW]); }
        ATT[(size_t)t * AW + hq * 64 + lane] = o / den;
    }
}
__device__ __forceinline__ void p_hgrn_simple(Frame& F) {
    constexpr int TT = 16;
    LAS float* sf = (LAS float*)(F.lds); LAS float* sk = sf + TT * 128; LAS float* sq = sk + TT * 128; LAS float* po = sq + TT * 128;
    const bf16_t* HQ = WSP(bf16_t, WS_HQ); const float* G = WSP(float, WS_G); const bf16_t* KK = WSP(bf16_t, WS_KK); const bf16_t* HI = WSP(bf16_t, WS_HI); float* ORAW = WSP(float, WS_ORAW);
    for (int u = blockIdx.x; u < BATCH * 4; u += F.G) {
        const int b = u >> 2, h = u & 3, v = F.tid & 127, kq = F.tid >> 7;
        float S[32];
#pragma unroll
        for (int k = 0; k < 32; ++k) S[k] = 0.f;
        for (int t0 = 0; t0 < SEQ; t0 += TT) {
            __syncthreads();
            for (int i = F.tid; i < TT * 128; i += NWAVES * 64) {
                const int tt = i >> 7, k = i & 127; const size_t idx = ((size_t)b * SEQ + t0 + tt) * HKW + h * 128 + k;
                sf[i] = __expf(G[idx]); sk[i] = bf2f(KK[idx]); sq[i] = bf2f(HQ[idx]);
            }
            __syncthreads();
            for (int tt = 0; tt < TT; ++tt) {
                const float vv = bf2f(HI[((size_t)b * SEQ + t0 + tt) * HW + h * 128 + v]);
                float o = 0.f;
#pragma unroll
                for (int k = 0; k < 32; ++k) { const int kk = tt * 128 + kq * 32 + k; S[k] = sf[kk] * S[k] + sk[kk] * vv; o += sq[kk] * S[k]; }
                po[(tt * 4 + kq) * 128 + v] = o;
            }
            __syncthreads();
            for (int i = F.tid; i < TT * 128; i += NWAVES * 64) {
                const int tt = i >> 7, vv = i & 127;
                ORAW[((size_t)b * SEQ + t0 + tt) * HW + h * 128 + vv] = (po[(tt * 4 + 0) * 128 + vv] + po[(tt * 4 + 1) * 128 + vv]) + (po[(tt * 4 + 2) * 128 + vv] + po[(tt * 4 + 3) * 128 + vv]);
            }
        }
        __syncthreads();
    }
}
__device__ __forceinline__ void p_mix_simple(Frame& F, bool do_attn, bool do_hgrn) {
    const float* ATT = WSP(float, WS_ATT); const float* ORAW = WSP(float, WS_ORAW); const bf16_t* HG = WSP(bf16_t, WS_HG); bf16_t* MIX = WSP(bf16_t, WS_MIX);
    const int gw0 = F.vcu * NWAVES + F.wave, NGW = F.G * NWAVES, lane = F.lane;
    for (int t = gw0; t < T; t += NGW) {
        if (do_attn) {
        float a[8]; float ss = 0.f;
#pragma unroll
        for (int j = 0; j < 8; ++j) { a[j] = ATT[(size_t)t * AW + lane + 64 * j]; ss += a[j] * a[j]; }
        const float r = rsqrtf(wave_sum(ss) * (1.f / AW) + EPS);
#pragma unroll
        for (int j = 0; j < 8; ++j) MIX[(size_t)t * MIXW + lane + 64 * j] = f2bf(a[j] * r * F.attn_g[lane + 64 * j]);
        }
        if (do_hgrn)
#pragma unroll
        for (int h = 0; h < 4; ++h) {
            const int c0 = h * 128 + lane, c1 = c0 + 64;
            const float o0 = ORAW[(size_t)t * HW + c0], o1 = ORAW[(size_t)t * HW + c1];
            const float rr = rsqrtf(wave_sum(o0 * o0 + o1 * o1) * (1.f / 128.f) + EPS);
            MIX[(size_t)t * MIXW + AW + c0] = f2bf(o0 * rr * F.hgrn_g[c0] * bf2f(HG[(size_t)t * HW + c0]));
            MIX[(size_t)t * MIXW + AW + c1] = f2bf(o1 * rr * F.hgrn_g[c1] * bf2f(HG[(size_t)t * HW + c1]));
        }
    }
}

struct Args { const float* in[18]; float* out; unsigned char* ws; int ph_lo, ph_hi, li, pad; };
__global__ void __launch_bounds__(NWAVES * 64, 2) mega_fwd(Args args) {
    extern __shared__ __attribute__((aligned(16))) unsigned char lds[];
    Frame F;
    F.lds = (LAS unsigned char*)lds; F.MISC = (volatile LAS unsigned*)(F.lds + MISC_OFF);
    F.tid = threadIdx.x; F.lane = F.tid & 63; F.wave = __builtin_amdgcn_readfirstlane(F.tid >> 6);
    F.G = gridDim.x; { const int bx = blockIdx.x; F.vcu = (F.G % 8 == 0) ? (bx % 8) * (F.G / 8) + bx / 8 : bx; }
    F.ws = args.ws; F.ctl = (gu32*)(args.ws + WS_CTL); F.out = args.out;
    F.x = args.in[0]; F.norm1_g = args.in[1]; F.w_in = args.in[2]; F.b_in = args.in[3]; F.sinks = args.in[4]; F.attn_g = args.in[5]; F.lb_logits = args.in[6]; F.hgrn_g = args.in[7];
    F.w_out = args.in[8]; F.b_out = args.in[9]; F.norm2_g = args.in[10]; F.router_w = args.in[11]; F.router_b = args.in[12]; F.w1 = args.in[13]; F.b1 = args.in[14]; F.w2 = args.in[15];
    F.b2 = args.in[16]; F.final_g = args.in[17];
    for (int u = F.tid; u < (LDS_BYTES - LDSCTL_OFF) / 4; u += NWAVES * 64) ((LAS unsigned*)(F.lds + LDSCTL_OFF))[u] = 0u;
    __syncthreads();
    XcdBarrier bar = xcd_barrier_post((unsigned*)(F.ctl + CW_BAR) + args.li * XCD_BAR_WORDS, F.MISC + 8);
    const int lo = args.ph_lo, hi = args.ph_hi;
#define IN(k) (lo <= (k) && (k) < hi)
#define SEAM(k) do { if (IN(k) && IN((k) + 1)) xcd_barrier(bar); } while (0)

    if (IN(0)) { p_prologue(F); SEAM(0); }
    if (IN(1)) {
        pg8::DenseOrder S; S.init(WSP(bf16_t, WS_XN), WSP(bf16_t, WS_WINT), T, INW, DM, F.G, (int)blockIdx.x);
        pg8::EpiInProj E{F.b_in, WSP(float, WS_LB), WSP(bf16_t, WS_AQ), WSP(bf16_t, WS_AK), WSP(bf16_t, WS_AV), WSP(bf16_t, WS_HQ), WSP(bf16_t, WS_KK), WSP(bf16_t, WS_HI), WSP(bf16_t, WS_HG), WSP(float, WS_G)};
        pg8::gemm_phase<pg8::EpiInProj, pg8::DenseOrder, false, true>(F.lds + RING_OFF, DM, S, E);
        SEAM(1);
    }
#ifndef NEW_ATTN
#define NEW_ATTN 1
#endif
#ifndef NEW_HGRN
#define NEW_HGRN 1
#endif
    if (IN(2)) { if (!NEW_ATTN) p_attn_simple(F); if (NEW_HGRN) p_hgrn_prep(F); SEAM(2); }
    if (IN(3)) { if (!NEW_HGRN) p_hgrn_simple(F); p_scan_attn(F, NEW_HGRN, NEW_ATTN); SEAM(3); }
    if (IN(4)) { if (!NEW_ATTN || !NEW_HGRN) p_mix_simple(F, !NEW_ATTN, !NEW_HGRN); SEAM(4); }
    if (IN(5)) {
        pg8::DenseOrder S; S.init(WSP(bf16_t, WS_MIX), WSP(bf16_t, WS_WOUTT), T, DM, MIXW, F.G, (int)blockIdx.x);
        pg8::EpiOutProj E{F.b_out, F.x, WSP(float, WS_X1)};
        pg8::gemm_phase<pg8::EpiOutProj, pg8::DenseOrder, false, true>(F.lds + RING_OFF, MIXW, S, E);
        SEAM(5);
    }
    if (IN(6)) { p_router(F); SEAM(6); }
    if (IN(7)) {
        moe_setup(F);
        LAS const int* pre = (LAS const int*)(F.lds + MOE_OFF); LAS const int* lc = (LAS const int*)(F.lds + MOE_OFF + 256);
        pg8::MoeOrder<true> S{(const char*)WSP(bf16_t, WS_H2), (const char*)WSP(bf16_t, WS_W1T), WSP(int, WS_LIST), pre, lc, DM, 2 * FF, 2 * FF / 256, pre[NE] * (2 * FF / 256), F.G, (int)blockIdx.x};
        pg8::EpiMoe1 E{F.b1, WSP(bf16_t, WS_ACT), WSP(int, WS_LIST), WSP(float, WS_RSTD)};
        pg8::gemm_phase<pg8::EpiMoe1, pg8::MoeOrder<true>, true, true>(F.lds + RING_OFF, DM, S, E);
        SEAM(7);
    }
    if (IN(8)) {
        if (!IN(7)) moe_setup(F);
        LAS const int* pre = (LAS const int*)(F.lds + MOE_OFF); LAS const int* lc = (LAS const int*)(F.lds + MOE_OFF + 256);
        pg8::MoeOrder<false> S{(const char*)WSP(bf16_t, WS_ACT), (const char*)WSP(bf16_t, WS_W2T), WSP(int, WS_LIST), pre, lc, FF, DM, DM / 256, pre[NE] * (DM / 256), F.G, (int)blockIdx.x};
        pg8::EpiMoe2 E{F.b2, WSP(int, WS_LIST), WSP(float, WS_GATE), WSP(bf16_t, WS_Y)};
        pg8::gemm_phase<pg8::EpiMoe2, pg8::MoeOrder<false>, false, true>(F.lds + RING_OFF, FF, S, E);
        SEAM(8);
    }
    if (IN(9)) p_final(F);
#undef IN
#undef SEAM
}

static int mega_grid() {
    static int grid = 0;
    if (grid == 0) {
        int dev = 0, cus = 0;
        if (hipGetDevice(&dev) != hipSuccess || hipDeviceGetAttribute(&cus, hipDeviceAttributeMultiprocessorCount, dev) != hipSuccess) { grid = -1; return grid; }
        if (hipFuncSetAttribute((const void*)mega_fwd, hipFuncAttributeMaxDynamicSharedMemorySize, LDS_BYTES) != hipSuccess) { grid = -1; return grid; }
        (void)hipGetLastError();
        grid = cus;
    }
    return grid;
}
extern "C" void kernel_launch(void* const* d_in, const int* in_sizes, int n_in, void* d_out, int out_size, void* d_ws, size_t ws_size, hipStream_t stream) {
    if (n_in != 18 || ws_size < WS_END) return;
    const int grid = mega_grid(); if (grid <= 0) return;
    unsigned char* ws = (unsigned char*)d_ws;
    (void)hipMemsetAsync(ws + WS_CTL, 0, 262144, stream);
    Args a{};
    for (int i = 0; i < 18; ++i) a.in[i] = (const float*)d_in[i];
    a.out = (float*)d_out; a.ws = ws;
#ifndef PLAN
#define PLAN {{0, N_PHASES}}
#endif
    static const int plan[][2] = PLAN;
    for (int li = 0; li < (int)(sizeof(plan) / sizeof(plan[0])); ++li) {
        a.ph_lo = plan[li][0]; a.ph_hi = plan[li][1]; a.li = li;
        hipLaunchKernelGGL(mega_fwd, dim3(grid), dim3(NWAVES * 64), LDS_BYTES, stream, a);
    }
}
```

```cpp
#include <hip/hip_runtime.h>
#include <stdint.h>

typedef unsigned short bf16_t;
typedef short bf16x8 __attribute__((ext_vector_type(8)));
typedef float f32x4 __attribute__((ext_vector_type(4)));

constexpr int BATCH = 8, SEQ = 2048, DM = 1024, T = BATCH * SEQ;
constexpr int AW = 512, AKW = 128, HKW = 512, HW = 512, INW = 2816, MIXW = 1024;
constexpr int NE = 32, TOPK = 4, FF = 1024;
constexpr int C_AQ = 0, C_AK = 512, C_AV = 640, C_HQ = 768, C_HF = 1280, C_HI = 1792, C_HG = 2304;
constexpr float EPS = 1e-5f;
constexpr int ACT_ROWS = T * TOPK + NE * 256;

constexpr size_t MiB = 1u << 20;
constexpr size_t al(size_t x) { return (x + 255) & ~(size_t)255; }
constexpr size_t WS_CTL = 0;
constexpr size_t WS_LB = 1 * MiB;
constexpr size_t WS_WINT = 2 * MiB;
constexpr size_t WS_WOUTT = WS_WINT + al((size_t)INW * DM * 2);
constexpr size_t WS_W1T = WS_WOUTT + al((size_t)DM * MIXW * 2);
constexpr size_t WS_W2T = WS_W1T + al((size_t)NE * 2 * FF * DM * 2);
constexpr size_t WS_XN = WS_W2T + al((size_t)NE * DM * FF * 2);
constexpr size_t WS_AQ = WS_XN + al((size_t)T * DM * 2);
constexpr size_t WS_AK = WS_AQ + al((size_t)T * AW * 2);
constexpr size_t WS_AV = WS_AK + al((size_t)T * AKW * 2);
constexpr size_t WS_HQ = WS_AV + al((size_t)T * AKW * 2);
constexpr size_t WS_G = WS_HQ + al((size_t)T * HKW * 2);
constexpr size_t WS_KK = WS_G + al((size_t)T * HKW * 4);
constexpr size_t WS_HI = WS_KK + al((size_t)T * HKW * 2);
constexpr size_t WS_HG = WS_HI + al((size_t)T * HW * 2);
constexpr size_t WS_ATT = WS_HG + al((size_t)T * HW * 2);
constexpr size_t WS_ORAW = WS_ATT + al((size_t)T * AW * 4);
constexpr size_t WS_MIX = WS_ORAW + al((size_t)T * HW * 4);
constexpr size_t WS_X1 = WS_MIX + al((size_t)T * MIXW * 2);
constexpr size_t WS_H2 = WS_X1 + al((size_t)T * DM * 4);
constexpr size_t WS_GATE = WS_H2 + al((size_t)T * DM * 2);
constexpr size_t WS_LIST = WS_GATE + al((size_t)T * TOPK * 4);
constexpr size_t WS_ACT = WS_LIST + al((size_t)NE * T * 4);
constexpr size_t WS_Y = WS_ACT + al((size_t)ACT_ROWS * FF * 2);
constexpr size_t WS_QF = WS_Y + al((size_t)T * TOPK * DM * 2);
constexpr size_t WS_KF = WS_QF + al((size_t)1024 * 16 * 512 * 2);
constexpr size_t WS_VF = WS_KF + al((size_t)1024 * 16 * 512 * 2);
constexpr size_t WS_INTRA = WS_VF + al((size_t)1024 * 16 * 512 * 2);
constexpr size_t WS_DEC = WS_INTRA + al((size_t)T * HW * 2);
constexpr size_t WS_RWF = WS_DEC + al((size_t)1024 * 128 * 4);
constexpr size_t WS_RSTD = WS_RWF + al((size_t)64 * 2 * 512 * 2);
constexpr size_t WS_END = WS_RSTD + al((size_t)T * 4);
static_assert(WS_END <= ((size_t)1 << 30), "workspace map exceeds 1 GiB");
constexpr int CW_CNT = 64;
constexpr int CW_OFF = 128;

__device__ __forceinline__ bf16_t f2bf(float f) { unsigned u = __builtin_bit_cast(unsigned, f); return (bf16_t)((u + 0x7fffu + ((u >> 16) & 1u)) >> 16); }
__device__ __forceinline__ float bf2f(bf16_t b) { return __builtin_bit_cast(float, (unsigned)b << 16); }
__device__ __forceinline__ float wave_sum(float v) {
#pragma unroll
    for (int o = 1; o < 64; o <<= 1) v += __shfl_xor(v, o);
    return v;
}
__device__ __forceinline__ float wave_max(float v) {
#pragma unroll
    for (int o = 1; o < 64; o <<= 1) v = fmaxf(v, __shfl_xor(v, o));
    return v;
}
__device__ __forceinline__ float sigmoidf_(float x) { return 1.f / (1.f + __expf(-x)); }
__device__ __forceinline__ float siluf_(float x) { return x / (1.f + __expf(-x)); }

#define LAS __attribute__((address_space(3)))
#define GAS __attribute__((address_space(1)))
typedef unsigned u32x4 __attribute__((ext_vector_type(4)));
typedef unsigned u32x2 __attribute__((ext_vector_type(2)));
typedef float f32x2 __attribute__((ext_vector_type(2)));

namespace pg8 {
constexpr int BM = 256, BK = 64, HALF = 128, HTB = HALF * BK * 2  , STAGE_BYTES = 8 * HTB, NXCD = 8, WGM = 8;
__host__ __device__ __forceinline__ int lds_byte(int r, int c) { const int st = (r >> 4) * 2 + (c >> 5), rr = r & 15, cc = c & 31, ob = rr * 64 + cc * 2; return st * 1024 + (ob ^ (((ob >> 9) & 1) << 5)); }
__host__ __device__ __forceinline__ void stage_rc(int b, int& R, int& C) { const int st = b / 1024, sb = b % 1024, swz = sb ^ (((sb >> 9) & 1) << 5); R = (st >> 1) * 16 + swz / 64; C = (st & 1) * 32 + (swz % 64) / 2; }
__host__ __device__ __forceinline__ int perm32(int rho) { const int n = rho >> 4, i = rho & 15; return 8 * (i >> 2) + 4 * n + (i & 3); }
__device__ __forceinline__ unsigned cvt_pk_bf16(float lo, float hi) { unsigned r; asm volatile("v_cvt_pk_bf16_f32 %0, %1, %2" : "=v"(r) : "v"(lo), "v"(hi)); return r; }

struct Unit { const char* A; const char* B; int pm, pn, e, rows, arow, lbase; };

struct DenseOrder {
    const char* A; const char* Bt; int K, nM, nN, nwg, G, c;
    __device__ void init(const void* A_, const void* Bt_, int M, int N, int K_, int G_, int c_) { A = (const char*)A_; Bt = (const char*)Bt_; K = K_; nM = M / BM; nN = N / BM; nwg = nM * nN; G = G_; c = c_; }
    __device__ __forceinline__ bool next(int i, Unit& u) const {
        const long L = (long)i * G + c; if (L >= nwg) return false;
        int wgid = (int)L; { const int q = nwg / NXCD, r = nwg % NXCD, xcd = wgid % NXCD, off = wgid / NXCD; wgid = (xcd < r ? xcd * (q + 1) : r * (q + 1) + (xcd - r) * q) + off; }
        const int nig = WGM * nN, gid = wgid / nig, fm = gid * WGM, gsz = (nM - fm) < WGM ? (nM - fm) : WGM;
        u.pm = fm + ((wgid % nig) % gsz); u.pn = (wgid % nig) / gsz; u.e = 0; u.rows = BM; u.arow = u.pm * BM; u.lbase = 0;
        u.A = A + (size_t)u.pm * BM * K * 2; u.B = Bt + (size_t)u.pn * BM * K * 2; return true;
    }
    __device__ __forceinline__ int row(const Unit&, int r) const { return r; }
};
template <bool G1, int ES>
struct MoeOrder {
    const char* A; const char* Bt; const int* list; LAS const int* pre; LAS const int* cnt; int K, N, nN, nwg, G, c;
    __device__ __forceinline__ bool next(int i, Unit& u) const {
        const long L = (long)i * G + c; if (L >= nwg) return false;
        int wgid = (int)L; { const int q = nwg / NXCD, r = nwg % NXCD, xcd = wgid % NXCD, off = wgid / NXCD; wgid = (xcd < r ? xcd * (q + 1) : r * (q + 1) + (xcd - r) * q) + off; }
        const int tau = wgid / nN; u.pn = wgid % nN;
        const int p = pre[(threadIdx.x & 31) + 1];
        const int e = __builtin_popcountll(__ballot(p <= tau) & 0xffffffffull);
        const int mt = tau - pre[e];
        u.e = e; u.pm = mt; const int left = cnt[e] - mt * BM; u.rows = left < BM ? left : BM;
        u.arow = tau * BM; u.lbase = e * T + mt * BM;
        u.A = G1 ? A : A + (size_t)u.arow * K * ES;
        u.B = Bt + ((size_t)e * N + (size_t)u.pn * BM) * K * ES; return true;
    }
    __device__ __forceinline__ int row(const Unit& u, int r) const { const int rr = r < u.rows ? r : u.rows - 1; return list[u.lbase + rr] >> 2; }
};

__device__ __forceinline__ u32x4 pack8(f32x4 v0, f32x4 v1) { u32x4 w; w.x = cvt_pk_bf16(v0[0], v0[1]); w.y = cvt_pk_bf16(v0[2], v0[3]); w.z = cvt_pk_bf16(v1[0], v1[1]); w.w = cvt_pk_bf16(v1[2], v1[3]); return w; }
__device__ __forceinline__ f32x4 silu4(f32x4 v) { f32x4 r; for (int i = 0; i < 4; ++i) r[i] = v[i] * __builtin_amdgcn_rcpf(1.f + __expf(-v[i])); return r; }

typedef int v8i32 __attribute__((ext_vector_type(8)));
__device__ __forceinline__ u32x2 pack8_fp8(f32x4 v0, f32x4 v1) {
    int a = 0, b = 0; a = __builtin_amdgcn_cvt_pk_fp8_f32(v0[0], v0[1], a, false); a = __builtin_amdgcn_cvt_pk_fp8_f32(v0[2], v0[3], a, true);
    b = __builtin_amdgcn_cvt_pk_fp8_f32(v1[0], v1[1], b, false); b = __builtin_amdgcn_cvt_pk_fp8_f32(v1[2], v1[3], b, true);
    return (u32x2){(unsigned)a, (unsigned)b};
}
constexpr float FP8_ACT_SCALE = 4.f, FP8_W_SCALE = 64.f, FP8_DESCALE = 1.f / (FP8_ACT_SCALE * FP8_W_SCALE);
struct EpiInProj {
    static constexpr bool PERM = true;
    const float* bias; const float* lb; bf16_t *AQ, *AK, *AV, *HQ, *KK, *HI, *HG; float* G;
    __device__ __forceinline__ void operator()(const f32x4 (&acc)[2][2][4][2], const Unit& u, int wr, int wc, int fr, int fq) const {
        const int row0 = u.pm * BM + wr * 64 + fr, cl = wc * 32 + 8 * fq;
#pragma unroll
        for (int bj = 0; bj < 2; ++bj) {
            const int cb = u.pn * BM + bj * HALF;
            const f32x4 b0 = *(const f32x4*)(bias + cb + cl), b1 = *(const f32x4*)(bias + cb + cl + 4);
            if (cb >= C_HF && cb < C_HI) {
                const int cc = cb - C_HF + cl;
                const f32x4 l0 = *(const f32x4*)(lb + cc), l1 = *(const f32x4*)(lb + cc + 4);
#pragma unroll
                for (int ai = 0; ai < 2; ++ai)
#pragma unroll
                    for (int m = 0; m < 4; ++m) {
                        const size_t r = (size_t)(row0 + ai * HALF + m * 16);
                        f32x4 v0 = acc[ai][bj][m][0] + b0, v1 = acc[ai][bj][m][1] + b1, g0, g1, k0, k1;
#pragma unroll
                        for (int i = 0; i < 4; ++i) {
                            const float f0 = l0[i] + (1.f - l0[i]) * __builtin_amdgcn_rcpf(1.f + __expf(-v0[i])); g0[i] = __logf(f0); k0[i] = 1.f - f0;
                            const float f1 = l1[i] + (1.f - l1[i]) * __builtin_amdgcn_rcpf(1.f + __expf(-v1[i])); g1[i] = __logf(f1); k1[i] = 1.f - f1;
                        }
                        *(f32x4*)(G + r * HKW + cc) = g0; *(f32x4*)(G + r * HKW + cc + 4) = g1;
                        *(u32x4*)(KK + r * HKW + cc) = pack8(k0, k1);
                    }
            } else {
                bf16_t* dst; int ld, cc; bool act = false;
                if (cb < C_AK) { dst = AQ; ld = AW; cc = cb - C_AQ; }
                else if (cb < C_AV) { dst = AK; ld = AKW; cc = cb - C_AK; }
                else if (cb < C_HQ) { dst = AV; ld = AKW; cc = cb - C_AV; }
                else if (cb < C_HF) { dst = HQ; ld = HKW; cc = cb - C_HQ; act = true; }
                else if (cb < C_HG) { dst = HI; ld = HW; cc = cb - C_HI; }
                else { dst = HG; ld = HW; cc = cb - C_HG; act = true; }
                cc += cl;
#pragma unroll
                for (int ai = 0; ai < 2; ++ai)
#pragma unroll
                    for (int m = 0; m < 4; ++m) {
                        const size_t r = (size_t)(row0 + ai * HALF + m * 16);
                        f32x4 v0 = acc[ai][bj][m][0] + b0, v1 = acc[ai][bj][m][1] + b1;
                        if (act) { v0 = silu4(v0); v1 = silu4(v1); }
                        *(u32x4*)(dst + r * ld + cc) = pack8(v0, v1);
                    }
            }
        }
    }
};
struct EpiOutProj {
    static constexpr bool PERM = false;
    const float* bias; const float* x; float* X1;
    __device__ __forceinline__ void operator()(const f32x4 (&acc)[2][2][4][2], const Unit& u, int wr, int wc, int fr, int fq) const {
        const int row0 = u.pm * BM + wr * 64 + fr, col0 = u.pn * BM + wc * 32 + 4 * fq;
#pragma unroll
        for (int bj = 0; bj < 2; ++bj)
#pragma unroll
            for (int n = 0; n < 2; ++n) {
                const int c = col0 + bj * HALF + n * 16; const f32x4 bv = *(const f32x4*)(bias + c);
#pragma unroll
                for (int ai = 0; ai < 2; ++ai)
#pragma unroll
                    for (int m = 0; m < 4; ++m) { const size_t o = (size_t)(row0 + ai * HALF + m * 16) * DM + c; *(f32x4*)(X1 + o) = acc[ai][bj][m][n] + bv + *(const f32x4*)(x + o); }
            }
    }
};
struct EpiMoe1 {
    static constexpr bool PERM = true;
    const float* b1; unsigned char* ACT; const int* list; const float* rstd;
    __device__ __forceinline__ void operator()(const f32x4 (&acc)[2][2][4][2], const Unit& u, int wr, int wc, int fr, int fq) const {
        const int ac0 = u.pn * HALF + wc * 32 + 8 * fq;
        const float* bp = b1 + (size_t)u.e * 2 * FF + 2 * ac0;
        const f32x4 q0 = *(const f32x4*)bp, q1 = *(const f32x4*)(bp + 4), q2 = *(const f32x4*)(bp + 8), q3 = *(const f32x4*)(bp + 12);
        const f32x4 bg0 = {q0[0], q0[2], q1[0], q1[2]}, bg1 = {q2[0], q2[2], q3[0], q3[2]}, bl0 = {q0[1], q0[3], q1[1], q1[3]}, bl1 = {q2[1], q2[3], q3[1], q3[3]};
#pragma unroll
        for (int ai = 0; ai < 2; ++ai)
#pragma unroll
            for (int m = 0; m < 4; ++m) {
                const int r = ai * HALF + wr * 64 + m * 16 + fr;
                const float rs = r < u.rows ? rstd[list[u.lbase + r] >> 2] * FP8_DESCALE : 0.f;
                const f32x4 g0 = acc[ai][0][m][0] * rs + bg0, g1 = acc[ai][0][m][1] * rs + bg1, l0 = acc[ai][1][m][0] * rs + bl0, l1 = acc[ai][1][m][1] * rs + bl1;
                f32x4 a0, a1;
#pragma unroll
                for (int i = 0; i < 4; ++i) {
                    const float u0 = fminf(g0[i], 7.f), u1 = fminf(g1[i], 7.f), w0 = fminf(fmaxf(l0[i], -7.f), 7.f), w1 = fminf(fmaxf(l1[i], -7.f), 7.f);
                    a0[i] = u0 * __builtin_amdgcn_rcpf(1.f + __expf(-1.702f * u0)) * (w0 + 1.f);
                    a1[i] = u1 * __builtin_amdgcn_rcpf(1.f + __expf(-1.702f * u1)) * (w1 + 1.f);
                }
                if (r < u.rows) *(u32x2*)(ACT + (size_t)(u.arow + r) * FF + ac0) = pack8_fp8(a0 * FP8_ACT_SCALE, a1 * FP8_ACT_SCALE);
            }
    }
};
struct EpiMoe2 {
    static constexpr bool PERM = true;
    const float* b2; const int* list; const float* gate; bf16_t* Y;
    __device__ __forceinline__ void operator()(const f32x4 (&acc)[2][2][4][2], const Unit& u, int wr, int wc, int fr, int fq) const {
        const int c0 = u.pn * BM + wc * 32 + 8 * fq;
        f32x4 bv[2][2];
#pragma unroll
        for (int bj = 0; bj < 2; ++bj)
#pragma unroll
            for (int n = 0; n < 2; ++n) bv[bj][n] = *(const f32x4*)(b2 + (size_t)u.e * DM + c0 + bj * HALF + 4 * n);
#pragma unroll
        for (int ai = 0; ai < 2; ++ai)
#pragma unroll
            for (int m = 0; m < 4; ++m) {
                const int r = ai * HALF + wr * 64 + m * 16 + fr;
                if (r < u.rows) {
                    const int slot = list[u.lbase + r]; const float gt = gate[slot];
                    bf16_t* yr = Y + (size_t)slot * DM + c0;
#pragma unroll
                    for (int bj = 0; bj < 2; ++bj) { const f32x4 v0 = (acc[ai][bj][m][0] * FP8_DESCALE + bv[bj][0]) * gt, v1 = (acc[ai][bj][m][1] * FP8_DESCALE + bv[bj][1]) * gt; *(u32x4*)(yr + bj * HALF) = pack8(v0, v1); }
                }
            }
    }
};

template <class Epi, class Sched, bool GATHER, bool ALIGN_EPI, int ES = 2>
__device__ __forceinline__ void gemm_phase(LAS unsigned char* lds, const int K, const Sched& S, const Epi& E) {
    const int tid = threadIdx.x, wid = __builtin_amdgcn_readfirstlane(tid >> 6), lane = tid & 63, wr = wid >> 2, wc = wid & 3, fr = lane & 15, fq = lane >> 4;
    int nt = K * ES / (BK * 2); asm volatile("" : "+s"(nt));
    unsigned voffB[2];
#pragma unroll
    for (int i = 0; i < 2; ++i) { int R, C; stage_rc(tid * 16 + i * 8192, R, C); const int Rb = Epi::PERM ? ((R & ~31) + perm32(R & 31)) : R; voffB[i] = (unsigned)(Rb * K * ES + C * 2); }
    const size_t kstep = (size_t)(BK * 2);
    const size_t hstep = (size_t)HALF * K * ES;
    const unsigned ldsw = (unsigned)wid * 1024u;
    const int aoff = lds_byte(wr * 64 + fr, fq * 8), boff = lds_byte(wc * 32 + fr, fq * 8);
#define PG8_SA(b, h) (((b) * 2 + (h)) * HTB)
#define PG8_SB(b, h) ((4 + (b) * 2 + (h)) * HTB)
#define PG8_STAGE(bufoff, gbase, voff) do { _Pragma("unroll") for (int _i = 0; _i < 2; ++_i) \
        __builtin_amdgcn_global_load_lds((const unsigned*)((const char*)(gbase) + (voff)[_i]), (LAS unsigned*)(lds + (bufoff) + ldsw + _i * 8192), 16, 0, 0); } while (0)
#define PG8_LD8(dst, off) do { const u32x4 lo_ = *(const LAS u32x4*)(lds + (off)), hi_ = *(const LAS u32x4*)(lds + (off) + 1024); \
        dst = (v8i32){(int)lo_.x, (int)lo_.y, (int)lo_.z, (int)lo_.w, (int)hi_.x, (int)hi_.y, (int)hi_.z, (int)hi_.w}; } while (0)
#define PG8_LDA(dst, b, h) do { _Pragma("unroll") for (int m = 0; m < 4; ++m) PG8_LD8(dst[m], PG8_SA(b, h) + aoff + m * 2048); } while (0)
#define PG8_LDB(dst, b, h) do { _Pragma("unroll") for (int n = 0; n < 2; ++n) PG8_LD8(dst[n], PG8_SB(b, h) + boff + n * 2048); } while (0)
#define PG8_LO(x) __builtin_bit_cast(bf16x8, __builtin_shufflevector(x, x, 0, 1, 2, 3))
#define PG8_HI(x) __builtin_bit_cast(bf16x8, __builtin_shufflevector(x, x, 4, 5, 6, 7))
#define PG8_MMA(ai, bj, At, Bt) do { __builtin_amdgcn_s_setprio(1); _Pragma("unroll") for (int m = 0; m < 4; ++m) _Pragma("unroll") for (int n = 0; n < 2; ++n) { \
        if constexpr (ES == 2) { acc[ai][bj][m][n] = __builtin_amdgcn_mfma_f32_16x16x32_bf16(PG8_LO(Bt[n]), PG8_LO(At[m]), acc[ai][bj][m][n], 0, 0, 0); \
                                 acc[ai][bj][m][n] = __builtin_amdgcn_mfma_f32_16x16x32_bf16(PG8_HI(Bt[n]), PG8_HI(At[m]), acc[ai][bj][m][n], 0, 0, 0); } \
        else asm volatile("v_mfma_scale_f32_16x16x128_f8f6f4 %0, %1, %2, %0, %3, %3 op_sel_hi:[0,0,0]" : "+v"(acc[ai][bj][m][n]) : "v"(Bt[n]), "v"(At[m]), "v"(unit_scale)); } \
          \
        __builtin_amdgcn_s_setprio(0); } while (0)
#define PG8_WAIT_V(n) asm volatile("s_waitcnt vmcnt(" #n ")" ::: "memory")
#define PG8_WAIT_L(n) asm volatile("s_waitcnt lgkmcnt(" #n ")" ::: "memory")
#define PG8_BAR __builtin_amdgcn_s_barrier()
#define PG8_SCHED __builtin_amdgcn_sched_barrier(0)
#define PG8_VOFFA(dst, u) do { int _t = tid; if (GATHER) asm volatile("" : "+v"(_t));     \
        _Pragma("unroll") for (int _i = 0; _i < 2; ++_i) { int _R, _C; stage_rc(_t * 16 + _i * 8192, _R, _C); _Pragma("unroll") for (int _h = 0; _h < 2; ++_h) { const int _r = _h * HALF + _R; \
        const unsigned _row = GATHER ? (unsigned)S.row(u, _r) : (unsigned)_r; dst[_h][_i] = _row * (unsigned)(K * ES) + (unsigned)_C * 2u; } } } while (0)
    Unit cur, nxt; int ui = 0;
    if (!S.next(0, cur)) return;
    f32x4 acc[2][2][4][2];
#pragma unroll
    for (int a = 0; a < 2; ++a)
#pragma unroll
        for (int b = 0; b < 2; ++b)
#pragma unroll
            for (int m = 0; m < 4; ++m)
#pragma unroll
                for (int n = 0; n < 2; ++n) acc[a][b][m][n] = (f32x4){0.f, 0.f, 0.f, 0.f};
    v8i32 At[4], B0[2], B1[2];
    const int unit_scale = 0x7F7F7F7F;
    unsigned vA[2][2], nvA[2][2];
    PG8_VOFFA(vA, cur);
    const char* cA = cur.A; const char* cB = cur.B;
    PG8_STAGE(PG8_SB(0, 0), cB, voffB); PG8_STAGE(PG8_SB(0, 1), cB + hstep, voffB); PG8_STAGE(PG8_SA(0, 0), cA, vA[0]); PG8_STAGE(PG8_SA(0, 1), cA, vA[1]);
    if (wr == 1) PG8_BAR;
    PG8_WAIT_V(2); PG8_BAR;
    PG8_STAGE(PG8_SB(1, 0), cB + kstep, voffB); PG8_STAGE(PG8_SA(1, 0), cA + kstep, vA[0]); PG8_STAGE(PG8_SB(1, 1), cB + hstep + kstep, voffB);
    PG8_WAIT_V(6); PG8_BAR;
    for (;;) {
        const bool has_next = S.next(ui + 1, nxt);
        const char* nA = has_next ? nxt.A : cA; const char* nB = has_next ? nxt.B : cB;
        if (has_next) { PG8_VOFFA(nvA, nxt); } else {
#pragma unroll
            for (int h = 0; h < 2; ++h)
#pragma unroll
                for (int i = 0; i < 2; ++i) nvA[h][i] = vA[h][i]; }
#pragma unroll 1
        for (int t = 0; t < nt; t += 2) {
            const bool last = (t == nt - 2);
            const char* a1 = cA + (size_t)(t + 1) * kstep;
            const char* a2 = last ? nA : cA + (size_t)(t + 2) * kstep; const char* b2 = last ? nB : cB + (size_t)(t + 2) * kstep;
            const char* a3 = a2 + kstep; const char* b3 = b2 + kstep;
            unsigned s0[2], s1[2];
#pragma unroll
            for (int i = 0; i < 2; ++i) { s0[i] = last ? nvA[0][i] : vA[0][i]; s1[i] = last ? nvA[1][i] : vA[1][i]; }
            PG8_LDB(B0, 0, 0); PG8_LDB(B1, 0, 1); PG8_SCHED; PG8_LDA(At, 0, 0); PG8_STAGE(PG8_SA(1, 1), a1, vA[1]);
            PG8_WAIT_V(8); PG8_WAIT_L(0); PG8_BAR; PG8_MMA(0, 0, At, B0); PG8_MMA(0, 1, At, B1); PG8_BAR; PG8_SCHED;
            PG8_LDA(At, 0, 1); PG8_STAGE(PG8_SB(0, 0), b2, voffB); PG8_STAGE(PG8_SB(0, 1), b2 + hstep, voffB); PG8_STAGE(PG8_SA(0, 0), a2, s0);
            PG8_WAIT_V(8); PG8_WAIT_L(0); PG8_BAR; PG8_MMA(1, 0, At, B0); PG8_MMA(1, 1, At, B1); PG8_BAR; PG8_SCHED;
            PG8_LDB(B0, 1, 0); PG8_LDB(B1, 1, 1); PG8_SCHED; PG8_LDA(At, 1, 0); PG8_STAGE(PG8_SA(0, 1), a2, s1);
            PG8_WAIT_V(8); PG8_WAIT_L(0); PG8_BAR; PG8_MMA(0, 0, At, B0); PG8_MMA(0, 1, At, B1); PG8_BAR; PG8_SCHED;
            PG8_LDA(At, 1, 1); PG8_STAGE(PG8_SB(1, 0), b3, voffB); PG8_STAGE(PG8_SB(1, 1), b3 + hstep, voffB); PG8_STAGE(PG8_SA(1, 0), a3, s0);
            PG8_WAIT_V(8); PG8_WAIT_L(0); PG8_BAR; PG8_MMA(1, 0, At, B0); PG8_MMA(1, 1, At, B1); PG8_BAR; PG8_SCHED;
        }
        if constexpr (ALIGN_EPI) { if (wr == 0) PG8_BAR; }
        if constexpr (ES == 1) asm volatile("s_nop 15\n\ts_nop 7" ::: "memory");
        { int l2 = lane; asm volatile("" : "+v"(l2)); E(acc, cur, wr, wc, l2 & 15, l2 >> 4); }
        if (!has_next) break;
#pragma unroll
        for (int a = 0; a < 2; ++a)
#pragma unroll
            for (int b = 0; b < 2; ++b)
#pragma unroll
                for (int m = 0; m < 4; ++m)
#pragma unroll
                    for (int n = 0; n < 2; ++n) acc[a][b][m][n] = (f32x4){0.f, 0.f, 0.f, 0.f};
        cur = nxt; cA = nA; cB = nB; ++ui;
#pragma unroll
        for (int h = 0; h < 2; ++h)
#pragma unroll
            for (int i = 0; i < 2; ++i) vA[h][i] = nvA[h][i];
        if constexpr (ALIGN_EPI) { if (wr == 1) PG8_BAR; }
    }
    PG8_WAIT_V(0);
    if constexpr (!ALIGN_EPI) { if (wr == 0) PG8_BAR; }
    PG8_BAR;
#undef PG8_SA
#undef PG8_SB
#undef PG8_STAGE
#undef PG8_LDA
#undef PG8_LDB
#undef PG8_MMA
#undef PG8_LD8
#undef PG8_LO
#undef PG8_HI
#undef PG8_WAIT_V
#undef PG8_WAIT_L
#undef PG8_BAR
#undef PG8_SCHED
#undef PG8_VOFFA
}
}

constexpr int NWAVES = 8;
constexpr int RING_OFF = 0, RING_BYTES = 139264;
constexpr int LDSCTL_OFF = RING_BYTES, MISC_OFF = LDSCTL_OFF + 320;
constexpr int MOE_OFF = LDSCTL_OFF + 1024;
constexpr int LDS_BYTES = RING_BYTES + 16384;
constexpr int CW_TMO = 0, CW_CODE = 1, CW_BAR = 4096;
constexpr int N_PHASES = 10;

typedef GAS unsigned gu32;
#define RLX_AGENT __ATOMIC_RELAXED, __HIP_MEMORY_SCOPE_AGENT
#define LDS_WAIT() asm volatile("s_waitcnt lgkmcnt(0)" ::: "memory")
#define VM_WAIT() asm volatile("s_waitcnt vmcnt(0)" ::: "memory")

#define XB_TMO      128
#define XB_XCNT(j)  (256  + 64 * (j))
#define XB_XSUB(j)  (1280 + 64 * (j))
#define XB_XGEN(j)  (2304 + 64 * (j))
#define XB_TOP      3328
#define XB_TOPGEN   3392
#define XCD_BAR_WORDS 3456
#define XB_SPIN_CAP (1u << 18)
__device__ __forceinline__ unsigned xb_ld(unsigned* p)              { return __hip_atomic_load(p, __ATOMIC_RELAXED, __HIP_MEMORY_SCOPE_AGENT); }
__device__ __forceinline__ unsigned xb_add(unsigned* p, unsigned v) { return __hip_atomic_fetch_add(p, v, __ATOMIC_RELAXED, __HIP_MEMORY_SCOPE_AGENT); }
__device__ __forceinline__ unsigned xb_xcc_id() { return (unsigned)__builtin_amdgcn_s_getreg((3 << 11) | 20) & 0xFu; }
#define XB_SPIN(cond, bar) do { unsigned _sp = 0; while (cond) { __builtin_amdgcn_s_sleep(1); \
    if ((++_sp & 255u) == 0u) { if (xb_ld(&(bar)[XB_TMO])) break; if (_sp > XB_SPIN_CAP) { atomicAdd(&(bar)[XB_TMO], 1u); break; } } } } while (0)
struct XcdBarrier { unsigned* bar; unsigned x; volatile LAS unsigned* st; };
__device__ __forceinline__ XcdBarrier xcd_barrier_post(unsigned* bar, volatile LAS unsigned* st) {
    XcdBarrier b; b.bar = bar; b.x = xb_xcc_id(); b.st = st;
    if (threadIdx.x == 0) (void)xb_add(&bar[XB_XCNT(b.x)], 1u);
    return b;
}
__device__ __forceinline__ void xcd_barrier_complete(unsigned* bar, unsigned x, unsigned& nloc, unsigned& nx) {
    const unsigned G = gridDim.x * gridDim.y * gridDim.z;
    unsigned sum, cnt, mine, sp = 0u;
    for (;;) {
        sum = 0u; cnt = 0u; mine = 0u;
#pragma unroll
        for (unsigned j = 0; j < 16; ++j) { const unsigned c = xb_ld(&bar[XB_XCNT(j)]); sum += c; cnt += (c > 0u) ? 1u : 0u; mine = (j == x) ? c : mine; }
        if (sum == G) break;
        __builtin_amdgcn_s_sleep(1);
        if ((++sp & 255u) == 0u) { if (xb_ld(&bar[XB_TMO])) break; if (sp > XB_SPIN_CAP) { atomicAdd(&bar[XB_TMO], 1u); break; } }
    }
    nloc = mine > 0u ? mine : 1u; nx = cnt > 0u ? cnt : 1u;
}
__device__ __forceinline__ void xcd_barrier(const XcdBarrier& b) {
    asm volatile("s_waitcnt vmcnt(0)" ::: "memory");
    __syncthreads();
    if (threadIdx.x == 0) {
        unsigned* bar = b.bar;
        __builtin_amdgcn_s_waitcnt(0);
        unsigned nloc = b.st[0], nx = b.st[1];
        if (nloc == 0u) { xcd_barrier_complete(bar, b.x, nloc, nx); b.st[0] = nloc; b.st[1] = nx; }
        const unsigned old = xb_add(&bar[XB_XSUB(b.x)], 1u);
        const unsigned gen = old / nloc;
        if (old + 1u == (gen + 1u) * nloc) {
            __builtin_amdgcn_fence(__ATOMIC_RELEASE, "agent");
            asm volatile("s_waitcnt vmcnt(0)" ::: "memory");
            const unsigned og = xb_add(&bar[XB_TOP], 1u);
            const unsigned tg = og / nx;
            if (og + 1u == (tg + 1u) * nx) xb_add(&bar[XB_TOPGEN], 1u);
            else XB_SPIN(xb_ld(&bar[XB_TOPGEN]) == tg, bar);
            __builtin_amdgcn_fence(__ATOMIC_ACQUIRE, "agent");
            xb_add(&bar[XB_XGEN(b.x)], 1u);
            asm volatile("s_waitcnt vmcnt(0)" ::: "memory");
        } else {
            XB_SPIN(xb_ld(&bar[XB_XGEN(b.x)]) == gen, bar);
            __builtin_amdgcn_fence(__ATOMIC_ACQUIRE, "agent");
            asm volatile("s_waitcnt vmcnt(0)" ::: "memory");
        }
    }
    __syncthreads();
}

struct Frame {
    LAS unsigned char* lds; volatile LAS unsigned* MISC; gu32* ctl;
    int tid, lane, wave, vcu, G;
    const float *x, *norm1_g, *w_in, *b_in, *sinks, *attn_g, *lb_logits, *hgrn_g, *w_out, *b_out, *norm2_g, *router_w, *router_b, *w1, *b1, *w2, *b2, *final_g;
    float* out; unsigned char* ws;
};
#define WSP(type, off) ((type*)(F.ws + (off)))

typedef float f32x16 __attribute__((ext_vector_type(16)));
typedef __bf16 bf16x2_t __attribute__((ext_vector_type(2)));
__device__ __forceinline__ unsigned cvtpk(float lo, float hi) { f32x2 v = {lo, hi}; bf16x2_t b = __builtin_convertvector(v, bf16x2_t); return __builtin_bit_cast(unsigned, b); }
__device__ __forceinline__ int crow(int reg, int h) { return (reg & 3) + 8 * (reg >> 2) + 4 * h; }
__device__ __forceinline__ float bflo(unsigned u) { return __builtin_bit_cast(float, u << 16); }
__device__ __forceinline__ float bfhi(unsigned u) { return __builtin_bit_cast(float, u & 0xffff0000u); }
__device__ __forceinline__ bf16x8 pack_step(const f32x16& x, int s) {
    u32x4 p; p.x = cvtpk(x[8 * s], x[8 * s + 1]); p.y = cvtpk(x[8 * s + 2], x[8 * s + 3]); p.z = cvtpk(x[8 * s + 4], x[8 * s + 5]); p.w = cvtpk(x[8 * s + 6], x[8 * s + 7]);
    return __builtin_bit_cast(bf16x8, p);
}
#define MFMA32(a, b, c) __builtin_amdgcn_mfma_f32_32x32x16_bf16((a), (b), (c), 0, 0, 0)
#define MFMA16(a, b, c) __builtin_amdgcn_mfma_f32_16x16x32_bf16((a), (b), (c), 0, 0, 0)

__device__ __forceinline__ void p_hgrn_prep(Frame& F) {
    constexpr int GP = 132, QP = 136, VP = 72, AP = 72;
    LAS float* Gs = (LAS float*)F.lds;
    LAS bf16_t* Qs = (LAS bf16_t*)(F.lds + 33792);
    LAS bf16_t* Ks = (LAS bf16_t*)(F.lds + 33792 + 17408);
    LAS bf16_t* Vt = (LAS bf16_t*)(F.lds + 33792 + 2 * 17408);
    LAS bf16_t* At = (LAS bf16_t*)(F.lds + 33792 + 2 * 17408 + 18432);
    LAS float* Tot = (LAS float*)(F.lds + 96256);
    LAS float* Bl = Tot + 8 * 128;
    const bf16_t* HQ = WSP(bf16_t, WS_HQ); const float* G = WSP(float, WS_G); const bf16_t* KK = WSP(bf16_t, WS_KK); const bf16_t* HI = WSP(bf16_t, WS_HI);
    bf16_t* QF = WSP(bf16_t, WS_QF); bf16_t* KF = WSP(bf16_t, WS_KF); bf16_t* VF = WSP(bf16_t, WS_VF); bf16_t* INTRA = WSP(bf16_t, WS_INTRA); float* DEC = WSP(float, WS_DEC);
    const int tid = F.tid, lane = F.lane, w = F.wave, r = lane & 31, h = lane >> 5, fr = lane & 15, fq = lane >> 4;
    for (int ch = blockIdx.x; ch < BATCH * 4 * 32; ch += F.G) {
        const int bh = ch >> 5, c = ch & 31, b = bh >> 2, hd = bh & 3;
        const size_t t0 = (size_t)b * SEQ + 64 * c; const int col0 = hd * 128;
#pragma unroll
        for (int i = 0; i < 4; ++i) { const int idx = tid + 512 * i, row = idx >> 5, c4 = idx & 31; *(LAS f32x4*)(Gs + row * GP + 4 * c4) = *(const f32x4*)(G + (t0 + row) * HKW + col0 + 4 * c4); }
#pragma unroll
        for (int i = 0; i < 2; ++i) { const int idx = tid + 512 * i, row = idx >> 4, c8 = idx & 15; const size_t go = (t0 + row) * HKW + col0 + 8 * c8;
            *(LAS u32x4*)(Qs + row * QP + 8 * c8) = *(const u32x4*)(HQ + go); *(LAS u32x4*)(Ks + row * QP + 8 * c8) = *(const u32x4*)(KK + go);
            const u32x4 vv = *(const u32x4*)(HI + go);
#pragma unroll
            for (int q = 0; q < 4; ++q) { Vt[(8 * c8 + 2 * q) * VP + row] = (bf16_t)(vv[q] & 0xffffu); Vt[(8 * c8 + 2 * q + 1) * VP + row] = (bf16_t)(vv[q] >> 16); } }
        for (int i = tid; i < 64 * AP / 8; i += 512) *(LAS u32x4*)(At + 8 * i) = (u32x4){0u, 0u, 0u, 0u};
        __syncthreads();
#pragma unroll
        for (int q = 0; q < 2; ++q) { const int kk = lane + 64 * q; float run = 0.f;
#pragma unroll
            for (int i = 0; i < 8; ++i) { run += Gs[(8 * w + i) * GP + kk]; Gs[(8 * w + i) * GP + kk] = run; }
            Tot[w * 128 + kk] = run; }
        __syncthreads();
#pragma unroll
        for (int q = 0; q < 2; ++q) { const int kk = lane + 64 * q; float off = 0.f, tot = 0.f;
#pragma unroll
            for (int i = 0; i < 8; ++i) { const float tv = Tot[i * 128 + kk]; tot += tv; if (i < w) off += tv; }
#pragma unroll
            for (int i = 0; i < 8; ++i) Gs[(8 * w + i) * GP + kk] += off;
            if (w == 0) Bl[kk] = tot; }
        __syncthreads();
#pragma unroll
        for (int q = 0; q < 2; ++q) {
            const int f = w + 8 * q;
            {
                const int tt = f >> 3, kt = (f >> 1) & 3, ks = f & 1, t = 32 * tt + r, kb = 32 * kt + 16 * ks + 4 * h;
                const u32x2 qa = *(const LAS u32x2*)(Qs + t * QP + kb), qb = *(const LAS u32x2*)(Qs + t * QP + kb + 8);
                const f32x4 ba = *(const LAS f32x4*)(Gs + t * GP + kb), bb = *(const LAS f32x4*)(Gs + t * GP + kb + 8);
                u32x4 o; o.x = cvtpk(bflo(qa.x) * __expf(ba[0]), bfhi(qa.x) * __expf(ba[1])); o.y = cvtpk(bflo(qa.y) * __expf(ba[2]), bfhi(qa.y) * __expf(ba[3]));
                o.z = cvtpk(bflo(qb.x) * __expf(bb[0]), bfhi(qb.x) * __expf(bb[1])); o.w = cvtpk(bflo(qb.y) * __expf(bb[2]), bfhi(qb.y) * __expf(bb[3]));
                *(u32x4*)(QF + (((size_t)ch * 16 + f) * 64 + lane) * 8) = o;
            }
            {
                const int kt = f >> 2, ss = f & 3, kc = 32 * kt + r, s0 = 16 * ss + 8 * h; const float bl = Bl[kc];
                float v[8];
#pragma unroll
                for (int j = 0; j < 8; ++j) v[j] = bf2f(Ks[(s0 + j) * QP + kc]) * __expf(bl - Gs[(s0 + j) * GP + kc]);
                u32x4 o; o.x = cvtpk(v[0], v[1]); o.y = cvtpk(v[2], v[3]); o.z = cvtpk(v[4], v[5]); o.w = cvtpk(v[6], v[7]);
                *(u32x4*)(KF + (((size_t)ch * 16 + f) * 64 + lane) * 8) = o;
            }
            {
                const int ss = f >> 2, dt = f & 3;
                *(u32x4*)(VF + (((size_t)ch * 16 + f) * 64 + lane) * 8) = *(const LAS u32x4*)(Vt + (32 * dt + r) * VP + 16 * ss + 8 * h);
            }
        }
        if (tid < 128) DEC[(size_t)ch * 128 + tid] = __expf(Bl[tid]);
        {
            const int i = w >> 1;
            for (int j = w & 1; j <= i; j += 2) {
                f32x4 acc = {0.f, 0.f, 0.f, 0.f};
                const int t = 16 * i + fr, s = 16 * j + fr;
#pragma unroll
                for (int k4 = 0; k4 < 4; ++k4) {
                    const int k0 = 32 * k4 + 8 * fq;
                    f32x4 r0 = {0.f, 0.f, 0.f, 0.f}, r1 = {0.f, 0.f, 0.f, 0.f};
                    if (i > 0) { r0 = *(const LAS f32x4*)(Gs + (16 * i - 1) * GP + k0); r1 = *(const LAS f32x4*)(Gs + (16 * i - 1) * GP + k0 + 4); }
                    const u32x4 q8 = *(const LAS u32x4*)(Qs + t * QP + k0), k8 = *(const LAS u32x4*)(Ks + s * QP + k0);
                    const f32x4 bt0 = *(const LAS f32x4*)(Gs + t * GP + k0), bt1 = *(const LAS f32x4*)(Gs + t * GP + k0 + 4);
                    const f32x4 bs0 = *(const LAS f32x4*)(Gs + s * GP + k0), bs1 = *(const LAS f32x4*)(Gs + s * GP + k0 + 4);
                    u32x4 a, bb;
                    a.x = cvtpk(bflo(q8.x) * __expf(bt0[0] - r0[0]), bfhi(q8.x) * __expf(bt0[1] - r0[1])); a.y = cvtpk(bflo(q8.y) * __expf(bt0[2] - r0[2]), bfhi(q8.y) * __expf(bt0[3] - r0[3]));
                    a.z = cvtpk(bflo(q8.z) * __expf(bt1[0] - r1[0]), bfhi(q8.z) * __expf(bt1[1] - r1[1])); a.w = cvtpk(bflo(q8.w) * __expf(bt1[2] - r1[2]), bfhi(q8.w) * __expf(bt1[3] - r1[3]));
                    bb.x = cvtpk(bflo(k8.x) * __expf(r0[0] - bs0[0]), bfhi(k8.x) * __expf(r0[1] - bs0[1])); bb.y = cvtpk(bflo(k8.y) * __expf(r0[2] - bs0[2]), bfhi(k8.y) * __expf(r0[3] - bs0[3]));
                    bb.z = cvtpk(bflo(k8.z) * __expf(r1[0] - bs1[0]), bfhi(k8.z) * __expf(r1[1] - bs1[1])); bb.w = cvtpk(bflo(k8.w) * __expf(r1[2] - bs1[2]), bfhi(k8.w) * __expf(r1[3] - bs1[3]));
                    acc = MFMA16(__builtin_bit_cast(bf16x8, a), __builtin_bit_cast(bf16x8, bb), acc);
                }
#pragma unroll
                for (int q = 0; q < 4; ++q) { const float v = (j < i || (4 * fq + q) >= fr) ? acc[q] : 0.f; At[(16 * i + 4 * fq + q) * AP + 16 * j + fr] = f2bf(v); }
            }
        }
        __syncthreads();
        {
            const int tt = w & 1, dt = w >> 1;
            f32x16 acc;
#pragma unroll
            for (int q = 0; q < 16; ++q) acc[q] = 0.f;
#pragma unroll
            for (int ss = 0; ss < 4; ++ss) if (ss < 2 * (tt + 1)) {
                const bf16x8 a = *(const LAS bf16x8*)(At + (32 * tt + r) * AP + 16 * ss + 8 * h), bv = *(const LAS bf16x8*)(Vt + (32 * dt + r) * VP + 16 * ss + 8 * h);
                acc = MFMA32(a, bv, acc);
            }
#pragma unroll
            for (int q = 0; q < 16; ++q) INTRA[(t0 + 32 * tt + crow(q, h)) * HW + col0 + 32 * dt + r] = f2bf(acc[q]);
        }
        __syncthreads();
    }
}

constexpr int SC_OPB = 0, SC_OBUF = 65536, SC_OBP = 132, SC_OBB = 64 * SC_OBP * 4, SC_DEC = SC_OBUF + 2 * SC_OBB;
__device__ __forceinline__ void scan_unit(Frame& F, int bh) {
    const bf16_t* QF = WSP(bf16_t, WS_QF); const bf16_t* KF = WSP(bf16_t, WS_KF); const bf16_t* VF = WSP(bf16_t, WS_VF); const bf16_t* INTRA = WSP(bf16_t, WS_INTRA); const float* DEC = WSP(float, WS_DEC);
    const bf16_t* HG = WSP(bf16_t, WS_HG); bf16_t* MIX = WSP(bf16_t, WS_MIX);
    const int tid = F.tid, lane = F.lane, w = F.wave, r = lane & 31, h = lane >> 5, tt = w & 1, d = w >> 1, b = bh >> 2, hd = bh & 3;
    LAS unsigned char* lds = F.lds;
    f32x16 S[4];
#pragma unroll
    for (int kt = 0; kt < 4; ++kt)
#pragma unroll
        for (int q = 0; q < 16; ++q) S[kt][q] = 0.f;
#define SC_DMA(c_) do { const size_t chn = (size_t)bh * 32 + (c_); const int slot = ((c_) & 1) * 32768; _Pragma("unroll") for (int i_ = 0; i_ < 2; ++i_) { \
        __builtin_amdgcn_global_load_lds((const unsigned*)(QF + ((chn * 16 + 2 * w + i_) * 64 + lane) * 8), (LAS unsigned*)(lds + SC_OPB + slot + (2 * w + i_) * 1024), 16, 0, 0); \
        __builtin_amdgcn_global_load_lds((const unsigned*)(KF + ((chn * 16 + 2 * w + i_) * 64 + lane) * 8), (LAS unsigned*)(lds + SC_OPB + slot + 16384 + (2 * w + i_) * 1024), 16, 0, 0); } \
        } while (0)
#define SC_DEC_LD(c_) (*(const f32x4*)(DEC + ((size_t)bh * 32 + (c_)) * 128 + (tid & 31) * 4))
#define SC_DEC_ST(c_, v_) do { if (tid < 32) *(LAS f32x4*)(lds + SC_DEC + ((c_) & 1) * 512 + tid * 16) = (v_); } while (0)
    bf16x8 Vf[4], Vn[4];
#pragma unroll
    for (int ss = 0; ss < 4; ++ss) Vf[ss] = *(const bf16x8*)(VF + ((((size_t)bh * 32) * 16 + ss * 4 + d) * 64 + lane) * 8);
    SC_DMA(0);
    { const f32x4 dv0 = SC_DEC_LD(0); SC_DEC_ST(0, dv0); }
    __syncthreads();
    const int ft = tid >> 3, fs = tid & 7;
    const int ocol = hd * 128 + 16 * fs;
    for (int c = 0; c < 32; ++c) {
        const int slot = (c & 1) * 32768;
        f32x4 dnext = {0.f, 0.f, 0.f, 0.f};
        if (c + 1 < 32) {
            SC_DMA(c + 1);
            dnext = SC_DEC_LD(c + 1);
#pragma unroll
            for (int ss = 0; ss < 4; ++ss) Vn[ss] = *(const bf16x8*)(VF + ((((size_t)bh * 32 + c + 1) * 16 + ss * 4 + d) * 64 + lane) * 8);
        }
        const size_t trow = (size_t)b * SEQ + 64 * c + ft;
        const u32x4 in0 = *(const u32x4*)(INTRA + trow * HW + ocol), in1 = *(const u32x4*)(INTRA + trow * HW + ocol + 8);
        const u32x4 hg0 = *(const u32x4*)(HG + trow * HW + ocol), hg1 = *(const u32x4*)(HG + trow * HW + ocol + 8);
        f32x16 P;
#pragma unroll
        for (int q = 0; q < 16; ++q) P[q] = 0.f;
#pragma unroll
        for (int kt = 0; kt < 4; ++kt)
#pragma unroll
            for (int ks = 0; ks < 2; ++ks) {
                const bf16x8 qf = *(const LAS bf16x8*)(lds + SC_OPB + slot + ((tt * 4 + kt) * 2 + ks) * 1024 + lane * 16);
                P = MFMA32(qf, pack_step(S[kt], ks), P);
            }
        {   LAS float* ob = (LAS float*)(lds + SC_OBUF + (c & 1) * SC_OBB);
#pragma unroll
            for (int q = 0; q < 16; ++q) ob[(32 * tt + crow(q, h)) * SC_OBP + 32 * d + r] = P[q]; }
#pragma unroll
        for (int kt = 0; kt < 4; ++kt) {
#pragma unroll
            for (int g = 0; g < 4; ++g) { const f32x4 dc = *(const LAS f32x4*)(lds + SC_DEC + (c & 1) * 512 + (32 * kt + 8 * g + 4 * h) * 4);
#pragma unroll
                for (int q = 0; q < 4; ++q) S[kt][4 * g + q] *= dc[q]; }
#pragma unroll
            for (int ss = 0; ss < 4; ++ss) {
                const bf16x8 kf = *(const LAS bf16x8*)(lds + SC_OPB + slot + 16384 + (kt * 4 + ss) * 1024 + lane * 16);
                S[kt] = MFMA32(kf, Vf[ss], S[kt]);
            }
        }
        SC_DEC_ST(c + 1, dnext);
        __syncthreads();
        {
            const LAS float* ob = (const LAS float*)(lds + SC_OBUF + (c & 1) * SC_OBB) + ft * SC_OBP + 16 * fs;
            const f32x4 p0 = *(const LAS f32x4*)ob, p1 = *(const LAS f32x4*)(ob + 4), p2 = *(const LAS f32x4*)(ob + 8), p3 = *(const LAS f32x4*)(ob + 12);
            float o[16];
            o[0] = p0[0] + bflo(in0.x); o[1] = p0[1] + bfhi(in0.x); o[2] = p0[2] + bflo(in0.y); o[3] = p0[3] + bfhi(in0.y);
            o[4] = p1[0] + bflo(in0.z); o[5] = p1[1] + bfhi(in0.z); o[6] = p1[2] + bflo(in0.w); o[7] = p1[3] + bfhi(in0.w);
            o[8] = p2[0] + bflo(in1.x); o[9] = p2[1] + bfhi(in1.x); o[10] = p2[2] + bflo(in1.y); o[11] = p2[3] + bfhi(in1.y);
            o[12] = p3[0] + bflo(in1.z); o[13] = p3[1] + bfhi(in1.z); o[14] = p3[2] + bflo(in1.w); o[15] = p3[3] + bfhi(in1.w);
            float ss2 = 0.f;
#pragma unroll
            for (int q = 0; q < 16; ++q) ss2 += o[q] * o[q];
            ss2 += __shfl_xor(ss2, 1); ss2 += __shfl_xor(ss2, 2); ss2 += __shfl_xor(ss2, 4);
            const float rs = rsqrtf(ss2 * (1.f / 128.f) + EPS);
            const float* gh = F.hgrn_g + ocol;
            const unsigned hgw[8] = {hg0.x, hg0.y, hg0.z, hg0.w, hg1.x, hg1.y, hg1.z, hg1.w};
            unsigned ow[8];
#pragma unroll
            for (int q = 0; q < 8; ++q) ow[q] = cvtpk(o[2 * q] * rs * gh[2 * q] * bflo(hgw[q]), o[2 * q + 1] * rs * gh[2 * q + 1] * bfhi(hgw[q]));
            bf16_t* mo = MIX + trow * MIXW + AW + ocol;
            *(u32x4*)mo = (u32x4){ow[0], ow[1], ow[2], ow[3]}; *(u32x4*)(mo + 8) = (u32x4){ow[4], ow[5], ow[6], ow[7]};
        }
#pragma unroll
        for (int ss = 0; ss < 4; ++ss) Vf[ss] = Vn[ss];
    }
    __syncthreads();
#undef SC_DMA
#undef SC_DEC_LD
#undef SC_DEC_ST
}

constexpr int AT_KP = 72, AT_VP = 260;
__device__ __forceinline__ void attn_stage(Frame& F, int kvh, int n, size_t t0, LAS bf16_t* Ks, LAS bf16_t* Vt) {
    const bf16_t* AK = WSP(bf16_t, WS_AK); const bf16_t* AV = WSP(bf16_t, WS_AV);
    __syncthreads();
    int tid_ = F.tid; asm volatile("" : "+v"(tid_));
#pragma unroll
    for (int i = 0; i < 4; ++i) {
        const int idx = tid_ + 512 * i, row = idx >> 3, c8 = idx & 7;
        u32x4 kv = {0u, 0u, 0u, 0u}, vv = {0u, 0u, 0u, 0u};
        if (n > 0 || row >= 128) { const size_t go = (t0 - 128 + row) * AKW + kvh * 64 + 8 * c8; kv = *(const u32x4*)(AK + go); vv = *(const u32x4*)(AV + go); }
        *(LAS u32x4*)(Ks + row * AT_KP + 8 * c8) = kv;
#pragma unroll
        for (int q = 0; q < 4; ++q) { Vt[(8 * c8 + 2 * q) * AT_VP + row] = (bf16_t)(vv[q] & 0xffffu); Vt[(8 * c8 + 2 * q + 1) * AT_VP + row] = (bf16_t)(vv[q] >> 16); }
    }
    __syncthreads();
}
__device__ __forceinline__ void attn_item(Frame& F, int hq, int rt, int n, size_t t0, const LAS bf16_t* Ks, const LAS bf16_t* Vt, LAS float* ssq, unsigned (&okp)[16]) {
    const bf16_t* AQ = WSP(bf16_t, WS_AQ);
    int lane = F.lane; asm volatile("" : "+v"(lane));
    const int r = lane & 31, h = lane >> 5;
    constexpr float L2E = 1.4426950408889634f;
    const float slope2 = exp2f(-(float)(hq + 1)) * L2E, sink2 = F.sinks[hq] * L2E;
    bf16x8 qf[4];
#pragma unroll
    for (int ds = 0; ds < 4; ++ds) qf[ds] = *(const bf16x8*)(AQ + (t0 + 32 * rt + r) * AW + hq * 64 + 16 * ds + 8 * h);
    float m = sink2;
#define AT_SCORE(SC, j) do { const int kt = rt + (j); int rq = r - 32 * (j); asm volatile("" : "+v"(rq));     \
        _Pragma("unroll") for (int q = 0; q < 16; ++q) SC[q] = 0.f; \
        _Pragma("unroll") for (int ds = 0; ds < 4; ++ds) SC = MFMA32(*(const LAS bf16x8*)(Ks + (32 * kt + r) * AT_KP + 16 * ds + 8 * h), qf[ds], SC); \
        const bool tile_ok = (n > 0) || (kt >= 4); \
        _Pragma("unroll") for (int q = 0; q < 16; ++q) { const int dist = 128 + rq - crow(q, h); const float v = SC[q] * (0.125f * L2E) - slope2 * (float)dist; \
            SC[q] = (tile_ok && dist >= 0 && dist < 128) ? v : -INFINITY; } } while (0)
#pragma unroll
    for (int j = 0; j < 5; ++j) { f32x16 sc; AT_SCORE(sc, j);
#pragma unroll
        for (int q = 0; q < 16; ++q) m = fmaxf(m, sc[q]); }
    m = fmaxf(m, __shfl_xor(m, 32));
    float l = 0.f; unsigned pp[5][8];
#pragma unroll
    for (int j = 0; j < 5; ++j) { f32x16 sc; AT_SCORE(sc, j);
#pragma unroll
        for (int q = 0; q < 16; ++q) { sc[q] = exp2f(sc[q] - m); l += sc[q]; }
#pragma unroll
        for (int q = 0; q < 8; ++q) pp[j][q] = cvtpk(sc[2 * q], sc[2 * q + 1]); }
#undef AT_SCORE
    l += __shfl_xor(l, 32); l += exp2f(sink2 - m);
    const float rl = 1.f / l;
    float sq = 0.f;
#pragma unroll
    for (int dt = 0; dt < 2; ++dt) {
        f32x16 o;
#pragma unroll
        for (int q = 0; q < 16; ++q) o[q] = 0.f;
        const LAS bf16_t* vrow = Vt + (32 * dt + r) * AT_VP + 4 * h;
#pragma unroll
        for (int j = 0; j < 5; ++j)
#pragma unroll
            for (int s = 0; s < 2; ++s) { const LAS bf16_t* vp = vrow + 32 * (rt + j) + 16 * s;
                const u32x2 va = *(const LAS u32x2*)vp, vb = *(const LAS u32x2*)(vp + 8); const u32x4 pa = {va.x, va.y, vb.x, vb.y};
                const u32x4 pb = {pp[j][4 * s], pp[j][4 * s + 1], pp[j][4 * s + 2], pp[j][4 * s + 3]};
                o = MFMA32(__builtin_bit_cast(bf16x8, pa), __builtin_bit_cast(bf16x8, pb), o); }
#pragma unroll
        for (int q = 0; q < 16; ++q) { o[q] *= rl; sq += o[q] * o[q]; }
#pragma unroll
        for (int q = 0; q < 8; ++q) okp[dt * 8 + q] = cvtpk(o[2 * q], o[2 * q + 1]);
    }
    sq += __shfl_xor(sq, 32);
    if (h == 0) __hip_atomic_fetch_add(&ssq[32 * rt + r], sq, __ATOMIC_RELAXED, __HIP_MEMORY_SCOPE_WORKGROUP);
}
__device__ __forceinline__ void attn_store(Frame& F, int hq, int rt, size_t t0, const LAS float* ssq, const unsigned (&okp)[16]) {
    bf16_t* MIX = WSP(bf16_t, WS_MIX);
    int lane = F.lane; asm volatile("" : "+v"(lane));
    const int r = lane & 31, h = lane >> 5;
    const float rs = rsqrtf(ssq[32 * rt + r] * (1.f / AW) + EPS);
    bf16_t* mo = MIX + (t0 + 32 * rt + r) * MIXW + hq * 64;
#pragma unroll
    for (int dt = 0; dt < 2; ++dt)
#pragma unroll
        for (int g4 = 0; g4 < 4; ++g4) {
            const int d0 = 32 * dt + 8 * g4 + 4 * h; const f32x4 ga = *(const f32x4*)(F.attn_g + hq * 64 + d0);
            const unsigned p0 = okp[dt * 8 + 2 * g4], p1 = okp[dt * 8 + 2 * g4 + 1];
            u32x2 ow; ow.x = cvtpk(bflo(p0) * rs * ga[0], bfhi(p0) * rs * ga[1]); ow.y = cvtpk(bflo(p1) * rs * ga[2], bfhi(p1) * rs * ga[3]);
            *(u32x2*)(mo + d0) = ow;
        }
}
__device__ __forceinline__ void attn_unit(Frame& F, int u) {
    LAS bf16_t* Ks = (LAS bf16_t*)F.lds;
    LAS bf16_t* Vt = (LAS bf16_t*)(F.lds + 36864);
    LAS float* ssq = (LAS float*)(F.lds + 36864 + 33280);
    const int w = F.wave, b = u >> 4, n = u & 15; const size_t t0 = (size_t)b * SEQ + 128 * n;
    if (F.tid < 128) ssq[F.tid] = 0.f;
    const int g0 = (2 * w) >> 2, rt0 = (2 * w) & 3, g1 = (2 * w + 1) >> 2, rt1 = (2 * w + 1) & 3;
    unsigned ok0[16], ok1[16], ok2[16], ok3[16];
    attn_stage(F, 0, n, t0, Ks, Vt);
    attn_item(F, g0, rt0, n, t0, Ks, Vt, ssq, ok0);
    attn_item(F, g1, rt1, n, t0, Ks, Vt, ssq, ok1);
    attn_stage(F, 1, n, t0, Ks, Vt);
    attn_item(F, 4 + g0, rt0, n, t0, Ks, Vt, ssq, ok2);
    attn_item(F, 4 + g1, rt1, n, t0, Ks, Vt, ssq, ok3);
    __syncthreads();
    attn_store(F, g0, rt0, t0, ssq, ok0); attn_store(F, g1, rt1, t0, ssq, ok1); attn_store(F, 4 + g0, rt0, t0, ssq, ok2); attn_store(F, 4 + g1, rt1, t0, ssq, ok3);
    __syncthreads();
}
__device__ __forceinline__ void p_scan_attn(Frame& F, bool do_scan, bool do_attn) {
    const int G = F.G, bx = blockIdx.x, nscan = (do_scan && do_attn && G >= 64) ? 32 : 0;
    if (do_scan) { if (nscan) { if (bx < nscan) scan_unit(F, bx); } else for (int u = bx; u < BATCH * 4; u += G) scan_unit(F, u); }
    if (do_attn) { if (nscan) { for (int u = bx - nscan; u >= 0 && u < BATCH * 16; u += G - nscan) attn_unit(F, u); } else for (int u = bx; u < BATCH * 16; u += G) attn_unit(F, u); }
}

__device__ __forceinline__ int w1col(int n) { const int pn = n >> 8, cl = n & 255; return cl < 128 ? 2 * (128 * pn + cl) : 2 * (128 * pn + cl - 128) + 1; }
template <bool W1MAP, bool FP8>
__device__ __forceinline__ void p0_transpose_item(const float* W, int K, int N, void* WTv, LAS float* scr, int item, int lane) {
    const int nblk = N / 32, kb = item / nblk, nb = item % nblk, k0 = 64 * kb, n0 = 32 * nb;
    const int sc = W1MAP ? w1col(n0 + (lane & 31)) : n0 + (lane & 31);
#pragma unroll 8
    for (int i = 0; i < 32; ++i) { const int kk = 2 * i + (lane >> 5); scr[kk * 33 + (lane & 31)] = W[(size_t)(k0 + kk) * N + sc]; }
    LDS_WAIT(); asm volatile("" ::: "memory");
    const int c = lane & 7;
#pragma unroll
    for (int j = 0; j < 4; ++j) { const int n = (lane >> 3) + 8 * j; const LAS float* s = scr + (8 * c) * 33 + n;
        if constexpr (FP8) { const f32x4 a = {s[0 * 33], s[1 * 33], s[2 * 33], s[3 * 33]}, b = {s[4 * 33], s[5 * 33], s[6 * 33], s[7 * 33]};
            *(GAS u32x2*)((unsigned char*)WTv + (size_t)(n0 + n) * K + k0 + 8 * c) = pg8::pack8_fp8(a * pg8::FP8_W_SCALE, b * pg8::FP8_W_SCALE); }
        else { u32x4 o; o.x = pg8::cvt_pk_bf16(s[0 * 33], s[1 * 33]); o.y = pg8::cvt_pk_bf16(s[2 * 33], s[3 * 33]); o.z = pg8::cvt_pk_bf16(s[4 * 33], s[5 * 33]); o.w = pg8::cvt_pk_bf16(s[6 * 33], s[7 * 33]);
            *(GAS u32x4*)((bf16_t*)WTv + (size_t)(n0 + n) * K + k0 + 8 * c) = o; } }
    LDS_WAIT(); asm volatile("" ::: "memory");
}
__device__ __forceinline__ void p_prologue(Frame& F) {
    LAS float* scr = (LAS float*)(F.lds + RING_OFF + F.wave * 16384);
    const int gw = F.vcu * NWAVES + F.wave, NGW = F.G * NWAVES;
    constexpr int I_IN = (DM / 64) * (INW / 32), I_OUT = (MIXW / 64) * (DM / 32), I_W1E = (DM / 64) * (2 * FF / 32), I_W2E = (FF / 64) * (DM / 32);
    constexpr int NITEMS = I_IN + I_OUT + NE * I_W1E + NE * I_W2E;
    bf16_t *WinT = WSP(bf16_t, WS_WINT), *WoutT = WSP(bf16_t, WS_WOUTT); unsigned char *W1T = WSP(unsigned char, WS_W1T), *W2T = WSP(unsigned char, WS_W2T);
    for (int it = gw; it < NITEMS; it += NGW) {
        int r = it;
        if (r < I_IN) { p0_transpose_item<false, false>(F.w_in, DM, INW, WinT, scr, r, F.lane); continue; } r -= I_IN;
        if (r < I_OUT) { p0_transpose_item<false, false>(F.w_out, MIXW, DM, WoutT, scr, r, F.lane); continue; } r -= I_OUT;
        if (r < NE * I_W1E) { const int e = r / I_W1E; p0_transpose_item<true, true>(F.w1 + (size_t)e * DM * 2 * FF, DM, 2 * FF, W1T + (size_t)e * 2 * FF * DM, scr, r % I_W1E, F.lane); continue; } r -= NE * I_W1E;
        { const int e = r / I_W2E; p0_transpose_item<false, true>(F.w2 + (size_t)e * FF * DM, FF, DM, W2T + (size_t)e * DM * FF, scr, r % I_W2E, F.lane); }
    }
    bf16_t* XN = WSP(bf16_t, WS_XN);
    for (int m = gw; m < T; m += NGW) {
        const GAS f32x4* xr = (const GAS f32x4*)(F.x + (size_t)m * DM) + F.lane;
        f32x4 v[4]; float s = 0.f;
#pragma unroll
        for (int j = 0; j < 4; ++j) { v[j] = xr[64 * j]; s += (v[j].x * v[j].x + v[j].y * v[j].y) + (v[j].z * v[j].z + v[j].w * v[j].w); }
        const float r = rsqrtf(wave_sum(s) * (1.f / DM) + EPS);
        GAS u32x2* o8 = (GAS u32x2*)(XN + (size_t)m * DM) + F.lane;
#pragma unroll
        for (int j = 0; j < 4; ++j) { const f32x4 g = *((const f32x4*)F.norm1_g + F.lane + 64 * j); u32x2 w; w.x = pg8::cvt_pk_bf16(v[j].x * r * g.x, v[j].y * r * g.y); w.y = pg8::cvt_pk_bf16(v[j].z * r * g.z, v[j].w * r * g.w); o8[64 * j] = w; }
    }
    if ((int)blockIdx.x == (F.G > 1 ? 1 : 0)) {
        bf16_t* RWF = WSP(bf16_t, WS_RWF);
        for (int i = F.tid; i < 64 * 64; i += NWAVES * 64) { const int ks = i >> 6, ln = i & 63, rr = ln & 31, hh = ln >> 5; float v[8];
#pragma unroll
            for (int j = 0; j < 8; ++j) v[j] = F.router_w[(size_t)(16 * ks + 8 * hh + j) * NE + rr];
            u32x4 hi, lo; hi.x = cvtpk(v[0], v[1]); hi.y = cvtpk(v[2], v[3]); hi.z = cvtpk(v[4], v[5]); hi.w = cvtpk(v[6], v[7]);
            lo.x = cvtpk(v[0] - bflo(hi.x), v[1] - bfhi(hi.x)); lo.y = cvtpk(v[2] - bflo(hi.y), v[3] - bfhi(hi.y)); lo.z = cvtpk(v[4] - bflo(hi.z), v[5] - bfhi(hi.z)); lo.w = cvtpk(v[6] - bflo(hi.w), v[7] - bfhi(hi.w));
            *(u32x4*)(RWF + ((size_t)(ks * 2 + 0) * 64 + ln) * 8) = hi; *(u32x4*)(RWF + ((size_t)(ks * 2 + 1) * 64 + ln) * 8) = lo; }
    }
    if (blockIdx.x == 0) { float* LB = WSP(float, WS_LB); for (int c = F.tid; c < HKW; c += NWAVES * 64) { const float a = F.lb_logits[c], b = F.lb_logits[HKW + c]; LB[c] = 1.f / (1.f + __expf(b - a)); } }
}

__device__ __forceinline__ void p_router(Frame& F) {
    LAS int* lcnt = (LAS int*)(F.lds + MOE_OFF + 512); LAS int* lbase = (LAS int*)(F.lds + MOE_OFF + 768);
    LAS float* part = (LAS float*)F.lds;
    LAS float* ssqp = (LAS float*)(F.lds + 32768);
    const float* X1 = WSP(float, WS_X1); unsigned char* H2 = WSP(unsigned char, WS_H2); float* GATE = WSP(float, WS_GATE); int* LIST = WSP(int, WS_LIST); float* RSTD = WSP(float, WS_RSTD);
    const bf16_t* RWF = WSP(bf16_t, WS_RWF);
    int* cnt = (int*)(F.ctl + CW_CNT);
    const int lane = F.lane, w = F.wave, r = lane & 31, h = lane >> 5, tile = w & 1, kq = w >> 1;
    for (int tb = blockIdx.x; tb < T / 64; tb += F.G) {
        if (F.tid < NE) lcnt[F.tid] = 0;
        const int t = tb * 64 + tile * 32 + r;
        f32x16 acc;
#pragma unroll
        for (int q = 0; q < 16; ++q) acc[q] = 0.f;
        float ssq = 0.f;
#pragma unroll 4
        for (int ks = 16 * kq; ks < 16 * kq + 16; ++ks) {
            const int k0 = 16 * ks + 8 * h;
            const f32x4 x0 = *(const f32x4*)(X1 + (size_t)t * DM + k0), x1v = *(const f32x4*)(X1 + (size_t)t * DM + k0 + 4);
            const f32x4 g0 = *(const f32x4*)(F.norm2_g + k0), g1 = *(const f32x4*)(F.norm2_g + k0 + 4);
            const u32x4 ahi = *(const u32x4*)(RWF + ((size_t)(ks * 2 + 0) * 64 + lane) * 8), alo = *(const u32x4*)(RWF + ((size_t)(ks * 2 + 1) * 64 + lane) * 8);
            float u[8];
#pragma unroll
            for (int q = 0; q < 4; ++q) { u[q] = x0[q] * g0[q]; u[4 + q] = x1v[q] * g1[q]; ssq += x0[q] * x0[q]; ssq += x1v[q] * x1v[q]; }
            u32x4 bh, bl;
            bh.x = cvtpk(u[0], u[1]); bh.y = cvtpk(u[2], u[3]); bh.z = cvtpk(u[4], u[5]); bh.w = cvtpk(u[6], u[7]);
            bl.x = cvtpk(u[0] - bflo(bh.x), u[1] - bfhi(bh.x)); bl.y = cvtpk(u[2] - bflo(bh.y), u[3] - bfhi(bh.y));
            bl.z = cvtpk(u[4] - bflo(bh.z), u[5] - bfhi(bh.z)); bl.w = cvtpk(u[6] - bflo(bh.w), u[7] - bfhi(bh.w));
            *(u32x2*)(H2 + (size_t)t * DM + k0) = pg8::pack8_fp8((f32x4){u[0], u[1], u[2], u[3]} * pg8::FP8_ACT_SCALE, (f32x4){u[4], u[5], u[6], u[7]} * pg8::FP8_ACT_SCALE);
            acc = MFMA32(__builtin_bit_cast(bf16x8, ahi), __builtin_bit_cast(bf16x8, bh), acc);
            acc = MFMA32(__builtin_bit_cast(bf16x8, alo), __builtin_bit_cast(bf16x8, bh), acc);
            acc = MFMA32(__builtin_bit_cast(bf16x8, ahi), __builtin_bit_cast(bf16x8, bl), acc);
        }
#pragma unroll
        for (int q = 0; q < 4; ++q) *(LAS f32x4*)(part + (w * 64 + lane) * 16 + 4 * q) = (f32x4){acc[4 * q], acc[4 * q + 1], acc[4 * q + 2], acc[4 * q + 3]};
        ssqp[w * 64 + lane] = ssq;
        __syncthreads();
        int my_e[TOPK], my_p[TOPK];
#pragma unroll
        for (int k = 0; k < TOPK; ++k) { my_e[k] = 0; my_p[k] = 0; }
        if (w < 2) {
            float lg[16];
#pragma unroll
            for (int q = 0; q < 16; ++q) lg[q] = 0.f;
            float s2 = 0.f;
#pragma unroll
            for (int k4 = 0; k4 < 4; ++k4) { const int ww = k4 * 2 + tile;
#pragma unroll
                for (int q = 0; q < 4; ++q) { const f32x4 p = *(const LAS f32x4*)(part + (ww * 64 + lane) * 16 + 4 * q); lg[4 * q] += p[0]; lg[4 * q + 1] += p[1]; lg[4 * q + 2] += p[2]; lg[4 * q + 3] += p[3]; }
                s2 += ssqp[ww * 64 + lane] + ssqp[ww * 64 + (lane ^ 32)]; }
            const float rstd = rsqrtf(s2 * (1.f / DM) + EPS);
#pragma unroll
            for (int q = 0; q < 16; ++q) lg[q] = lg[q] * rstd + F.router_b[crow(q, h)];
            float cv[8]; int ci[8];
#pragma unroll
            for (int k = 0; k < TOPK; ++k) {
                float bv = -INFINITY; int bi = 1 << 20;
#pragma unroll
                for (int q = 0; q < 16; ++q) { const int e = crow(q, h); const bool better = (lg[q] > bv) || (lg[q] == bv && e < bi); bv = better ? lg[q] : bv; bi = better ? e : bi; }
#pragma unroll
                for (int q = 0; q < 16; ++q) if (crow(q, h) == bi) lg[q] = -INFINITY;
                cv[k] = bv; ci[k] = bi;
            }
#pragma unroll
            for (int k = 0; k < TOPK; ++k) { cv[4 + k] = __shfl_xor(cv[k], 32); ci[4 + k] = __shfl_xor(ci[k], 32); }
            float tv[TOPK]; int te[TOPK];
#pragma unroll
            for (int k = 0; k < TOPK; ++k) {
                float bv = -INFINITY; int bi = 1 << 20;
#pragma unroll
                for (int q = 0; q < 8; ++q) { const bool better = (cv[q] > bv) || (cv[q] == bv && ci[q] < bi); bv = better ? cv[q] : bv; bi = better ? ci[q] : bi; }
#pragma unroll
                for (int q = 0; q < 8; ++q) if (ci[q] == bi) cv[q] = -INFINITY;
                tv[k] = bv; te[k] = bi;
            }
            const float e1 = __expf(tv[1] - tv[0]), e2 = __expf(tv[2] - tv[0]), e3 = __expf(tv[3] - tv[0]), inv = 1.f / (1.f + e1 + e2 + e3);
            if (h == 0) {
                RSTD[t] = rstd;
                *(f32x4*)(GATE + (size_t)t * TOPK) = (f32x4){inv, e1 * inv, e2 * inv, e3 * inv};
#pragma unroll
                for (int k = 0; k < TOPK; ++k) { my_e[k] = te[k]; my_p[k] = __hip_atomic_fetch_add(&lcnt[te[k]], 1, __ATOMIC_RELAXED, __HIP_MEMORY_SCOPE_WORKGROUP); }
            }
        }
        __syncthreads();
        if (F.tid < NE) lbase[F.tid] = atomicAdd(&cnt[F.tid], (int)lcnt[F.tid]);
        __syncthreads();
        if (w < 2 && h == 0) {
#pragma unroll
            for (int k = 0; k < TOPK; ++k) LIST[(size_t)my_e[k] * T + lbase[my_e[k]] + my_p[k]] = t * TOPK + k;
        }
        __syncthreads();
    }
}
__device__ __forceinline__ void moe_setup(Frame& F) {
    LAS int* pre = (LAS int*)(F.lds + MOE_OFF); LAS int* lc = (LAS int*)(F.lds + MOE_OFF + 256);
    if (F.tid < 64) {
        const int c = F.lane < NE ? (int)__hip_atomic_load((int*)(F.ctl + CW_CNT) + F.lane, RLX_AGENT) : 0;
        int s = (c + 255) >> 8;
#pragma unroll
        for (int o = 1; o < 32; o <<= 1) { const int v = __shfl_up(s, o); if ((F.lane & 31) >= o) s += v; }
        if (F.lane < NE) { pre[F.lane + 1] = s; lc[F.lane] = c; }
        if (F.lane == 0) pre[0] = 0;
    }
    __syncthreads();
}
__device__ __forceinline__ void p_final(Frame& F) {
    const float* X1 = WSP(float, WS_X1); const bf16_t* Y = WSP(bf16_t, WS_Y);
    const int gw = F.vcu * NWAVES + F.wave, NGW = F.G * NWAVES;
    for (int t = gw; t < T; t += NGW) {
        const GAS f32x4* xr = (const GAS f32x4*)(X1 + (size_t)t * DM) + F.lane;
        f32x4 v[4]; float s = 0.f;
#pragma unroll
        for (int j = 0; j < 4; ++j) {
            v[j] = xr[64 * j];
#pragma unroll
            for (int k = 0; k < TOPK; ++k) { const u32x2 y = *((const GAS u32x2*)(Y + ((size_t)t * TOPK + k) * DM) + F.lane + 64 * j);
                v[j].x += __builtin_bit_cast(float, y.x << 16); v[j].y += __builtin_bit_cast(float, y.x & 0xffff0000u); v[j].z += __builtin_bit_cast(float, y.y << 16); v[j].w += __builtin_bit_cast(float, y.y & 0xffff0000u); }
            s += (v[j].x * v[j].x + v[j].y * v[j].y) + (v[j].z * v[j].z + v[j].w * v[j].w);
        }
        const float r = rsqrtf(wave_sum(s) * (1.f / DM) + EPS);
        GAS f32x4* o = (GAS f32x4*)(F.out + (size_t)t * DM) + F.lane;
#pragma unroll
        for (int j = 0; j < 4; ++j) { const f32x4 g = *((const f32x4*)F.final_g + F.lane + 64 * j); o[64 * j] = (f32x4){v[j].x * r * g.x, v[j].y * r * g.y, v[j].z * r * g.z, v[j].w * r * g.w}; }
    }
}


__device__ __forceinline__ void p_attn_simple(Frame& F) {
    const bf16_t* AQ = WSP(bf16_t, WS_AQ); const bf16_t* AK = WSP(bf16_t, WS_AK); const bf16_t* AV = WSP(bf16_t, WS_AV); float* ATT = WSP(float, WS_ATT);
    const int gw0 = F.vcu * NWAVES + F.wave, NGW = F.G * NWAVES, lane = F.lane;
    for (int gw = gw0; gw < T * 8; gw += NGW) {
        const int t = gw >> 3, hq = gw & 7, kvh = hq >> 2, b = t / SEQ, tp = t % SEQ;
        const float slope = exp2f(-(float)(hq + 1)), sink = F.sinks[hq];
        const float qd = bf2f(AQ[(size_t)t * AW + hq * 64 + lane]);
        const int s0 = tp >= 127 ? tp - 127 : 0, nk = tp - s0 + 1;
        const bf16_t* kb = AK + ((size_t)b * SEQ + s0) * AKW + kvh * 64 + lane;
        const bf16_t* vb = AV + ((size_t)b * SEQ + s0) * AKW + kvh * 64 + lane;
        float slo = -INFINITY, shi = -INFINITY;
        for (int i = 0; i < nk; ++i) {
            const float d = wave_sum(qd * bf2f(kb[(size_t)i * AKW]));
            const float sc = d * 0.125f - slope * (float)(tp - (s0 + i));
            if ((i & 63) == lane) { if (i < 64) slo = sc; else shi = sc; }
        }
        const float m = fmaxf(wave_max(fmaxf(slo, shi)), sink);
        const float plo = __expf(slo - m), phi = __expf(shi - m);
        const float den = wave_sum(plo + phi) + __expf(sink - m);
        float o = 0.f;
        for (int i = 0; i < nk; ++i) { const float p = __shfl(i < 64 ? plo : phi, i & 63); o += p * bf2f(vb[(size_t)i * AKW]); }
        ATT[(size_t)t * AW + hq * 64 + lane] = o / den;
    }
}
__device__ __forceinline__ void p_hgrn_simple(Frame& F) {
    constexpr int TT = 16;
    LAS float* sf = (LAS float*)(F.lds); LAS float* sk = sf + TT * 128; LAS float* sq = sk + TT * 128; LAS float* po = sq + TT * 128;
    const bf16_t* HQ = WSP(bf16_t, WS_HQ); const float* G = WSP(float, WS_G); const bf16_t* KK = WSP(bf16_t, WS_KK); const bf16_t* HI = WSP(bf16_t, WS_HI); float* ORAW = WSP(float, WS_ORAW);
    for (int u = blockIdx.x; u < BATCH * 4; u += F.G) {
        const int b = u >> 2, h = u & 3, v = F.tid & 127, kq = F.tid >> 7;
        float S[32];
#pragma unroll
        for (int k = 0; k < 32; ++k) S[k] = 0.f;
        for (int t0 = 0; t0 < SEQ; t0 += TT) {
            __syncthreads();
            for (int i = F.tid; i < TT * 128; i += NWAVES * 64) {
                const int tt = i >> 7, k = i & 127; const size_t idx = ((size_t)b * SEQ + t0 + tt) * HKW + h * 128 + k;
                sf[i] = __expf(G[idx]); sk[i] = bf2f(KK[idx]); sq[i] = bf2f(HQ[idx]);
            }
            __syncthreads();
            for (int tt = 0; tt < TT; ++tt) {
                const float vv = bf2f(HI[((size_t)b * SEQ + t0 + tt) * HW + h * 128 + v]);
                float o = 0.f;
#pragma unroll
                for (int k = 0; k < 32; ++k) { const int kk = tt * 128 + kq * 32 + k; S[k] = sf[kk] * S[k] + sk[kk] * vv; o += sq[kk] * S[k]; }
                po[(tt * 4 + kq) * 128 + v] = o;
            }
            __syncthreads();
            for (int i = F.tid; i < TT * 128; i += NWAVES * 64) {
                const int tt = i >> 7, vv = i & 127;
                ORAW[((size_t)b * SEQ + t0 + tt) * HW + h * 128 + vv] = (po[(tt * 4 + 0) * 128 + vv] + po[(tt * 4 + 1) * 128 + vv]) + (po[(tt * 4 + 2) * 128 + vv] + po[(tt * 4 + 3) * 128 + vv]);
            }
        }
        __syncthreads();
    }
}
__device__ __forceinline__ void p_mix_simple(Frame& F, bool do_attn, bool do_hgrn) {
    const float* ATT = WSP(float, WS_ATT); const float* ORAW = WSP(float, WS_ORAW); const bf16_t* HG = WSP(bf16_t, WS_HG); bf16_t* MIX = WSP(bf16_t, WS_MIX);
    const int gw0 = F.vcu * NWAVES + F.wave, NGW = F.G * NWAVES, lane = F.lane;
    for (int t = gw0; t < T; t += NGW) {
        if (do_attn) {
        float a[8]; float ss = 0.f;
#pragma unroll
        for (int j = 0; j < 8; ++j) { a[j] = ATT[(size_t)t * AW + lane + 64 * j]; ss += a[j] * a[j]; }
        const float r = rsqrtf(wave_sum(ss) * (1.f / AW) + EPS);
#pragma unroll
        for (int j = 0; j < 8; ++j) MIX[(size_t)t * MIXW + lane + 64 * j] = f2bf(a[j] * r * F.attn_g[lane + 64 * j]);
        }
        if (do_hgrn)
#pragma unroll
        for (int h = 0; h < 4; ++h) {
            const int c0 = h * 128 + lane, c1 = c0 + 64;
            const float o0 = ORAW[(size_t)t * HW + c0], o1 = ORAW[(size_t)t * HW + c1];
            const float rr = rsqrtf(wave_sum(o0 * o0 + o1 * o1) * (1.f / 128.f) + EPS);
            MIX[(size_t)t * MIXW + AW + c0] = f2bf(o0 * rr * F.hgrn_g[c0] * bf2f(HG[(size_t)t * HW + c0]));
            MIX[(size_t)t * MIXW + AW + c1] = f2bf(o1 * rr * F.hgrn_g[c1] * bf2f(HG[(size_t)t * HW + c1]));
        }
    }
}

struct Args { const float* in[18]; float* out; unsigned char* ws; int ph_lo, ph_hi, li, pad; };
__global__ void __launch_bounds__(NWAVES * 64, 2) mega_fwd(Args args) {
    extern __shared__ __attribute__((aligned(16))) unsigned char lds[];
    Frame F;
    F.lds = (LAS unsigned char*)lds; F.MISC = (volatile LAS unsigned*)(F.lds + MISC_OFF);
    F.tid = threadIdx.x; F.lane = F.tid & 63; F.wave = __builtin_amdgcn_readfirstlane(F.tid >> 6);
    F.G = gridDim.x; { const int bx = blockIdx.x; F.vcu = (F.G % 8 == 0) ? (bx % 8) * (F.G / 8) + bx / 8 : bx; }
    F.ws = args.ws; F.ctl = (gu32*)(args.ws + WS_CTL); F.out = args.out;
    F.x = args.in[0]; F.norm1_g = args.in[1]; F.w_in = args.in[2]; F.b_in = args.in[3]; F.sinks = args.in[4]; F.attn_g = args.in[5]; F.lb_logits = args.in[6]; F.hgrn_g = args.in[7];
    F.w_out = args.in[8]; F.b_out = args.in[9]; F.norm2_g = args.in[10]; F.router_w = args.in[11]; F.router_b = args.in[12]; F.w1 = args.in[13]; F.b1 = args.in[14]; F.w2 = args.in[15];
    F.b2 = args.in[16]; F.final_g = args.in[17];
    for (int u = F.tid; u < (LDS_BYTES - LDSCTL_OFF) / 4; u += NWAVES * 64) ((LAS unsigned*)(F.lds + LDSCTL_OFF))[u] = 0u;
    __syncthreads();
    XcdBarrier bar = xcd_barrier_post((unsigned*)(F.ctl + CW_BAR) + args.li * XCD_BAR_WORDS, F.MISC + 8);
    const int lo = args.ph_lo, hi = args.ph_hi;
#define IN(k) (lo <= (k) && (k) < hi)
#define SEAM(k) do { if (IN(k) && IN((k) + 1)) xcd_barrier(bar); } while (0)

    if (IN(0)) { p_prologue(F); SEAM(0); }
    if (IN(1)) {
        pg8::DenseOrder S; S.init(WSP(bf16_t, WS_XN), WSP(bf16_t, WS_WINT), T, INW, DM, F.G, (int)blockIdx.x);
        pg8::EpiInProj E{F.b_in, WSP(float, WS_LB), WSP(bf16_t, WS_AQ), WSP(bf16_t, WS_AK), WSP(bf16_t, WS_AV), WSP(bf16_t, WS_HQ), WSP(bf16_t, WS_KK), WSP(bf16_t, WS_HI), WSP(bf16_t, WS_HG), WSP(float, WS_G)};
        pg8::gemm_phase<pg8::EpiInProj, pg8::DenseOrder, false, true>(F.lds + RING_OFF, DM, S, E);
        SEAM(1);
    }
#ifndef NEW_ATTN
#define NEW_ATTN 1
#endif
#ifndef NEW_HGRN
#define NEW_HGRN 1
#endif
    if (IN(2)) { if (!NEW_ATTN) p_attn_simple(F); if (NEW_HGRN) p_hgrn_prep(F); SEAM(2); }
    if (IN(3)) { if (!NEW_HGRN) p_hgrn_simple(F); p_scan_attn(F, NEW_HGRN, NEW_ATTN); SEAM(3); }
    if (IN(4)) { if (!NEW_ATTN || !NEW_HGRN) p_mix_simple(F, !NEW_ATTN, !NEW_HGRN); SEAM(4); }
    if (IN(5)) {
        pg8::DenseOrder S; S.init(WSP(bf16_t, WS_MIX), WSP(bf16_t, WS_WOUTT), T, DM, MIXW, F.G, (int)blockIdx.x);
        pg8::EpiOutProj E{F.b_out, F.x, WSP(float, WS_X1)};
        pg8::gemm_phase<pg8::EpiOutProj, pg8::DenseOrder, false, true>(F.lds + RING_OFF, MIXW, S, E);
        SEAM(5);
    }
    if (IN(6)) { p_router(F); SEAM(6); }
    if (IN(7)) {
        moe_setup(F);
        LAS const int* pre = (LAS const int*)(F.lds + MOE_OFF); LAS const int* lc = (LAS const int*)(F.lds + MOE_OFF + 256);
        pg8::MoeOrder<true, 1> S{(const char*)WSP(unsigned char, WS_H2), (const char*)WSP(unsigned char, WS_W1T), WSP(int, WS_LIST), pre, lc, DM, 2 * FF, 2 * FF / 256, pre[NE] * (2 * FF / 256), F.G, (int)blockIdx.x};
        pg8::EpiMoe1 E{F.b1, WSP(unsigned char, WS_ACT), WSP(int, WS_LIST), WSP(float, WS_RSTD)};
        pg8::gemm_phase<pg8::EpiMoe1, pg8::MoeOrder<true, 1>, true, true, 1>(F.lds + RING_OFF, DM, S, E);
        SEAM(7);
    }
    if (IN(8)) {
        if (!IN(7)) moe_setup(F);
        LAS const int* pre = (LAS const int*)(F.lds + MOE_OFF); LAS const int* lc = (LAS const int*)(F.lds + MOE_OFF + 256);
        pg8::MoeOrder<false, 1> S{(const char*)WSP(unsigned char, WS_ACT), (const char*)WSP(unsigned char, WS_W2T), WSP(int, WS_LIST), pre, lc, FF, DM, DM / 256, pre[NE] * (DM / 256), F.G, (int)blockIdx.x};
        pg8::EpiMoe2 E{F.b2, WSP(int, WS_LIST), WSP(float, WS_GATE), WSP(bf16_t, WS_Y)};
        pg8::gemm_phase<pg8::EpiMoe2, pg8::MoeOrder<false, 1>, false, true, 1>(F.lds + RING_OFF, FF, S, E);
        SEAM(8);
    }
    if (IN(9)) p_final(F);
#undef IN
#undef SEAM
}

static int mega_grid() {
    static int grid = 0;
    if (grid == 0) {
        int dev = 0, cus = 0;
        if (hipGetDevice(&dev) != hipSuccess || hipDeviceGetAttribute(&cus, hipDeviceAttributeMultiprocessorCount, dev) != hipSuccess) { grid = -1; return grid; }
        if (hipFuncSetAttribute((const void*)mega_fwd, hipFuncAttributeMaxDynamicSharedMemorySize, LDS_BYTES) != hipSuccess) { grid = -1; return grid; }
        (void)hipGetLastError();
        grid = cus;
    }
    return grid;
}
extern "C" void kernel_launch(void* const* d_in, const int* in_sizes, int n_in, void* d_out, int out_size, void* d_ws, size_t ws_size, hipStream_t stream) {
    if (n_in != 18 || ws_size < WS_END) return;
    const int grid = mega_grid(); if (grid <= 0) return;
    unsigned char* ws = (unsigned char*)d_ws;
    (void)hipMemsetAsync(ws + WS_CTL, 0, 262144, stream);
    Args a{};
    for (int i = 0; i < 18; ++i) a.in[i] = (const float*)d_in[i];
    a.out = (float*)d_out; a.ws = ws;
#ifndef PLAN
#define PLAN {{0, N_PHASES}}
#endif
    static const int plan[][2] = PLAN;
    for (int li = 0; li < (int)(sizeof(plan) / sizeof(plan[0])); ++li) {
        a.ph_lo = plan[li][0]; a.ph_hi = plan[li][1]; a.li = li;
        hipLaunchKernelGGL(mega_fwd, dim3(grid), dim3(NWAVES * 64), LDS_BYTES, stream, a);
    }
}
```

```cpp
#include <hip/hip_runtime.h>
#include <stdint.h>

typedef unsigned short bf16_t;
typedef short bf16x8 __attribute__((ext_vector_type(8)));
typedef float f32x4 __attribute__((ext_vector_type(4)));

constexpr int BATCH = 8, SEQ = 2048, DM = 1024, T = BATCH * SEQ;
constexpr int AW = 512, AKW = 128, HKW = 512, HW = 512, INW = 2816, MIXW = 1024;
constexpr int NE = 32, TOPK = 4, FF = 1024;
constexpr int C_AQ = 0, C_AK = 512, C_AV = 640, C_HQ = 768, C_HF = 1280, C_HI = 1792, C_HG = 2304;
constexpr float EPS = 1e-5f;
constexpr int ACT_ROWS = T * TOPK + NE * 256;

constexpr size_t MiB = 1u << 20;
constexpr size_t al(size_t x) { return (x + 255) & ~(size_t)255; }
constexpr size_t WS_CTL = 0;
constexpr size_t WS_LB = 1 * MiB;
constexpr size_t WS_WINT = 2 * MiB;
constexpr size_t WS_WOUTT = WS_WINT + al((size_t)INW * DM * 2);
constexpr size_t WS_W1T = WS_WOUTT + al((size_t)DM * MIXW * 2);
constexpr size_t WS_W2T = WS_W1T + al((size_t)NE * 2 * FF * DM * 2);
constexpr size_t WS_XN = WS_W2T + al((size_t)NE * DM * FF * 2);
constexpr size_t WS_AQ = WS_XN + al((size_t)T * DM * 2);
constexpr size_t WS_AK = WS_AQ + al((size_t)T * AW * 2);
constexpr size_t WS_AV = WS_AK + al((size_t)T * AKW * 2);
constexpr size_t WS_HQ = WS_AV + al((size_t)T * AKW * 2);
constexpr size_t WS_G = WS_HQ + al((size_t)T * HKW * 2);
constexpr size_t WS_KK = WS_G + al((size_t)T * HKW * 4);
constexpr size_t WS_HI = WS_KK + al((size_t)T * HKW * 2);
constexpr size_t WS_HG = WS_HI + al((size_t)T * HW * 2);
constexpr size_t WS_ATT = WS_HG + al((size_t)T * HW * 2);
constexpr size_t WS_ORAW = WS_ATT + al((size_t)T * AW * 4);
constexpr size_t WS_MIX = WS_ORAW + al((size_t)T * HW * 4);
constexpr size_t WS_X1 = WS_MIX + al((size_t)T * MIXW * 2);
constexpr size_t WS_H2 = WS_X1 + al((size_t)T * DM * 4);
constexpr size_t WS_GATE = WS_H2 + al((size_t)T * DM * 2);
constexpr size_t WS_LIST = WS_GATE + al((size_t)T * TOPK * 4);
constexpr size_t WS_ACT = WS_LIST + al((size_t)NE * T * 4);
constexpr size_t WS_Y = WS_ACT + al((size_t)ACT_ROWS * FF * 2);
constexpr size_t WS_QF = WS_Y + al((size_t)T * TOPK * DM * 2);
constexpr size_t WS_KF = WS_QF + al((size_t)1024 * 16 * 512 * 2);
constexpr size_t WS_VF = WS_KF + al((size_t)1024 * 16 * 512 * 2);
constexpr size_t WS_INTRA = WS_VF + al((size_t)1024 * 16 * 512 * 2);
constexpr size_t WS_DEC = WS_INTRA + al((size_t)T * HW * 2);
constexpr size_t WS_RWF = WS_DEC + al((size_t)1024 * 128 * 4);
constexpr size_t WS_RSTD = WS_RWF + al((size_t)64 * 2 * 512 * 2);
constexpr size_t WS_END = WS_RSTD + al((size_t)T * 4);
static_assert(WS_END <= ((size_t)1 << 30), "workspace map exceeds 1 GiB");
constexpr int CW_CNT = 64;
constexpr int CW_OFF = 128;

__device__ __forceinline__ bf16_t f2bf(float f) { unsigned u = __builtin_bit_cast(unsigned, f); return (bf16_t)((u + 0x7fffu + ((u >> 16) & 1u)) >> 16); }
__device__ __forceinline__ float bf2f(bf16_t b) { return __builtin_bit_cast(float, (unsigned)b << 16); }
__device__ __forceinline__ float wave_sum(float v) {
#pragma unroll
    for (int o = 1; o < 64; o <<= 1) v += __shfl_xor(v, o);
    return v;
}
__device__ __forceinline__ float wave_max(float v) {
#pragma unroll
    for (int o = 1; o < 64; o <<= 1) v = fmaxf(v, __shfl_xor(v, o));
    return v;
}
__device__ __forceinline__ float sigmoidf_(float x) { return 1.f / (1.f + __expf(-x)); }
__device__ __forceinline__ float siluf_(float x) { return x / (1.f + __expf(-x)); }

#define LAS __attribute__((address_space(3)))
#define GAS __attribute__((address_space(1)))
typedef unsigned u32x4 __attribute__((ext_vector_type(4)));
typedef unsigned u32x2 __attribute__((ext_vector_type(2)));
typedef float f32x2 __attribute__((ext_vector_type(2)));

namespace pg8 {
constexpr int BM = 256, BK = 64, HALF = 128, HTB = HALF * BK * 2  , STAGE_BYTES = 8 * HTB, NXCD = 8, WGM = 8;
__host__ __device__ __forceinline__ int lds_byte(int r, int c) { const int st = (r >> 4) * 2 + (c >> 5), rr = r & 15, cc = c & 31, ob = rr * 64 + cc * 2; return st * 1024 + (ob ^ (((ob >> 9) & 1) << 5)); }
__host__ __device__ __forceinline__ void stage_rc(int b, int& R, int& C) { const int st = b / 1024, sb = b % 1024, swz = sb ^ (((sb >> 9) & 1) << 5); R = (st >> 1) * 16 + swz / 64; C = (st & 1) * 32 + (swz % 64) / 2; }
__host__ __device__ __forceinline__ int perm32(int rho) { const int n = rho >> 4, i = rho & 15; return 8 * (i >> 2) + 4 * n + (i & 3); }
__device__ __forceinline__ unsigned cvt_pk_bf16(float lo, float hi) { unsigned r; asm volatile("v_cvt_pk_bf16_f32 %0, %1, %2" : "=v"(r) : "v"(lo), "v"(hi)); return r; }

struct Unit { const char* A; const char* B; int pm, pn, e, rows, arow, lbase; };

struct DenseOrder {
    const char* A; const char* Bt; int K, nM, nN, nwg, G, c;
    __device__ void init(const void* A_, const void* Bt_, int M, int N, int K_, int G_, int c_) { A = (const char*)A_; Bt = (const char*)Bt_; K = K_; nM = M / BM; nN = N / BM; nwg = nM * nN; G = G_; c = c_; }
    __device__ __forceinline__ bool next(int i, Unit& u) const {
        const long L = (long)i * G + c; if (L >= nwg) return false;
        int wgid = (int)L; { const int q = nwg / NXCD, r = nwg % NXCD, xcd = wgid % NXCD, off = wgid / NXCD; wgid = (xcd < r ? xcd * (q + 1) : r * (q + 1) + (xcd - r) * q) + off; }
        const int nig = WGM * nN, gid = wgid / nig, fm = gid * WGM, gsz = (nM - fm) < WGM ? (nM - fm) : WGM;
        u.pm = fm + ((wgid % nig) % gsz); u.pn = (wgid % nig) / gsz; u.e = 0; u.rows = BM; u.arow = u.pm * BM; u.lbase = 0;
        u.A = A + (size_t)u.pm * BM * K * 2; u.B = Bt + (size_t)u.pn * BM * K * 2; return true;
    }
    __device__ __forceinline__ int row(const Unit&, int r) const { return r; }
};
template <bool G1, int ES>
struct MoeOrder {
    const char* A; const char* Bt; const int* list; LAS const int* pre; LAS const int* cnt; int K, N, nN, nwg, G, c;
    __device__ __forceinline__ bool next(int i, Unit& u) const {
        const long L = (long)i * G + c; if (L >= nwg) return false;
        int wgid = (int)L; { const int q = nwg / NXCD, r = nwg % NXCD, xcd = wgid % NXCD, off = wgid / NXCD; wgid = (xcd < r ? xcd * (q + 1) : r * (q + 1) + (xcd - r) * q) + off; }
        const int tau = wgid / nN; u.pn = wgid % nN;
        const int p = pre[(threadIdx.x & 31) + 1];
        const int e = __builtin_popcountll(__ballot(p <= tau) & 0xffffffffull);
        const int mt = tau - pre[e];
        u.e = e; u.pm = mt; const int left = cnt[e] - mt * BM; u.rows = left < BM ? left : BM;
        u.arow = tau * BM; u.lbase = e * T + mt * BM;
        u.A = G1 ? A : A + (size_t)u.arow * K * ES;
        u.B = Bt + ((size_t)e * N + (size_t)u.pn * BM) * K * ES; return true;
    }
    __device__ __forceinline__ int row(const Unit& u, int r) const { const int rr = r < u.rows ? r : u.rows - 1; return list[u.lbase + rr] >> 2; }
};

__device__ __forceinline__ u32x4 pack8(f32x4 v0, f32x4 v1) { u32x4 w; w.x = cvt_pk_bf16(v0[0], v0[1]); w.y = cvt_pk_bf16(v0[2], v0[3]); w.z = cvt_pk_bf16(v1[0], v1[1]); w.w = cvt_pk_bf16(v1[2], v1[3]); return w; }
__device__ __forceinline__ f32x4 silu4(f32x4 v) { f32x4 r; for (int i = 0; i < 4; ++i) r[i] = v[i] * __builtin_amdgcn_rcpf(1.f + __expf(-v[i])); return r; }

typedef int v8i32 __attribute__((ext_vector_type(8)));
__device__ __forceinline__ u32x2 pack8_fp8(f32x4 v0, f32x4 v1) {
    int a = 0, b = 0; a = __builtin_amdgcn_cvt_pk_fp8_f32(v0[0], v0[1], a, false); a = __builtin_amdgcn_cvt_pk_fp8_f32(v0[2], v0[3], a, true);
    b = __builtin_amdgcn_cvt_pk_fp8_f32(v1[0], v1[1], b, false); b = __builtin_amdgcn_cvt_pk_fp8_f32(v1[2], v1[3], b, true);
    return (u32x2){(unsigned)a, (unsigned)b};
}
constexpr float FP8_ACT_SCALE = 4.f, FP8_W_SCALE = 64.f, FP8_DESCALE = 1.f / (FP8_ACT_SCALE * FP8_W_SCALE);
struct EpiInProj {
    static constexpr bool PERM = true;
    const float* bias; const float* lb; bf16_t *AQ, *AK, *AV, *HQ, *KK, *HI, *HG; float* G;
    __device__ __forceinline__ void operator()(const f32x4 (&acc)[2][2][4][2], const Unit& u, int wr, int wc, int fr, int fq) const {
        const int row0 = u.pm * BM + wr * 64 + fr, cl = wc * 32 + 8 * fq;
#pragma unroll
        for (int bj = 0; bj < 2; ++bj) {
            const int cb = u.pn * BM + bj * HALF;
            const f32x4 b0 = *(const f32x4*)(bias + cb + cl), b1 = *(const f32x4*)(bias + cb + cl + 4);
            if (cb >= C_HF && cb < C_HI) {
                const int cc = cb - C_HF + cl;
                const f32x4 l0 = *(const f32x4*)(lb + cc), l1 = *(const f32x4*)(lb + cc + 4);
#pragma unroll
                for (int ai = 0; ai < 2; ++ai)
#pragma unroll
                    for (int m = 0; m < 4; ++m) {
                        const size_t r = (size_t)(row0 + ai * HALF + m * 16);
                        f32x4 v0 = acc[ai][bj][m][0] + b0, v1 = acc[ai][bj][m][1] + b1, g0, g1, k0, k1;
#pragma unroll
                        for (int i = 0; i < 4; ++i) {
                            const float f0 = l0[i] + (1.f - l0[i]) * __builtin_amdgcn_rcpf(1.f + __expf(-v0[i])); g0[i] = __logf(f0); k0[i] = 1.f - f0;
                            const float f1 = l1[i] + (1.f - l1[i]) * __builtin_amdgcn_rcpf(1.f + __expf(-v1[i])); g1[i] = __logf(f1); k1[i] = 1.f - f1;
                        }
                        *(f32x4*)(G + r * HKW + cc) = g0; *(f32x4*)(G + r * HKW + cc + 4) = g1;
                        *(u32x4*)(KK + r * HKW + cc) = pack8(k0, k1);
                    }
            } else {
                bf16_t* dst; int ld, cc; bool act = false;
                if (cb < C_AK) { dst = AQ; ld = AW; cc = cb - C_AQ; }
                else if (cb < C_AV) { dst = AK; ld = AKW; cc = cb - C_AK; }
                else if (cb < C_HQ) { dst = AV; ld = AKW; cc = cb - C_AV; }
                else if (cb < C_HF) { dst = HQ; ld = HKW; cc = cb - C_HQ; act = true; }
                else if (cb < C_HG) { dst = HI; ld = HW; cc = cb - C_HI; }
                else { dst = HG; ld = HW; cc = cb - C_HG; act = true; }
                cc += cl;
#pragma unroll
                for (int ai = 0; ai < 2; ++ai)
#pragma unroll
                    for (int m = 0; m < 4; ++m) {
                        const size_t r = (size_t)(row0 + ai * HALF + m * 16);
                        f32x4 v0 = acc[ai][bj][m][0] + b0, v1 = acc[ai][bj][m][1] + b1;
                        if (act) { v0 = silu4(v0); v1 = silu4(v1); }
                        *(u32x4*)(dst + r * ld + cc) = pack8(v0, v1);
                    }
            }
        }
    }
};
struct EpiOutProj {
    static constexpr bool PERM = false;
    const float* bias; const float* x; float* X1;
    __device__ __forceinline__ void operator()(const f32x4 (&acc)[2][2][4][2], const Unit& u, int wr, int wc, int fr, int fq) const {
        const int row0 = u.pm * BM + wr * 64 + fr, col0 = u.pn * BM + wc * 32 + 4 * fq;
#pragma unroll
        for (int bj = 0; bj < 2; ++bj)
#pragma unroll
            for (int n = 0; n < 2; ++n) {
                const int c = col0 + bj * HALF + n * 16; const f32x4 bv = *(const f32x4*)(bias + c);
#pragma unroll
                for (int ai = 0; ai < 2; ++ai)
#pragma unroll
                    for (int m = 0; m < 4; ++m) { const size_t o = (size_t)(row0 + ai * HALF + m * 16) * DM + c; *(f32x4*)(X1 + o) = acc[ai][bj][m][n] + bv + *(const f32x4*)(x + o); }
            }
    }
};
struct EpiMoe1 {
    static constexpr bool PERM = true;
    const float* b1; unsigned char* ACT; const int* list; const float* rstd;
    __device__ __forceinline__ void operator()(const f32x4 (&acc)[2][2][4][2], const Unit& u, int wr, int wc, int fr, int fq) const {
        const int ac0 = u.pn * HALF + wc * 32 + 8 * fq;
        const float* bp = b1 + (size_t)u.e * 2 * FF + 2 * ac0;
        const f32x4 q0 = *(const f32x4*)bp, q1 = *(const f32x4*)(bp + 4), q2 = *(const f32x4*)(bp + 8), q3 = *(const f32x4*)(bp + 12);
        const f32x4 bg0 = {q0[0], q0[2], q1[0], q1[2]}, bg1 = {q2[0], q2[2], q3[0], q3[2]}, bl0 = {q0[1], q0[3], q1[1], q1[3]}, bl1 = {q2[1], q2[3], q3[1], q3[3]};
#pragma unroll
        for (int ai = 0; ai < 2; ++ai)
#pragma unroll
            for (int m = 0; m < 4; ++m) {
                const int r = ai * HALF + wr * 64 + m * 16 + fr;
                const float rs = r < u.rows ? rstd[list[u.lbase + r] >> 2] * FP8_DESCALE : 0.f;
                const f32x4 g0 = acc[ai][0][m][0] * rs + bg0, g1 = acc[ai][0][m][1] * rs + bg1, l0 = acc[ai][1][m][0] * rs + bl0, l1 = acc[ai][1][m][1] * rs + bl1;
                f32x4 a0, a1;
#pragma unroll
                for (int i = 0; i < 4; ++i) {
                    const float u0 = fminf(g0[i], 7.f), u1 = fminf(g1[i], 7.f), w0 = fminf(fmaxf(l0[i], -7.f), 7.f), w1 = fminf(fmaxf(l1[i], -7.f), 7.f);
                    a0[i] = u0 * __builtin_amdgcn_rcpf(1.f + __expf(-1.702f * u0)) * (w0 + 1.f);
                    a1[i] = u1 * __builtin_amdgcn_rcpf(1.f + __expf(-1.702f * u1)) * (w1 + 1.f);
                }
                if (r < u.rows) *(u32x2*)(ACT + (size_t)(u.arow + r) * FF + ac0) = pack8_fp8(a0 * FP8_ACT_SCALE, a1 * FP8_ACT_SCALE);
            }
    }
};
struct EpiMoe2 {
    static constexpr bool PERM = true;
    const float* b2; const int* list; const float* gate; bf16_t* Y;
    __device__ __forceinline__ void operator()(const f32x4 (&acc)[2][2][4][2], const Unit& u, int wr, int wc, int fr, int fq) const {
        const int c0 = u.pn * BM + wc * 32 + 8 * fq;
        f32x4 bv[2][2];
#pragma unroll
        for (int bj = 0; bj < 2; ++bj)
#pragma unroll
            for (int n = 0; n < 2; ++n) bv[bj][n] = *(const f32x4*)(b2 + (size_t)u.e * DM + c0 + bj * HALF + 4 * n);
#pragma unroll
        for (int ai = 0; ai < 2; ++ai)
#pragma unroll
            for (int m = 0; m < 4; ++m) {
                const int r = ai * HALF + wr * 64 + m * 16 + fr;
                if (r < u.rows) {
                    const int slot = list[u.lbase + r]; const float gt = gate[slot];
                    bf16_t* yr = Y + (size_t)slot * DM + c0;
#pragma unroll
                    for (int bj = 0; bj < 2; ++bj) { const f32x4 v0 = (acc[ai][bj][m][0] * FP8_DESCALE + bv[bj][0]) * gt, v1 = (acc[ai][bj][m][1] * FP8_DESCALE + bv[bj][1]) * gt; *(u32x4*)(yr + bj * HALF) = pack8(v0, v1); }
                }
            }
    }
};

template <class Epi, class Sched, bool GATHER, bool ALIGN_EPI, int ES = 2>
__device__ __forceinline__ void gemm_phase(LAS unsigned char* lds, const int K, const Sched& S, const Epi& E) {
    const int tid = threadIdx.x, wid = __builtin_amdgcn_readfirstlane(tid >> 6), lane = tid & 63, wr = wid >> 2, wc = wid & 3, fr = lane & 15, fq = lane >> 4;
    int nt = K * ES / (BK * 2); asm volatile("" : "+s"(nt));
    unsigned voffB[2];
#pragma unroll
    for (int i = 0; i < 2; ++i) { int R, C; stage_rc(tid * 16 + i * 8192, R, C); const int Rb = Epi::PERM ? ((R & ~31) + perm32(R & 31)) : R; voffB[i] = (unsigned)(Rb * K * ES + C * 2); }
    const size_t kstep = (size_t)(BK * 2);
    const size_t hstep = (size_t)HALF * K * ES;
    const unsigned ldsw = (unsigned)wid * 1024u;
    const int aoff = lds_byte(wr * 64 + fr, fq * 8), boff = lds_byte(wc * 32 + fr, fq * 8);
#define PG8_SA(b, h) (((b) * 2 + (h)) * HTB)
#define PG8_SB(b, h) ((4 + (b) * 2 + (h)) * HTB)
#define PG8_STAGE(bufoff, gbase, voff) do { _Pragma("unroll") for (int _i = 0; _i < 2; ++_i) \
        __builtin_amdgcn_global_load_lds((const unsigned*)((const char*)(gbase) + (voff)[_i]), (LAS unsigned*)(lds + (bufoff) + ldsw + _i * 8192), 16, 0, 0); } while (0)
#define PG8_LD8(dst, off) do { const u32x4 lo_ = *(const LAS u32x4*)(lds + (off)), hi_ = *(const LAS u32x4*)(lds + (off) + 1024); \
        dst = (v8i32){(int)lo_.x, (int)lo_.y, (int)lo_.z, (int)lo_.w, (int)hi_.x, (int)hi_.y, (int)hi_.z, (int)hi_.w}; } while (0)
#define PG8_LDA(dst, b, h) do { _Pragma("unroll") for (int m = 0; m < 4; ++m) PG8_LD8(dst[m], PG8_SA(b, h) + aoff + m * 2048); } while (0)
#define PG8_LDB(dst, b, h) do { _Pragma("unroll") for (int n = 0; n < 2; ++n) PG8_LD8(dst[n], PG8_SB(b, h) + boff + n * 2048); } while (0)
#define PG8_LO(x) __builtin_bit_cast(bf16x8, __builtin_shufflevector(x, x, 0, 1, 2, 3))
#define PG8_HI(x) __builtin_bit_cast(bf16x8, __builtin_shufflevector(x, x, 4, 5, 6, 7))
#define PG8_MMA(ai, bj, At, Bt) do { __builtin_amdgcn_s_setprio(1); _Pragma("unroll") for (int m = 0; m < 4; ++m) _Pragma("unroll") for (int n = 0; n < 2; ++n) { \
        if constexpr (ES == 2) { acc[ai][bj][m][n] = __builtin_amdgcn_mfma_f32_16x16x32_bf16(PG8_LO(Bt[n]), PG8_LO(At[m]), acc[ai][bj][m][n], 0, 0, 0); \
                                 acc[ai][bj][m][n] = __builtin_amdgcn_mfma_f32_16x16x32_bf16(PG8_HI(Bt[n]), PG8_HI(At[m]), acc[ai][bj][m][n], 0, 0, 0); } \
        else asm volatile("v_mfma_scale_f32_16x16x128_f8f6f4 %0, %1, %2, %0, %3, %3 op_sel_hi:[0,0,0]" : "+v"(acc[ai][bj][m][n]) : "v"(Bt[n]), "v"(At[m]), "v"(unit_scale)); } \
          \
        __builtin_amdgcn_s_setprio(0); } while (0)
#define PG8_WAIT_V(n) asm volatile("s_waitcnt vmcnt(" #n ")" ::: "memory")
#define PG8_WAIT_L(n) asm volatile("s_waitcnt lgkmcnt(" #n ")" ::: "memory")
#define PG8_BAR __builtin_amdgcn_s_barrier()
#define PG8_SCHED __builtin_amdgcn_sched_barrier(0)
#define PG8_VOFFA(dst, u) do { int _t = tid; if (GATHER) asm volatile("" : "+v"(_t));     \
        _Pragma("unroll") for (int _i = 0; _i < 2; ++_i) { int _R, _C; stage_rc(_t * 16 + _i * 8192, _R, _C); _Pragma("unroll") for (int _h = 0; _h < 2; ++_h) { const int _r = _h * HALF + _R; \
        const unsigned _row = GATHER ? (unsigned)S.row(u, _r) : (unsigned)_r; dst[_h][_i] = _row * (unsigned)(K * ES) + (unsigned)_C * 2u; } } } while (0)
    Unit cur, nxt; int ui = 0;
    if (!S.next(0, cur)) return;
    f32x4 acc[2][2][4][2];
#pragma unroll
    for (int a = 0; a < 2; ++a)
#pragma unroll
        for (int b = 0; b < 2; ++b)
#pragma unroll
            for (int m = 0; m < 4; ++m)
#pragma unroll
                for (int n = 0; n < 2; ++n) acc[a][b][m][n] = (f32x4){0.f, 0.f, 0.f, 0.f};
    v8i32 At[4], B0[2], B1[2];
    const int unit_scale = 0x7F7F7F7F;
    unsigned vA[2][2], nvA[2][2];
    PG8_VOFFA(vA, cur);
    const char* cA = cur.A; const char* cB = cur.B;
    PG8_STAGE(PG8_SB(0, 0), cB, voffB); PG8_STAGE(PG8_SB(0, 1), cB + hstep, voffB); PG8_STAGE(PG8_SA(0, 0), cA, vA[0]); PG8_STAGE(PG8_SA(0, 1), cA, vA[1]);
    if (wr == 1) PG8_BAR;
    PG8_WAIT_V(2); PG8_BAR;
    PG8_STAGE(PG8_SB(1, 0), cB + kstep, voffB); PG8_STAGE(PG8_SA(1, 0), cA + kstep, vA[0]); PG8_STAGE(PG8_SB(1, 1), cB + hstep + kstep, voffB);
    PG8_WAIT_V(6); PG8_BAR;
    for (;;) {
        const bool has_next = S.next(ui + 1, nxt);
        const char* nA = has_next ? nxt.A : cA; const char* nB = has_next ? nxt.B : cB;
        if (has_next) { PG8_VOFFA(nvA, nxt); } else {
#pragma unroll
            for (int h = 0; h < 2; ++h)
#pragma unroll
                for (int i = 0; i < 2; ++i) nvA[h][i] = vA[h][i]; }
#pragma unroll 1
        for (int t = 0; t < nt; t += 2) {
            const bool last = (t == nt - 2);
            const char* a1 = cA + (size_t)(t + 1) * kstep;
            const char* a2 = last ? nA : cA + (size_t)(t + 2) * kstep; const char* b2 = last ? nB : cB + (size_t)(t + 2) * kstep;
            const char* a3 = a2 + kstep; const char* b3 = b2 + kstep;
            unsigned s0[2], s1[2];
#pragma unroll
            for (int i = 0; i < 2; ++i) { s0[i] = last ? nvA[0][i] : vA[0][i]; s1[i] = last ? nvA[1][i] : vA[1][i]; }
            PG8_LDB(B0, 0, 0); PG8_LDB(B1, 0, 1); PG8_SCHED; PG8_LDA(At, 0, 0); PG8_STAGE(PG8_SA(1, 1), a1, vA[1]);
            PG8_WAIT_V(8); PG8_WAIT_L(0); PG8_BAR; PG8_MMA(0, 0, At, B0); PG8_MMA(0, 1, At, B1); PG8_BAR; PG8_SCHED;
            PG8_LDA(At, 0, 1); PG8_STAGE(PG8_SB(0, 0), b2, voffB); PG8_STAGE(PG8_SB(0, 1), b2 + hstep, voffB); PG8_STAGE(PG8_SA(0, 0), a2, s0);
            PG8_WAIT_V(8); PG8_WAIT_L(0); PG8_BAR; PG8_MMA(1, 0, At, B0); PG8_MMA(1, 1, At, B1); PG8_BAR; PG8_SCHED;
            PG8_LDB(B0, 1, 0); PG8_LDB(B1, 1, 1); PG8_SCHED; PG8_LDA(At, 1, 0); PG8_STAGE(PG8_SA(0, 1), a2, s1);
            PG8_WAIT_V(8); PG8_WAIT_L(0); PG8_BAR; PG8_MMA(0, 0, At, B0); PG8_MMA(0, 1, At, B1); PG8_BAR; PG8_SCHED;
            PG8_LDA(At, 1, 1); PG8_STAGE(PG8_SB(1, 0), b3, voffB); PG8_STAGE(PG8_SB(1, 1), b3 + hstep, voffB); PG8_STAGE(PG8_SA(1, 0), a3, s0);
            PG8_WAIT_V(8); PG8_WAIT_L(0); PG8_BAR; PG8_MMA(1, 0, At, B0); PG8_MMA(1, 1, At, B1); PG8_BAR; PG8_SCHED;
        }
        if constexpr (ALIGN_EPI) { if (wr == 0) PG8_BAR; }
        if constexpr (ES == 1) asm volatile("s_nop 15\n\ts_nop 7" ::: "memory");
        { int l2 = lane; asm volatile("" : "+v"(l2)); E(acc, cur, wr, wc, l2 & 15, l2 >> 4); }
        if (!has_next) break;
#pragma unroll
        for (int a = 0; a < 2; ++a)
#pragma unroll
            for (int b = 0; b < 2; ++b)
#pragma unroll
                for (int m = 0; m < 4; ++m)
#pragma unroll
                    for (int n = 0; n < 2; ++n) acc[a][b][m][n] = (f32x4){0.f, 0.f, 0.f, 0.f};
        cur = nxt; cA = nA; cB = nB; ++ui;
#pragma unroll
        for (int h = 0; h < 2; ++h)
#pragma unroll
            for (int i = 0; i < 2; ++i) vA[h][i] = nvA[h][i];
        if constexpr (ALIGN_EPI) { if (wr == 1) PG8_BAR; }
    }
    PG8_WAIT_V(0);
    if constexpr (!ALIGN_EPI) { if (wr == 0) PG8_BAR; }
    PG8_BAR;
#undef PG8_SA
#undef PG8_SB
#undef PG8_STAGE
#undef PG8_LDA
#undef PG8_LDB
#undef PG8_MMA
#undef PG8_LD8
#undef PG8_LO
#undef PG8_HI
#undef PG8_WAIT_V
#undef PG8_WAIT_L
#undef PG8_BAR
#undef PG8_SCHED
#undef PG8_VOFFA
}
}

constexpr int NWAVES = 8;
constexpr int RING_OFF = 0, RING_BYTES = 139264;
constexpr int LDSCTL_OFF = RING_BYTES, MISC_OFF = LDSCTL_OFF + 320;
constexpr int MOE_OFF = LDSCTL_OFF + 1024;
constexpr int LDS_BYTES = RING_BYTES + 16384;
constexpr int CW_TMO = 0, CW_CODE = 1, CW_BAR = 4096;
constexpr int N_PHASES = 10;

typedef GAS unsigned gu32;
#define RLX_AGENT __ATOMIC_RELAXED, __HIP_MEMORY_SCOPE_AGENT
#define LDS_WAIT() asm volatile("s_waitcnt lgkmcnt(0)" ::: "memory")
#define VM_WAIT() asm volatile("s_waitcnt vmcnt(0)" ::: "memory")

#define XB_TMO      128
#define XB_XCNT(j)  (256  + 64 * (j))
#define XB_XSUB(j)  (1280 + 64 * (j))
#define XB_XGEN(j)  (2304 + 64 * (j))
#define XB_TOP      3328
#define XB_TOPGEN   3392
#define XCD_BAR_WORDS 3456
#define XB_SPIN_CAP (1u << 18)
__device__ __forceinline__ unsigned xb_ld(unsigned* p)              { return __hip_atomic_load(p, __ATOMIC_RELAXED, __HIP_MEMORY_SCOPE_AGENT); }
__device__ __forceinline__ unsigned xb_add(unsigned* p, unsigned v) { return __hip_atomic_fetch_add(p, v, __ATOMIC_RELAXED, __HIP_MEMORY_SCOPE_AGENT); }
__device__ __forceinline__ unsigned xb_xcc_id() { return (unsigned)__builtin_amdgcn_s_getreg((3 << 11) | 20) & 0xFu; }
#define XB_SPIN(cond, bar) do { unsigned _sp = 0; while (cond) { __builtin_amdgcn_s_sleep(1); \
    if ((++_sp & 255u) == 0u) { if (xb_ld(&(bar)[XB_TMO])) break; if (_sp > XB_SPIN_CAP) { atomicAdd(&(bar)[XB_TMO], 1u); break; } } } } while (0)
struct XcdBarrier { unsigned* bar; unsigned x; volatile LAS unsigned* st; };
__device__ __forceinline__ XcdBarrier xcd_barrier_post(unsigned* bar, volatile LAS unsigned* st) {
    XcdBarrier b; b.bar = bar; b.x = xb_xcc_id(); b.st = st;
    if (threadIdx.x == 0) (void)xb_add(&bar[XB_XCNT(b.x)], 1u);
    return b;
}
__device__ __forceinline__ void xcd_barrier_complete(unsigned* bar, unsigned x, unsigned& nloc, unsigned& nx) {
    const unsigned G = gridDim.x * gridDim.y * gridDim.z;
    unsigned sum, cnt, mine, sp = 0u;
    for (;;) {
        sum = 0u; cnt = 0u; mine = 0u;
#pragma unroll
        for (unsigned j = 0; j < 16; ++j) { const unsigned c = xb_ld(&bar[XB_XCNT(j)]); sum += c; cnt += (c > 0u) ? 1u : 0u; mine = (j == x) ? c : mine; }
        if (sum == G) break;
        __builtin_amdgcn_s_sleep(1);
        if ((++sp & 255u) == 0u) { if (xb_ld(&bar[XB_TMO])) break; if (sp > XB_SPIN_CAP) { atomicAdd(&bar[XB_TMO], 1u); break; } }
    }
    nloc = mine > 0u ? mine : 1u; nx = cnt > 0u ? cnt : 1u;
}
__device__ __forceinline__ void xcd_barrier(const XcdBarrier& b) {
    asm volatile("s_waitcnt vmcnt(0)" ::: "memory");
    __syncthreads();
    if (threadIdx.x == 0) {
        unsigned* bar = b.bar;
        __builtin_amdgcn_s_waitcnt(0);
        unsigned nloc = b.st[0], nx = b.st[1];
        if (nloc == 0u) { xcd_barrier_complete(bar, b.x, nloc, nx); b.st[0] = nloc; b.st[1] = nx; }
        const unsigned old = xb_add(&bar[XB_XSUB(b.x)], 1u);
        const unsigned gen = old / nloc;
        if (old + 1u == (gen + 1u) * nloc) {
            __builtin_amdgcn_fence(__ATOMIC_RELEASE, "agent");
            asm volatile("s_waitcnt vmcnt(0)" ::: "memory");
            const unsigned og = xb_add(&bar[XB_TOP], 1u);
            const unsigned tg = og / nx;
            if (og + 1u == (tg + 1u) * nx) xb_add(&bar[XB_TOPGEN], 1u);
            else XB_SPIN(xb_ld(&bar[XB_TOPGEN]) == tg, bar);
            __builtin_amdgcn_fence(__ATOMIC_ACQUIRE, "agent");
            xb_add(&bar[XB_XGEN(b.x)], 1u);
            asm volatile("s_waitcnt vmcnt(0)" ::: "memory");
        } else {
            XB_SPIN(xb_ld(&bar[XB_XGEN(b.x)]) == gen, bar);
            __builtin_amdgcn_fence(__ATOMIC_ACQUIRE, "agent");
            asm volatile("s_waitcnt vmcnt(0)" ::: "memory");
        }
    }
    __syncthreads();
}

struct Frame {
    LAS unsigned char* lds; volatile LAS unsigned* MISC; gu32* ctl;
    int tid, lane, wave, vcu, G;
    const float *x, *norm1_g, *w_in, *b_in, *sinks, *attn_g, *lb_logits, *hgrn_g, *w_out, *b_out, *norm2_g, *router_w, *router_b, *w1, *b1, *w2, *b2, *final_g;
    float* out; unsigned char* ws;
};
#define WSP(type, off) ((type*)(F.ws + (off)))

typedef float f32x16 __attribute__((ext_vector_type(16)));
typedef __bf16 bf16x2_t __attribute__((ext_vector_type(2)));
__device__ __forceinline__ unsigned cvtpk(float lo, float hi) { f32x2 v = {lo, hi}; bf16x2_t b = __builtin_convertvector(v, bf16x2_t); return __builtin_bit_cast(unsigned, b); }
__device__ __forceinline__ int crow(int reg, int h) { return (reg & 3) + 8 * (reg >> 2) + 4 * h; }
__device__ __forceinline__ float bflo(unsigned u) { return __builtin_bit_cast(float, u << 16); }
__device__ __forceinline__ float bfhi(unsigned u) { return __builtin_bit_cast(float, u & 0xffff0000u); }
__device__ __forceinline__ bf16x8 pack_step(const f32x16& x, int s) {
    u32x4 p; p.x = cvtpk(x[8 * s], x[8 * s + 1]); p.y = cvtpk(x[8 * s + 2], x[8 * s + 3]); p.z = cvtpk(x[8 * s + 4], x[8 * s + 5]); p.w = cvtpk(x[8 * s + 6], x[8 * s + 7]);
    return __builtin_bit_cast(bf16x8, p);
}
#define MFMA32(a, b, c) __builtin_amdgcn_mfma_f32_32x32x16_bf16((a), (b), (c), 0, 0, 0)
#define MFMA16(a, b, c) __builtin_amdgcn_mfma_f32_16x16x32_bf16((a), (b), (c), 0, 0, 0)

__device__ __forceinline__ void p_hgrn_prep(Frame& F) {
    constexpr int GP = 132, QP = 136, VP = 72, AP = 72;
    LAS float* Gs = (LAS float*)F.lds;
    LAS bf16_t* Qs = (LAS bf16_t*)(F.lds + 33792);
    LAS bf16_t* Ks = (LAS bf16_t*)(F.lds + 33792 + 17408);
    LAS bf16_t* Vt = (LAS bf16_t*)(F.lds + 33792 + 2 * 17408);
    LAS bf16_t* At = (LAS bf16_t*)(F.lds + 33792 + 2 * 17408 + 18432);
    LAS float* Tot = (LAS float*)(F.lds + 96256);
    LAS float* Bl = Tot + 8 * 128;
    const bf16_t* HQ = WSP(bf16_t, WS_HQ); const float* G = WSP(float, WS_G); const bf16_t* KK = WSP(bf16_t, WS_KK); const bf16_t* HI = WSP(bf16_t, WS_HI);
    bf16_t* QF = WSP(bf16_t, WS_QF); bf16_t* KF = WSP(bf16_t, WS_KF); bf16_t* VF = WSP(bf16_t, WS_VF); bf16_t* INTRA = WSP(bf16_t, WS_INTRA); float* DEC = WSP(float, WS_DEC);
    const int tid = F.tid, lane = F.lane, w = F.wave, r = lane & 31, h = lane >> 5, fr = lane & 15, fq = lane >> 4;
    for (int ch = blockIdx.x; ch < BATCH * 4 * 32; ch += F.G) {
        const int bh = ch >> 5, c = ch & 31, b = bh >> 2, hd = bh & 3;
        const size_t t0 = (size_t)b * SEQ + 64 * c; const int col0 = hd * 128;
#pragma unroll
        for (int i = 0; i < 4; ++i) { const int idx = tid + 512 * i, row = idx >> 5, c4 = idx & 31; *(LAS f32x4*)(Gs + row * GP + 4 * c4) = *(const f32x4*)(G + (t0 + row) * HKW + col0 + 4 * c4); }
#pragma unroll
        for (int i = 0; i < 2; ++i) { const int idx = tid + 512 * i, row = idx >> 4, c8 = idx & 15; const size_t go = (t0 + row) * HKW + col0 + 8 * c8;
            *(LAS u32x4*)(Qs + row * QP + 8 * c8) = *(const u32x4*)(HQ + go); *(LAS u32x4*)(Ks + row * QP + 8 * c8) = *(const u32x4*)(KK + go);
            const u32x4 vv = *(const u32x4*)(HI + go);
#pragma unroll
            for (int q = 0; q < 4; ++q) { Vt[(8 * c8 + 2 * q) * VP + row] = (bf16_t)(vv[q] & 0xffffu); Vt[(8 * c8 + 2 * q + 1) * VP + row] = (bf16_t)(vv[q] >> 16); } }
        for (int i = tid; i < 64 * AP / 8; i += 512) *(LAS u32x4*)(At + 8 * i) = (u32x4){0u, 0u, 0u, 0u};
        __syncthreads();
#pragma unroll
        for (int q = 0; q < 2; ++q) { const int kk = lane + 64 * q; float run = 0.f;
#pragma unroll
            for (int i = 0; i < 8; ++i) { run += Gs[(8 * w + i) * GP + kk]; Gs[(8 * w + i) * GP + kk] = run; }
            Tot[w * 128 + kk] = run; }
        __syncthreads();
#pragma unroll
        for (int q = 0; q < 2; ++q) { const int kk = lane + 64 * q; float off = 0.f, tot = 0.f;
#pragma unroll
            for (int i = 0; i < 8; ++i) { const float tv = Tot[i * 128 + kk]; tot += tv; if (i < w) off += tv; }
#pragma unroll
            for (int i = 0; i < 8; ++i) Gs[(8 * w + i) * GP + kk] += off;
            if (w == 0) Bl[kk] = tot; }
        __syncthreads();
#pragma unroll
        for (int q = 0; q < 2; ++q) {
            const int f = w + 8 * q;
            {
                const int tt = f >> 3, kt = (f >> 1) & 3, ks = f & 1, t = 32 * tt + r, kb = 32 * kt + 16 * ks + 4 * h;
                const u32x2 qa = *(const LAS u32x2*)(Qs + t * QP + kb), qb = *(const LAS u32x2*)(Qs + t * QP + kb + 8);
                const f32x4 ba = *(const LAS f32x4*)(Gs + t * GP + kb), bb = *(const LAS f32x4*)(Gs + t * GP + kb + 8);
                u32x4 o; o.x = cvtpk(bflo(qa.x) * __expf(ba[0]), bfhi(qa.x) * __expf(ba[1])); o.y = cvtpk(bflo(qa.y) * __expf(ba[2]), bfhi(qa.y) * __expf(ba[3]));
                o.z = cvtpk(bflo(qb.x) * __expf(bb[0]), bfhi(qb.x) * __expf(bb[1])); o.w = cvtpk(bflo(qb.y) * __expf(bb[2]), bfhi(qb.y) * __expf(bb[3]));
                *(u32x4*)(QF + (((size_t)ch * 16 + f) * 64 + lane) * 8) = o;
            }
            {
                const int kt = f >> 2, ss = f & 3, kc = 32 * kt + r, s0 = 16 * ss + 8 * h; const float bl = Bl[kc];
                float v[8];
#pragma unroll
                for (int j = 0; j < 8; ++j) v[j] = bf2f(Ks[(s0 + j) * QP + kc]) * __expf(bl - Gs[(s0 + j) * GP + kc]);
                u32x4 o; o.x = cvtpk(v[0], v[1]); o.y = cvtpk(v[2], v[3]); o.z = cvtpk(v[4], v[5]); o.w = cvtpk(v[6], v[7]);
                *(u32x4*)(KF + (((size_t)ch * 16 + f) * 64 + lane) * 8) = o;
            }
            {
                const int ss = f >> 2, dt = f & 3;
                *(u32x4*)(VF + (((size_t)ch * 16 + f) * 64 + lane) * 8) = *(const LAS u32x4*)(Vt + (32 * dt + r) * VP + 16 * ss + 8 * h);
            }
        }
        if (tid < 128) DEC[(size_t)ch * 128 + tid] = __expf(Bl[tid]);
        {
            const int i = w >> 1;
            for (int j = w & 1; j <= i; j += 2) {
                f32x4 acc = {0.f, 0.f, 0.f, 0.f};
                const int t = 16 * i + fr, s = 16 * j + fr;
#pragma unroll
                for (int k4 = 0; k4 < 4; ++k4) {
                    const int k0 = 32 * k4 + 8 * fq;
                    f32x4 r0 = {0.f, 0.f, 0.f, 0.f}, r1 = {0.f, 0.f, 0.f, 0.f};
                    if (i > 0) { r0 = *(const LAS f32x4*)(Gs + (16 * i - 1) * GP + k0); r1 = *(const LAS f32x4*)(Gs + (16 * i - 1) * GP + k0 + 4); }
                    const u32x4 q8 = *(const LAS u32x4*)(Qs + t * QP + k0), k8 = *(const LAS u32x4*)(Ks + s * QP + k0);
                    const f32x4 bt0 = *(const LAS f32x4*)(Gs + t * GP + k0), bt1 = *(const LAS f32x4*)(Gs + t * GP + k0 + 4);
                    const f32x4 bs0 = *(const LAS f32x4*)(Gs + s * GP + k0), bs1 = *(const LAS f32x4*)(Gs + s * GP + k0 + 4);
                    u32x4 a, bb;
                    a.x = cvtpk(bflo(q8.x) * __expf(bt0[0] - r0[0]), bfhi(q8.x) * __expf(bt0[1] - r0[1])); a.y = cvtpk(bflo(q8.y) * __expf(bt0[2] - r0[2]), bfhi(q8.y) * __expf(bt0[3] - r0[3]));
                    a.z = cvtpk(bflo(q8.z) * __expf(bt1[0] - r1[0]), bfhi(q8.z) * __expf(bt1[1] - r1[1])); a.w = cvtpk(bflo(q8.w) * __expf(bt1[2] - r1[2]), bfhi(q8.w) * __expf(bt1[3] - r1[3]));
                    bb.x = cvtpk(bflo(k8.x) * __expf(r0[0] - bs0[0]), bfhi(k8.x) * __expf(r0[1] - bs0[1])); bb.y = cvtpk(bflo(k8.y) * __expf(r0[2] - bs0[2]), bfhi(k8.y) * __expf(r0[3] - bs0[3]));
                    bb.z = cvtpk(bflo(k8.z) * __expf(r1[0] - bs1[0]), bfhi(k8.z) * __expf(r1[1] - bs1[1])); bb.w = cvtpk(bflo(k8.w) * __expf(r1[2] - bs1[2]), bfhi(k8.w) * __expf(r1[3] - bs1[3]));
                    acc = MFMA16(__builtin_bit_cast(bf16x8, a), __builtin_bit_cast(bf16x8, bb), acc);
                }
#pragma unroll
                for (int q = 0; q < 4; ++q) { const float v = (j < i || (4 * fq + q) >= fr) ? acc[q] : 0.f; At[(16 * i + 4 * fq + q) * AP + 16 * j + fr] = f2bf(v); }
            }
        }
        __syncthreads();
        {
            const int tt = w & 1, dt = w >> 1;
            f32x16 acc;
#pragma unroll
            for (int q = 0; q < 16; ++q) acc[q] = 0.f;
#pragma unroll
            for (int ss = 0; ss < 4; ++ss) if (ss < 2 * (tt + 1)) {
                const bf16x8 a = *(const LAS bf16x8*)(At + (32 * tt + r) * AP + 16 * ss + 8 * h), bv = *(const LAS bf16x8*)(Vt + (32 * dt + r) * VP + 16 * ss + 8 * h);
                acc = MFMA32(a, bv, acc);
            }
#pragma unroll
            for (int q = 0; q < 16; ++q) INTRA[(t0 + 32 * tt + crow(q, h)) * HW + col0 + 32 * dt + r] = f2bf(acc[q]);
        }
        __syncthreads();
    }
}

constexpr int SC_OPB = 0, SC_OBUF = 65536, SC_OBP = 132, SC_OBB = 64 * SC_OBP * 4, SC_DEC = SC_OBUF + 2 * SC_OBB;
__device__ __forceinline__ void scan_unit(Frame& F, int bh) {
    const bf16_t* QF = WSP(bf16_t, WS_QF); const bf16_t* KF = WSP(bf16_t, WS_KF); const bf16_t* VF = WSP(bf16_t, WS_VF); const bf16_t* INTRA = WSP(bf16_t, WS_INTRA); const float* DEC = WSP(float, WS_DEC);
    const bf16_t* HG = WSP(bf16_t, WS_HG); bf16_t* MIX = WSP(bf16_t, WS_MIX);
    const int tid = F.tid, lane = F.lane, w = F.wave, r = lane & 31, h = lane >> 5, tt = w & 1, d = w >> 1, b = bh >> 2, hd = bh & 3;
    LAS unsigned char* lds = F.lds;
    f32x16 S[4];
#pragma unroll
    for (int kt = 0; kt < 4; ++kt)
#pragma unroll
        for (int q = 0; q < 16; ++q) S[kt][q] = 0.f;
#define SC_DMA(c_) do { const size_t chn = (size_t)bh * 32 + (c_); const int slot = ((c_) & 1) * 32768; _Pragma("unroll") for (int i_ = 0; i_ < 2; ++i_) { \
        __builtin_amdgcn_global_load_lds((const unsigned*)(QF + ((chn * 16 + 2 * w + i_) * 64 + lane) * 8), (LAS unsigned*)(lds + SC_OPB + slot + (2 * w + i_) * 1024), 16, 0, 0); \
        __builtin_amdgcn_global_load_lds((const unsigned*)(KF + ((chn * 16 + 2 * w + i_) * 64 + lane) * 8), (LAS unsigned*)(lds + SC_OPB + slot + 16384 + (2 * w + i_) * 1024), 16, 0, 0); } \
        } while (0)
#define SC_DEC_LD(c_) (*(const f32x4*)(DEC + ((size_t)bh * 32 + (c_)) * 128 + (tid & 31) * 4))
#define SC_DEC_ST(c_, v_) do { if (tid < 32) *(LAS f32x4*)(lds + SC_DEC + ((c_) & 1) * 512 + tid * 16) = (v_); } while (0)
    bf16x8 Vf[4], Vn[4];
#pragma unroll
    for (int ss = 0; ss < 4; ++ss) Vf[ss] = *(const bf16x8*)(VF + ((((size_t)bh * 32) * 16 + ss * 4 + d) * 64 + lane) * 8);
    SC_DMA(0);
    { const f32x4 dv0 = SC_DEC_LD(0); SC_DEC_ST(0, dv0); }
    __syncthreads();
    const int ft = tid >> 3, fs = tid & 7;
    const int ocol = hd * 128 + 16 * fs;
    for (int c = 0; c < 32; ++c) {
        const int slot = (c & 1) * 32768;
        f32x4 dnext = {0.f, 0.f, 0.f, 0.f};
        if (c + 1 < 32) {
            SC_DMA(c + 1);
            dnext = SC_DEC_LD(c + 1);
#pragma unroll
            for (int ss = 0; ss < 4; ++ss) Vn[ss] = *(const bf16x8*)(VF + ((((size_t)bh * 32 + c + 1) * 16 + ss * 4 + d) * 64 + lane) * 8);
        }
        const size_t trow = (size_t)b * SEQ + 64 * c + ft;
        const u32x4 in0 = *(const u32x4*)(INTRA + trow * HW + ocol), in1 = *(const u32x4*)(INTRA + trow * HW + ocol + 8);
        const u32x4 hg0 = *(const u32x4*)(HG + trow * HW + ocol), hg1 = *(const u32x4*)(HG + trow * HW + ocol + 8);
        f32x16 P;
#pragma unroll
        for (int q = 0; q < 16; ++q) P[q] = 0.f;
#pragma unroll
        for (int kt = 0; kt < 4; ++kt)
#pragma unroll
            for (int ks = 0; ks < 2; ++ks) {
                const bf16x8 qf = *(const LAS bf16x8*)(lds + SC_OPB + slot + ((tt * 4 + kt) * 2 + ks) * 1024 + lane * 16);
                P = MFMA32(qf, pack_step(S[kt], ks), P);
            }
        {   LAS float* ob = (LAS float*)(lds + SC_OBUF + (c & 1) * SC_OBB);
#pragma unroll
            for (int q = 0; q < 16; ++q) ob[(32 * tt + crow(q, h)) * SC_OBP + 32 * d + r] = P[q]; }
#pragma unroll
        for (int kt = 0; kt < 4; ++kt) {
#pragma unroll
            for (int g = 0; g < 4; ++g) { const f32x4 dc = *(const LAS f32x4*)(lds + SC_DEC + (c & 1) * 512 + (32 * kt + 8 * g + 4 * h) * 4);
#pragma unroll
                for (int q = 0; q < 4; ++q) S[kt][4 * g + q] *= dc[q]; }
#pragma unroll
            for (int ss = 0; ss < 4; ++ss) {
                const bf16x8 kf = *(const LAS bf16x8*)(lds + SC_OPB + slot + 16384 + (kt * 4 + ss) * 1024 + lane * 16);
                S[kt] = MFMA32(kf, Vf[ss], S[kt]);
            }
        }
        SC_DEC_ST(c + 1, dnext);
        __syncthreads();
        {
            const LAS float* ob = (const LAS float*)(lds + SC_OBUF + (c & 1) * SC_OBB) + ft * SC_OBP + 16 * fs;
            const f32x4 p0 = *(const LAS f32x4*)ob, p1 = *(const LAS f32x4*)(ob + 4), p2 = *(const LAS f32x4*)(ob + 8), p3 = *(const LAS f32x4*)(ob + 12);
            float o[16];
            o[0] = p0[0] + bflo(in0.x); o[1] = p0[1] + bfhi(in0.x); o[2] = p0[2] + bflo(in0.y); o[3] = p0[3] + bfhi(in0.y);
            o[4] = p1[0] + bflo(in0.z); o[5] = p1[1] + bfhi(in0.z); o[6] = p1[2] + bflo(in0.w); o[7] = p1[3] + bfhi(in0.w);
            o[8] = p2[0] + bflo(in1.x); o[9] = p2[1] + bfhi(in1.x); o[10] = p2[2] + bflo(in1.y); o[11] = p2[3] + bfhi(in1.y);
            o[12] = p3[0] + bflo(in1.z); o[13] = p3[1] + bfhi(in1.z); o[14] = p3[2] + bflo(in1.w); o[15] = p3[3] + bfhi(in1.w);
            float ss2 = 0.f;
#pragma unroll
            for (int q = 0; q < 16; ++q) ss2 += o[q] * o[q];
            ss2 += __shfl_xor(ss2, 1); ss2 += __shfl_xor(ss2, 2); ss2 += __shfl_xor(ss2, 4);
            const float rs = rsqrtf(ss2 * (1.f / 128.f) + EPS);
            const float* gh = F.hgrn_g + ocol;
            const unsigned hgw[8] = {hg0.x, hg0.y, hg0.z, hg0.w, hg1.x, hg1.y, hg1.z, hg1.w};
            unsigned ow[8];
#pragma unroll
            for (int q = 0; q < 8; ++q) ow[q] = cvtpk(o[2 * q] * rs * gh[2 * q] * bflo(hgw[q]), o[2 * q + 1] * rs * gh[2 * q + 1] * bfhi(hgw[q]));
            bf16_t* mo = MIX + trow * MIXW + AW + ocol;
            *(u32x4*)mo = (u32x4){ow[0], ow[1], ow[2], ow[3]}; *(u32x4*)(mo + 8) = (u32x4){ow[4], ow[5], ow[6], ow[7]};
        }
#pragma unroll
        for (int ss = 0; ss < 4; ++ss) Vf[ss] = Vn[ss];
    }
    __syncthreads();
#undef SC_DMA
#undef SC_DEC_LD
#undef SC_DEC_ST
}

constexpr int AT_KP = 72, AT_VP = 260;
__device__ __forceinline__ void attn_stage(Frame& F, int kvh, int n, size_t t0, LAS bf16_t* Ks, LAS bf16_t* Vt) {
    const bf16_t* AK = WSP(bf16_t, WS_AK); const bf16_t* AV = WSP(bf16_t, WS_AV);
    __syncthreads();
    int tid_ = F.tid; asm volatile("" : "+v"(tid_));
#pragma unroll
    for (int i = 0; i < 4; ++i) {
        const int idx = tid_ + 512 * i, row = idx >> 3, c8 = idx & 7;
        u32x4 kv = {0u, 0u, 0u, 0u}, vv = {0u, 0u, 0u, 0u};
        if (n > 0 || row >= 128) { const size_t go = (t0 - 128 + row) * AKW + kvh * 64 + 8 * c8; kv = *(const u32x4*)(AK + go); vv = *(const u32x4*)(AV + go); }
        *(LAS u32x4*)(Ks + row * AT_KP + 8 * c8) = kv;
#pragma unroll
        for (int q = 0; q < 4; ++q) { Vt[(8 * c8 + 2 * q) * AT_VP + row] = (bf16_t)(vv[q] & 0xffffu); Vt[(8 * c8 + 2 * q + 1) * AT_VP + row] = (bf16_t)(vv[q] >> 16); }
    }
    __syncthreads();
}
__device__ __forceinline__ void attn_item(Frame& F, int hq, int rt, int n, size_t t0, const LAS bf16_t* Ks, const LAS bf16_t* Vt, LAS float* ssq, unsigned (&okp)[16]) {
    const bf16_t* AQ = WSP(bf16_t, WS_AQ);
    int lane = F.lane; asm volatile("" : "+v"(lane));
    const int r = lane & 31, h = lane >> 5;
    constexpr float L2E = 1.4426950408889634f;
    const float slope2 = exp2f(-(float)(hq + 1)) * L2E, sink2 = F.sinks[hq] * L2E;
    bf16x8 qf[4];
#pragma unroll
    for (int ds = 0; ds < 4; ++ds) qf[ds] = *(const bf16x8*)(AQ + (t0 + 32 * rt + r) * AW + hq * 64 + 16 * ds + 8 * h);
    float m = sink2;
#define AT_SCORE(SC, j) do { const int kt = rt + (j); int rq = r - 32 * (j); asm volatile("" : "+v"(rq));     \
        _Pragma("unroll") for (int q = 0; q < 16; ++q) SC[q] = 0.f; \
        _Pragma("unroll") for (int ds = 0; ds < 4; ++ds) SC = MFMA32(*(const LAS bf16x8*)(Ks + (32 * kt + r) * AT_KP + 16 * ds + 8 * h), qf[ds], SC); \
        const bool tile_ok = (n > 0) || (kt >= 4); \
        _Pragma("unroll") for (int q = 0; q < 16; ++q) { const int dist = 128 + rq - crow(q, h); const float v = SC[q] * (0.125f * L2E) - slope2 * (float)dist; \
            SC[q] = (tile_ok && dist >= 0 && dist < 128) ? v : -INFINITY; } } while (0)
#pragma unroll
    for (int j = 0; j < 5; ++j) { f32x16 sc; AT_SCORE(sc, j);
#pragma unroll
        for (int q = 0; q < 16; ++q) m = fmaxf(m, sc[q]); }
    m = fmaxf(m, __shfl_xor(m, 32));
    float l = 0.f; unsigned pp[5][8];
#pragma unroll
    for (int j = 0; j < 5; ++j) { f32x16 sc; AT_SCORE(sc, j);
#pragma unroll
        for (int q = 0; q < 16; ++q) { sc[q] = exp2f(sc[q] - m); l += sc[q]; }
#pragma unroll
        for (int q = 0; q < 8; ++q) pp[j][q] = cvtpk(sc[2 * q], sc[2 * q + 1]); }
#undef AT_SCORE
    l += __shfl_xor(l, 32); l += exp2f(sink2 - m);
    const float rl = 1.f / l;
    float sq = 0.f;
#pragma unroll
    for (int dt = 0; dt < 2; ++dt) {
        f32x16 o;
#pragma unroll
        for (int q = 0; q < 16; ++q) o[q] = 0.f;
        const LAS bf16_t* vrow = Vt + (32 * dt + r) * AT_VP + 4 * h;
#pragma unroll
        for (int j = 0; j < 5; ++j)
#pragma unroll
            for (int s = 0; s < 2; ++s) { const LAS bf16_t* vp = vrow + 32 * (rt + j) + 16 * s;
                const u32x2 va = *(const LAS u32x2*)vp, vb = *(const LAS u32x2*)(vp + 8); const u32x4 pa = {va.x, va.y, vb.x, vb.y};
                const u32x4 pb = {pp[j][4 * s], pp[j][4 * s + 1], pp[j][4 * s + 2], pp[j][4 * s + 3]};
                o = MFMA32(__builtin_bit_cast(bf16x8, pa), __builtin_bit_cast(bf16x8, pb), o); }
#pragma unroll
        for (int q = 0; q < 16; ++q) { o[q] *= rl; sq += o[q] * o[q]; }
#pragma unroll
        for (int q = 0; q < 8; ++q) okp[dt * 8 + q] = cvtpk(o[2 * q], o[2 * q + 1]);
    }
    sq += __shfl_xor(sq, 32);
    if (h == 0) __hip_atomic_fetch_add(&ssq[32 * rt + r], sq, __ATOMIC_RELAXED, __HIP_MEMORY_SCOPE_WORKGROUP);
}
__device__ __forceinline__ void attn_store(Frame& F, int hq, int rt, size_t t0, const LAS float* ssq, const unsigned (&okp)[16]) {
    bf16_t* MIX = WSP(bf16_t, WS_MIX);
    int lane = F.lane; asm volatile("" : "+v"(lane));
    const int r = lane & 31, h = lane >> 5;
    const float rs = rsqrtf(ssq[32 * rt + r] * (1.f / AW) + EPS);
    bf16_t* mo = MIX + (t0 + 32 * rt + r) * MIXW + hq * 64;
#pragma unroll
    for (int dt = 0; dt < 2; ++dt)
#pragma unroll
        for (int g4 = 0; g4 < 4; ++g4) {
            const int d0 = 32 * dt + 8 * g4 + 4 * h; const f32x4 ga = *(const f32x4*)(F.attn_g + hq * 64 + d0);
            const unsigned p0 = okp[dt * 8 + 2 * g4], p1 = okp[dt * 8 + 2 * g4 + 1];
            u32x2 ow; ow.x = cvtpk(bflo(p0) * rs * ga[0], bfhi(p0) * rs * ga[1]); ow.y = cvtpk(bflo(p1) * rs * ga[2], bfhi(p1) * rs * ga[3]);
            *(u32x2*)(mo + d0) = ow;
        }
}
__device__ __forceinline__ void attn_unit(Frame& F, int u) {
    LAS bf16_t* Ks = (LAS bf16_t*)F.lds;
    LAS bf16_t* Vt = (LAS bf16_t*)(F.lds + 36864);
    LAS float* ssq = (LAS float*)(F.lds + 36864 + 33280);
    const int w = F.wave, b = u >> 4, n = u & 15; const size_t t0 = (size_t)b * SEQ + 128 * n;
    if (F.tid < 128) ssq[F.tid] = 0.f;
    const int g0 = (2 * w) >> 2, rt0 = (2 * w) & 3, g1 = (2 * w + 1) >> 2, rt1 = (2 * w + 1) & 3;
    unsigned ok0[16], ok1[16], ok2[16], ok3[16];
    attn_stage(F, 0, n, t0, Ks, Vt);
    attn_item(F, g0, rt0, n, t0, Ks, Vt, ssq, ok0);
    attn_item(F, g1, rt1, n, t0, Ks, Vt, ssq, ok1);
    attn_stage(F, 1, n, t0, Ks, Vt);
    attn_item(F, 4 + g0, rt0, n, t0, Ks, Vt, ssq, ok2);
    attn_item(F, 4 + g1, rt1, n, t0, Ks, Vt, ssq, ok3);
    __syncthreads();
    attn_store(F, g0, rt0, t0, ssq, ok0); attn_store(F, g1, rt1, t0, ssq, ok1); attn_store(F, 4 + g0, rt0, t0, ssq, ok2); attn_store(F, 4 + g1, rt1, t0, ssq, ok3);
    __syncthreads();
}
__device__ __forceinline__ void p_convert_experts(Frame& F, int rank, int nrank);
__device__ __forceinline__ void p_scan_attn(Frame& F, bool do_scan, bool do_attn) {
    const int G = F.G, bx = blockIdx.x, nscan = (do_scan && do_attn && G >= 64) ? 32 : 0;
    if (do_scan) { if (nscan) { if (bx < nscan) scan_unit(F, bx); } else for (int u = bx; u < BATCH * 4; u += G) scan_unit(F, u); }
    if (do_attn) { if (nscan) { for (int u = bx - nscan; u >= 0 && u < BATCH * 16; u += G - nscan) attn_unit(F, u); } else for (int u = bx; u < BATCH * 16; u += G) attn_unit(F, u); }
    if (nscan) { if (bx >= nscan) p_convert_experts(F, bx - nscan, G - nscan); } else p_convert_experts(F, bx, G);
}

__device__ __forceinline__ int w1col(int n) { const int pn = n >> 8, cl = n & 255; return cl < 128 ? 2 * (128 * pn + cl) : 2 * (128 * pn + cl - 128) + 1; }
template <bool W1MAP, bool FP8>
__device__ __forceinline__ void p0_transpose_item(const float* W, int K, int N, void* WTv, LAS float* scr, int item, int lane) {
    const int nblk = N / 32, kb = item / nblk, nb = item % nblk, k0 = 64 * kb, n0 = 32 * nb;
    const int sc = W1MAP ? w1col(n0 + (lane & 31)) : n0 + (lane & 31);
#pragma unroll 8
    for (int i = 0; i < 32; ++i) { const int kk = 2 * i + (lane >> 5); scr[kk * 33 + (lane & 31)] = W[(size_t)(k0 + kk) * N + sc]; }
    LDS_WAIT(); asm volatile("" ::: "memory");
    const int c = lane & 7;
#pragma unroll
    for (int j = 0; j < 4; ++j) { const int n = (lane >> 3) + 8 * j; const LAS float* s = scr + (8 * c) * 33 + n;
        if constexpr (FP8) { const f32x4 a = {s[0 * 33], s[1 * 33], s[2 * 33], s[3 * 33]}, b = {s[4 * 33], s[5 * 33], s[6 * 33], s[7 * 33]};
            *(GAS u32x2*)((unsigned char*)WTv + (size_t)(n0 + n) * K + k0 + 8 * c) = pg8::pack8_fp8(a * pg8::FP8_W_SCALE, b * pg8::FP8_W_SCALE); }
        else { u32x4 o; o.x = pg8::cvt_pk_bf16(s[0 * 33], s[1 * 33]); o.y = pg8::cvt_pk_bf16(s[2 * 33], s[3 * 33]); o.z = pg8::cvt_pk_bf16(s[4 * 33], s[5 * 33]); o.w = pg8::cvt_pk_bf16(s[6 * 33], s[7 * 33]);
            *(GAS u32x4*)((bf16_t*)WTv + (size_t)(n0 + n) * K + k0 + 8 * c) = o; } }
    LDS_WAIT(); asm volatile("" ::: "memory");
}
__device__ __forceinline__ void p_convert_experts(Frame& F, int rank, int nrank) {
    LAS float* scr = (LAS float*)(F.lds + RING_OFF + F.wave * 16384);
    constexpr int I_W1E = (DM / 64) * (2 * FF / 32), I_W2E = (FF / 64) * (DM / 32), NITEMS = NE * I_W1E + NE * I_W2E;
    unsigned char *W1T = WSP(unsigned char, WS_W1T), *W2T = WSP(unsigned char, WS_W2T);
    __syncthreads();
    for (int it = rank * NWAVES + F.wave; it < NITEMS; it += nrank * NWAVES) {
        int r = it;
        if (r < NE * I_W1E) { const int e = r / I_W1E; p0_transpose_item<true, true>(F.w1 + (size_t)e * DM * 2 * FF, DM, 2 * FF, W1T + (size_t)e * 2 * FF * DM, scr, r % I_W1E, F.lane); continue; } r -= NE * I_W1E;
        { const int e = r / I_W2E; p0_transpose_item<false, true>(F.w2 + (size_t)e * FF * DM, FF, DM, W2T + (size_t)e * DM * FF, scr, r % I_W2E, F.lane); }
    }
}
__device__ __forceinline__ void p_prologue(Frame& F) {
    LAS float* scr = (LAS float*)(F.lds + RING_OFF + F.wave * 16384);
    const int gw = F.vcu * NWAVES + F.wave, NGW = F.G * NWAVES;
    constexpr int I_IN = (DM / 64) * (INW / 32), I_OUT = (MIXW / 64) * (DM / 32), I_W1E = (DM / 64) * (2 * FF / 32), I_W2E = (FF / 64) * (DM / 32);
    constexpr int NITEMS = I_IN + I_OUT;
    bf16_t *WinT = WSP(bf16_t, WS_WINT), *WoutT = WSP(bf16_t, WS_WOUTT);
    for (int it = gw; it < NITEMS; it += NGW) {
        int r = it;
        if (r < I_IN) { p0_transpose_item<false, false>(F.w_in, DM, INW, WinT, scr, r, F.lane); continue; } r -= I_IN;
        p0_transpose_item<false, false>(F.w_out, MIXW, DM, WoutT, scr, r, F.lane);
    }
    bf16_t* XN = WSP(bf16_t, WS_XN);
    for (int m = gw; m < T; m += NGW) {
        const GAS f32x4* xr = (const GAS f32x4*)(F.x + (size_t)m * DM) + F.lane;
        f32x4 v[4]; float s = 0.f;
#pragma unroll
        for (int j = 0; j < 4; ++j) { v[j] = xr[64 * j]; s += (v[j].x * v[j].x + v[j].y * v[j].y) + (v[j].z * v[j].z + v[j].w * v[j].w); }
        const float r = rsqrtf(wave_sum(s) * (1.f / DM) + EPS);
        GAS u32x2* o8 = (GAS u32x2*)(XN + (size_t)m * DM) + F.lane;
#pragma unroll
        for (int j = 0; j < 4; ++j) { const f32x4 g = *((const f32x4*)F.norm1_g + F.lane + 64 * j); u32x2 w; w.x = pg8::cvt_pk_bf16(v[j].x * r * g.x, v[j].y * r * g.y); w.y = pg8::cvt_pk_bf16(v[j].z * r * g.z, v[j].w * r * g.w); o8[64 * j] = w; }
    }
    if ((int)blockIdx.x == (F.G > 1 ? 1 : 0)) {
        bf16_t* RWF = WSP(bf16_t, WS_RWF);
        for (int i = F.tid; i < 64 * 64; i += NWAVES * 64) { const int ks = i >> 6, ln = i & 63, rr = ln & 31, hh = ln >> 5; float v[8];
#pragma unroll
            for (int j = 0; j < 8; ++j) v[j] = F.router_w[(size_t)(16 * ks + 8 * hh + j) * NE + rr];
            u32x4 hi, lo; hi.x = cvtpk(v[0], v[1]); hi.y = cvtpk(v[2], v[3]); hi.z = cvtpk(v[4], v[5]); hi.w = cvtpk(v[6], v[7]);
            lo.x = cvtpk(v[0] - bflo(hi.x), v[1] - bfhi(hi.x)); lo.y = cvtpk(v[2] - bflo(hi.y), v[3] - bfhi(hi.y)); lo.z = cvtpk(v[4] - bflo(hi.z), v[5] - bfhi(hi.z)); lo.w = cvtpk(v[6] - bflo(hi.w), v[7] - bfhi(hi.w));
            *(u32x4*)(RWF + ((size_t)(ks * 2 + 0) * 64 + ln) * 8) = hi; *(u32x4*)(RWF + ((size_t)(ks * 2 + 1) * 64 + ln) * 8) = lo; }
    }
    if (blockIdx.x == 0) { float* LB = WSP(float, WS_LB); for (int c = F.tid; c < HKW; c += NWAVES * 64) { const float a = F.lb_logits[c], b = F.lb_logits[HKW + c]; LB[c] = 1.f / (1.f + __expf(b - a)); } }
}

__device__ __forceinline__ void p_router(Frame& F) {
    LAS int* lcnt = (LAS int*)(F.lds + MOE_OFF + 512); LAS int* lbase = (LAS int*)(F.lds + MOE_OFF + 768);
    LAS float* part = (LAS float*)F.lds;
    LAS float* ssqp = (LAS float*)(F.lds + 32768);
    const float* X1 = WSP(float, WS_X1); unsigned char* H2 = WSP(unsigned char, WS_H2); float* GATE = WSP(float, WS_GATE); int* LIST = WSP(int, WS_LIST); float* RSTD = WSP(float, WS_RSTD);
    const bf16_t* RWF = WSP(bf16_t, WS_RWF);
    int* cnt = (int*)(F.ctl + CW_CNT);
    const int lane = F.lane, w = F.wave, r = lane & 31, h = lane >> 5, tile = w & 1, kq = w >> 1;
    for (int tb = blockIdx.x; tb < T / 64; tb += F.G) {
        if (F.tid < NE) lcnt[F.tid] = 0;
        const int t = tb * 64 + tile * 32 + r;
        f32x16 acc;
#pragma unroll
        for (int q = 0; q < 16; ++q) acc[q] = 0.f;
        float ssq = 0.f;
#pragma unroll 4
        for (int ks = 16 * kq; ks < 16 * kq + 16; ++ks) {
            const int k0 = 16 * ks + 8 * h;
            const f32x4 x0 = *(const f32x4*)(X1 + (size_t)t * DM + k0), x1v = *(const f32x4*)(X1 + (size_t)t * DM + k0 + 4);
            const f32x4 g0 = *(const f32x4*)(F.norm2_g + k0), g1 = *(const f32x4*)(F.norm2_g + k0 + 4);
            const u32x4 ahi = *(const u32x4*)(RWF + ((size_t)(ks * 2 + 0) * 64 + lane) * 8), alo = *(const u32x4*)(RWF + ((size_t)(ks * 2 + 1) * 64 + lane) * 8);
            float u[8];
#pragma unroll
            for (int q = 0; q < 4; ++q) { u[q] = x0[q] * g0[q]; u[4 + q] = x1v[q] * g1[q]; ssq += x0[q] * x0[q]; ssq += x1v[q] * x1v[q]; }
            u32x4 bh, bl;
            bh.x = cvtpk(u[0], u[1]); bh.y = cvtpk(u[2], u[3]); bh.z = cvtpk(u[4], u[5]); bh.w = cvtpk(u[6], u[7]);
            bl.x = cvtpk(u[0] - bflo(bh.x), u[1] - bfhi(bh.x)); bl.y = cvtpk(u[2] - bflo(bh.y), u[3] - bfhi(bh.y));
            bl.z = cvtpk(u[4] - bflo(bh.z), u[5] - bfhi(bh.z)); bl.w = cvtpk(u[6] - bflo(bh.w), u[7] - bfhi(bh.w));
            *(u32x2*)(H2 + (size_t)t * DM + k0) = pg8::pack8_fp8((f32x4){u[0], u[1], u[2], u[3]} * pg8::FP8_ACT_SCALE, (f32x4){u[4], u[5], u[6], u[7]} * pg8::FP8_ACT_SCALE);
            acc = MFMA32(__builtin_bit_cast(bf16x8, ahi), __builtin_bit_cast(bf16x8, bh), acc);
            acc = MFMA32(__builtin_bit_cast(bf16x8, alo), __builtin_bit_cast(bf16x8, bh), acc);
            acc = MFMA32(__builtin_bit_cast(bf16x8, ahi), __builtin_bit_cast(bf16x8, bl), acc);
        }
#pragma unroll
        for (int q = 0; q < 4; ++q) *(LAS f32x4*)(part + (w * 64 + lane) * 16 + 4 * q) = (f32x4){acc[4 * q], acc[4 * q + 1], acc[4 * q + 2], acc[4 * q + 3]};
        ssqp[w * 64 + lane] = ssq;
        __syncthreads();
        int my_e[TOPK], my_p[TOPK];
#pragma unroll
        for (int k = 0; k < TOPK; ++k) { my_e[k] = 0; my_p[k] = 0; }
        if (w < 2) {
            float lg[16];
#pragma unroll
            for (int q = 0; q < 16; ++q) lg[q] = 0.f;
            float s2 = 0.f;
#pragma unroll
            for (int k4 = 0; k4 < 4; ++k4) { const int ww = k4 * 2 + tile;
#pragma unroll
                for (int q = 0; q < 4; ++q) { const f32x4 p = *(const LAS f32x4*)(part + (ww * 64 + lane) * 16 + 4 * q); lg[4 * q] += p[0]; lg[4 * q + 1] += p[1]; lg[4 * q + 2] += p[2]; lg[4 * q + 3] += p[3]; }
                s2 += ssqp[ww * 64 + lane] + ssqp[ww * 64 + (lane ^ 32)]; }
            const float rstd = rsqrtf(s2 * (1.f / DM) + EPS);
#pragma unroll
            for (int q = 0; q < 16; ++q) lg[q] = lg[q] * rstd + F.router_b[crow(q, h)];
            float cv[8]; int ci[8];
#pragma unroll
            for (int k = 0; k < TOPK; ++k) {
                float bv = -INFINITY; int bi = 1 << 20;
#pragma unroll
                for (int q = 0; q < 16; ++q) { const int e = crow(q, h); const bool better = (lg[q] > bv) || (lg[q] == bv && e < bi); bv = better ? lg[q] : bv; bi = better ? e : bi; }
#pragma unroll
                for (int q = 0; q < 16; ++q) if (crow(q, h) == bi) lg[q] = -INFINITY;
                cv[k] = bv; ci[k] = bi;
            }
#pragma unroll
            for (int k = 0; k < TOPK; ++k) { cv[4 + k] = __shfl_xor(cv[k], 32); ci[4 + k] = __shfl_xor(ci[k], 32); }
            float tv[TOPK]; int te[TOPK];
#pragma unroll
            for (int k = 0; k < TOPK; ++k) {
                float bv = -INFINITY; int bi = 1 << 20;
#pragma unroll
                for (int q = 0; q < 8; ++q) { const bool better = (cv[q] > bv) || (cv[q] == bv && ci[q] < bi); bv = better ? cv[q] : bv; bi = better ? ci[q] : bi; }
#pragma unroll
                for (int q = 0; q < 8; ++q) if (ci[q] == bi) cv[q] = -INFINITY;
                tv[k] = bv; te[k] = bi;
            }
            const float e1 = __expf(tv[1] - tv[0]), e2 = __expf(tv[2] - tv[0]), e3 = __expf(tv[3] - tv[0]), inv = 1.f / (1.f + e1 + e2 + e3);
            if (h == 0) {
                RSTD[t] = rstd;
                *(f32x4*)(GATE + (size_t)t * TOPK) = (f32x4){inv, e1 * inv, e2 * inv, e3 * inv};
#pragma unroll
                for (int k = 0; k < TOPK; ++k) { my_e[k] = te[k]; my_p[k] = __hip_atomic_fetch_add(&lcnt[te[k]], 1, __ATOMIC_RELAXED, __HIP_MEMORY_SCOPE_WORKGROUP); }
            }
        }
        __syncthreads();
        if (F.tid < NE) lbase[F.tid] = atomicAdd(&cnt[F.tid], (int)lcnt[F.tid]);
        __syncthreads();
        if (w < 2 && h == 0) {
#pragma unroll
            for (int k = 0; k < TOPK; ++k) LIST[(size_t)my_e[k] * T + lbase[my_e[k]] + my_p[k]] = t * TOPK + k;
        }
        __syncthreads();
    }
}
__device__ __forceinline__ void moe_setup(Frame& F) {
    LAS int* pre = (LAS int*)(F.lds + MOE_OFF); LAS int* lc = (LAS int*)(F.lds + MOE_OFF + 256);
    if (F.tid < 64) {
        const int c = F.lane < NE ? (int)__hip_atomic_load((int*)(F.ctl + CW_CNT) + F.lane, RLX_AGENT) : 0;
        int s = (c + 255) >> 8;
#pragma unroll
        for (int o = 1; o < 32; o <<= 1) { const int v = __shfl_up(s, o); if ((F.lane & 31) >= o) s += v; }
        if (F.lane < NE) { pre[F.lane + 1] = s; lc[F.lane] = c; }
        if (F.lane == 0) pre[0] = 0;
    }
    __syncthreads();
}
__device__ __forceinline__ void p_final(Frame& F) {
    const float* X1 = WSP(float, WS_X1); const bf16_t* Y = WSP(bf16_t, WS_Y);
    const int gw = F.vcu * NWAVES + F.wave, NGW = F.G * NWAVES;
    for (int t = gw; t < T; t += NGW) {
        const GAS f32x4* xr = (const GAS f32x4*)(X1 + (size_t)t * DM) + F.lane;
        f32x4 v[4]; float s = 0.f;
#pragma unroll
        for (int j = 0; j < 4; ++j) {
            v[j] = xr[64 * j];
#pragma unroll
            for (int k = 0; k < TOPK; ++k) { const u32x2 y = *((const GAS u32x2*)(Y + ((size_t)t * TOPK + k) * DM) + F.lane + 64 * j);
                v[j].x += __builtin_bit_cast(float, y.x << 16); v[j].y += __builtin_bit_cast(float, y.x & 0xffff0000u); v[j].z += __builtin_bit_cast(float, y.y << 16); v[j].w += __builtin_bit_cast(float, y.y & 0xffff0000u); }
            s += (v[j].x * v[j].x + v[j].y * v[j].y) + (v[j].z * v[j].z + v[j].w * v[j].w);
        }
        const float r = rsqrtf(wave_sum(s) * (1.f / DM) + EPS);
        GAS f32x4* o = (GAS f32x4*)(F.out + (size_t)t * DM) + F.lane;
#pragma unroll
        for (int j = 0; j < 4; ++j) { const f32x4 g = *((const f32x4*)F.final_g + F.lane + 64 * j); o[64 * j] = (f32x4){v[j].x * r * g.x, v[j].y * r * g.y, v[j].z * r * g.z, v[j].w * r * g.w}; }
    }
}


__device__ __forceinline__ void p_attn_simple(Frame& F) {
    const bf16_t* AQ = WSP(bf16_t, WS_AQ); const bf16_t* AK = WSP(bf16_t, WS_AK); const bf16_t* AV = WSP(bf16_t, WS_AV); float* ATT = WSP(float, WS_ATT);
    const int gw0 = F.vcu * NWAVES + F.wave, NGW = F.G * NWAVES, lane = F.lane;
    for (int gw = gw0; gw < T * 8; gw += NGW) {
        const int t = gw >> 3, hq = gw & 7, kvh = hq >> 2, b = t / SEQ, tp = t % SEQ;
        const float slope = exp2f(-(float)(hq + 1)), sink = F.sinks[hq];
        const float qd = bf2f(AQ[(size_t)t * AW + hq * 64 + lane]);
        const int s0 = tp >= 127 ? tp - 127 : 0, nk = tp - s0 + 1;
        const bf16_t* kb = AK + ((size_t)b * SEQ + s0) * AKW + kvh * 64 + lane;
        const bf16_t* vb = AV + ((size_t)b * SEQ + s0) * AKW + kvh * 64 + lane;
        float slo = -INFINITY, shi = -INFINITY;
        for (int i = 0; i < nk; ++i) {
            const float d = wave_sum(qd * bf2f(kb[(size_t)i * AKW]));
            const float sc = d * 0.125f - slope * (float)(tp - (s0 + i));
            if ((i & 63) == lane) { if (i < 64) slo = sc; else shi = sc; }
        }
        const float m = fmaxf(wave_max(fmaxf(slo, shi)), sink);
        const float plo = __expf(slo - m), phi = __expf(shi - m);
        const float den = wave_sum(plo + phi) + __expf(sink - m);
        float o = 0.f;
        for (int i = 0; i < nk; ++i) { const float p = __shfl(i < 64 ? plo : phi, i & 63); o += p * bf2f(vb[(size_t)i * AKW]); }
        ATT[(size_t)t * AW + hq * 64 + lane] = o / den;
    }
}
__device__ __forceinline__ void p_hgrn_simple(Frame& F) {
    constexpr int TT = 16;
    LAS float* sf = (LAS float*)(F.lds); LAS float* sk = sf + TT * 128; LAS float* sq = sk + TT * 128; LAS float* po = sq + TT * 128;
    const bf16_t* HQ = WSP(bf16_t, WS_HQ); const float* G = WSP(float, WS_G); const bf16_t* KK = WSP(bf16_t, WS_KK); const bf16_t* HI = WSP(bf16_t, WS_HI); float* ORAW = WSP(float, WS_ORAW);
    for (int u = blockIdx.x; u < BATCH * 4; u += F.G) {
        const int b = u >> 2, h = u & 3, v = F.tid & 127, kq = F.tid >> 7;
        float S[32];
#pragma unroll
        for (int k = 0; k < 32; ++k) S[k] = 0.f;
        for (int t0 = 0; t0 < SEQ; t0 += TT) {
            __syncthreads();
            for (int i = F.tid; i < TT * 128; i += NWAVES * 64) {
                const int tt = i >> 7, k = i & 127; const size_t idx = ((size_t)b * SEQ + t0 + tt) * HKW + h * 128 + k;
                sf[i] = __expf(G[idx]); sk[i] = bf2f(KK[idx]); sq[i] = bf2f(HQ[idx]);
            }
            __syncthreads();
            for (int tt = 0; tt < TT; ++tt) {
                const float vv = bf2f(HI[((size_t)b * SEQ + t0 + tt) * HW + h * 128 + v]);
                float o = 0.f;
#pragma unroll
                for (int k = 0; k < 32; ++k) { const int kk = tt * 128 + kq * 32 + k; S[k] = sf[kk] * S[k] + sk[kk] * vv; o += sq[kk] * S[k]; }
                po[(tt * 4 + kq) * 128 + v] = o;
            }
            __syncthreads();
            for (int i = F.tid; i < TT * 128; i += NWAVES * 64) {
                const int tt = i >> 7, vv = i & 127;
                ORAW[((size_t)b * SEQ + t0 + tt) * HW + h * 128 + vv] = (po[(tt * 4 + 0) * 128 + vv] + po[(tt * 4 + 1) * 128 + vv]) + (po[(tt * 4 + 2) * 128 + vv] + po[(tt * 4 + 3) * 128 + vv]);
            }
        }
        __syncthreads();
    }
}
__device__ __forceinline__ void p_mix_simple(Frame& F, bool do_attn, bool do_hgrn) {
    const float* ATT = WSP(float, WS_ATT); const float* ORAW = WSP(float, WS_ORAW); const bf16_t* HG = WSP(bf16_t, WS_HG); bf16_t* MIX = WSP(bf16_t, WS_MIX);
    const int gw0 = F.vcu * NWAVES + F.wave, NGW = F.G * NWAVES, lane = F.lane;
    for (int t = gw0; t < T; t += NGW) {
        if (do_attn) {
        float a[8]; float ss = 0.f;
#pragma unroll
        for (int j = 0; j < 8; ++j) { a[j] = ATT[(size_t)t * AW + lane + 64 * j]; ss += a[j] * a[j]; }
        const float r = rsqrtf(wave_sum(ss) * (1.f / AW) + EPS);
#pragma unroll
        for (int j = 0; j < 8; ++j) MIX[(size_t)t * MIXW + lane + 64 * j] = f2bf(a[j] * r * F.attn_g[lane + 64 * j]);
        }
        if (do_hgrn)
#pragma unroll
        for (int h = 0; h < 4; ++h) {
            const int c0 = h * 128 + lane, c1 = c0 + 64;
            const float o0 = ORAW[(size_t)t * HW + c0], o1 = ORAW[(size_t)t * HW + c1];
            const float rr = rsqrtf(wave_sum(o0 * o0 + o1 * o1) * (1.f / 128.f) + EPS);
            MIX[(size_t)t * MIXW + AW + c0] = f2bf(o0 * rr * F.hgrn_g[c0] * bf2f(HG[(size_t)t * HW + c0]));
            MIX[(size_t)t * MIXW + AW + c1] = f2bf(o1 * rr * F.hgrn_g[c1] * bf2f(HG[(size_t)t * HW + c1]));
        }
    }
}

struct Args { const float* in[18]; float* out; unsigned char* ws; int ph_lo, ph_hi, li, pad; };
__global__ void __launch_bounds__(NWAVES * 64, 2) mega_fwd(Args args) {
    extern __shared__ __attribute__((aligned(16))) unsigned char lds[];
    Frame F;
    F.lds = (LAS unsigned char*)lds; F.MISC = (volatile LAS unsigned*)(F.lds + MISC_OFF);
    F.tid = threadIdx.x; F.lane = F.tid & 63; F.wave = __builtin_amdgcn_readfirstlane(F.tid >> 6);
    F.G = gridDim.x; { const int bx = blockIdx.x; F.vcu = (F.G % 8 == 0) ? (bx % 8) * (F.G / 8) + bx / 8 : bx; }
    F.ws = args.ws; F.ctl = (gu32*)(args.ws + WS_CTL); F.out = args.out;
    F.x = args.in[0]; F.norm1_g = args.in[1]; F.w_in = args.in[2]; F.b_in = args.in[3]; F.sinks = args.in[4]; F.attn_g = args.in[5]; F.lb_logits = args.in[6]; F.hgrn_g = args.in[7];
    F.w_out = args.in[8]; F.b_out = args.in[9]; F.norm2_g = args.in[10]; F.router_w = args.in[11]; F.router_b = args.in[12]; F.w1 = args.in[13]; F.b1 = args.in[14]; F.w2 = args.in[15];
    F.b2 = args.in[16]; F.final_g = args.in[17];
    for (int u = F.tid; u < (LDS_BYTES - LDSCTL_OFF) / 4; u += NWAVES * 64) ((LAS unsigned*)(F.lds + LDSCTL_OFF))[u] = 0u;
    __syncthreads();
    XcdBarrier bar = xcd_barrier_post((unsigned*)(F.ctl + CW_BAR) + args.li * XCD_BAR_WORDS, F.MISC + 8);
    const int lo = args.ph_lo, hi = args.ph_hi;
#define IN(k) (lo <= (k) && (k) < hi)
#define SEAM(k) do { if (IN(k) && IN((k) + 1)) xcd_barrier(bar); } while (0)

    if (IN(0)) { p_prologue(F); SEAM(0); }
    if (IN(1)) {
        pg8::DenseOrder S; S.init(WSP(bf16_t, WS_XN), WSP(bf16_t, WS_WINT), T, INW, DM, F.G, (int)blockIdx.x);
        pg8::EpiInProj E{F.b_in, WSP(float, WS_LB), WSP(bf16_t, WS_AQ), WSP(bf16_t, WS_AK), WSP(bf16_t, WS_AV), WSP(bf16_t, WS_HQ), WSP(bf16_t, WS_KK), WSP(bf16_t, WS_HI), WSP(bf16_t, WS_HG), WSP(float, WS_G)};
        pg8::gemm_phase<pg8::EpiInProj, pg8::DenseOrder, false, true>(F.lds + RING_OFF, DM, S, E);
        SEAM(1);
    }
#ifndef NEW_ATTN
#define NEW_ATTN 1
#endif
#ifndef NEW_HGRN
#define NEW_HGRN 1
#endif
    if (IN(2)) { if (!NEW_ATTN) p_attn_simple(F); if (NEW_HGRN) p_hgrn_prep(F); SEAM(2); }
    if (IN(3)) { if (!NEW_HGRN) p_hgrn_simple(F); p_scan_attn(F, NEW_HGRN, NEW_ATTN); SEAM(3); }
    if (IN(4)) { if (!NEW_ATTN || !NEW_HGRN) p_mix_simple(F, !NEW_ATTN, !NEW_HGRN); SEAM(4); }
    if (IN(5)) {
        pg8::DenseOrder S; S.init(WSP(bf16_t, WS_MIX), WSP(bf16_t, WS_WOUTT), T, DM, MIXW, F.G, (int)blockIdx.x);
        pg8::EpiOutProj E{F.b_out, F.x, WSP(float, WS_X1)};
        pg8::gemm_phase<pg8::EpiOutProj, pg8::DenseOrder, false, true>(F.lds + RING_OFF, MIXW, S, E);
        SEAM(5);
    }
    if (IN(6)) { p_router(F); SEAM(6); }
    if (IN(7)) {
        moe_setup(F);
        LAS const int* pre = (LAS const int*)(F.lds + MOE_OFF); LAS const int* lc = (LAS const int*)(F.lds + MOE_OFF + 256);
        pg8::MoeOrder<true, 1> S{(const char*)WSP(unsigned char, WS_H2), (const char*)WSP(unsigned char, WS_W1T), WSP(int, WS_LIST), pre, lc, DM, 2 * FF, 2 * FF / 256, pre[NE] * (2 * FF / 256), F.G, (int)blockIdx.x};
        pg8::EpiMoe1 E{F.b1, WSP(unsigned char, WS_ACT), WSP(int, WS_LIST), WSP(float, WS_RSTD)};
        pg8::gemm_phase<pg8::EpiMoe1, pg8::MoeOrder<true, 1>, true, true, 1>(F.lds + RING_OFF, DM, S, E);
        SEAM(7);
    }
    if (IN(8)) {
        if (!IN(7)) moe_setup(F);
        LAS const int* pre = (LAS const int*)(F.lds + MOE_OFF); LAS const int* lc = (LAS const int*)(F.lds + MOE_OFF + 256);
        pg8::MoeOrder<false, 1> S{(const char*)WSP(unsigned char, WS_ACT), (const char*)WSP(unsigned char, WS_W2T), WSP(int, WS_LIST), pre, lc, FF, DM, DM / 256, pre[NE] * (DM / 256), F.G, (int)blockIdx.x};
        pg8::EpiMoe2 E{F.b2, WSP(int, WS_LIST), WSP(float, WS_GATE), WSP(bf16_t, WS_Y)};
        pg8::gemm_phase<pg8::EpiMoe2, pg8::MoeOrder<false, 1>, false, true, 1>(F.lds + RING_OFF, FF, S, E);
        SEAM(8);
    }
    if (IN(9)) p_final(F);
#undef IN
#undef SEAM
}

static int mega_grid() {
    static int grid = 0;
    if (grid == 0) {
        int dev = 0, cus = 0;
        if (hipGetDevice(&dev) != hipSuccess || hipDeviceGetAttribute(&cus, hipDeviceAttributeMultiprocessorCount, dev) != hipSuccess) { grid = -1; return grid; }
        if (hipFuncSetAttribute((const void*)mega_fwd, hipFuncAttributeMaxDynamicSharedMemorySize, LDS_BYTES) != hipSuccess) { grid = -1; return grid; }
        (void)hipGetLastError();
        grid = cus;
    }
    return grid;
}
extern "C" void kernel_launch(void* const* d_in, const int* in_sizes, int n_in, void* d_out, int out_size, void* d_ws, size_t ws_size, hipStream_t stream) {
    if (n_in != 18 || ws_size < WS_END) return;
    const int grid = mega_grid(); if (grid <= 0) return;
    unsigned char* ws = (unsigned char*)d_ws;
    (void)hipMemsetAsync(ws + WS_CTL, 0, 262144, stream);
    Args a{};
    for (int i = 0; i < 18; ++i) a.in[i] = (const float*)d_in[i];
    a.out = (float*)d_out; a.ws = ws;
#ifndef PLAN
#define PLAN {{0, N_PHASES}}
#endif
    static const int plan[][2] = PLAN;
    for (int li = 0; li < (int)(sizeof(plan) / sizeof(plan[0])); ++li) {
        a.ph_lo = plan[li][0]; a.ph_hi = plan[li][1]; a.li = li;
        hipLaunchKernelGGL(mega_fwd, dim3(grid), dim3(NWAVES * 64), LDS_BYTES, stream, a);
    }
}
```

```cpp
#include <hip/hip_runtime.h>
#include <stdint.h>

typedef unsigned short bf16_t;
typedef short bf16x8 __attribute__((ext_vector_type(8)));
typedef float f32x4 __attribute__((ext_vector_type(4)));

constexpr int BATCH = 8, SEQ = 2048, DM = 1024, T = BATCH * SEQ;
constexpr int AW = 512, AKW = 128, HKW = 512, HW = 512, INW = 2816, MIXW = 1024;
constexpr int NE = 32, TOPK = 4, FF = 1024;
constexpr int C_AQ = 0, C_AK = 512, C_AV = 640, C_HQ = 768, C_HF = 1280, C_HI = 1792, C_HG = 2304;
constexpr float EPS = 1e-5f;
constexpr int ACT_ROWS = T * TOPK + NE * 256;

constexpr size_t MiB = 1u << 20;
constexpr size_t al(size_t x) { return (x + 255) & ~(size_t)255; }
constexpr size_t WS_CTL = 0;
constexpr size_t WS_LB = 1 * MiB;
constexpr size_t WS_WINT = 2 * MiB;
constexpr size_t WS_WOUTT = WS_WINT + al((size_t)INW * DM * 2);
constexpr size_t WS_W1T = WS_WOUTT + al((size_t)DM * MIXW * 2);
constexpr size_t WS_W2T = WS_W1T + al((size_t)NE * 2 * FF * DM * 2);
constexpr size_t WS_XN = WS_W2T + al((size_t)NE * DM * FF * 2);
constexpr size_t WS_AQ = WS_XN + al((size_t)T * DM * 2);
constexpr size_t WS_AK = WS_AQ + al((size_t)T * AW * 2);
constexpr size_t WS_AV = WS_AK + al((size_t)T * AKW * 2);
constexpr size_t WS_HQ = WS_AV + al((size_t)T * AKW * 2);
constexpr size_t WS_G = WS_HQ + al((size_t)T * HKW * 2);
constexpr size_t WS_KK = WS_G + al((size_t)T * HKW * 4);
constexpr size_t WS_HI = WS_KK + al((size_t)T * HKW * 2);
constexpr size_t WS_HG = WS_HI + al((size_t)T * HW * 2);
constexpr size_t WS_ATT = WS_HG + al((size_t)T * HW * 2);
constexpr size_t WS_ORAW = WS_ATT + al((size_t)T * AW * 4);
constexpr size_t WS_MIX = WS_ORAW + al((size_t)T * HW * 4);
constexpr size_t WS_X1 = WS_MIX + al((size_t)T * MIXW * 2);
constexpr size_t WS_H2 = WS_X1 + al((size_t)T * DM * 4);
constexpr size_t WS_GATE = WS_H2 + al((size_t)T * DM * 2);
constexpr size_t WS_LIST = WS_GATE + al((size_t)T * TOPK * 4);
constexpr size_t WS_ACT = WS_LIST + al((size_t)NE * T * 4);
constexpr size_t WS_Y = WS_ACT + al((size_t)ACT_ROWS * FF * 2);
constexpr size_t WS_QF = WS_Y + al((size_t)T * TOPK * DM * 2);
constexpr size_t WS_KF = WS_QF + al((size_t)1024 * 16 * 512 * 2);
constexpr size_t WS_VF = WS_KF + al((size_t)1024 * 16 * 512 * 2);
constexpr size_t WS_INTRA = WS_VF + al((size_t)1024 * 16 * 512 * 2);
constexpr size_t WS_DEC = WS_INTRA + al((size_t)T * HW * 2);
constexpr size_t WS_RWF = WS_DEC + al((size_t)1024 * 128 * 4);
constexpr size_t WS_RSTD = WS_RWF + al((size_t)64 * 2 * 512 * 2);
constexpr size_t WS_END = WS_RSTD + al((size_t)T * 4);
static_assert(WS_END <= ((size_t)1 << 30), "workspace map exceeds 1 GiB");
constexpr int CW_CNT = 64;
constexpr int CW_OFF = 128;

__device__ __forceinline__ bf16_t f2bf(float f) { unsigned u = __builtin_bit_cast(unsigned, f); return (bf16_t)((u + 0x7fffu + ((u >> 16) & 1u)) >> 16); }
__device__ __forceinline__ float bf2f(bf16_t b) { return __builtin_bit_cast(float, (unsigned)b << 16); }
__device__ __forceinline__ float wave_sum(float v) {
#pragma unroll
    for (int o = 1; o < 64; o <<= 1) v += __shfl_xor(v, o);
    return v;
}
__device__ __forceinline__ float wave_max(float v) {
#pragma unroll
    for (int o = 1; o < 64; o <<= 1) v = fmaxf(v, __shfl_xor(v, o));
    return v;
}
__device__ __forceinline__ float sigmoidf_(float x) { return 1.f / (1.f + __expf(-x)); }
__device__ __forceinline__ float siluf_(float x) { return x / (1.f + __expf(-x)); }

#define LAS __attribute__((address_space(3)))
#define GAS __attribute__((address_space(1)))
typedef unsigned u32x4 __attribute__((ext_vector_type(4)));
typedef unsigned u32x2 __attribute__((ext_vector_type(2)));
typedef float f32x2 __attribute__((ext_vector_type(2)));

namespace pg8 {
constexpr int BM = 256, BK = 64, HALF = 128, HTB = HALF * BK * 2  , STAGE_BYTES = 8 * HTB, NXCD = 8, WGM = 8;
__host__ __device__ __forceinline__ int lds_byte(int r, int c) { const int st = (r >> 4) * 2 + (c >> 5), rr = r & 15, cc = c & 31, ob = rr * 64 + cc * 2; return st * 1024 + (ob ^ (((ob >> 9) & 1) << 5)); }
__host__ __device__ __forceinline__ void stage_rc(int b, int& R, int& C) { const int st = b / 1024, sb = b % 1024, swz = sb ^ (((sb >> 9) & 1) << 5); R = (st >> 1) * 16 + swz / 64; C = (st & 1) * 32 + (swz % 64) / 2; }
__host__ __device__ __forceinline__ int perm32(int rho) { const int n = rho >> 4, i = rho & 15; return 8 * (i >> 2) + 4 * n + (i & 3); }
__device__ __forceinline__ unsigned cvt_pk_bf16(float lo, float hi) { unsigned r; asm volatile("v_cvt_pk_bf16_f32 %0, %1, %2" : "=v"(r) : "v"(lo), "v"(hi)); return r; }

struct Unit { const char* A; const char* B; int pm, pn, e, rows, arow, lbase; };

struct DenseOrder {
    const char* A; const char* Bt; int K, nM, nN, nwg, G, c;
    __device__ void init(const void* A_, const void* Bt_, int M, int N, int K_, int G_, int c_) { A = (const char*)A_; Bt = (const char*)Bt_; K = K_; nM = M / BM; nN = N / BM; nwg = nM * nN; G = G_; c = c_; }
    __device__ __forceinline__ bool next(int i, Unit& u) const {
        const long L = (long)i * G + c; if (L >= nwg) return false;
        int wgid = (int)L; { const int q = nwg / NXCD, r = nwg % NXCD, xcd = wgid % NXCD, off = wgid / NXCD; wgid = (xcd < r ? xcd * (q + 1) : r * (q + 1) + (xcd - r) * q) + off; }
        const int nig = WGM * nN, gid = wgid / nig, fm = gid * WGM, gsz = (nM - fm) < WGM ? (nM - fm) : WGM;
        u.pm = fm + ((wgid % nig) % gsz); u.pn = (wgid % nig) / gsz; u.e = 0; u.rows = BM; u.arow = u.pm * BM; u.lbase = 0;
        u.A = A + (size_t)u.pm * BM * K * 2; u.B = Bt + (size_t)u.pn * BM * K * 2; return true;
    }
    __device__ __forceinline__ int row(const Unit&, int r) const { return r; }
};
template <bool G1, int ES>
struct MoeOrder {
    const char* A; const char* Bt; const int* list; LAS const int* pre; LAS const int* cnt; int K, N, nN, nwg, G, c;
    __device__ __forceinline__ bool next(int i, Unit& u) const {
        const long L = (long)i * G + c; if (L >= nwg) return false;
        int wgid = (int)L; { const int q = nwg / NXCD, r = nwg % NXCD, xcd = wgid % NXCD, off = wgid / NXCD; wgid = (xcd < r ? xcd * (q + 1) : r * (q + 1) + (xcd - r) * q) + off; }
        const int tau = wgid / nN; u.pn = wgid % nN;
        const int p = pre[(threadIdx.x & 31) + 1];
        const int e = __builtin_popcountll(__ballot(p <= tau) & 0xffffffffull);
        const int mt = tau - pre[e];
        u.e = e; u.pm = mt; const int left = cnt[e] - mt * BM; u.rows = left < BM ? left : BM;
        u.arow = tau * BM; u.lbase = e * T + mt * BM;
        u.A = G1 ? A : A + (size_t)u.arow * K * ES;
        u.B = Bt + ((size_t)e * N + (size_t)u.pn * BM) * K * ES; return true;
    }
    __device__ __forceinline__ int row(const Unit& u, int r) const { const int rr = r < u.rows ? r : u.rows - 1; return list[u.lbase + rr] >> 2; }
};

__device__ __forceinline__ u32x4 pack8(f32x4 v0, f32x4 v1) { u32x4 w; w.x = cvt_pk_bf16(v0[0], v0[1]); w.y = cvt_pk_bf16(v0[2], v0[3]); w.z = cvt_pk_bf16(v1[0], v1[1]); w.w = cvt_pk_bf16(v1[2], v1[3]); return w; }
__device__ __forceinline__ f32x4 silu4(f32x4 v) { f32x4 r; for (int i = 0; i < 4; ++i) r[i] = v[i] * __builtin_amdgcn_rcpf(1.f + __expf(-v[i])); return r; }

typedef int v8i32 __attribute__((ext_vector_type(8)));
__device__ __forceinline__ u32x2 pack8_fp8(f32x4 v0, f32x4 v1) {
    int a = 0, b = 0; a = __builtin_amdgcn_cvt_pk_fp8_f32(v0[0], v0[1], a, false); a = __builtin_amdgcn_cvt_pk_fp8_f32(v0[2], v0[3], a, true);
    b = __builtin_amdgcn_cvt_pk_fp8_f32(v1[0], v1[1], b, false); b = __builtin_amdgcn_cvt_pk_fp8_f32(v1[2], v1[3], b, true);
    return (u32x2){(unsigned)a, (unsigned)b};
}
constexpr float FP8_ACT_SCALE = 4.f, FP8_W_SCALE = 64.f, FP8_DESCALE = 1.f / (FP8_ACT_SCALE * FP8_W_SCALE);
struct EpiInProj {
    static constexpr bool PERM = true;
    const float* bias; const float* lb; bf16_t *AQ, *AK, *AV, *HQ, *KK, *HI, *HG; float* G;
    __device__ __forceinline__ void operator()(const f32x4 (&acc)[2][2][4][2], const Unit& u, int wr, int wc, int fr, int fq) const {
        const int row0 = u.pm * BM + wr * 64 + fr, cl = wc * 32 + 8 * fq;
#pragma unroll
        for (int bj = 0; bj < 2; ++bj) {
            const int cb = u.pn * BM + bj * HALF;
            const f32x4 b0 = *(const f32x4*)(bias + cb + cl), b1 = *(const f32x4*)(bias + cb + cl + 4);
            if (cb >= C_HF && cb < C_HI) {
                const int cc = cb - C_HF + cl;
                const f32x4 l0 = *(const f32x4*)(lb + cc), l1 = *(const f32x4*)(lb + cc + 4);
#pragma unroll
                for (int ai = 0; ai < 2; ++ai)
#pragma unroll
                    for (int m = 0; m < 4; ++m) {
                        const size_t r = (size_t)(row0 + ai * HALF + m * 16);
                        f32x4 v0 = acc[ai][bj][m][0] + b0, v1 = acc[ai][bj][m][1] + b1, g0, g1, k0, k1;
#pragma unroll
                        for (int i = 0; i < 4; ++i) {
                            const float f0 = l0[i] + (1.f - l0[i]) * __builtin_amdgcn_rcpf(1.f + __expf(-v0[i])); g0[i] = __logf(f0); k0[i] = 1.f - f0;
                            const float f1 = l1[i] + (1.f - l1[i]) * __builtin_amdgcn_rcpf(1.f + __expf(-v1[i])); g1[i] = __logf(f1); k1[i] = 1.f - f1;
                        }
                        *(f32x4*)(G + r * HKW + cc) = g0; *(f32x4*)(G + r * HKW + cc + 4) = g1;
                        *(u32x4*)(KK + r * HKW + cc) = pack8(k0, k1);
                    }
            } else {
                bf16_t* dst; int ld, cc; bool act = false;
                if (cb < C_AK) { dst = AQ; ld = AW; cc = cb - C_AQ; }
                else if (cb < C_AV) { dst = AK; ld = AKW; cc = cb - C_AK; }
                else if (cb < C_HQ) { dst = AV; ld = AKW; cc = cb - C_AV; }
                else if (cb < C_HF) { dst = HQ; ld = HKW; cc = cb - C_HQ; act = true; }
                else if (cb < C_HG) { dst = HI; ld = HW; cc = cb - C_HI; }
                else { dst = HG; ld = HW; cc = cb - C_HG; act = true; }
                cc += cl;
#pragma unroll
                for (int ai = 0; ai < 2; ++ai)
#pragma unroll
                    for (int m = 0; m < 4; ++m) {
                        const size_t r = (size_t)(row0 + ai * HALF + m * 16);
                        f32x4 v0 = acc[ai][bj][m][0] + b0, v1 = acc[ai][bj][m][1] + b1;
                        if (act) { v0 = silu4(v0); v1 = silu4(v1); }
                        *(u32x4*)(dst + r * ld + cc) = pack8(v0, v1);
                    }
            }
        }
    }
};
struct EpiOutProj {
    static constexpr bool PERM = false;
    const float* bias; const float* x; float* X1;
    __device__ __forceinline__ void operator()(const f32x4 (&acc)[2][2][4][2], const Unit& u, int wr, int wc, int fr, int fq) const {
        const int row0 = u.pm * BM + wr * 64 + fr, col0 = u.pn * BM + wc * 32 + 4 * fq;
#pragma unroll
        for (int bj = 0; bj < 2; ++bj)
#pragma unroll
            for (int n = 0; n < 2; ++n) {
                const int c = col0 + bj * HALF + n * 16; const f32x4 bv = *(const f32x4*)(bias + c);
#pragma unroll
                for (int ai = 0; ai < 2; ++ai)
#pragma unroll
                    for (int m = 0; m < 4; ++m) { const size_t o = (size_t)(row0 + ai * HALF + m * 16) * DM + c; *(f32x4*)(X1 + o) = acc[ai][bj][m][n] + bv + *(const f32x4*)(x + o); }
            }
    }
};
struct EpiMoe1 {
    static constexpr bool PERM = true;
    const float* b1; unsigned char* ACT; const int* list; const float* rstd;
    __device__ __forceinline__ void operator()(const f32x4 (&acc)[2][2][4][2], const Unit& u, int wr, int wc, int fr, int fq) const {
        const int ac0 = u.pn * HALF + wc * 32 + 8 * fq;
        const float* bp = b1 + (size_t)u.e * 2 * FF + 2 * ac0;
        const f32x4 q0 = *(const f32x4*)bp, q1 = *(const f32x4*)(bp + 4), q2 = *(const f32x4*)(bp + 8), q3 = *(const f32x4*)(bp + 12);
        const f32x4 bg0 = {q0[0], q0[2], q1[0], q1[2]}, bg1 = {q2[0], q2[2], q3[0], q3[2]}, bl0 = {q0[1], q0[3], q1[1], q1[3]}, bl1 = {q2[1], q2[3], q3[1], q3[3]};
#pragma unroll
        for (int ai = 0; ai < 2; ++ai)
#pragma unroll
            for (int m = 0; m < 4; ++m) {
                const int r = ai * HALF + wr * 64 + m * 16 + fr;
                const float rs = r < u.rows ? rstd[list[u.lbase + r] >> 2] * FP8_DESCALE : 0.f;
                const f32x4 g0 = acc[ai][0][m][0] * rs + bg0, g1 = acc[ai][0][m][1] * rs + bg1, l0 = acc[ai][1][m][0] * rs + bl0, l1 = acc[ai][1][m][1] * rs + bl1;
                f32x4 a0, a1;
#pragma unroll
                for (int i = 0; i < 4; ++i) {
                    const float u0 = fminf(g0[i], 7.f), u1 = fminf(g1[i], 7.f), w0 = fminf(fmaxf(l0[i], -7.f), 7.f), w1 = fminf(fmaxf(l1[i], -7.f), 7.f);
                    a0[i] = u0 * __builtin_amdgcn_rcpf(1.f + __expf(-1.702f * u0)) * (w0 + 1.f);
                    a1[i] = u1 * __builtin_amdgcn_rcpf(1.f + __expf(-1.702f * u1)) * (w1 + 1.f);
                }
                if (r < u.rows) *(u32x2*)(ACT + (size_t)(u.arow + r) * FF + ac0) = pack8_fp8(a0 * FP8_ACT_SCALE, a1 * FP8_ACT_SCALE);
            }
    }
};
struct EpiMoe2 {
    static constexpr bool PERM = true;
    const float* b2; const int* list; const float* gate; bf16_t* Y;
    __device__ __forceinline__ void operator()(const f32x4 (&acc)[2][2][4][2], const Unit& u, int wr, int wc, int fr, int fq) const {
        const int c0 = u.pn * BM + wc * 32 + 8 * fq;
        f32x4 bv[2][2];
#pragma unroll
        for (int bj = 0; bj < 2; ++bj)
#pragma unroll
            for (int n = 0; n < 2; ++n) bv[bj][n] = *(const f32x4*)(b2 + (size_t)u.e * DM + c0 + bj * HALF + 4 * n);
#pragma unroll
        for (int ai = 0; ai < 2; ++ai)
#pragma unroll
            for (int m = 0; m < 4; ++m) {
                const int r = ai * HALF + wr * 64 + m * 16 + fr;
                if (r < u.rows) {
                    const int slot = list[u.lbase + r]; const float gt = gate[slot];
                    bf16_t* yr = Y + (size_t)slot * DM + c0;
#pragma unroll
                    for (int bj = 0; bj < 2; ++bj) { const f32x4 v0 = (acc[ai][bj][m][0] * FP8_DESCALE + bv[bj][0]) * gt, v1 = (acc[ai][bj][m][1] * FP8_DESCALE + bv[bj][1]) * gt; *(u32x4*)(yr + bj * HALF) = pack8(v0, v1); }
                }
            }
    }
};

template <class Epi, class Sched, bool GATHER, bool ALIGN_EPI, int ES = 2>
__device__ __forceinline__ void gemm_phase(LAS unsigned char* lds, const int K, const Sched& S, const Epi& E) {
    const int tid = threadIdx.x, wid = __builtin_amdgcn_readfirstlane(tid >> 6), lane = tid & 63, wr = wid >> 2, wc = wid & 3, fr = lane & 15, fq = lane >> 4;
    int nt = K * ES / (BK * 2); asm volatile("" : "+s"(nt));
    unsigned voffB[2];
#pragma unroll
    for (int i = 0; i < 2; ++i) { int R, C; stage_rc(tid * 16 + i * 8192, R, C); const int Rb = Epi::PERM ? ((R & ~31) + perm32(R & 31)) : R; voffB[i] = (unsigned)(Rb * K * ES + C * 2); }
    const size_t kstep = (size_t)(BK * 2);
    const size_t hstep = (size_t)HALF * K * ES;
    const unsigned ldsw = (unsigned)wid * 1024u;
    const int aoff = lds_byte(wr * 64 + fr, fq * 8), boff = lds_byte(wc * 32 + fr, fq * 8);
#define PG8_SA(b, h) (((b) * 2 + (h)) * HTB)
#define PG8_SB(b, h) ((4 + (b) * 2 + (h)) * HTB)
#define PG8_STAGE(bufoff, gbase, voff) do { _Pragma("unroll") for (int _i = 0; _i < 2; ++_i) \
        __builtin_amdgcn_global_load_lds((const unsigned*)((const char*)(gbase) + (voff)[_i]), (LAS unsigned*)(lds + (bufoff) + ldsw + _i * 8192), 16, 0, 0); } while (0)
#define PG8_LD8(dst, off) do { const u32x4 lo_ = *(const LAS u32x4*)(lds + (off)), hi_ = *(const LAS u32x4*)(lds + (off) + 1024); \
        dst = (v8i32){(int)lo_.x, (int)lo_.y, (int)lo_.z, (int)lo_.w, (int)hi_.x, (int)hi_.y, (int)hi_.z, (int)hi_.w}; } while (0)
#define PG8_LDA(dst, b, h) do { _Pragma("unroll") for (int m = 0; m < 4; ++m) PG8_LD8(dst[m], PG8_SA(b, h) + aoff + m * 2048); } while (0)
#define PG8_LDB(dst, b, h) do { _Pragma("unroll") for (int n = 0; n < 2; ++n) PG8_LD8(dst[n], PG8_SB(b, h) + boff + n * 2048); } while (0)
#define PG8_LO(x) __builtin_bit_cast(bf16x8, __builtin_shufflevector(x, x, 0, 1, 2, 3))
#define PG8_HI(x) __builtin_bit_cast(bf16x8, __builtin_shufflevector(x, x, 4, 5, 6, 7))
#define PG8_MMA(ai, bj, At, Bt) do { __builtin_amdgcn_s_setprio(1); _Pragma("unroll") for (int m = 0; m < 4; ++m) _Pragma("unroll") for (int n = 0; n < 2; ++n) { \
        if constexpr (ES == 2) { acc[ai][bj][m][n] = __builtin_amdgcn_mfma_f32_16x16x32_bf16(PG8_LO(Bt[n]), PG8_LO(At[m]), acc[ai][bj][m][n], 0, 0, 0); \
                                 acc[ai][bj][m][n] = __builtin_amdgcn_mfma_f32_16x16x32_bf16(PG8_HI(Bt[n]), PG8_HI(At[m]), acc[ai][bj][m][n], 0, 0, 0); } \
        else asm volatile("v_mfma_scale_f32_16x16x128_f8f6f4 %0, %1, %2, %0, %3, %3 op_sel_hi:[0,0,0]" : "+v"(acc[ai][bj][m][n]) : "v"(Bt[n]), "v"(At[m]), "v"(unit_scale)); } \
          \
        __builtin_amdgcn_s_setprio(0); } while (0)
#define PG8_WAIT_V(n) asm volatile("s_waitcnt vmcnt(" #n ")" ::: "memory")
#define PG8_WAIT_L(n) asm volatile("s_waitcnt lgkmcnt(" #n ")" ::: "memory")
#define PG8_BAR __builtin_amdgcn_s_barrier()
#define PG8_SCHED __builtin_amdgcn_sched_barrier(0)
#define PG8_VOFFA(dst, u) do { int _t = tid; if (GATHER) asm volatile("" : "+v"(_t));     \
        _Pragma("unroll") for (int _i = 0; _i < 2; ++_i) { int _R, _C; stage_rc(_t * 16 + _i * 8192, _R, _C); _Pragma("unroll") for (int _h = 0; _h < 2; ++_h) { const int _r = _h * HALF + _R; \
        const unsigned _row = GATHER ? (unsigned)S.row(u, _r) : (unsigned)_r; dst[_h][_i] = _row * (unsigned)(K * ES) + (unsigned)_C * 2u; } } } while (0)
    Unit cur, nxt; int ui = 0;
    if (!S.next(0, cur)) return;
    f32x4 acc[2][2][4][2];
#pragma unroll
    for (int a = 0; a < 2; ++a)
#pragma unroll
        for (int b = 0; b < 2; ++b)
#pragma unroll
            for (int m = 0; m < 4; ++m)
#pragma unroll
                for (int n = 0; n < 2; ++n) acc[a][b][m][n] = (f32x4){0.f, 0.f, 0.f, 0.f};
    v8i32 At[4], B0[2], B1[2];
    const int unit_scale = 0x7F7F7F7F;
    unsigned vA[2][2], nvA[2][2];
    PG8_VOFFA(vA, cur);
    const char* cA = cur.A; const char* cB = cur.B;
    PG8_STAGE(PG8_SB(0, 0), cB, voffB); PG8_STAGE(PG8_SB(0, 1), cB + hstep, voffB); PG8_STAGE(PG8_SA(0, 0), cA, vA[0]); PG8_STAGE(PG8_SA(0, 1), cA, vA[1]);
    if (wr == 1) PG8_BAR;
    PG8_WAIT_V(2); PG8_BAR;
    PG8_STAGE(PG8_SB(1, 0), cB + kstep, voffB); PG8_STAGE(PG8_SA(1, 0), cA + kstep, vA[0]); PG8_STAGE(PG8_SB(1, 1), cB + hstep + kstep, voffB);
    PG8_WAIT_V(6); PG8_BAR;
    for (;;) {
        const bool has_next = S.next(ui + 1, nxt);
        const char* nA = has_next ? nxt.A : cA; const char* nB = has_next ? nxt.B : cB;
        if (has_next) { PG8_VOFFA(nvA, nxt); } else {
#pragma unroll
            for (int h = 0; h < 2; ++h)
#pragma unroll
                for (int i = 0; i < 2; ++i) nvA[h][i] = vA[h][i]; }
#pragma unroll 1
        for (int t = 0; t < nt; t += 2) {
            const bool last = (t == nt - 2);
            const char* a1 = cA + (size_t)(t + 1) * kstep;
            const char* a2 = last ? nA : cA + (size_t)(t + 2) * kstep; const char* b2 = last ? nB : cB + (size_t)(t + 2) * kstep;
            const char* a3 = a2 + kstep; const char* b3 = b2 + kstep;
            unsigned s0[2], s1[2];
#pragma unroll
            for (int i = 0; i < 2; ++i) { s0[i] = last ? nvA[0][i] : vA[0][i]; s1[i] = last ? nvA[1][i] : vA[1][i]; }
            PG8_LDB(B0, 0, 0); PG8_LDB(B1, 0, 1); PG8_SCHED; PG8_LDA(At, 0, 0); PG8_STAGE(PG8_SA(1, 1), a1, vA[1]);
            PG8_WAIT_V(8); PG8_WAIT_L(0); PG8_BAR; PG8_MMA(0, 0, At, B0); PG8_MMA(0, 1, At, B1); PG8_BAR; PG8_SCHED;
            PG8_LDA(At, 0, 1); PG8_STAGE(PG8_SB(0, 0), b2, voffB); PG8_STAGE(PG8_SB(0, 1), b2 + hstep, voffB); PG8_STAGE(PG8_SA(0, 0), a2, s0);
            PG8_WAIT_V(8); PG8_WAIT_L(0); PG8_BAR; PG8_MMA(1, 0, At, B0); PG8_MMA(1, 1, At, B1); PG8_BAR; PG8_SCHED;
            PG8_LDB(B0, 1, 0); PG8_LDB(B1, 1, 1); PG8_SCHED; PG8_LDA(At, 1, 0); PG8_STAGE(PG8_SA(0, 1), a2, s1);
            PG8_WAIT_V(8); PG8_WAIT_L(0); PG8_BAR; PG8_MMA(0, 0, At, B0); PG8_MMA(0, 1, At, B1); PG8_BAR; PG8_SCHED;
            PG8_LDA(At, 1, 1); PG8_STAGE(PG8_SB(1, 0), b3, voffB); PG8_STAGE(PG8_SB(1, 1), b3 + hstep, voffB); PG8_STAGE(PG8_SA(1, 0), a3, s0);
            PG8_WAIT_V(8); PG8_WAIT_L(0); PG8_BAR; PG8_MMA(1, 0, At, B0); PG8_MMA(1, 1, At, B1); PG8_BAR; PG8_SCHED;
        }
        if constexpr (ALIGN_EPI) { if (wr == 0) PG8_BAR; }
        if constexpr (ES == 1) asm volatile("s_nop 15\n\ts_nop 7" ::: "memory");
        { int l2 = lane; asm volatile("" : "+v"(l2)); E(acc, cur, wr, wc, l2 & 15, l2 >> 4); }
        if (!has_next) break;
#pragma unroll
        for (int a = 0; a < 2; ++a)
#pragma unroll
            for (int b = 0; b < 2; ++b)
#pragma unroll
                for (int m = 0; m < 4; ++m)
#pragma unroll
                    for (int n = 0; n < 2; ++n) acc[a][b][m][n] = (f32x4){0.f, 0.f, 0.f, 0.f};
        cur = nxt; cA = nA; cB = nB; ++ui;
#pragma unroll
        for (int h = 0; h < 2; ++h)
#pragma unroll
            for (int i = 0; i < 2; ++i) vA[h][i] = nvA[h][i];
        if constexpr (ALIGN_EPI) { if (wr == 1) PG8_BAR; }
    }
    PG8_WAIT_V(0);
    if constexpr (!ALIGN_EPI) { if (wr == 0) PG8_BAR; }
    PG8_BAR;
#undef PG8_SA
#undef PG8_SB
#undef PG8_STAGE
#undef PG8_LDA
#undef PG8_LDB
#undef PG8_MMA
#undef PG8_LD8
#undef PG8_LO
#undef PG8_HI
#undef PG8_WAIT_V
#undef PG8_WAIT_L
#undef PG8_BAR
#undef PG8_SCHED
#undef PG8_VOFFA
}
}

constexpr int NWAVES = 8;
constexpr int RING_OFF = 0, RING_BYTES = 139264;
constexpr int LDSCTL_OFF = RING_BYTES, MISC_OFF = LDSCTL_OFF + 320;
constexpr int MOE_OFF = LDSCTL_OFF + 1024;
constexpr int LDS_BYTES = RING_BYTES + 16384;
constexpr int CW_TMO = 0, CW_CODE = 1, CW_BAR = 4096;
constexpr int N_PHASES = 10;

typedef GAS unsigned gu32;
#define RLX_AGENT __ATOMIC_RELAXED, __HIP_MEMORY_SCOPE_AGENT
#define LDS_WAIT() asm volatile("s_waitcnt lgkmcnt(0)" ::: "memory")
#define VM_WAIT() asm volatile("s_waitcnt vmcnt(0)" ::: "memory")

#define XB_TMO      128
#define XB_XCNT(j)  (256  + 64 * (j))
#define XB_XSUB(j)  (1280 + 64 * (j))
#define XB_XGEN(j)  (2304 + 64 * (j))
#define XB_TOP      3328
#define XB_TOPGEN   3392
#define XCD_BAR_WORDS 3456
#define XB_SPIN_CAP (1u << 18)
__device__ __forceinline__ unsigned xb_ld(unsigned* p)              { return __hip_atomic_load(p, __ATOMIC_RELAXED, __HIP_MEMORY_SCOPE_AGENT); }
__device__ __forceinline__ unsigned xb_add(unsigned* p, unsigned v) { return __hip_atomic_fetch_add(p, v, __ATOMIC_RELAXED, __HIP_MEMORY_SCOPE_AGENT); }
__device__ __forceinline__ unsigned xb_xcc_id() { return (unsigned)__builtin_amdgcn_s_getreg((3 << 11) | 20) & 0xFu; }
#define XB_SPIN(cond, bar) do { unsigned _sp = 0; while (cond) { __builtin_amdgcn_s_sleep(1); \
    if ((++_sp & 255u) == 0u) { if (xb_ld(&(bar)[XB_TMO])) break; if (_sp > XB_SPIN_CAP) { atomicAdd(&(bar)[XB_TMO], 1u); break; } } } } while (0)
struct XcdBarrier { unsigned* bar; unsigned x; volatile LAS unsigned* st; };
__device__ __forceinline__ XcdBarrier xcd_barrier_post(unsigned* bar, volatile LAS unsigned* st) {
    XcdBarrier b; b.bar = bar; b.x = xb_xcc_id(); b.st = st;
    if (threadIdx.x == 0) (void)xb_add(&bar[XB_XCNT(b.x)], 1u);
    return b;
}
__device__ __forceinline__ void xcd_barrier_complete(unsigned* bar, unsigned x, unsigned& nloc, unsigned& nx) {
    const unsigned G = gridDim.x * gridDim.y * gridDim.z;
    unsigned sum, cnt, mine, sp = 0u;
    for (;;) {
        sum = 0u; cnt = 0u; mine = 0u;
#pragma unroll
        for (unsigned j = 0; j < 16; ++j) { const unsigned c = xb_ld(&bar[XB_XCNT(j)]); sum += c; cnt += (c > 0u) ? 1u : 0u; mine = (j == x) ? c : mine; }
        if (sum == G) break;
        __builtin_amdgcn_s_sleep(1);
        if ((++sp & 255u) == 0u) { if (xb_ld(&bar[XB_TMO])) break; if (sp > XB_SPIN_CAP) { atomicAdd(&bar[XB_TMO], 1u); break; } }
    }
    nloc = mine > 0u ? mine : 1u; nx = cnt > 0u ? cnt : 1u;
}
__device__ __forceinline__ void xcd_barrier(const XcdBarrier& b) {
    asm volatile("s_waitcnt vmcnt(0)" ::: "memory");
    __syncthreads();
    if (threadIdx.x == 0) {
        unsigned* bar = b.bar;
        __builtin_amdgcn_s_waitcnt(0);
        unsigned nloc = b.st[0], nx = b.st[1];
        if (nloc == 0u) { xcd_barrier_complete(bar, b.x, nloc, nx); b.st[0] = nloc; b.st[1] = nx; }
        const unsigned old = xb_add(&bar[XB_XSUB(b.x)], 1u);
        const unsigned gen = old / nloc;
        if (old + 1u == (gen + 1u) * nloc) {
            __builtin_amdgcn_fence(__ATOMIC_RELEASE, "agent");
            asm volatile("s_waitcnt vmcnt(0)" ::: "memory");
            const unsigned og = xb_add(&bar[XB_TOP], 1u);
            const unsigned tg = og / nx;
            if (og + 1u == (tg + 1u) * nx) xb_add(&bar[XB_TOPGEN], 1u);
            else XB_SPIN(xb_ld(&bar[XB_TOPGEN]) == tg, bar);
            __builtin_amdgcn_fence(__ATOMIC_ACQUIRE, "agent");
            xb_add(&bar[XB_XGEN(b.x)], 1u);
            asm volatile("s_waitcnt vmcnt(0)" ::: "memory");
        } else {
            XB_SPIN(xb_ld(&bar[XB_XGEN(b.x)]) == gen, bar);
            __builtin_amdgcn_fence(__ATOMIC_ACQUIRE, "agent");
            asm volatile("s_waitcnt vmcnt(0)" ::: "memory");
        }
    }
    __syncthreads();
}

struct Frame {
    LAS unsigned char* lds; volatile LAS unsigned* MISC; gu32* ctl;
    int tid, lane, wave, vcu, G;
    const float *x, *norm1_g, *w_in, *b_in, *sinks, *attn_g, *lb_logits, *hgrn_g, *w_out, *b_out, *norm2_g, *router_w, *router_b, *w1, *b1, *w2, *b2, *final_g;
    float* out; unsigned char* ws;
};
#define WSP(type, off) ((type*)(F.ws + (off)))

typedef float f32x16 __attribute__((ext_vector_type(16)));
typedef __bf16 bf16x2_t __attribute__((ext_vector_type(2)));
__device__ __forceinline__ unsigned cvtpk(float lo, float hi) { f32x2 v = {lo, hi}; bf16x2_t b = __builtin_convertvector(v, bf16x2_t); return __builtin_bit_cast(unsigned, b); }
__device__ __forceinline__ int crow(int reg, int h) { return (reg & 3) + 8 * (reg >> 2) + 4 * h; }
__device__ __forceinline__ float bflo(unsigned u) { return __builtin_bit_cast(float, u << 16); }
__device__ __forceinline__ float bfhi(unsigned u) { return __builtin_bit_cast(float, u & 0xffff0000u); }
__device__ __forceinline__ bf16x8 pack_step(const f32x16& x, int s) {
    u32x4 p; p.x = cvtpk(x[8 * s], x[8 * s + 1]); p.y = cvtpk(x[8 * s + 2], x[8 * s + 3]); p.z = cvtpk(x[8 * s + 4], x[8 * s + 5]); p.w = cvtpk(x[8 * s + 6], x[8 * s + 7]);
    return __builtin_bit_cast(bf16x8, p);
}
#define MFMA32(a, b, c) __builtin_amdgcn_mfma_f32_32x32x16_bf16((a), (b), (c), 0, 0, 0)
#define MFMA16(a, b, c) __builtin_amdgcn_mfma_f32_16x16x32_bf16((a), (b), (c), 0, 0, 0)

__device__ __forceinline__ void p_hgrn_prep(Frame& F) {
    constexpr int GP = 132, QP = 136, VP = 72, AP = 72;
    LAS float* Gs = (LAS float*)F.lds;
    LAS bf16_t* Qs = (LAS bf16_t*)(F.lds + 33792);
    LAS bf16_t* Ks = (LAS bf16_t*)(F.lds + 33792 + 17408);
    LAS bf16_t* Vt = (LAS bf16_t*)(F.lds + 33792 + 2 * 17408);
    LAS bf16_t* At = (LAS bf16_t*)(F.lds + 33792 + 2 * 17408 + 18432);
    LAS float* Tot = (LAS float*)(F.lds + 96256);
    LAS float* Bl = Tot + 8 * 128;
    const bf16_t* HQ = WSP(bf16_t, WS_HQ); const float* G = WSP(float, WS_G); const bf16_t* KK = WSP(bf16_t, WS_KK); const bf16_t* HI = WSP(bf16_t, WS_HI);
    bf16_t* QF = WSP(bf16_t, WS_QF); bf16_t* KF = WSP(bf16_t, WS_KF); bf16_t* VF = WSP(bf16_t, WS_VF); bf16_t* INTRA = WSP(bf16_t, WS_INTRA); float* DEC = WSP(float, WS_DEC);
    const int tid = F.tid, lane = F.lane, w = F.wave, r = lane & 31, h = lane >> 5, fr = lane & 15, fq = lane >> 4;
    for (int ch = blockIdx.x; ch < BATCH * 4 * 32; ch += F.G) {
        const int bh = ch >> 5, c = ch & 31, b = bh >> 2, hd = bh & 3;
        const size_t t0 = (size_t)b * SEQ + 64 * c; const int col0 = hd * 128;
#pragma unroll
        for (int i = 0; i < 4; ++i) { const int idx = tid + 512 * i, row = idx >> 5, c4 = idx & 31; *(LAS f32x4*)(Gs + row * GP + 4 * c4) = *(const f32x4*)(G + (t0 + row) * HKW + col0 + 4 * c4); }
#pragma unroll
        for (int i = 0; i < 2; ++i) { const int idx = tid + 512 * i, row = idx >> 4, c8 = idx & 15; const size_t go = (t0 + row) * HKW + col0 + 8 * c8;
            *(LAS u32x4*)(Qs + row * QP + 8 * c8) = *(const u32x4*)(HQ + go); *(LAS u32x4*)(Ks + row * QP + 8 * c8) = *(const u32x4*)(KK + go);
            const u32x4 vv = *(const u32x4*)(HI + go);
#pragma unroll
            for (int q = 0; q < 4; ++q) { Vt[(8 * c8 + 2 * q) * VP + row] = (bf16_t)(vv[q] & 0xffffu); Vt[(8 * c8 + 2 * q + 1) * VP + row] = (bf16_t)(vv[q] >> 16); } }
        for (int i = tid; i < 64 * AP / 8; i += 512) *(LAS u32x4*)(At + 8 * i) = (u32x4){0u, 0u, 0u, 0u};
        __syncthreads();
#pragma unroll
        for (int q = 0; q < 2; ++q) { const int kk = lane + 64 * q; float run = 0.f;
#pragma unroll
            for (int i = 0; i < 8; ++i) { run += Gs[(8 * w + i) * GP + kk]; Gs[(8 * w + i) * GP + kk] = run; }
            Tot[w * 128 + kk] = run; }
        __syncthreads();
#pragma unroll
        for (int q = 0; q < 2; ++q) { const int kk = lane + 64 * q; float off = 0.f, tot = 0.f;
#pragma unroll
            for (int i = 0; i < 8; ++i) { const float tv = Tot[i * 128 + kk]; tot += tv; if (i < w) off += tv; }
#pragma unroll
            for (int i = 0; i < 8; ++i) Gs[(8 * w + i) * GP + kk] += off;
            if (w == 0) Bl[kk] = tot; }
        __syncthreads();
#pragma unroll
        for (int q = 0; q < 2; ++q) {
            const int f = w + 8 * q;
            {
                const int tt = f >> 3, kt = (f >> 1) & 3, ks = f & 1, t = 32 * tt + r, kb = 32 * kt + 16 * ks + 4 * h;
                const u32x2 qa = *(const LAS u32x2*)(Qs + t * QP + kb), qb = *(const LAS u32x2*)(Qs + t * QP + kb + 8);
                const f32x4 ba = *(const LAS f32x4*)(Gs + t * GP + kb), bb = *(const LAS f32x4*)(Gs + t * GP + kb + 8);
                u32x4 o; o.x = cvtpk(bflo(qa.x) * __expf(ba[0]), bfhi(qa.x) * __expf(ba[1])); o.y = cvtpk(bflo(qa.y) * __expf(ba[2]), bfhi(qa.y) * __expf(ba[3]));
                o.z = cvtpk(bflo(qb.x) * __expf(bb[0]), bfhi(qb.x) * __expf(bb[1])); o.w = cvtpk(bflo(qb.y) * __expf(bb[2]), bfhi(qb.y) * __expf(bb[3]));
                *(u32x4*)(QF + (((size_t)ch * 16 + f) * 64 + lane) * 8) = o;
            }
            {
                const int kt = f >> 2, ss = f & 3, kc = 32 * kt + r, s0 = 16 * ss + 8 * h; const float bl = Bl[kc];
                float v[8];
#pragma unroll
                for (int j = 0; j < 8; ++j) v[j] = bf2f(Ks[(s0 + j) * QP + kc]) * __expf(bl - Gs[(s0 + j) * GP + kc]);
                u32x4 o; o.x = cvtpk(v[0], v[1]); o.y = cvtpk(v[2], v[3]); o.z = cvtpk(v[4], v[5]); o.w = cvtpk(v[6], v[7]);
                *(u32x4*)(KF + (((size_t)ch * 16 + f) * 64 + lane) * 8) = o;
            }
            {
                const int ss = f >> 2, dt = f & 3;
                *(u32x4*)(VF + (((size_t)ch * 16 + f) * 64 + lane) * 8) = *(const LAS u32x4*)(Vt + (32 * dt + r) * VP + 16 * ss + 8 * h);
            }
        }
        if (tid < 128) DEC[(size_t)ch * 128 + tid] = __expf(Bl[tid]);
        {
            const int i = w >> 1;
            for (int j = w & 1; j <= i; j += 2) {
                f32x4 acc = {0.f, 0.f, 0.f, 0.f};
                const int t = 16 * i + fr, s = 16 * j + fr;
#pragma unroll
                for (int k4 = 0; k4 < 4; ++k4) {
                    const int k0 = 32 * k4 + 8 * fq;
                    f32x4 r0 = {0.f, 0.f, 0.f, 0.f}, r1 = {0.f, 0.f, 0.f, 0.f};
                    if (i > 0) { r0 = *(const LAS f32x4*)(Gs + (16 * i - 1) * GP + k0); r1 = *(const LAS f32x4*)(Gs + (16 * i - 1) * GP + k0 + 4); }
                    const u32x4 q8 = *(const LAS u32x4*)(Qs + t * QP + k0), k8 = *(const LAS u32x4*)(Ks + s * QP + k0);
                    const f32x4 bt0 = *(const LAS f32x4*)(Gs + t * GP + k0), bt1 = *(const LAS f32x4*)(Gs + t * GP + k0 + 4);
                    const f32x4 bs0 = *(const LAS f32x4*)(Gs + s * GP + k0), bs1 = *(const LAS f32x4*)(Gs + s * GP + k0 + 4);
                    u32x4 a, bb;
                    a.x = cvtpk(bflo(q8.x) * __expf(bt0[0] - r0[0]), bfhi(q8.x) * __expf(bt0[1] - r0[1])); a.y = cvtpk(bflo(q8.y) * __expf(bt0[2] - r0[2]), bfhi(q8.y) * __expf(bt0[3] - r0[3]));
                    a.z = cvtpk(bflo(q8.z) * __expf(bt1[0] - r1[0]), bfhi(q8.z) * __expf(bt1[1] - r1[1])); a.w = cvtpk(bflo(q8.w) * __expf(bt1[2] - r1[2]), bfhi(q8.w) * __expf(bt1[3] - r1[3]));
                    bb.x = cvtpk(bflo(k8.x) * __expf(r0[0] - bs0[0]), bfhi(k8.x) * __expf(r0[1] - bs0[1])); bb.y = cvtpk(bflo(k8.y) * __expf(r0[2] - bs0[2]), bfhi(k8.y) * __expf(r0[3] - bs0[3]));
                    bb.z = cvtpk(bflo(k8.z) * __expf(r1[0] - bs1[0]), bfhi(k8.z) * __expf(r1[1] - bs1[1])); bb.w = cvtpk(bflo(k8.w) * __expf(r1[2] - bs1[2]), bfhi(k8.w) * __expf(r1[3] - bs1[3]));
                    acc = MFMA16(__builtin_bit_cast(bf16x8, a), __builtin_bit_cast(bf16x8, bb), acc);
                }
#pragma unroll
                for (int q = 0; q < 4; ++q) { const float v = (j < i || (4 * fq + q) >= fr) ? acc[q] : 0.f; At[(16 * i + 4 * fq + q) * AP + 16 * j + fr] = f2bf(v); }
            }
        }
        __syncthreads();
        {
            const int tt = w & 1, dt = w >> 1;
            f32x16 acc;
#pragma unroll
            for (int q = 0; q < 16; ++q) acc[q] = 0.f;
#pragma unroll
            for (int ss = 0; ss < 4; ++ss) if (ss < 2 * (tt + 1)) {
                const bf16x8 a = *(const LAS bf16x8*)(At + (32 * tt + r) * AP + 16 * ss + 8 * h), bv = *(const LAS bf16x8*)(Vt + (32 * dt + r) * VP + 16 * ss + 8 * h);
                acc = MFMA32(a, bv, acc);
            }
#pragma unroll
            for (int q = 0; q < 16; ++q) INTRA[(t0 + 32 * tt + crow(q, h)) * HW + col0 + 32 * dt + r] = f2bf(acc[q]);
        }
        __syncthreads();
    }
}

constexpr int SC_OPB = 0, SC_OBUF = 65536, SC_OBP = 132, SC_OBB = 64 * SC_OBP * 4, SC_DEC = SC_OBUF + 2 * SC_OBB;
__device__ __forceinline__ void scan_unit(Frame& F, int bh) {
    const bf16_t* QF = WSP(bf16_t, WS_QF); const bf16_t* KF = WSP(bf16_t, WS_KF); const bf16_t* VF = WSP(bf16_t, WS_VF); const bf16_t* INTRA = WSP(bf16_t, WS_INTRA); const float* DEC = WSP(float, WS_DEC);
    const bf16_t* HG = WSP(bf16_t, WS_HG); bf16_t* MIX = WSP(bf16_t, WS_MIX);
    const int tid = F.tid, lane = F.lane, w = F.wave, r = lane & 31, h = lane >> 5, tt = w & 1, d = w >> 1, b = bh >> 2, hd = bh & 3;
    LAS unsigned char* lds = F.lds;
    f32x16 S[4];
#pragma unroll
    for (int kt = 0; kt < 4; ++kt)
#pragma unroll
        for (int q = 0; q < 16; ++q) S[kt][q] = 0.f;
#define SC_DMA(c_) do { const size_t chn = (size_t)bh * 32 + (c_); const int slot = ((c_) & 1) * 32768; _Pragma("unroll") for (int i_ = 0; i_ < 2; ++i_) { \
        __builtin_amdgcn_global_load_lds((const unsigned*)(QF + ((chn * 16 + 2 * w + i_) * 64 + lane) * 8), (LAS unsigned*)(lds + SC_OPB + slot + (2 * w + i_) * 1024), 16, 0, 0); \
        __builtin_amdgcn_global_load_lds((const unsigned*)(KF + ((chn * 16 + 2 * w + i_) * 64 + lane) * 8), (LAS unsigned*)(lds + SC_OPB + slot + 16384 + (2 * w + i_) * 1024), 16, 0, 0); } \
        } while (0)
#define SC_DEC_LD(c_) (*(const f32x4*)(DEC + ((size_t)bh * 32 + (c_)) * 128 + (tid & 31) * 4))
#define SC_DEC_ST(c_, v_) do { if (tid < 32) *(LAS f32x4*)(lds + SC_DEC + ((c_) & 1) * 512 + tid * 16) = (v_); } while (0)
    bf16x8 Vf[4], Vn[4];
#pragma unroll
    for (int ss = 0; ss < 4; ++ss) Vf[ss] = *(const bf16x8*)(VF + ((((size_t)bh * 32) * 16 + ss * 4 + d) * 64 + lane) * 8);
    SC_DMA(0);
    { const f32x4 dv0 = SC_DEC_LD(0); SC_DEC_ST(0, dv0); }
    __syncthreads();
    const int ft = tid >> 3, fs = tid & 7;
    const int ocol = hd * 128 + 16 * fs;
    for (int c = 0; c < 32; ++c) {
        const int slot = (c & 1) * 32768;
        f32x4 dnext = {0.f, 0.f, 0.f, 0.f};
        if (c + 1 < 32) {
            SC_DMA(c + 1);
            dnext = SC_DEC_LD(c + 1);
#pragma unroll
            for (int ss = 0; ss < 4; ++ss) Vn[ss] = *(const bf16x8*)(VF + ((((size_t)bh * 32 + c + 1) * 16 + ss * 4 + d) * 64 + lane) * 8);
        }
        const size_t trow = (size_t)b * SEQ + 64 * c + ft;
        const u32x4 in0 = *(const u32x4*)(INTRA + trow * HW + ocol), in1 = *(const u32x4*)(INTRA + trow * HW + ocol + 8);
        const u32x4 hg0 = *(const u32x4*)(HG + trow * HW + ocol), hg1 = *(const u32x4*)(HG + trow * HW + ocol + 8);
        f32x16 P;
#pragma unroll
        for (int q = 0; q < 16; ++q) P[q] = 0.f;
#pragma unroll
        for (int kt = 0; kt < 4; ++kt)
#pragma unroll
            for (int ks = 0; ks < 2; ++ks) {
                const bf16x8 qf = *(const LAS bf16x8*)(lds + SC_OPB + slot + ((tt * 4 + kt) * 2 + ks) * 1024 + lane * 16);
                P = MFMA32(qf, pack_step(S[kt], ks), P);
            }
        {   LAS float* ob = (LAS float*)(lds + SC_OBUF + (c & 1) * SC_OBB);
#pragma unroll
            for (int q = 0; q < 16; ++q) ob[(32 * tt + crow(q, h)) * SC_OBP + 32 * d + r] = P[q]; }
#pragma unroll
        for (int kt = 0; kt < 4; ++kt) {
#pragma unroll
            for (int g = 0; g < 4; ++g) { const f32x4 dc = *(const LAS f32x4*)(lds + SC_DEC + (c & 1) * 512 + (32 * kt + 8 * g + 4 * h) * 4);
#pragma unroll
                for (int q = 0; q < 4; ++q) S[kt][4 * g + q] *= dc[q]; }
#pragma unroll
            for (int ss = 0; ss < 4; ++ss) {
                const bf16x8 kf = *(const LAS bf16x8*)(lds + SC_OPB + slot + 16384 + (kt * 4 + ss) * 1024 + lane * 16);
                S[kt] = MFMA32(kf, Vf[ss], S[kt]);
            }
        }
        SC_DEC_ST(c + 1, dnext);
        __syncthreads();
        {
            const LAS float* ob = (const LAS float*)(lds + SC_OBUF + (c & 1) * SC_OBB) + ft * SC_OBP + 16 * fs;
            const f32x4 p0 = *(const LAS f32x4*)ob, p1 = *(const LAS f32x4*)(ob + 4), p2 = *(const LAS f32x4*)(ob + 8), p3 = *(const LAS f32x4*)(ob + 12);
            float o[16];
            o[0] = p0[0] + bflo(in0.x); o[1] = p0[1] + bfhi(in0.x); o[2] = p0[2] + bflo(in0.y); o[3] = p0[3] + bfhi(in0.y);
            o[4] = p1[0] + bflo(in0.z); o[5] = p1[1] + bfhi(in0.z); o[6] = p1[2] + bflo(in0.w); o[7] = p1[3] + bfhi(in0.w);
            o[8] = p2[0] + bflo(in1.x); o[9] = p2[1] + bfhi(in1.x); o[10] = p2[2] + bflo(in1.y); o[11] = p2[3] + bfhi(in1.y);
            o[12] = p3[0] + bflo(in1.z); o[13] = p3[1] + bfhi(in1.z); o[14] = p3[2] + bflo(in1.w); o[15] = p3[3] + bfhi(in1.w);
            float ss2 = 0.f;
#pragma unroll
            for (int q = 0; q < 16; ++q) ss2 += o[q] * o[q];
            ss2 += __shfl_xor(ss2, 1); ss2 += __shfl_xor(ss2, 2); ss2 += __shfl_xor(ss2, 4);
            const float rs = rsqrtf(ss2 * (1.f / 128.f) + EPS);
            const float* gh = F.hgrn_g + ocol;
            const unsigned hgw[8] = {hg0.x, hg0.y, hg0.z, hg0.w, hg1.x, hg1.y, hg1.z, hg1.w};
            unsigned ow[8];
#pragma unroll
            for (int q = 0; q < 8; ++q) ow[q] = cvtpk(o[2 * q] * rs * gh[2 * q] * bflo(hgw[q]), o[2 * q + 1] * rs * gh[2 * q + 1] * bfhi(hgw[q]));
            bf16_t* mo = MIX + trow * MIXW + AW + ocol;
            *(u32x4*)mo = (u32x4){ow[0], ow[1], ow[2], ow[3]}; *(u32x4*)(mo + 8) = (u32x4){ow[4], ow[5], ow[6], ow[7]};
        }
#pragma unroll
        for (int ss = 0; ss < 4; ++ss) Vf[ss] = Vn[ss];
    }
    __syncthreads();
#undef SC_DMA
#undef SC_DEC_LD
#undef SC_DEC_ST
}

constexpr int AT_KP = 72, AT_VP = 260;
__device__ __forceinline__ void attn_stage(Frame& F, int kvh, int n, size_t t0, LAS bf16_t* Ks, LAS bf16_t* Vt) {
    const bf16_t* AK = WSP(bf16_t, WS_AK); const bf16_t* AV = WSP(bf16_t, WS_AV);
    __syncthreads();
    int tid_ = F.tid; asm volatile("" : "+v"(tid_));
#pragma unroll
    for (int i = 0; i < 4; ++i) {
        const int idx = tid_ + 512 * i, row = idx >> 3, c8 = idx & 7;
        u32x4 kv = {0u, 0u, 0u, 0u}, vv = {0u, 0u, 0u, 0u};
        if (n > 0 || row >= 128) { const size_t go = (t0 - 128 + row) * AKW + kvh * 64 + 8 * c8; kv = *(const u32x4*)(AK + go); vv = *(const u32x4*)(AV + go); }
        *(LAS u32x4*)(Ks + row * AT_KP + 8 * c8) = kv;
#pragma unroll
        for (int q = 0; q < 4; ++q) { Vt[(8 * c8 + 2 * q) * AT_VP + row] = (bf16_t)(vv[q] & 0xffffu); Vt[(8 * c8 + 2 * q + 1) * AT_VP + row] = (bf16_t)(vv[q] >> 16); }
    }
    __syncthreads();
}
__device__ __forceinline__ void attn_item(Frame& F, int hq, int rt, int n, size_t t0, const LAS bf16_t* Ks, const LAS bf16_t* Vt, LAS float* ssq, unsigned (&okp)[16]) {
    const bf16_t* AQ = WSP(bf16_t, WS_AQ);
    int lane = F.lane; asm volatile("" : "+v"(lane));
    const int r = lane & 31, h = lane >> 5;
    constexpr float L2E = 1.4426950408889634f;
    const float slope2 = exp2f(-(float)(hq + 1)) * L2E, sink2 = F.sinks[hq] * L2E;
    bf16x8 qf[4];
#pragma unroll
    for (int ds = 0; ds < 4; ++ds) qf[ds] = *(const bf16x8*)(AQ + (t0 + 32 * rt + r) * AW + hq * 64 + 16 * ds + 8 * h);
    float m = sink2;
#define AT_SCORE(SC, j) do { const int kt = rt + (j); int rq = r - 32 * (j); asm volatile("" : "+v"(rq));     \
        _Pragma("unroll") for (int q = 0; q < 16; ++q) SC[q] = 0.f; \
        _Pragma("unroll") for (int ds = 0; ds < 4; ++ds) SC = MFMA32(*(const LAS bf16x8*)(Ks + (32 * kt + r) * AT_KP + 16 * ds + 8 * h), qf[ds], SC); \
        const bool tile_ok = (n > 0) || (kt >= 4); \
        _Pragma("unroll") for (int q = 0; q < 16; ++q) { const int dist = 128 + rq - crow(q, h); const float v = SC[q] * (0.125f * L2E) - slope2 * (float)dist; \
            SC[q] = (tile_ok && dist >= 0 && dist < 128) ? v : -INFINITY; } } while (0)
#pragma unroll
    for (int j = 0; j < 5; ++j) { f32x16 sc; AT_SCORE(sc, j);
#pragma unroll
        for (int q = 0; q < 16; ++q) m = fmaxf(m, sc[q]); }
    m = fmaxf(m, __shfl_xor(m, 32));
    float l = 0.f; unsigned pp[5][8];
#pragma unroll
    for (int j = 0; j < 5; ++j) { f32x16 sc; AT_SCORE(sc, j);
#pragma unroll
        for (int q = 0; q < 16; ++q) { sc[q] = exp2f(sc[q] - m); l += sc[q]; }
#pragma unroll
        for (int q = 0; q < 8; ++q) pp[j][q] = cvtpk(sc[2 * q], sc[2 * q + 1]); }
#undef AT_SCORE
    l += __shfl_xor(l, 32); l += exp2f(sink2 - m);
    const float rl = 1.f / l;
    float sq = 0.f;
#pragma unroll
    for (int dt = 0; dt < 2; ++dt) {
        f32x16 o;
#pragma unroll
        for (int q = 0; q < 16; ++q) o[q] = 0.f;
        const LAS bf16_t* vrow = Vt + (32 * dt + r) * AT_VP + 4 * h;
#pragma unroll
        for (int j = 0; j < 5; ++j)
#pragma unroll
            for (int s = 0; s < 2; ++s) { const LAS bf16_t* vp = vrow + 32 * (rt + j) + 16 * s;
                const u32x2 va = *(const LAS u32x2*)vp, vb = *(const LAS u32x2*)(vp + 8); const u32x4 pa = {va.x, va.y, vb.x, vb.y};
                const u32x4 pb = {pp[j][4 * s], pp[j][4 * s + 1], pp[j][4 * s + 2], pp[j][4 * s + 3]};
                o = MFMA32(__builtin_bit_cast(bf16x8, pa), __builtin_bit_cast(bf16x8, pb), o); }
#pragma unroll
        for (int q = 0; q < 16; ++q) { o[q] *= rl; sq += o[q] * o[q]; }
#pragma unroll
        for (int q = 0; q < 8; ++q) okp[dt * 8 + q] = cvtpk(o[2 * q], o[2 * q + 1]);
    }
    sq += __shfl_xor(sq, 32);
    if (h == 0) __hip_atomic_fetch_add(&ssq[32 * rt + r], sq, __ATOMIC_RELAXED, __HIP_MEMORY_SCOPE_WORKGROUP);
}
__device__ __forceinline__ void attn_store(Frame& F, int hq, int rt, size_t t0, const LAS float* ssq, const unsigned (&okp)[16]) {
    bf16_t* MIX = WSP(bf16_t, WS_MIX);
    int lane = F.lane; asm volatile("" : "+v"(lane));
    const int r = lane & 31, h = lane >> 5;
    const float rs = rsqrtf(ssq[32 * rt + r] * (1.f / AW) + EPS);
    bf16_t* mo = MIX + (t0 + 32 * rt + r) * MIXW + hq * 64;
#pragma unroll
    for (int dt = 0; dt < 2; ++dt)
#pragma unroll
        for (int g4 = 0; g4 < 4; ++g4) {
            const int d0 = 32 * dt + 8 * g4 + 4 * h; const f32x4 ga = *(const f32x4*)(F.attn_g + hq * 64 + d0);
            const unsigned p0 = okp[dt * 8 + 2 * g4], p1 = okp[dt * 8 + 2 * g4 + 1];
            u32x2 ow; ow.x = cvtpk(bflo(p0) * rs * ga[0], bfhi(p0) * rs * ga[1]); ow.y = cvtpk(bflo(p1) * rs * ga[2], bfhi(p1) * rs * ga[3]);
            *(u32x2*)(mo + d0) = ow;
        }
}
__device__ __forceinline__ void attn_unit(Frame& F, int u) {
    LAS bf16_t* Ks = (LAS bf16_t*)F.lds;
    LAS bf16_t* Vt = (LAS bf16_t*)(F.lds + 36864);
    LAS float* ssq = (LAS float*)(F.lds + 36864 + 33280);
    const int w = F.wave, b = u >> 4, n = u & 15; const size_t t0 = (size_t)b * SEQ + 128 * n;
    if (F.tid < 128) ssq[F.tid] = 0.f;
    const int g0 = (2 * w) >> 2, rt0 = (2 * w) & 3, g1 = (2 * w + 1) >> 2, rt1 = (2 * w + 1) & 3;
    unsigned ok0[16], ok1[16], ok2[16], ok3[16];
    attn_stage(F, 0, n, t0, Ks, Vt);
    attn_item(F, g0, rt0, n, t0, Ks, Vt, ssq, ok0);
    attn_item(F, g1, rt1, n, t0, Ks, Vt, ssq, ok1);
    attn_stage(F, 1, n, t0, Ks, Vt);
    attn_item(F, 4 + g0, rt0, n, t0, Ks, Vt, ssq, ok2);
    attn_item(F, 4 + g1, rt1, n, t0, Ks, Vt, ssq, ok3);
    __syncthreads();
    attn_store(F, g0, rt0, t0, ssq, ok0); attn_store(F, g1, rt1, t0, ssq, ok1); attn_store(F, 4 + g0, rt0, t0, ssq, ok2); attn_store(F, 4 + g1, rt1, t0, ssq, ok3);
    __syncthreads();
}
__device__ __forceinline__ void p_convert_experts(Frame& F, int rank, int nrank);
__device__ __forceinline__ void p_scan_attn(Frame& F, bool do_scan, bool do_attn) {
    const int G = F.G, bx = blockIdx.x, nscan = (do_scan && do_attn && G >= 64) ? 32 : 0;
    if (do_scan) { if (nscan) { if (bx < nscan) scan_unit(F, bx); } else for (int u = bx; u < BATCH * 4; u += G) scan_unit(F, u); }
    if (do_attn) { if (nscan) { for (int u = bx - nscan; u >= 0 && u < BATCH * 16; u += G - nscan) attn_unit(F, u); } else for (int u = bx; u < BATCH * 16; u += G) attn_unit(F, u); }
    if (nscan) { if (bx >= nscan) p_convert_experts(F, bx - nscan, G - nscan); } else p_convert_experts(F, bx, G);
}

__device__ __forceinline__ int w1col(int n) { const int pn = n >> 8, cl = n & 255; return cl < 128 ? 2 * (128 * pn + cl) : 2 * (128 * pn + cl - 128) + 1; }
template <bool W1MAP, bool FP8>
__device__ __forceinline__ void p0_transpose_item(const float* W, int K, int N, void* WTv, LAS float* scr, int item, int lane) {
    const int nblk = N / 32, kb = item / nblk, nb = item % nblk, k0 = 64 * kb, n0 = 32 * nb;
    const int sc = W1MAP ? w1col(n0 + (lane & 31)) : n0 + (lane & 31);
    float v[32];
#pragma unroll
    for (int i = 0; i < 32; ++i) v[i] = W[(size_t)(k0 + 2 * i + (lane >> 5)) * N + sc];
#pragma unroll
    for (int i = 0; i < 32; ++i) scr[(2 * i + (lane >> 5)) * 33 + (lane & 31)] = v[i];
    LDS_WAIT(); asm volatile("" ::: "memory");
    const int c = lane & 7;
#pragma unroll
    for (int j = 0; j < 4; ++j) { const int n = (lane >> 3) + 8 * j; const LAS float* s = scr + (8 * c) * 33 + n;
        if constexpr (FP8) { const f32x4 a = {s[0 * 33], s[1 * 33], s[2 * 33], s[3 * 33]}, b = {s[4 * 33], s[5 * 33], s[6 * 33], s[7 * 33]};
            *(GAS u32x2*)((unsigned char*)WTv + (size_t)(n0 + n) * K + k0 + 8 * c) = pg8::pack8_fp8(a * pg8::FP8_W_SCALE, b * pg8::FP8_W_SCALE); }
        else { u32x4 o; o.x = pg8::cvt_pk_bf16(s[0 * 33], s[1 * 33]); o.y = pg8::cvt_pk_bf16(s[2 * 33], s[3 * 33]); o.z = pg8::cvt_pk_bf16(s[4 * 33], s[5 * 33]); o.w = pg8::cvt_pk_bf16(s[6 * 33], s[7 * 33]);
            *(GAS u32x4*)((bf16_t*)WTv + (size_t)(n0 + n) * K + k0 + 8 * c) = o; } }
    LDS_WAIT(); asm volatile("" ::: "memory");
}
struct ConvItem { const float* W; unsigned char* WT; int N, k0, n0, map; };
__device__ __forceinline__ ConvItem conv_desc(Frame& F, int it) {
    constexpr int I_W1E = (DM / 128) * (2 * FF / 32), I_W2E = (FF / 128) * (DM / 32);
    ConvItem c;
    if (it < NE * I_W1E) { const int e = it / I_W1E, r = it % I_W1E, nblk = 2 * FF / 32; c.W = F.w1 + (size_t)e * DM * 2 * FF; c.WT = WSP(unsigned char, WS_W1T) + (size_t)e * 2 * FF * DM; c.N = 2 * FF; c.k0 = 128 * (r / nblk); c.n0 = 32 * (r % nblk); c.map = 1; }
    else { it -= NE * I_W1E; const int e = it / I_W2E, r = it % I_W2E, nblk = DM / 32; c.W = F.w2 + (size_t)e * FF * DM; c.WT = WSP(unsigned char, WS_W2T) + (size_t)e * DM * FF; c.N = DM; c.k0 = 128 * (r / nblk); c.n0 = 32 * (r % nblk); c.map = 0; }
    return c;
}
__device__ __forceinline__ void conv_item(const ConvItem& c, int lane, LAS float* scr) {
    const int sc = c.map ? w1col(c.n0 + (lane & 31)) : c.n0 + (lane & 31);
    const float* p = c.W + (size_t)(c.k0 + (lane >> 5)) * c.N + sc;
    float v[64];
#pragma unroll
    for (int i = 0; i < 64; ++i) v[i] = p[(size_t)(2 * i) * c.N];
#pragma unroll
    for (int i = 0; i < 64; ++i) scr[(2 * i + (lane >> 5)) * 33 + (lane & 31)] = v[i];
    LDS_WAIT(); asm volatile("" ::: "memory");
    const int cg = lane & 15;
#pragma unroll
    for (int j = 0; j < 8; ++j) { const int n = (lane >> 4) + 4 * j; const LAS float* s = scr + (8 * cg) * 33 + n;
        const f32x4 a = {s[0 * 33], s[1 * 33], s[2 * 33], s[3 * 33]}, b = {s[4 * 33], s[5 * 33], s[6 * 33], s[7 * 33]};
        *(GAS u32x2*)(c.WT + (size_t)(c.n0 + n) * DM + c.k0 + 8 * cg) = pg8::pack8_fp8(a * pg8::FP8_W_SCALE, b * pg8::FP8_W_SCALE); }
    LDS_WAIT(); asm volatile("" ::: "memory");
}
__device__ __forceinline__ void p_convert_experts(Frame& F, int rank, int nrank) {
    static_assert(DM == FF && RING_BYTES >= NWAVES * 128 * 33 * 4, "conv_item assumes K = 1024 for both expert matrices and a 16.5 KiB LDS tile per wave");
    LAS float* scr = (LAS float*)(F.lds + RING_OFF + F.wave * (128 * 33 * 4));
    constexpr int NITEMS = NE * (DM / 128) * (2 * FF / 32) + NE * (FF / 128) * (DM / 32);
    __syncthreads();
    for (int it = rank * NWAVES + F.wave; it < NITEMS; it += nrank * NWAVES) { const ConvItem c = conv_desc(F, it); conv_item(c, F.lane, scr); }
}
__device__ __forceinline__ void p_prologue(Frame& F) {
    LAS float* scr = (LAS float*)(F.lds + RING_OFF + F.wave * 16384);
    const int gw = F.vcu * NWAVES + F.wave, NGW = F.G * NWAVES;
    constexpr int I_IN = (DM / 64) * (INW / 32), I_OUT = (MIXW / 64) * (DM / 32), I_W1E = (DM / 64) * (2 * FF / 32), I_W2E = (FF / 64) * (DM / 32);
    constexpr int NITEMS = I_IN + I_OUT;
    bf16_t *WinT = WSP(bf16_t, WS_WINT), *WoutT = WSP(bf16_t, WS_WOUTT);
    for (int it = gw; it < NITEMS; it += NGW) {
        int r = it;
        if (r < I_IN) { p0_transpose_item<false, false>(F.w_in, DM, INW, WinT, scr, r, F.lane); continue; } r -= I_IN;
        p0_transpose_item<false, false>(F.w_out, MIXW, DM, WoutT, scr, r, F.lane);
    }
    bf16_t* XN = WSP(bf16_t, WS_XN);
    for (int m = gw; m < T; m += NGW) {
        const GAS f32x4* xr = (const GAS f32x4*)(F.x + (size_t)m * DM) + F.lane;
        f32x4 v[4]; float s = 0.f;
#pragma unroll
        for (int j = 0; j < 4; ++j) { v[j] = xr[64 * j]; s += (v[j].x * v[j].x + v[j].y * v[j].y) + (v[j].z * v[j].z + v[j].w * v[j].w); }
        const float r = rsqrtf(wave_sum(s) * (1.f / DM) + EPS);
        GAS u32x2* o8 = (GAS u32x2*)(XN + (size_t)m * DM) + F.lane;
#pragma unroll
        for (int j = 0; j < 4; ++j) { const f32x4 g = *((const f32x4*)F.norm1_g + F.lane + 64 * j); u32x2 w; w.x = pg8::cvt_pk_bf16(v[j].x * r * g.x, v[j].y * r * g.y); w.y = pg8::cvt_pk_bf16(v[j].z * r * g.z, v[j].w * r * g.w); o8[64 * j] = w; }
    }
    if ((int)blockIdx.x == (F.G > 1 ? 1 : 0)) {
        bf16_t* RWF = WSP(bf16_t, WS_RWF);
        for (int i = F.tid; i < 64 * 64; i += NWAVES * 64) { const int ks = i >> 6, ln = i & 63, rr = ln & 31, hh = ln >> 5; float v[8];
#pragma unroll
            for (int j = 0; j < 8; ++j) v[j] = F.router_w[(size_t)(16 * ks + 8 * hh + j) * NE + rr];
            u32x4 hi, lo; hi.x = cvtpk(v[0], v[1]); hi.y = cvtpk(v[2], v[3]); hi.z = cvtpk(v[4], v[5]); hi.w = cvtpk(v[6], v[7]);
            lo.x = cvtpk(v[0] - bflo(hi.x), v[1] - bfhi(hi.x)); lo.y = cvtpk(v[2] - bflo(hi.y), v[3] - bfhi(hi.y)); lo.z = cvtpk(v[4] - bflo(hi.z), v[5] - bfhi(hi.z)); lo.w = cvtpk(v[6] - bflo(hi.w), v[7] - bfhi(hi.w));
            *(u32x4*)(RWF + ((size_t)(ks * 2 + 0) * 64 + ln) * 8) = hi; *(u32x4*)(RWF + ((size_t)(ks * 2 + 1) * 64 + ln) * 8) = lo; }
    }
    if (blockIdx.x == 0) { float* LB = WSP(float, WS_LB); for (int c = F.tid; c < HKW; c += NWAVES * 64) { const float a = F.lb_logits[c], b = F.lb_logits[HKW + c]; LB[c] = 1.f / (1.f + __expf(b - a)); } }
}

__device__ __forceinline__ void p_router(Frame& F) {
    LAS int* lcnt = (LAS int*)(F.lds + MOE_OFF + 512); LAS int* lbase = (LAS int*)(F.lds + MOE_OFF + 768);
    LAS float* part = (LAS float*)F.lds;
    LAS float* ssqp = (LAS float*)(F.lds + 32768);
    const float* X1 = WSP(float, WS_X1); unsigned char* H2 = WSP(unsigned char, WS_H2); float* GATE = WSP(float, WS_GATE); int* LIST = WSP(int, WS_LIST); float* RSTD = WSP(float, WS_RSTD);
    const bf16_t* RWF = WSP(bf16_t, WS_RWF);
    int* cnt = (int*)(F.ctl + CW_CNT);
    const int lane = F.lane, w = F.wave, r = lane & 31, h = lane >> 5, tile = w & 1, kq = w >> 1;
    for (int tb = blockIdx.x; tb < T / 64; tb += F.G) {
        if (F.tid < NE) lcnt[F.tid] = 0;
        const int t = tb * 64 + tile * 32 + r;
        f32x16 acc;
#pragma unroll
        for (int q = 0; q < 16; ++q) acc[q] = 0.f;
        float ssq = 0.f;
#pragma unroll 4
        for (int ks = 16 * kq; ks < 16 * kq + 16; ++ks) {
            const int k0 = 16 * ks + 8 * h;
            const f32x4 x0 = *(const f32x4*)(X1 + (size_t)t * DM + k0), x1v = *(const f32x4*)(X1 + (size_t)t * DM + k0 + 4);
            const f32x4 g0 = *(const f32x4*)(F.norm2_g + k0), g1 = *(const f32x4*)(F.norm2_g + k0 + 4);
            const u32x4 ahi = *(const u32x4*)(RWF + ((size_t)(ks * 2 + 0) * 64 + lane) * 8), alo = *(const u32x4*)(RWF + ((size_t)(ks * 2 + 1) * 64 + lane) * 8);
            float u[8];
#pragma unroll
            for (int q = 0; q < 4; ++q) { u[q] = x0[q] * g0[q]; u[4 + q] = x1v[q] * g1[q]; ssq += x0[q] * x0[q]; ssq += x1v[q] * x1v[q]; }
            u32x4 bh, bl;
            bh.x = cvtpk(u[0], u[1]); bh.y = cvtpk(u[2], u[3]); bh.z = cvtpk(u[4], u[5]); bh.w = cvtpk(u[6], u[7]);
            bl.x = cvtpk(u[0] - bflo(bh.x), u[1] - bfhi(bh.x)); bl.y = cvtpk(u[2] - bflo(bh.y), u[3] - bfhi(bh.y));
            bl.z = cvtpk(u[4] - bflo(bh.z), u[5] - bfhi(bh.z)); bl.w = cvtpk(u[6] - bflo(bh.w), u[7] - bfhi(bh.w));
            *(u32x2*)(H2 + (size_t)t * DM + k0) = pg8::pack8_fp8((f32x4){u[0], u[1], u[2], u[3]} * pg8::FP8_ACT_SCALE, (f32x4){u[4], u[5], u[6], u[7]} * pg8::FP8_ACT_SCALE);
            acc = MFMA32(__builtin_bit_cast(bf16x8, ahi), __builtin_bit_cast(bf16x8, bh), acc);
            acc = MFMA32(__builtin_bit_cast(bf16x8, alo), __builtin_bit_cast(bf16x8, bh), acc);
            acc = MFMA32(__builtin_bit_cast(bf16x8, ahi), __builtin_bit_cast(bf16x8, bl), acc);
        }
#pragma unroll
        for (int q = 0; q < 4; ++q) *(LAS f32x4*)(part + (w * 64 + lane) * 16 + 4 * q) = (f32x4){acc[4 * q], acc[4 * q + 1], acc[4 * q + 2], acc[4 * q + 3]};
        ssqp[w * 64 + lane] = ssq;
        __syncthreads();
        int my_e[TOPK], my_p[TOPK];
#pragma unroll
        for (int k = 0; k < TOPK; ++k) { my_e[k] = 0; my_p[k] = 0; }
        if (w < 2) {
            float lg[16];
#pragma unroll
            for (int q = 0; q < 16; ++q) lg[q] = 0.f;
            float s2 = 0.f;
#pragma unroll
            for (int k4 = 0; k4 < 4; ++k4) { const int ww = k4 * 2 + tile;
#pragma unroll
                for (int q = 0; q < 4; ++q) { const f32x4 p = *(const LAS f32x4*)(part + (ww * 64 + lane) * 16 + 4 * q); lg[4 * q] += p[0]; lg[4 * q + 1] += p[1]; lg[4 * q + 2] += p[2]; lg[4 * q + 3] += p[3]; }
                s2 += ssqp[ww * 64 + lane] + ssqp[ww * 64 + (lane ^ 32)]; }
            const float rstd = rsqrtf(s2 * (1.f / DM) + EPS);
#pragma unroll
            for (int q = 0; q < 16; ++q) lg[q] = lg[q] * rstd + F.router_b[crow(q, h)];
            float cv[8]; int ci[8];
#pragma unroll
            for (int k = 0; k < TOPK; ++k) {
                float bv = -INFINITY; int bi = 1 << 20;
#pragma unroll
                for (int q = 0; q < 16; ++q) { const int e = crow(q, h); const bool better = (lg[q] > bv) || (lg[q] == bv && e < bi); bv = better ? lg[q] : bv; bi = better ? e : bi; }
#pragma unroll
                for (int q = 0; q < 16; ++q) if (crow(q, h) == bi) lg[q] = -INFINITY;
                cv[k] = bv; ci[k] = bi;
            }
#pragma unroll
            for (int k = 0; k < TOPK; ++k) { cv[4 + k] = __shfl_xor(cv[k], 32); ci[4 + k] = __shfl_xor(ci[k], 32); }
            float tv[TOPK]; int te[TOPK];
#pragma unroll
            for (int k = 0; k < TOPK; ++k) {
                float bv = -INFINITY; int bi = 1 << 20;
#pragma unroll
                for (int q = 0; q < 8; ++q) { const bool better = (cv[q] > bv) || (cv[q] == bv && ci[q] < bi); bv = better ? cv[q] : bv; bi = better ? ci[q] : bi; }
#pragma unroll
                for (int q = 0; q < 8; ++q) if (ci[q] == bi) cv[q] = -INFINITY;
                tv[k] = bv; te[k] = bi;
            }
            const float e1 = __expf(tv[1] - tv[0]), e2 = __expf(tv[2] - tv[0]), e3 = __expf(tv[3] - tv[0]), inv = 1.f / (1.f + e1 + e2 + e3);
            if (h == 0) {
                RSTD[t] = rstd;
                *(f32x4*)(GATE + (size_t)t * TOPK) = (f32x4){inv, e1 * inv, e2 * inv, e3 * inv};
#pragma unroll
                for (int k = 0; k < TOPK; ++k) { my_e[k] = te[k]; my_p[k] = __hip_atomic_fetch_add(&lcnt[te[k]], 1, __ATOMIC_RELAXED, __HIP_MEMORY_SCOPE_WORKGROUP); }
            }
        }
        __syncthreads();
        if (F.tid < NE) lbase[F.tid] = atomicAdd(&cnt[F.tid], (int)lcnt[F.tid]);
        __syncthreads();
        if (w < 2 && h == 0) {
#pragma unroll
            for (int k = 0; k < TOPK; ++k) LIST[(size_t)my_e[k] * T + lbase[my_e[k]] + my_p[k]] = t * TOPK + k;
        }
        __syncthreads();
    }
}
__device__ __forceinline__ void moe_setup(Frame& F) {
    LAS int* pre = (LAS int*)(F.lds + MOE_OFF); LAS int* lc = (LAS int*)(F.lds + MOE_OFF + 256);
    if (F.tid < 64) {
        const int c = F.lane < NE ? (int)__hip_atomic_load((int*)(F.ctl + CW_CNT) + F.lane, RLX_AGENT) : 0;
        int s = (c + 255) >> 8;
#pragma unroll
        for (int o = 1; o < 32; o <<= 1) { const int v = __shfl_up(s, o); if ((F.lane & 31) >= o) s += v; }
        if (F.lane < NE) { pre[F.lane + 1] = s; lc[F.lane] = c; }
        if (F.lane == 0) pre[0] = 0;
    }
    __syncthreads();
}
__device__ __forceinline__ void p_final(Frame& F) {
    const float* X1 = WSP(float, WS_X1); const bf16_t* Y = WSP(bf16_t, WS_Y);
    const int gw = F.vcu * NWAVES + F.wave, NGW = F.G * NWAVES;
    for (int t = gw; t < T; t += NGW) {
        const GAS f32x4* xr = (const GAS f32x4*)(X1 + (size_t)t * DM) + F.lane;
        f32x4 v[4]; float s = 0.f;
#pragma unroll
        for (int j = 0; j < 4; ++j) {
            v[j] = xr[64 * j];
#pragma unroll
            for (int k = 0; k < TOPK; ++k) { const u32x2 y = *((const GAS u32x2*)(Y + ((size_t)t * TOPK + k) * DM) + F.lane + 64 * j);
                v[j].x += __builtin_bit_cast(float, y.x << 16); v[j].y += __builtin_bit_cast(float, y.x & 0xffff0000u); v[j].z += __builtin_bit_cast(float, y.y << 16); v[j].w += __builtin_bit_cast(float, y.y & 0xffff0000u); }
            s += (v[j].x * v[j].x + v[j].y * v[j].y) + (v[j].z * v[j].z + v[j].w * v[j].w);
        }
        const float r = rsqrtf(wave_sum(s) * (1.f / DM) + EPS);
        GAS f32x4* o = (GAS f32x4*)(F.out + (size_t)t * DM) + F.lane;
#pragma unroll
        for (int j = 0; j < 4; ++j) { const f32x4 g = *((const f32x4*)F.final_g + F.lane + 64 * j); o[64 * j] = (f32x4){v[j].x * r * g.x, v[j].y * r * g.y, v[j].z * r * g.z, v[j].w * r * g.w}; }
    }
}


__device__ __forceinline__ void p_attn_simple(Frame& F) {
    const bf16_t* AQ = WSP(bf16_t, WS_AQ); const bf16_t* AK = WSP(bf16_t, WS_AK); const bf16_t* AV = WSP(bf16_t, WS_AV); float* ATT = WSP(float, WS_ATT);
    const int gw0 = F.vcu * NWAVES + F.wave, NGW = F.G * NWAVES, lane = F.lane;
    for (int gw = gw0; gw < T * 8; gw += NGW) {
        const int t = gw >> 3, hq = gw & 7, kvh = hq >> 2, b = t / SEQ, tp = t % SEQ;
        const float slope = exp2f(-(float)(hq + 1)), sink = F.sinks[hq];
        const float qd = bf2f(AQ[(size_t)t * AW + hq * 64 + lane]);
        const int s0 = tp >= 127 ? tp - 127 : 0, nk = tp - s0 + 1;
        const bf16_t* kb = AK + ((size_t)b * SEQ + s0) * AKW + kvh * 64 + lane;
        const bf16_t* vb = AV + ((size_t)b * SEQ + s0) * AKW + kvh * 64 + lane;
        float slo = -INFINITY, shi = -INFINITY;
        for (int i = 0; i < nk; ++i) {
            const float d = wave_sum(qd * bf2f(kb[(size_t)i * AKW]));
            const float sc = d * 0.125f - slope * (float)(tp - (s0 + i));
            if ((i & 63) == lane) { if (i < 64) slo = sc; else shi = sc; }
        }
        const float m = fmaxf(wave_max(fmaxf(slo, shi)), sink);
        const float plo = __expf(slo - m), phi = __expf(shi - m);
        const float den = wave_sum(plo + phi) + __expf(sink - m);
        float o = 0.f;
        for (int i = 0; i < nk; ++i) { const float p = __shfl(i < 64 ? plo : phi, i & 63); o += p * bf2f(vb[(size_t)i * AKW]); }
        ATT[(size_t)t * AW + hq * 64 + lane] = o / den;
    }
}
__device__ __forceinline__ void p_hgrn_simple(Frame& F) {
    constexpr int TT = 16;
    LAS float* sf = (LAS float*)(F.lds); LAS float* sk = sf + TT * 128; LAS float* sq = sk + TT * 128; LAS float* po = sq + TT * 128;
    const bf16_t* HQ = WSP(bf16_t, WS_HQ); const float* G = WSP(float, WS_G); const bf16_t* KK = WSP(bf16_t, WS_KK); const bf16_t* HI = WSP(bf16_t, WS_HI); float* ORAW = WSP(float, WS_ORAW);
    for (int u = blockIdx.x; u < BATCH * 4; u += F.G) {
        const int b = u >> 2, h = u & 3, v = F.tid & 127, kq = F.tid >> 7;
        float S[32];
#pragma unroll
        for (int k = 0; k < 32; ++k) S[k] = 0.f;
        for (int t0 = 0; t0 < SEQ; t0 += TT) {
            __syncthreads();
            for (int i = F.tid; i < TT * 128; i += NWAVES * 64) {
                const int tt = i >> 7, k = i & 127; const size_t idx = ((size_t)b * SEQ + t0 + tt) * HKW + h * 128 + k;
                sf[i] = __expf(G[idx]); sk[i] = bf2f(KK[idx]); sq[i] = bf2f(HQ[idx]);
            }
            __syncthreads();
            for (int tt = 0; tt < TT; ++tt) {
                const float vv = bf2f(HI[((size_t)b * SEQ + t0 + tt) * HW + h * 128 + v]);
                float o = 0.f;
#pragma unroll
                for (int k = 0; k < 32; ++k) { const int kk = tt * 128 + kq * 32 + k; S[k] = sf[kk] * S[k] + sk[kk] * vv; o += sq[kk] * S[k]; }
                po[(tt * 4 + kq) * 128 + v] = o;
            }
            __syncthreads();
            for (int i = F.tid; i < TT * 128; i += NWAVES * 64) {
                const int tt = i >> 7, vv = i & 127;
                ORAW[((size_t)b * SEQ + t0 + tt) * HW + h * 128 + vv] = (po[(tt * 4 + 0) * 128 + vv] + po[(tt * 4 + 1) * 128 + vv]) + (po[(tt * 4 + 2) * 128 + vv] + po[(tt * 4 + 3) * 128 + vv]);
            }
        }
        __syncthreads();
    }
}
__device__ __forceinline__ void p_mix_simple(Frame& F, bool do_attn, bool do_hgrn) {
    const float* ATT = WSP(float, WS_ATT); const float* ORAW = WSP(float, WS_ORAW); const bf16_t* HG = WSP(bf16_t, WS_HG); bf16_t* MIX = WSP(bf16_t, WS_MIX);
    const int gw0 = F.vcu * NWAVES + F.wave, NGW = F.G * NWAVES, lane = F.lane;
    for (int t = gw0; t < T; t += NGW) {
        if (do_attn) {
        float a[8]; float ss = 0.f;
#pragma unroll
        for (int j = 0; j < 8; ++j) { a[j] = ATT[(size_t)t * AW + lane + 64 * j]; ss += a[j] * a[j]; }
        const float r = rsqrtf(wave_sum(ss) * (1.f / AW) + EPS);
#pragma unroll
        for (int j = 0; j < 8; ++j) MIX[(size_t)t * MIXW + lane + 64 * j] = f2bf(a[j] * r * F.attn_g[lane + 64 * j]);
        }
        if (do_hgrn)
#pragma unroll
        for (int h = 0; h < 4; ++h) {
            const int c0 = h * 128 + lane, c1 = c0 + 64;
            const float o0 = ORAW[(size_t)t * HW + c0], o1 = ORAW[(size_t)t * HW + c1];
            const float rr = rsqrtf(wave_sum(o0 * o0 + o1 * o1) * (1.f / 128.f) + EPS);
            MIX[(size_t)t * MIXW + AW + c0] = f2bf(o0 * rr * F.hgrn_g[c0] * bf2f(HG[(size_t)t * HW + c0]));
            MIX[(size_t)t * MIXW + AW + c1] = f2bf(o1 * rr * F.hgrn_g[c1] * bf2f(HG[(size_t)t * HW + c1]));
        }
    }
}

struct Args { const float* in[18]; float* out; unsigned char* ws; int ph_lo, ph_hi, li, pad; };
__global__ void __launch_bounds__(NWAVES * 64, 2) mega_fwd(Args args) {
    extern __shared__ __attribute__((aligned(16))) unsigned char lds[];
    Frame F;
    F.lds = (LAS unsigned char*)lds; F.MISC = (volatile LAS unsigned*)(F.lds + MISC_OFF);
    F.tid = threadIdx.x; F.lane = F.tid & 63; F.wave = __builtin_amdgcn_readfirstlane(F.tid >> 6);
    F.G = gridDim.x; { const int bx = blockIdx.x; F.vcu = (F.G % 8 == 0) ? (bx % 8) * (F.G / 8) + bx / 8 : bx; }
    F.ws = args.ws; F.ctl = (gu32*)(args.ws + WS_CTL); F.out = args.out;
    F.x = args.in[0]; F.norm1_g = args.in[1]; F.w_in = args.in[2]; F.b_in = args.in[3]; F.sinks = args.in[4]; F.attn_g = args.in[5]; F.lb_logits = args.in[6]; F.hgrn_g = args.in[7];
    F.w_out = args.in[8]; F.b_out = args.in[9]; F.norm2_g = args.in[10]; F.router_w = args.in[11]; F.router_b = args.in[12]; F.w1 = args.in[13]; F.b1 = args.in[14]; F.w2 = args.in[15];
    F.b2 = args.in[16]; F.final_g = args.in[17];
    for (int u = F.tid; u < (LDS_BYTES - LDSCTL_OFF) / 4; u += NWAVES * 64) ((LAS unsigned*)(F.lds + LDSCTL_OFF))[u] = 0u;
    __syncthreads();
    XcdBarrier bar = xcd_barrier_post((unsigned*)(F.ctl + CW_BAR) + args.li * XCD_BAR_WORDS, F.MISC + 8);
    const int lo = args.ph_lo, hi = args.ph_hi;
#define IN(k) (lo <= (k) && (k) < hi)
#define SEAM(k) do { if (IN(k) && IN((k) + 1)) xcd_barrier(bar); } while (0)

    if (IN(0)) { p_prologue(F); SEAM(0); }
    if (IN(1)) {
        pg8::DenseOrder S; S.init(WSP(bf16_t, WS_XN), WSP(bf16_t, WS_WINT), T, INW, DM, F.G, (int)blockIdx.x);
        pg8::EpiInProj E{F.b_in, WSP(float, WS_LB), WSP(bf16_t, WS_AQ), WSP(bf16_t, WS_AK), WSP(bf16_t, WS_AV), WSP(bf16_t, WS_HQ), WSP(bf16_t, WS_KK), WSP(bf16_t, WS_HI), WSP(bf16_t, WS_HG), WSP(float, WS_G)};
        pg8::gemm_phase<pg8::EpiInProj, pg8::DenseOrder, false, true>(F.lds + RING_OFF, DM, S, E);
        SEAM(1);
    }
#ifndef NEW_ATTN
#define NEW_ATTN 1
#endif
#ifndef NEW_HGRN
#define NEW_HGRN 1
#endif
    if (IN(2)) { if (!NEW_ATTN) p_attn_simple(F); if (NEW_HGRN) p_hgrn_prep(F); SEAM(2); }
    if (IN(3)) { if (!NEW_HGRN) p_hgrn_simple(F); p_scan_attn(F, NEW_HGRN, NEW_ATTN); SEAM(3); }
    if (IN(4)) { if (!NEW_ATTN || !NEW_HGRN) p_mix_simple(F, !NEW_ATTN, !NEW_HGRN); SEAM(4); }
    if (IN(5)) {
        pg8::DenseOrder S; S.init(WSP(bf16_t, WS_MIX), WSP(bf16_t, WS_WOUTT), T, DM, MIXW, F.G, (int)blockIdx.x);
        pg8::EpiOutProj E{F.b_out, F.x, WSP(float, WS_X1)};
        pg8::gemm_phase<pg8::EpiOutProj, pg8::DenseOrder, false, true>(F.lds + RING_OFF, MIXW, S, E);
        SEAM(5);
    }
    if (IN(6)) { p_router(F); SEAM(6); }
    if (IN(7)) {
        moe_setup(F);
        LAS const int* pre = (LAS const int*)(F.lds + MOE_OFF); LAS const int* lc = (LAS const int*)(F.lds + MOE_OFF + 256);
        pg8::MoeOrder<true, 1> S{(const char*)WSP(unsigned char, WS_H2), (const char*)WSP(unsigned char, WS_W1T), WSP(int, WS_LIST), pre, lc, DM, 2 * FF, 2 * FF / 256, pre[NE] * (2 * FF / 256), F.G, (int)blockIdx.x};
        pg8::EpiMoe1 E{F.b1, WSP(unsigned char, WS_ACT), WSP(int, WS_LIST), WSP(float, WS_RSTD)};
        pg8::gemm_phase<pg8::EpiMoe1, pg8::MoeOrder<true, 1>, true, true, 1>(F.lds + RING_OFF, DM, S, E);
        SEAM(7);
    }
    if (IN(8)) {
        if (!IN(7)) moe_setup(F);
        LAS const int* pre = (LAS const int*)(F.lds + MOE_OFF); LAS const int* lc = (LAS const int*)(F.lds + MOE_OFF + 256);
        pg8::MoeOrder<false, 1> S{(const char*)WSP(unsigned char, WS_ACT), (const char*)WSP(unsigned char, WS_W2T), WSP(int, WS_LIST), pre, lc, FF, DM, DM / 256, pre[NE] * (DM / 256), F.G, (int)blockIdx.x};
        pg8::EpiMoe2 E{F.b2, WSP(int, WS_LIST), WSP(float, WS_GATE), WSP(bf16_t, WS_Y)};
        pg8::gemm_phase<pg8::EpiMoe2, pg8::MoeOrder<false, 1>, false, true, 1>(F.lds + RING_OFF, FF, S, E);
        SEAM(8);
    }
    if (IN(9)) p_final(F);
#undef IN
#undef SEAM
}

static int mega_grid() {
    static int grid = 0;
    if (grid == 0) {
        int dev = 0, cus = 0;
        if (hipGetDevice(&dev) != hipSuccess || hipDeviceGetAttribute(&cus, hipDeviceAttributeMultiprocessorCount, dev) != hipSuccess) { grid = -1; return grid; }
        if (hipFuncSetAttribute((const void*)mega_fwd, hipFuncAttributeMaxDynamicSharedMemorySize, LDS_BYTES) != hipSuccess) { grid = -1; return grid; }
        (void)hipGetLastError();
        grid = cus;
    }
    return grid;
}
extern "C" void kernel_launch(void* const* d_in, const int* in_sizes, int n_in, void* d_out, int out_size, void* d_ws, size_t ws_size, hipStream_t stream) {
    if (n_in != 18 || ws_size < WS_END) return;
    const int grid = mega_grid(); if (grid <= 0) return;
    unsigned char* ws = (unsigned char*)d_ws;
    (void)hipMemsetAsync(ws + WS_CTL, 0, 262144, stream);
    Args a{};
    for (int i = 0; i < 18; ++i) a.in[i] = (const float*)d_in[i];
    a.out = (float*)d_out; a.ws = ws;
#ifndef PLAN
#define PLAN {{0, N_PHASES}}
#endif
    static const int plan[][2] = PLAN;
    for (int li = 0; li < (int)(sizeof(plan) / sizeof(plan[0])); ++li) {
        a.ph_lo = plan[li][0]; a.ph_hi = plan[li][1]; a.li = li;
        hipLaunchKernelGGL(mega_fwd, dim3(grid), dim3(NWAVES * 64), LDS_BYTES, stream, a);
    }
}
```

```cpp
#include <hip/hip_runtime.h>
#include <stdint.h>

typedef unsigned short bf16_t;
typedef short bf16x8 __attribute__((ext_vector_type(8)));
typedef float f32x4 __attribute__((ext_vector_type(4)));

constexpr int BATCH = 8, SEQ = 2048, DM = 1024, T = BATCH * SEQ;
constexpr int AW = 512, AKW = 128, HKW = 512, HW = 512, INW = 2816, MIXW = 1024;
constexpr int NE = 32, TOPK = 4, FF = 1024;
constexpr int C_AQ = 0, C_AK = 512, C_AV = 640, C_HQ = 768, C_HF = 1280, C_HI = 1792, C_HG = 2304;
constexpr float EPS = 1e-5f;
constexpr int ACT_ROWS = T * TOPK + NE * 256;

constexpr size_t MiB = 1u << 20;
constexpr size_t al(size_t x) { return (x + 255) & ~(size_t)255; }
constexpr size_t WS_CTL = 0;
constexpr size_t WS_LB = 1 * MiB;
constexpr size_t WS_WINT = 2 * MiB;
constexpr size_t WS_WOUTT = WS_WINT + al((size_t)INW * DM * 2);
constexpr size_t WS_W1T = WS_WOUTT + al((size_t)DM * MIXW * 2);
constexpr size_t WS_W2T = WS_W1T + al((size_t)NE * 2 * FF * DM * 2);
constexpr size_t WS_XN = WS_W2T + al((size_t)NE * DM * FF * 2);
constexpr size_t WS_AQ = WS_XN + al((size_t)T * DM * 2);
constexpr size_t WS_AK = WS_AQ + al((size_t)T * AW * 2);
constexpr size_t WS_AV = WS_AK + al((size_t)T * AKW * 2);
constexpr size_t WS_HQ = WS_AV + al((size_t)T * AKW * 2);
constexpr size_t WS_G = WS_HQ + al((size_t)T * HKW * 2);
constexpr size_t WS_KK = WS_G + al((size_t)T * HKW * 4);
constexpr size_t WS_HI = WS_KK + al((size_t)T * HKW * 2);
constexpr size_t WS_HG = WS_HI + al((size_t)T * HW * 2);
constexpr size_t WS_ATT = WS_HG + al((size_t)T * HW * 2);
constexpr size_t WS_ORAW = WS_ATT + al((size_t)T * AW * 4);
constexpr size_t WS_MIX = WS_ORAW + al((size_t)T * HW * 4);
constexpr size_t WS_X1 = WS_MIX + al((size_t)T * MIXW * 2);
constexpr size_t WS_H2 = WS_X1 + al((size_t)T * DM * 4);
constexpr size_t WS_GATE = WS_H2 + al((size_t)T * DM * 2);
constexpr size_t WS_LIST = WS_GATE + al((size_t)T * TOPK * 4);
constexpr size_t WS_ACT = WS_LIST + al((size_t)NE * T * 4);
constexpr size_t WS_Y = WS_ACT + al((size_t)ACT_ROWS * FF * 2);
constexpr size_t WS_QF = WS_Y + al((size_t)T * TOPK * DM * 2);
constexpr size_t WS_KF = WS_QF + al((size_t)1024 * 16 * 512 * 2);
constexpr size_t WS_VF = WS_KF + al((size_t)1024 * 16 * 512 * 2);
constexpr size_t WS_INTRA = WS_VF + al((size_t)1024 * 16 * 512 * 2);
constexpr size_t WS_DEC = WS_INTRA + al((size_t)T * HW * 2);
constexpr size_t WS_RWF = WS_DEC + al((size_t)1024 * 128 * 4);
constexpr size_t WS_RSTD = WS_RWF + al((size_t)64 * 2 * 512 * 2);
constexpr size_t WS_END = WS_RSTD + al((size_t)T * 4);
static_assert(WS_END <= ((size_t)1 << 30), "workspace map exceeds 1 GiB");
constexpr int CW_CNT = 64;
constexpr int CW_OFF = 128;

__device__ __forceinline__ bf16_t f2bf(float f) { unsigned u = __builtin_bit_cast(unsigned, f); return (bf16_t)((u + 0x7fffu + ((u >> 16) & 1u)) >> 16); }
__device__ __forceinline__ float bf2f(bf16_t b) { return __builtin_bit_cast(float, (unsigned)b << 16); }
__device__ __forceinline__ float wave_sum(float v) {
#pragma unroll
    for (int o = 1; o < 64; o <<= 1) v += __shfl_xor(v, o);
    return v;
}
__device__ __forceinline__ float wave_max(float v) {
#pragma unroll
    for (int o = 1; o < 64; o <<= 1) v = fmaxf(v, __shfl_xor(v, o));
    return v;
}
__device__ __forceinline__ float sigmoidf_(float x) { return 1.f / (1.f + __expf(-x)); }
__device__ __forceinline__ float siluf_(float x) { return x / (1.f + __expf(-x)); }

#define LAS __attribute__((address_space(3)))
#define GAS __attribute__((address_space(1)))
typedef unsigned u32x4 __attribute__((ext_vector_type(4)));
typedef unsigned u32x2 __attribute__((ext_vector_type(2)));
typedef float f32x2 __attribute__((ext_vector_type(2)));

namespace pg8 {
constexpr int BM = 256, BK = 64, HALF = 128, HTB = HALF * BK * 2  , STAGE_BYTES = 8 * HTB, NXCD = 8, WGM = 8;
__host__ __device__ __forceinline__ int lds_byte(int r, int c) { const int st = (r >> 4) * 2 + (c >> 5), rr = r & 15, cc = c & 31, ob = rr * 64 + cc * 2; return st * 1024 + (ob ^ (((ob >> 9) & 1) << 5)); }
__host__ __device__ __forceinline__ void stage_rc(int b, int& R, int& C) { const int st = b / 1024, sb = b % 1024, swz = sb ^ (((sb >> 9) & 1) << 5); R = (st >> 1) * 16 + swz / 64; C = (st & 1) * 32 + (swz % 64) / 2; }
__host__ __device__ __forceinline__ int perm32(int rho) { const int n = rho >> 4, i = rho & 15; return 8 * (i >> 2) + 4 * n + (i & 3); }
__device__ __forceinline__ unsigned cvt_pk_bf16(float lo, float hi) { unsigned r; asm volatile("v_cvt_pk_bf16_f32 %0, %1, %2" : "=v"(r) : "v"(lo), "v"(hi)); return r; }

struct Unit { const char* A; const char* B; int pm, pn, e, rows, arow, lbase; };

struct DenseOrder {
    const char* A; const char* Bt; int K, nM, nN, nwg, G, c;
    __device__ void init(const void* A_, const void* Bt_, int M, int N, int K_, int G_, int c_) { A = (const char*)A_; Bt = (const char*)Bt_; K = K_; nM = M / BM; nN = N / BM; nwg = nM * nN; G = G_; c = c_; }
    __device__ __forceinline__ bool next(int i, Unit& u) const {
        const long L = (long)i * G + c; if (L >= nwg) return false;
        int wgid = (int)L; { const int q = nwg / NXCD, r = nwg % NXCD, xcd = wgid % NXCD, off = wgid / NXCD; wgid = (xcd < r ? xcd * (q + 1) : r * (q + 1) + (xcd - r) * q) + off; }
        const int nig = WGM * nN, gid = wgid / nig, fm = gid * WGM, gsz = (nM - fm) < WGM ? (nM - fm) : WGM;
        u.pm = fm + ((wgid % nig) % gsz); u.pn = (wgid % nig) / gsz; u.e = 0; u.rows = BM; u.arow = u.pm * BM; u.lbase = 0;
        u.A = A + (size_t)u.pm * BM * K * 2; u.B = Bt + (size_t)u.pn * BM * K * 2; return true;
    }
    __device__ __forceinline__ int row(const Unit&, int r) const { return r; }
};
template <bool G1, int ES>
struct MoeOrder {
    const char* A; const char* Bt; const int* list; LAS const int* pre; LAS const int* cnt; int K, N, nN, nwg, G, c;
    __device__ __forceinline__ bool next(int i, Unit& u) const {
        const long L = (long)i * G + c; if (L >= nwg) return false;
        int wgid = (int)L; { const int q = nwg / NXCD, r = nwg % NXCD, xcd = wgid % NXCD, off = wgid / NXCD; wgid = (xcd < r ? xcd * (q + 1) : r * (q + 1) + (xcd - r) * q) + off; }
        const int tau = wgid / nN; u.pn = wgid % nN;
        const int p = pre[(threadIdx.x & 31) + 1];
        const int e = __builtin_popcountll(__ballot(p <= tau) & 0xffffffffull);
        const int mt = tau - pre[e];
        u.e = e; u.pm = mt; const int left = cnt[e] - mt * BM; u.rows = left < BM ? left : BM;
        u.arow = tau * BM; u.lbase = e * T + mt * BM;
        u.A = G1 ? A : A + (size_t)u.arow * K * ES;
        u.B = Bt + ((size_t)e * N + (size_t)u.pn * BM) * K * ES; return true;
    }
    __device__ __forceinline__ int row(const Unit& u, int r) const { const int rr = r < u.rows ? r : u.rows - 1; return list[u.lbase + rr] >> 2; }
};

__device__ __forceinline__ u32x4 pack8(f32x4 v0, f32x4 v1) { u32x4 w; w.x = cvt_pk_bf16(v0[0], v0[1]); w.y = cvt_pk_bf16(v0[2], v0[3]); w.z = cvt_pk_bf16(v1[0], v1[1]); w.w = cvt_pk_bf16(v1[2], v1[3]); return w; }
__device__ __forceinline__ f32x4 silu4(f32x4 v) { f32x4 r; for (int i = 0; i < 4; ++i) r[i] = v[i] * __builtin_amdgcn_rcpf(1.f + __expf(-v[i])); return r; }

typedef int v8i32 __attribute__((ext_vector_type(8)));
__device__ __forceinline__ u32x2 pack8_fp8(f32x4 v0, f32x4 v1) {
    int a = 0, b = 0; a = __builtin_amdgcn_cvt_pk_fp8_f32(v0[0], v0[1], a, false); a = __builtin_amdgcn_cvt_pk_fp8_f32(v0[2], v0[3], a, true);
    b = __builtin_amdgcn_cvt_pk_fp8_f32(v1[0], v1[1], b, false); b = __builtin_amdgcn_cvt_pk_fp8_f32(v1[2], v1[3], b, true);
    return (u32x2){(unsigned)a, (unsigned)b};
}
constexpr float FP8_ACT_SCALE = 4.f, FP8_W_SCALE = 64.f, FP8_DESCALE = 1.f / (FP8_ACT_SCALE * FP8_W_SCALE);
struct EpiInProj {
    static constexpr bool PERM = true;
    const float* bias; const float* lb; bf16_t *AQ, *AK, *AV, *HQ, *KK, *HI, *HG; float* G;
    __device__ __forceinline__ void operator()(const f32x4 (&acc)[2][2][4][2], const Unit& u, int wr, int wc, int fr, int fq) const {
        const int row0 = u.pm * BM + wr * 64 + fr, cl = wc * 32 + 8 * fq;
#pragma unroll
        for (int bj = 0; bj < 2; ++bj) {
            const int cb = u.pn * BM + bj * HALF;
            const f32x4 b0 = *(const f32x4*)(bias + cb + cl), b1 = *(const f32x4*)(bias + cb + cl + 4);
            if (cb >= C_HF && cb < C_HI) {
                const int cc = cb - C_HF + cl;
                const f32x4 l0 = *(const f32x4*)(lb + cc), l1 = *(const f32x4*)(lb + cc + 4);
#pragma unroll
                for (int ai = 0; ai < 2; ++ai)
#pragma unroll
                    for (int m = 0; m < 4; ++m) {
                        const size_t r = (size_t)(row0 + ai * HALF + m * 16);
                        f32x4 v0 = acc[ai][bj][m][0] + b0, v1 = acc[ai][bj][m][1] + b1, g0, g1, k0, k1;
#pragma unroll
                        for (int i = 0; i < 4; ++i) {
                            const float f0 = l0[i] + (1.f - l0[i]) * __builtin_amdgcn_rcpf(1.f + __expf(-v0[i])); g0[i] = __logf(f0); k0[i] = 1.f - f0;
                            const float f1 = l1[i] + (1.f - l1[i]) * __builtin_amdgcn_rcpf(1.f + __expf(-v1[i])); g1[i] = __logf(f1); k1[i] = 1.f - f1;
                        }
                        *(f32x4*)(G + r * HKW + cc) = g0; *(f32x4*)(G + r * HKW + cc + 4) = g1;
                        *(u32x4*)(KK + r * HKW + cc) = pack8(k0, k1);
                    }
            } else {
                bf16_t* dst; int ld, cc; bool act = false;
                if (cb < C_AK) { dst = AQ; ld = AW; cc = cb - C_AQ; }
                else if (cb < C_AV) { dst = AK; ld = AKW; cc = cb - C_AK; }
                else if (cb < C_HQ) { dst = AV; ld = AKW; cc = cb - C_AV; }
                else if (cb < C_HF) { dst = HQ; ld = HKW; cc = cb - C_HQ; act = true; }
                else if (cb < C_HG) { dst = HI; ld = HW; cc = cb - C_HI; }
                else { dst = HG; ld = HW; cc = cb - C_HG; act = true; }
                cc += cl;
#pragma unroll
                for (int ai = 0; ai < 2; ++ai)
#pragma unroll
                    for (int m = 0; m < 4; ++m) {
                        const size_t r = (size_t)(row0 + ai * HALF + m * 16);
                        f32x4 v0 = acc[ai][bj][m][0] + b0, v1 = acc[ai][bj][m][1] + b1;
                        if (act) { v0 = silu4(v0); v1 = silu4(v1); }
                        *(u32x4*)(dst + r * ld + cc) = pack8(v0, v1);
                    }
            }
        }
    }
};
struct EpiOutProj {
    static constexpr bool PERM = false;
    const float* bias; const float* x; float* X1;
    __device__ __forceinline__ void operator()(const f32x4 (&acc)[2][2][4][2], const Unit& u, int wr, int wc, int fr, int fq) const {
        const int row0 = u.pm * BM + wr * 64 + fr, col0 = u.pn * BM + wc * 32 + 4 * fq;
#pragma unroll
        for (int bj = 0; bj < 2; ++bj)
#pragma unroll
            for (int n = 0; n < 2; ++n) {
                const int c = col0 + bj * HALF + n * 16; const f32x4 bv = *(const f32x4*)(bias + c);
#pragma unroll
                for (int ai = 0; ai < 2; ++ai)
#pragma unroll
                    for (int m = 0; m < 4; ++m) { const size_t o = (size_t)(row0 + ai * HALF + m * 16) * DM + c; *(f32x4*)(X1 + o) = acc[ai][bj][m][n] + bv + *(const f32x4*)(x + o); }
            }
    }
};
struct EpiMoe1 {
    static constexpr bool PERM = true;
    const float* b1; unsigned char* ACT; const int* list; const float* rstd;
    __device__ __forceinline__ void operator()(const f32x4 (&acc)[2][2][4][2], const Unit& u, int wr, int wc, int fr, int fq) const {
        const int ac0 = u.pn * HALF + wc * 32 + 8 * fq;
        const float* bp = b1 + (size_t)u.e * 2 * FF + 2 * ac0;
        const f32x4 q0 = *(const f32x4*)bp, q1 = *(const f32x4*)(bp + 4), q2 = *(const f32x4*)(bp + 8), q3 = *(const f32x4*)(bp + 12);
        const f32x4 bg0 = {q0[0], q0[2], q1[0], q1[2]}, bg1 = {q2[0], q2[2], q3[0], q3[2]}, bl0 = {q0[1], q0[3], q1[1], q1[3]}, bl1 = {q2[1], q2[3], q3[1], q3[3]};
#pragma unroll
        for (int ai = 0; ai < 2; ++ai)
#pragma unroll
            for (int m = 0; m < 4; ++m) {
                const int r = ai * HALF + wr * 64 + m * 16 + fr;
                const float rs = r < u.rows ? rstd[list[u.lbase + r] >> 2] * FP8_DESCALE : 0.f;
                const f32x4 g0 = acc[ai][0][m][0] * rs + bg0, g1 = acc[ai][0][m][1] * rs + bg1, l0 = acc[ai][1][m][0] * rs + bl0, l1 = acc[ai][1][m][1] * rs + bl1;
                f32x4 a0, a1;
#pragma unroll
                for (int i = 0; i < 4; ++i) {
                    const float u0 = fminf(g0[i], 7.f), u1 = fminf(g1[i], 7.f), w0 = fminf(fmaxf(l0[i], -7.f), 7.f), w1 = fminf(fmaxf(l1[i], -7.f), 7.f);
                    a0[i] = u0 * __builtin_amdgcn_rcpf(1.f + __expf(-1.702f * u0)) * (w0 + 1.f);
                    a1[i] = u1 * __builtin_amdgcn_rcpf(1.f + __expf(-1.702f * u1)) * (w1 + 1.f);
                }
                if (r < u.rows) *(u32x2*)(ACT + (size_t)(u.arow + r) * FF + ac0) = pack8_fp8(a0 * FP8_ACT_SCALE, a1 * FP8_ACT_SCALE);
            }
    }
};
struct EpiMoe2 {
    static constexpr bool PERM = true;
    const float* b2; const int* list; const float* gate; bf16_t* Y;
    __device__ __forceinline__ void operator()(const f32x4 (&acc)[2][2][4][2], const Unit& u, int wr, int wc, int fr, int fq) const {
        const int c0 = u.pn * BM + wc * 32 + 8 * fq;
        f32x4 bv[2][2];
#pragma unroll
        for (int bj = 0; bj < 2; ++bj)
#pragma unroll
            for (int n = 0; n < 2; ++n) bv[bj][n] = *(const f32x4*)(b2 + (size_t)u.e * DM + c0 + bj * HALF + 4 * n);
#pragma unroll
        for (int ai = 0; ai < 2; ++ai)
#pragma unroll
            for (int m = 0; m < 4; ++m) {
                const int r = ai * HALF + wr * 64 + m * 16 + fr;
                if (r < u.rows) {
                    const int slot = list[u.lbase + r]; const float gt = gate[slot];
                    bf16_t* yr = Y + (size_t)slot * DM + c0;
#pragma unroll
                    for (int bj = 0; bj < 2; ++bj) { const f32x4 v0 = (acc[ai][bj][m][0] * FP8_DESCALE + bv[bj][0]) * gt, v1 = (acc[ai][bj][m][1] * FP8_DESCALE + bv[bj][1]) * gt; *(u32x4*)(yr + bj * HALF) = pack8(v0, v1); }
                }
            }
    }
};

template <class Epi, class Sched, bool GATHER, bool ALIGN_EPI, int ES = 2>
__device__ __forceinline__ void gemm_phase(LAS unsigned char* lds, const int K, const Sched& S, const Epi& E, const int DRY_FLAG = 0) {
    const int tid = threadIdx.x, wid = __builtin_amdgcn_readfirstlane(tid >> 6), lane = tid & 63, wr = wid >> 2, wc = wid & 3, fr = lane & 15, fq = lane >> 4;
    int nt = K * ES / (BK * 2); asm volatile("" : "+s"(nt));
    unsigned voffB[2];
#pragma unroll
    for (int i = 0; i < 2; ++i) { int R, C; stage_rc(tid * 16 + i * 8192, R, C); const int Rb = Epi::PERM ? ((R & ~31) + perm32(R & 31)) : R; voffB[i] = (unsigned)(Rb * K * ES + C * 2); }
    const size_t kstep = (size_t)(BK * 2);
    const size_t hstep = (size_t)HALF * K * ES;
    const unsigned ldsw = (unsigned)wid * 1024u;
    const int aoff = lds_byte(wr * 64 + fr, fq * 8), boff = lds_byte(wc * 32 + fr, fq * 8);
#define PG8_SA(b, h) (((b) * 2 + (h)) * HTB)
#define PG8_SB(b, h) ((4 + (b) * 2 + (h)) * HTB)
#define PG8_STAGE(bufoff, gbase, voff) do { _Pragma("unroll") for (int _i = 0; _i < 2; ++_i) \
        __builtin_amdgcn_global_load_lds((const unsigned*)((const char*)(gbase) + (voff)[_i]), (LAS unsigned*)(lds + (bufoff) + ldsw + _i * 8192), 16, 0, 0); } while (0)
#define PG8_LD8(dst, off) do { const u32x4 lo_ = *(const LAS u32x4*)(lds + (off)), hi_ = *(const LAS u32x4*)(lds + (off) + 1024); \
        dst = (v8i32){(int)lo_.x, (int)lo_.y, (int)lo_.z, (int)lo_.w, (int)hi_.x, (int)hi_.y, (int)hi_.z, (int)hi_.w}; } while (0)
#define PG8_LDA(dst, b, h) do { _Pragma("unroll") for (int m = 0; m < 4; ++m) PG8_LD8(dst[m], PG8_SA(b, h) + aoff + m * 2048); } while (0)
#define PG8_LDB(dst, b, h) do { _Pragma("unroll") for (int n = 0; n < 2; ++n) PG8_LD8(dst[n], PG8_SB(b, h) + boff + n * 2048); } while (0)
#define PG8_LO(x) __builtin_bit_cast(bf16x8, __builtin_shufflevector(x, x, 0, 1, 2, 3))
#define PG8_HI(x) __builtin_bit_cast(bf16x8, __builtin_shufflevector(x, x, 4, 5, 6, 7))
#define PG8_MMA(ai, bj, At, Bt) do { __builtin_amdgcn_s_setprio(1); _Pragma("unroll") for (int m = 0; m < 4; ++m) _Pragma("unroll") for (int n = 0; n < 2; ++n) { \
        if constexpr (ES == 2) { acc[ai][bj][m][n] = __builtin_amdgcn_mfma_f32_16x16x32_bf16(PG8_LO(Bt[n]), PG8_LO(At[m]), acc[ai][bj][m][n], 0, 0, 0); \
                                 acc[ai][bj][m][n] = __builtin_amdgcn_mfma_f32_16x16x32_bf16(PG8_HI(Bt[n]), PG8_HI(At[m]), acc[ai][bj][m][n], 0, 0, 0); } \
        else asm volatile("v_mfma_scale_f32_16x16x128_f8f6f4 %0, %1, %2, %0, %3, %3 op_sel_hi:[0,0,0]" : "+v"(acc[ai][bj][m][n]) : "v"(Bt[n]), "v"(At[m]), "v"(unit_scale)); } \
          \
        __builtin_amdgcn_s_setprio(0); } while (0)
#define PG8_WAIT_V(n) asm volatile("s_waitcnt vmcnt(" #n ")" ::: "memory")
#define PG8_WAIT_L(n) asm volatile("s_waitcnt lgkmcnt(" #n ")" ::: "memory")
#define PG8_BAR __builtin_amdgcn_s_barrier()
#define PG8_SCHED __builtin_amdgcn_sched_barrier(0)
#define PG8_VOFFA(dst, u) do { int _t = tid; if (GATHER) asm volatile("" : "+v"(_t));     \
        _Pragma("unroll") for (int _i = 0; _i < 2; ++_i) { int _R, _C; stage_rc(_t * 16 + _i * 8192, _R, _C); _Pragma("unroll") for (int _h = 0; _h < 2; ++_h) { const int _r = _h * HALF + _R; \
        const unsigned _row = GATHER ? (unsigned)S.row(u, _r) : (unsigned)_r; dst[_h][_i] = _row * (unsigned)(K * ES) + (unsigned)_C * 2u; } } } while (0)
    Unit cur, nxt; int ui = 0;
    if (!S.next(0, cur)) return;
    f32x4 acc[2][2][4][2];
#pragma unroll
    for (int a = 0; a < 2; ++a)
#pragma unroll
        for (int b = 0; b < 2; ++b)
#pragma unroll
            for (int m = 0; m < 4; ++m)
#pragma unroll
                for (int n = 0; n < 2; ++n) acc[a][b][m][n] = (f32x4){0.f, 0.f, 0.f, 0.f};
    v8i32 At[4], B0[2], B1[2];
    const int unit_scale = 0x7F7F7F7F;
    unsigned vA[2][2], nvA[2][2];
    PG8_VOFFA(vA, cur);
    const char* cA = cur.A; const char* cB = cur.B;
    PG8_STAGE(PG8_SB(0, 0), cB, voffB); PG8_STAGE(PG8_SB(0, 1), cB + hstep, voffB); PG8_STAGE(PG8_SA(0, 0), cA, vA[0]); PG8_STAGE(PG8_SA(0, 1), cA, vA[1]);
    if (wr == 1) PG8_BAR;
    PG8_WAIT_V(2); PG8_BAR;
    PG8_STAGE(PG8_SB(1, 0), cB + kstep, voffB); PG8_STAGE(PG8_SA(1, 0), cA + kstep, vA[0]); PG8_STAGE(PG8_SB(1, 1), cB + hstep + kstep, voffB);
    PG8_WAIT_V(6); PG8_BAR;
    for (;;) {
        const bool has_next = S.next(ui + 1, nxt);
        const char* nA = has_next ? nxt.A : cA; const char* nB = has_next ? nxt.B : cB;
        if (has_next) { PG8_VOFFA(nvA, nxt); } else {
#pragma unroll
            for (int h = 0; h < 2; ++h)
#pragma unroll
                for (int i = 0; i < 2; ++i) nvA[h][i] = vA[h][i]; }
#pragma unroll 1
        for (int t = 0; t < nt; t += 2) {
            const bool last = (t == nt - 2);
            const char* a1 = cA + (size_t)(t + 1) * kstep;
            const char* a2 = last ? nA : cA + (size_t)(t + 2) * kstep; const char* b2 = last ? nB : cB + (size_t)(t + 2) * kstep;
            const char* a3 = a2 + kstep; const char* b3 = b2 + kstep;
            unsigned s0[2], s1[2];
#pragma unroll
            for (int i = 0; i < 2; ++i) { s0[i] = last ? nvA[0][i] : vA[0][i]; s1[i] = last ? nvA[1][i] : vA[1][i]; }
            PG8_LDB(B0, 0, 0); PG8_LDB(B1, 0, 1); PG8_SCHED; PG8_LDA(At, 0, 0); PG8_STAGE(PG8_SA(1, 1), a1, vA[1]);
            PG8_WAIT_V(8); PG8_WAIT_L(0); PG8_BAR; PG8_MMA(0, 0, At, B0); PG8_MMA(0, 1, At, B1); PG8_BAR; PG8_SCHED;
            PG8_LDA(At, 0, 1); PG8_STAGE(PG8_SB(0, 0), b2, voffB); PG8_STAGE(PG8_SB(0, 1), b2 + hstep, voffB); PG8_STAGE(PG8_SA(0, 0), a2, s0);
            PG8_WAIT_V(8); PG8_WAIT_L(0); PG8_BAR; PG8_MMA(1, 0, At, B0); PG8_MMA(1, 1, At, B1); PG8_BAR; PG8_SCHED;
            PG8_LDB(B0, 1, 0); PG8_LDB(B1, 1, 1); PG8_SCHED; PG8_LDA(At, 1, 0); PG8_STAGE(PG8_SA(0, 1), a2, s1);
            PG8_WAIT_V(8); PG8_WAIT_L(0); PG8_BAR; PG8_MMA(0, 0, At, B0); PG8_MMA(0, 1, At, B1); PG8_BAR; PG8_SCHED;
            PG8_LDA(At, 1, 1); PG8_STAGE(PG8_SB(1, 0), b3, voffB); PG8_STAGE(PG8_SB(1, 1), b3 + hstep, voffB); PG8_STAGE(PG8_SA(1, 0), a3, s0);
            PG8_WAIT_V(8); PG8_WAIT_L(0); PG8_BAR; PG8_MMA(1, 0, At, B0); PG8_MMA(1, 1, At, B1); PG8_BAR; PG8_SCHED;
        }
        if constexpr (ALIGN_EPI) { if (wr == 0) PG8_BAR; }
        if constexpr (ES == 1) asm volatile("s_nop 15\n\ts_nop 7" ::: "memory");
        if (!DRY_FLAG) { int l2 = lane; asm volatile("" : "+v"(l2)); E(acc, cur, wr, wc, l2 & 15, l2 >> 4); }
        if (!has_next) break;
#pragma unroll
        for (int a = 0; a < 2; ++a)
#pragma unroll
            for (int b = 0; b < 2; ++b)
#pragma unroll
                for (int m = 0; m < 4; ++m)
#pragma unroll
                    for (int n = 0; n < 2; ++n) acc[a][b][m][n] = (f32x4){0.f, 0.f, 0.f, 0.f};
        cur = nxt; cA = nA; cB = nB; ++ui;
#pragma unroll
        for (int h = 0; h < 2; ++h)
#pragma unroll
            for (int i = 0; i < 2; ++i) vA[h][i] = nvA[h][i];
        if constexpr (ALIGN_EPI) { if (wr == 1) PG8_BAR; }
    }
    PG8_WAIT_V(0);
    if constexpr (!ALIGN_EPI) { if (wr == 0) PG8_BAR; }
    PG8_BAR;
#undef PG8_SA
#undef PG8_SB
#undef PG8_STAGE
#undef PG8_LDA
#undef PG8_LDB
#undef PG8_MMA
#undef PG8_LD8
#undef PG8_LO
#undef PG8_HI
#undef PG8_WAIT_V
#undef PG8_WAIT_L
#undef PG8_BAR
#undef PG8_SCHED
#undef PG8_VOFFA
}
}

constexpr int NWAVES = 8;
constexpr int RING_OFF = 0, RING_BYTES = 139264;
constexpr int LDSCTL_OFF = RING_BYTES, MISC_OFF = LDSCTL_OFF + 320;
constexpr int MOE_OFF = LDSCTL_OFF + 1024;
constexpr int LDS_BYTES = RING_BYTES + 16384;
constexpr int CW_TMO = 0, CW_CODE = 1, CW_BAR = 4096;
constexpr int N_PHASES = 10;

typedef GAS unsigned gu32;
#define RLX_AGENT __ATOMIC_RELAXED, __HIP_MEMORY_SCOPE_AGENT
#define LDS_WAIT() asm volatile("s_waitcnt lgkmcnt(0)" ::: "memory")
#define VM_WAIT() asm volatile("s_waitcnt vmcnt(0)" ::: "memory")

#define XB_TMO      128
#define XB_XCNT(j)  (256  + 64 * (j))
#define XB_XSUB(j)  (1280 + 64 * (j))
#define XB_XGEN(j)  (2304 + 64 * (j))
#define XB_TOP      3328
#define XB_TOPGEN   3392
#define XCD_BAR_WORDS 3456
#define XB_SPIN_CAP (1u << 18)
__device__ __forceinline__ unsigned xb_ld(unsigned* p)              { return __hip_atomic_load(p, __ATOMIC_RELAXED, __HIP_MEMORY_SCOPE_AGENT); }
__device__ __forceinline__ unsigned xb_add(unsigned* p, unsigned v) { return __hip_atomic_fetch_add(p, v, __ATOMIC_RELAXED, __HIP_MEMORY_SCOPE_AGENT); }
__device__ __forceinline__ unsigned xb_xcc_id() { return (unsigned)__builtin_amdgcn_s_getreg((3 << 11) | 20) & 0xFu; }
#define XB_SPIN(cond, bar) do { unsigned _sp = 0; while (cond) { __builtin_amdgcn_s_sleep(1); \
    if ((++_sp & 255u) == 0u) { if (xb_ld(&(bar)[XB_TMO])) break; if (_sp > XB_SPIN_CAP) { atomicAdd(&(bar)[XB_TMO], 1u); break; } } } } while (0)
struct XcdBarrier { unsigned* bar; unsigned x; volatile LAS unsigned* st; };
__device__ __forceinline__ XcdBarrier xcd_barrier_post(unsigned* bar, volatile LAS unsigned* st) {
    XcdBarrier b; b.bar = bar; b.x = xb_xcc_id(); b.st = st;
    if (threadIdx.x == 0) (void)xb_add(&bar[XB_XCNT(b.x)], 1u);
    return b;
}
__device__ __forceinline__ void xcd_barrier_complete(unsigned* bar, unsigned x, unsigned& nloc, unsigned& nx) {
    const unsigned G = gridDim.x * gridDim.y * gridDim.z;
    unsigned sum, cnt, mine, sp = 0u;
    for (;;) {
        sum = 0u; cnt = 0u; mine = 0u;
#pragma unroll
        for (unsigned j = 0; j < 16; ++j) { const unsigned c = xb_ld(&bar[XB_XCNT(j)]); sum += c; cnt += (c > 0u) ? 1u : 0u; mine = (j == x) ? c : mine; }
        if (sum == G) break;
        __builtin_amdgcn_s_sleep(1);
        if ((++sp & 255u) == 0u) { if (xb_ld(&bar[XB_TMO])) break; if (sp > XB_SPIN_CAP) { atomicAdd(&bar[XB_TMO], 1u); break; } }
    }
    nloc = mine > 0u ? mine : 1u; nx = cnt > 0u ? cnt : 1u;
}
__device__ __forceinline__ void xcd_barrier(const XcdBarrier& b) {
    asm volatile("s_waitcnt vmcnt(0)" ::: "memory");
    __syncthreads();
    if (threadIdx.x == 0) {
        unsigned* bar = b.bar;
        __builtin_amdgcn_s_waitcnt(0);
        unsigned nloc = b.st[0], nx = b.st[1];
        if (nloc == 0u) { xcd_barrier_complete(bar, b.x, nloc, nx); b.st[0] = nloc; b.st[1] = nx; }
        const unsigned old = xb_add(&bar[XB_XSUB(b.x)], 1u);
        const unsigned gen = old / nloc;
        if (old + 1u == (gen + 1u) * nloc) {
            __builtin_amdgcn_fence(__ATOMIC_RELEASE, "agent");
            asm volatile("s_waitcnt vmcnt(0)" ::: "memory");
            const unsigned og = xb_add(&bar[XB_TOP], 1u);
            const unsigned tg = og / nx;
            if (og + 1u == (tg + 1u) * nx) xb_add(&bar[XB_TOPGEN], 1u);
            else XB_SPIN(xb_ld(&bar[XB_TOPGEN]) == tg, bar);
            __builtin_amdgcn_fence(__ATOMIC_ACQUIRE, "agent");
            xb_add(&bar[XB_XGEN(b.x)], 1u);
            asm volatile("s_waitcnt vmcnt(0)" ::: "memory");
        } else {
            XB_SPIN(xb_ld(&bar[XB_XGEN(b.x)]) == gen, bar);
            __builtin_amdgcn_fence(__ATOMIC_ACQUIRE, "agent");
            asm volatile("s_waitcnt vmcnt(0)" ::: "memory");
        }
    }
    __syncthreads();
}

struct Frame {
    LAS unsigned char* lds; volatile LAS unsigned* MISC; gu32* ctl;
    int tid, lane, wave, vcu, G;
    const float *x, *norm1_g, *w_in, *b_in, *sinks, *attn_g, *lb_logits, *hgrn_g, *w_out, *b_out, *norm2_g, *router_w, *router_b, *w1, *b1, *w2, *b2, *final_g;
    float* out; unsigned char* ws;
};
#define WSP(type, off) ((type*)(F.ws + (off)))

typedef float f32x16 __attribute__((ext_vector_type(16)));
typedef __bf16 bf16x2_t __attribute__((ext_vector_type(2)));
__device__ __forceinline__ unsigned cvtpk(float lo, float hi) { f32x2 v = {lo, hi}; bf16x2_t b = __builtin_convertvector(v, bf16x2_t); return __builtin_bit_cast(unsigned, b); }
__device__ __forceinline__ int crow(int reg, int h) { return (reg & 3) + 8 * (reg >> 2) + 4 * h; }
__device__ __forceinline__ float bflo(unsigned u) { return __builtin_bit_cast(float, u << 16); }
__device__ __forceinline__ float bfhi(unsigned u) { return __builtin_bit_cast(float, u & 0xffff0000u); }
__device__ __forceinline__ bf16x8 pack_step(const f32x16& x, int s) {
    u32x4 p; p.x = cvtpk(x[8 * s], x[8 * s + 1]); p.y = cvtpk(x[8 * s + 2], x[8 * s + 3]); p.z = cvtpk(x[8 * s + 4], x[8 * s + 5]); p.w = cvtpk(x[8 * s + 6], x[8 * s + 7]);
    return __builtin_bit_cast(bf16x8, p);
}
#define MFMA32(a, b, c) __builtin_amdgcn_mfma_f32_32x32x16_bf16((a), (b), (c), 0, 0, 0)
#define MFMA16(a, b, c) __builtin_amdgcn_mfma_f32_16x16x32_bf16((a), (b), (c), 0, 0, 0)

__device__ __forceinline__ void p_hgrn_prep(Frame& F) {
    constexpr int GP = 132, QP = 136, VP = 72, AP = 72;
    LAS float* Gs = (LAS float*)F.lds;
    LAS bf16_t* Qs = (LAS bf16_t*)(F.lds + 33792);
    LAS bf16_t* Ks = (LAS bf16_t*)(F.lds + 33792 + 17408);
    LAS bf16_t* Vt = (LAS bf16_t*)(F.lds + 33792 + 2 * 17408);
    LAS bf16_t* At = (LAS bf16_t*)(F.lds + 33792 + 2 * 17408 + 18432);
    LAS float* Tot = (LAS float*)(F.lds + 96256);
    LAS float* Bl = Tot + 8 * 128;
    const bf16_t* HQ = WSP(bf16_t, WS_HQ); const float* G = WSP(float, WS_G); const bf16_t* KK = WSP(bf16_t, WS_KK); const bf16_t* HI = WSP(bf16_t, WS_HI);
    bf16_t* QF = WSP(bf16_t, WS_QF); bf16_t* KF = WSP(bf16_t, WS_KF); bf16_t* VF = WSP(bf16_t, WS_VF); bf16_t* INTRA = WSP(bf16_t, WS_INTRA); float* DEC = WSP(float, WS_DEC);
    const int tid = F.tid, lane = F.lane, w = F.wave, r = lane & 31, h = lane >> 5, fr = lane & 15, fq = lane >> 4;
    for (int ch = blockIdx.x; ch < BATCH * 4 * 32; ch += F.G) {
        const int bh = ch >> 5, c = ch & 31, b = bh >> 2, hd = bh & 3;
        const size_t t0 = (size_t)b * SEQ + 64 * c; const int col0 = hd * 128;
#pragma unroll
        for (int i = 0; i < 4; ++i) { const int idx = tid + 512 * i, row = idx >> 5, c4 = idx & 31; *(LAS f32x4*)(Gs + row * GP + 4 * c4) = *(const f32x4*)(G + (t0 + row) * HKW + col0 + 4 * c4); }
#pragma unroll
        for (int i = 0; i < 2; ++i) { const int idx = tid + 512 * i, row = idx >> 4, c8 = idx & 15; const size_t go = (t0 + row) * HKW + col0 + 8 * c8;
            *(LAS u32x4*)(Qs + row * QP + 8 * c8) = *(const u32x4*)(HQ + go); *(LAS u32x4*)(Ks + row * QP + 8 * c8) = *(const u32x4*)(KK + go);
            const u32x4 vv = *(const u32x4*)(HI + go);
#pragma unroll
            for (int q = 0; q < 4; ++q) { Vt[(8 * c8 + 2 * q) * VP + row] = (bf16_t)(vv[q] & 0xffffu); Vt[(8 * c8 + 2 * q + 1) * VP + row] = (bf16_t)(vv[q] >> 16); } }
        for (int i = tid; i < 64 * AP / 8; i += 512) *(LAS u32x4*)(At + 8 * i) = (u32x4){0u, 0u, 0u, 0u};
        __syncthreads();
#pragma unroll
        for (int q = 0; q < 2; ++q) { const int kk = lane + 64 * q; float run = 0.f;
#pragma unroll
            for (int i = 0; i < 8; ++i) { run += Gs[(8 * w + i) * GP + kk]; Gs[(8 * w + i) * GP + kk] = run; }
            Tot[w * 128 + kk] = run; }
        __syncthreads();
#pragma unroll
        for (int q = 0; q < 2; ++q) { const int kk = lane + 64 * q; float off = 0.f, tot = 0.f;
#pragma unroll
            for (int i = 0; i < 8; ++i) { const float tv = Tot[i * 128 + kk]; tot += tv; if (i < w) off += tv; }
#pragma unroll
            for (int i = 0; i < 8; ++i) Gs[(8 * w + i) * GP + kk] += off;
            if (w == 0) Bl[kk] = tot; }
        __syncthreads();
#pragma unroll
        for (int q = 0; q < 2; ++q) {
            const int f = w + 8 * q;
            {
                const int tt = f >> 3, kt = (f >> 1) & 3, ks = f & 1, t = 32 * tt + r, kb = 32 * kt + 16 * ks + 4 * h;
                const u32x2 qa = *(const LAS u32x2*)(Qs + t * QP + kb), qb = *(const LAS u32x2*)(Qs + t * QP + kb + 8);
                const f32x4 ba = *(const LAS f32x4*)(Gs + t * GP + kb), bb = *(const LAS f32x4*)(Gs + t * GP + kb + 8);
                u32x4 o; o.x = cvtpk(bflo(qa.x) * __expf(ba[0]), bfhi(qa.x) * __expf(ba[1])); o.y = cvtpk(bflo(qa.y) * __expf(ba[2]), bfhi(qa.y) * __expf(ba[3]));
                o.z = cvtpk(bflo(qb.x) * __expf(bb[0]), bfhi(qb.x) * __expf(bb[1])); o.w = cvtpk(bflo(qb.y) * __expf(bb[2]), bfhi(qb.y) * __expf(bb[3]));
                *(u32x4*)(QF + (((size_t)ch * 16 + f) * 64 + lane) * 8) = o;
            }
            {
                const int kt = f >> 2, ss = f & 3, kc = 32 * kt + r, s0 = 16 * ss + 8 * h; const float bl = Bl[kc];
                float v[8];
#pragma unroll
                for (int j = 0; j < 8; ++j) v[j] = bf2f(Ks[(s0 + j) * QP + kc]) * __expf(bl - Gs[(s0 + j) * GP + kc]);
                u32x4 o; o.x = cvtpk(v[0], v[1]); o.y = cvtpk(v[2], v[3]); o.z = cvtpk(v[4], v[5]); o.w = cvtpk(v[6], v[7]);
                *(u32x4*)(KF + (((size_t)ch * 16 + f) * 64 + lane) * 8) = o;
            }
            {
                const int ss = f >> 2, dt = f & 3;
                *(u32x4*)(VF + (((size_t)ch * 16 + f) * 64 + lane) * 8) = *(const LAS u32x4*)(Vt + (32 * dt + r) * VP + 16 * ss + 8 * h);
            }
        }
        if (tid < 128) DEC[(size_t)ch * 128 + tid] = __expf(Bl[tid]);
        {
            const int i = w >> 1;
            for (int j = w & 1; j <= i; j += 2) {
                f32x4 acc = {0.f, 0.f, 0.f, 0.f};
                const int t = 16 * i + fr, s = 16 * j + fr;
#pragma unroll
                for (int k4 = 0; k4 < 4; ++k4) {
                    const int k0 = 32 * k4 + 8 * fq;
                    f32x4 r0 = {0.f, 0.f, 0.f, 0.f}, r1 = {0.f, 0.f, 0.f, 0.f};
                    if (i > 0) { r0 = *(const LAS f32x4*)(Gs + (16 * i - 1) * GP + k0); r1 = *(const LAS f32x4*)(Gs + (16 * i - 1) * GP + k0 + 4); }
                    const u32x4 q8 = *(const LAS u32x4*)(Qs + t * QP + k0), k8 = *(const LAS u32x4*)(Ks + s * QP + k0);
                    const f32x4 bt0 = *(const LAS f32x4*)(Gs + t * GP + k0), bt1 = *(const LAS f32x4*)(Gs + t * GP + k0 + 4);
                    const f32x4 bs0 = *(const LAS f32x4*)(Gs + s * GP + k0), bs1 = *(const LAS f32x4*)(Gs + s * GP + k0 + 4);
                    u32x4 a, bb;
                    a.x = cvtpk(bflo(q8.x) * __expf(bt0[0] - r0[0]), bfhi(q8.x) * __expf(bt0[1] - r0[1])); a.y = cvtpk(bflo(q8.y) * __expf(bt0[2] - r0[2]), bfhi(q8.y) * __expf(bt0[3] - r0[3]));
                    a.z = cvtpk(bflo(q8.z) * __expf(bt1[0] - r1[0]), bfhi(q8.z) * __expf(bt1[1] - r1[1])); a.w = cvtpk(bflo(q8.w) * __expf(bt1[2] - r1[2]), bfhi(q8.w) * __expf(bt1[3] - r1[3]));
                    bb.x = cvtpk(bflo(k8.x) * __expf(r0[0] - bs0[0]), bfhi(k8.x) * __expf(r0[1] - bs0[1])); bb.y = cvtpk(bflo(k8.y) * __expf(r0[2] - bs0[2]), bfhi(k8.y) * __expf(r0[3] - bs0[3]));
                    bb.z = cvtpk(bflo(k8.z) * __expf(r1[0] - bs1[0]), bfhi(k8.z) * __expf(r1[1] - bs1[1])); bb.w = cvtpk(bflo(k8.w) * __expf(r1[2] - bs1[2]), bfhi(k8.w) * __expf(r1[3] - bs1[3]));
                    acc = MFMA16(__builtin_bit_cast(bf16x8, a), __builtin_bit_cast(bf16x8, bb), acc);
                }
#pragma unroll
                for (int q = 0; q < 4; ++q) { const float v = (j < i || (4 * fq + q) >= fr) ? acc[q] : 0.f; At[(16 * i + 4 * fq + q) * AP + 16 * j + fr] = f2bf(v); }
            }
        }
        __syncthreads();
        {
            const int tt = w & 1, dt = w >> 1;
            f32x16 acc;
#pragma unroll
            for (int q = 0; q < 16; ++q) acc[q] = 0.f;
#pragma unroll
            for (int ss = 0; ss < 4; ++ss) if (ss < 2 * (tt + 1)) {
                const bf16x8 a = *(const LAS bf16x8*)(At + (32 * tt + r) * AP + 16 * ss + 8 * h), bv = *(const LAS bf16x8*)(Vt + (32 * dt + r) * VP + 16 * ss + 8 * h);
                acc = MFMA32(a, bv, acc);
            }
#pragma unroll
            for (int q = 0; q < 16; ++q) INTRA[(t0 + 32 * tt + crow(q, h)) * HW + col0 + 32 * dt + r] = f2bf(acc[q]);
        }
        __syncthreads();
    }
}

constexpr int SC_OPB = 0, SC_OBUF = 65536, SC_OBP = 132, SC_OBB = 64 * SC_OBP * 4, SC_DEC = SC_OBUF + 2 * SC_OBB;
__device__ __forceinline__ void scan_unit(Frame& F, int bh) {
    const bf16_t* QF = WSP(bf16_t, WS_QF); const bf16_t* KF = WSP(bf16_t, WS_KF); const bf16_t* VF = WSP(bf16_t, WS_VF); const bf16_t* INTRA = WSP(bf16_t, WS_INTRA); const float* DEC = WSP(float, WS_DEC);
    const bf16_t* HG = WSP(bf16_t, WS_HG); bf16_t* MIX = WSP(bf16_t, WS_MIX);
    const int tid = F.tid, lane = F.lane, w = F.wave, r = lane & 31, h = lane >> 5, tt = w & 1, d = w >> 1, b = bh >> 2, hd = bh & 3;
    LAS unsigned char* lds = F.lds;
    f32x16 S[4];
#pragma unroll
    for (int kt = 0; kt < 4; ++kt)
#pragma unroll
        for (int q = 0; q < 16; ++q) S[kt][q] = 0.f;
#define SC_DMA(c_) do { const size_t chn = (size_t)bh * 32 + (c_); const int slot = ((c_) & 1) * 32768; _Pragma("unroll") for (int i_ = 0; i_ < 2; ++i_) { \
        __builtin_amdgcn_global_load_lds((const unsigned*)(QF + ((chn * 16 + 2 * w + i_) * 64 + lane) * 8), (LAS unsigned*)(lds + SC_OPB + slot + (2 * w + i_) * 1024), 16, 0, 0); \
        __builtin_amdgcn_global_load_lds((const unsigned*)(KF + ((chn * 16 + 2 * w + i_) * 64 + lane) * 8), (LAS unsigned*)(lds + SC_OPB + slot + 16384 + (2 * w + i_) * 1024), 16, 0, 0); } \
        } while (0)
#define SC_DEC_LD(c_) (*(const f32x4*)(DEC + ((size_t)bh * 32 + (c_)) * 128 + (tid & 31) * 4))
#define SC_DEC_ST(c_, v_) do { if (tid < 32) *(LAS f32x4*)(lds + SC_DEC + ((c_) & 1) * 512 + tid * 16) = (v_); } while (0)
    bf16x8 Vf[4], Vn[4];
#pragma unroll
    for (int ss = 0; ss < 4; ++ss) Vf[ss] = *(const bf16x8*)(VF + ((((size_t)bh * 32) * 16 + ss * 4 + d) * 64 + lane) * 8);
    SC_DMA(0);
    { const f32x4 dv0 = SC_DEC_LD(0); SC_DEC_ST(0, dv0); }
    __syncthreads();
    const int ft = tid >> 3, fs = tid & 7;
    const int ocol = hd * 128 + 16 * fs;
    for (int c = 0; c < 32; ++c) {
        const int slot = (c & 1) * 32768;
        f32x4 dnext = {0.f, 0.f, 0.f, 0.f};
        if (c + 1 < 32) {
            SC_DMA(c + 1);
            dnext = SC_DEC_LD(c + 1);
#pragma unroll
            for (int ss = 0; ss < 4; ++ss) Vn[ss] = *(const bf16x8*)(VF + ((((size_t)bh * 32 + c + 1) * 16 + ss * 4 + d) * 64 + lane) * 8);
        }
        const size_t trow = (size_t)b * SEQ + 64 * c + ft;
        const u32x4 in0 = *(const u32x4*)(INTRA + trow * HW + ocol), in1 = *(const u32x4*)(INTRA + trow * HW + ocol + 8);
        const u32x4 hg0 = *(const u32x4*)(HG + trow * HW + ocol), hg1 = *(const u32x4*)(HG + trow * HW + ocol + 8);
        f32x16 P;
#pragma unroll
        for (int q = 0; q < 16; ++q) P[q] = 0.f;
#pragma unroll
        for (int kt = 0; kt < 4; ++kt)
#pragma unroll
            for (int ks = 0; ks < 2; ++ks) {
                const bf16x8 qf = *(const LAS bf16x8*)(lds + SC_OPB + slot + ((tt * 4 + kt) * 2 + ks) * 1024 + lane * 16);
                P = MFMA32(qf, pack_step(S[kt], ks), P);
            }
        {   LAS float* ob = (LAS float*)(lds + SC_OBUF + (c & 1) * SC_OBB);
#pragma unroll
            for (int q = 0; q < 16; ++q) ob[(32 * tt + crow(q, h)) * SC_OBP + 32 * d + r] = P[q]; }
#pragma unroll
        for (int kt = 0; kt < 4; ++kt) {
#pragma unroll
            for (int g = 0; g < 4; ++g) { const f32x4 dc = *(const LAS f32x4*)(lds + SC_DEC + (c & 1) * 512 + (32 * kt + 8 * g + 4 * h) * 4);
#pragma unroll
                for (int q = 0; q < 4; ++q) S[kt][4 * g + q] *= dc[q]; }
#pragma unroll
            for (int ss = 0; ss < 4; ++ss) {
                const bf16x8 kf = *(const LAS bf16x8*)(lds + SC_OPB + slot + 16384 + (kt * 4 + ss) * 1024 + lane * 16);
                S[kt] = MFMA32(kf, Vf[ss], S[kt]);
            }
        }
        SC_DEC_ST(c + 1, dnext);
        __syncthreads();
        {
            const LAS float* ob = (const LAS float*)(lds + SC_OBUF + (c & 1) * SC_OBB) + ft * SC_OBP + 16 * fs;
            const f32x4 p0 = *(const LAS f32x4*)ob, p1 = *(const LAS f32x4*)(ob + 4), p2 = *(const LAS f32x4*)(ob + 8), p3 = *(const LAS f32x4*)(ob + 12);
            float o[16];
            o[0] = p0[0] + bflo(in0.x); o[1] = p0[1] + bfhi(in0.x); o[2] = p0[2] + bflo(in0.y); o[3] = p0[3] + bfhi(in0.y);
            o[4] = p1[0] + bflo(in0.z); o[5] = p1[1] + bfhi(in0.z); o[6] = p1[2] + bflo(in0.w); o[7] = p1[3] + bfhi(in0.w);
            o[8] = p2[0] + bflo(in1.x); o[9] = p2[1] + bfhi(in1.x); o[10] = p2[2] + bflo(in1.y); o[11] = p2[3] + bfhi(in1.y);
            o[12] = p3[0] + bflo(in1.z); o[13] = p3[1] + bfhi(in1.z); o[14] = p3[2] + bflo(in1.w); o[15] = p3[3] + bfhi(in1.w);
            float ss2 = 0.f;
#pragma unroll
            for (int q = 0; q < 16; ++q) ss2 += o[q] * o[q];
            ss2 += __shfl_xor(ss2, 1); ss2 += __shfl_xor(ss2, 2); ss2 += __shfl_xor(ss2, 4);
            const float rs = rsqrtf(ss2 * (1.f / 128.f) + EPS);
            const float* gh = F.hgrn_g + ocol;
            const unsigned hgw[8] = {hg0.x, hg0.y, hg0.z, hg0.w, hg1.x, hg1.y, hg1.z, hg1.w};
            unsigned ow[8];
#pragma unroll
            for (int q = 0; q < 8; ++q) ow[q] = cvtpk(o[2 * q] * rs * gh[2 * q] * bflo(hgw[q]), o[2 * q + 1] * rs * gh[2 * q + 1] * bfhi(hgw[q]));
            bf16_t* mo = MIX + trow * MIXW + AW + ocol;
            *(u32x4*)mo = (u32x4){ow[0], ow[1], ow[2], ow[3]}; *(u32x4*)(mo + 8) = (u32x4){ow[4], ow[5], ow[6], ow[7]};
        }
#pragma unroll
        for (int ss = 0; ss < 4; ++ss) Vf[ss] = Vn[ss];
    }
    __syncthreads();
#undef SC_DMA
#undef SC_DEC_LD
#undef SC_DEC_ST
}

constexpr int AT_KP = 72, AT_VP = 260;
__device__ __forceinline__ void attn_stage(Frame& F, int kvh, int n, size_t t0, LAS bf16_t* Ks, LAS bf16_t* Vt) {
    const bf16_t* AK = WSP(bf16_t, WS_AK); const bf16_t* AV = WSP(bf16_t, WS_AV);
    __syncthreads();
    int tid_ = F.tid; asm volatile("" : "+v"(tid_));
#pragma unroll
    for (int i = 0; i < 4; ++i) {
        const int idx = tid_ + 512 * i, row = idx >> 3, c8 = idx & 7;
        u32x4 kv = {0u, 0u, 0u, 0u}, vv = {0u, 0u, 0u, 0u};
        if (n > 0 || row >= 128) { const size_t go = (t0 - 128 + row) * AKW + kvh * 64 + 8 * c8; kv = *(const u32x4*)(AK + go); vv = *(const u32x4*)(AV + go); }
        *(LAS u32x4*)(Ks + row * AT_KP + 8 * c8) = kv;
#pragma unroll
        for (int q = 0; q < 4; ++q) { Vt[(8 * c8 + 2 * q) * AT_VP + row] = (bf16_t)(vv[q] & 0xffffu); Vt[(8 * c8 + 2 * q + 1) * AT_VP + row] = (bf16_t)(vv[q] >> 16); }
    }
    __syncthreads();
}
__device__ __forceinline__ void attn_item(Frame& F, int hq, int rt, int n, size_t t0, const LAS bf16_t* Ks, const LAS bf16_t* Vt, LAS float* ssq, unsigned (&okp)[16]) {
    const bf16_t* AQ = WSP(bf16_t, WS_AQ);
    int lane = F.lane; asm volatile("" : "+v"(lane));
    const int r = lane & 31, h = lane >> 5;
    constexpr float L2E = 1.4426950408889634f;
    const float slope2 = exp2f(-(float)(hq + 1)) * L2E, sink2 = F.sinks[hq] * L2E;
    bf16x8 qf[4];
#pragma unroll
    for (int ds = 0; ds < 4; ++ds) qf[ds] = *(const bf16x8*)(AQ + (t0 + 32 * rt + r) * AW + hq * 64 + 16 * ds + 8 * h);
    float m = sink2;
#define AT_SCORE(SC, j) do { const int kt = rt + (j); int rq = r - 32 * (j); asm volatile("" : "+v"(rq));     \
        _Pragma("unroll") for (int q = 0; q < 16; ++q) SC[q] = 0.f; \
        _Pragma("unroll") for (int ds = 0; ds < 4; ++ds) SC = MFMA32(*(const LAS bf16x8*)(Ks + (32 * kt + r) * AT_KP + 16 * ds + 8 * h), qf[ds], SC); \
        const bool tile_ok = (n > 0) || (kt >= 4); \
        _Pragma("unroll") for (int q = 0; q < 16; ++q) { const int dist = 128 + rq - crow(q, h); const float v = SC[q] * (0.125f * L2E) - slope2 * (float)dist; \
            SC[q] = (tile_ok && dist >= 0 && dist < 128) ? v : -INFINITY; } } while (0)
#pragma unroll
    for (int j = 0; j < 5; ++j) { f32x16 sc; AT_SCORE(sc, j);
#pragma unroll
        for (int q = 0; q < 16; ++q) m = fmaxf(m, sc[q]); }
    m = fmaxf(m, __shfl_xor(m, 32));
    float l = 0.f; unsigned pp[5][8];
#pragma unroll
    for (int j = 0; j < 5; ++j) { f32x16 sc; AT_SCORE(sc, j);
#pragma unroll
        for (int q = 0; q < 16; ++q) { sc[q] = exp2f(sc[q] - m); l += sc[q]; }
#pragma unroll
        for (int q = 0; q < 8; ++q) pp[j][q] = cvtpk(sc[2 * q], sc[2 * q + 1]); }
#undef AT_SCORE
    l += __shfl_xor(l, 32); l += exp2f(sink2 - m);
    const float rl = 1.f / l;
    float sq = 0.f;
#pragma unroll
    for (int dt = 0; dt < 2; ++dt) {
        f32x16 o;
#pragma unroll
        for (int q = 0; q < 16; ++q) o[q] = 0.f;
        const LAS bf16_t* vrow = Vt + (32 * dt + r) * AT_VP + 4 * h;
#pragma unroll
        for (int j = 0; j < 5; ++j)
#pragma unroll
            for (int s = 0; s < 2; ++s) { const LAS bf16_t* vp = vrow + 32 * (rt + j) + 16 * s;
                const u32x2 va = *(const LAS u32x2*)vp, vb = *(const LAS u32x2*)(vp + 8); const u32x4 pa = {va.x, va.y, vb.x, vb.y};
                const u32x4 pb = {pp[j][4 * s], pp[j][4 * s + 1], pp[j][4 * s + 2], pp[j][4 * s + 3]};
                o = MFMA32(__builtin_bit_cast(bf16x8, pa), __builtin_bit_cast(bf16x8, pb), o); }
#pragma unroll
        for (int q = 0; q < 16; ++q) { o[q] *= rl; sq += o[q] * o[q]; }
#pragma unroll
        for (int q = 0; q < 8; ++q) okp[dt * 8 + q] = cvtpk(o[2 * q], o[2 * q + 1]);
    }
    sq += __shfl_xor(sq, 32);
    if (h == 0) __hip_atomic_fetch_add(&ssq[32 * rt + r], sq, __ATOMIC_RELAXED, __HIP_MEMORY_SCOPE_WORKGROUP);
}
__device__ __forceinline__ void attn_store(Frame& F, int hq, int rt, size_t t0, const LAS float* ssq, const unsigned (&okp)[16]) {
    bf16_t* MIX = WSP(bf16_t, WS_MIX);
    int lane = F.lane; asm volatile("" : "+v"(lane));
    const int r = lane & 31, h = lane >> 5;
    const float rs = rsqrtf(ssq[32 * rt + r] * (1.f / AW) + EPS);
    bf16_t* mo = MIX + (t0 + 32 * rt + r) * MIXW + hq * 64;
#pragma unroll
    for (int dt = 0; dt < 2; ++dt)
#pragma unroll
        for (int g4 = 0; g4 < 4; ++g4) {
            const int d0 = 32 * dt + 8 * g4 + 4 * h; const f32x4 ga = *(const f32x4*)(F.attn_g + hq * 64 + d0);
            const unsigned p0 = okp[dt * 8 + 2 * g4], p1 = okp[dt * 8 + 2 * g4 + 1];
            u32x2 ow; ow.x = cvtpk(bflo(p0) * rs * ga[0], bfhi(p0) * rs * ga[1]); ow.y = cvtpk(bflo(p1) * rs * ga[2], bfhi(p1) * rs * ga[3]);
            *(u32x2*)(mo + d0) = ow;
        }
}
__device__ __forceinline__ void attn_unit(Frame& F, int u) {
    LAS bf16_t* Ks = (LAS bf16_t*)F.lds;
    LAS bf16_t* Vt = (LAS bf16_t*)(F.lds + 36864);
    LAS float* ssq = (LAS float*)(F.lds + 36864 + 33280);
    const int w = F.wave, b = u >> 4, n = u & 15; const size_t t0 = (size_t)b * SEQ + 128 * n;
    if (F.tid < 128) ssq[F.tid] = 0.f;
    const int g0 = (2 * w) >> 2, rt0 = (2 * w) & 3, g1 = (2 * w + 1) >> 2, rt1 = (2 * w + 1) & 3;
    unsigned ok0[16], ok1[16], ok2[16], ok3[16];
    attn_stage(F, 0, n, t0, Ks, Vt);
    attn_item(F, g0, rt0, n, t0, Ks, Vt, ssq, ok0);
    attn_item(F, g1, rt1, n, t0, Ks, Vt, ssq, ok1);
    attn_stage(F, 1, n, t0, Ks, Vt);
    attn_item(F, 4 + g0, rt0, n, t0, Ks, Vt, ssq, ok2);
    attn_item(F, 4 + g1, rt1, n, t0, Ks, Vt, ssq, ok3);
    __syncthreads();
    attn_store(F, g0, rt0, t0, ssq, ok0); attn_store(F, g1, rt1, t0, ssq, ok1); attn_store(F, 4 + g0, rt0, t0, ssq, ok2); attn_store(F, 4 + g1, rt1, t0, ssq, ok3);
    __syncthreads();
}
__device__ __forceinline__ void p_convert_experts(Frame& F, int rank, int nrank);
__device__ __forceinline__ void p_scan_attn(Frame& F, bool do_scan, bool do_attn) {
    const int G = F.G, bx = blockIdx.x, nscan = (do_scan && do_attn && G >= 64) ? 32 : 0;
    if (do_scan) { if (nscan) { if (bx < nscan) scan_unit(F, bx); } else for (int u = bx; u < BATCH * 4; u += G) scan_unit(F, u); }
    if (do_attn) { if (nscan) { for (int u = bx - nscan; u >= 0 && u < BATCH * 16; u += G - nscan) attn_unit(F, u); } else for (int u = bx; u < BATCH * 16; u += G) attn_unit(F, u); }
    if (nscan) { if (bx >= nscan) p_convert_experts(F, bx - nscan, G - nscan); } else p_convert_experts(F, bx, G);
}

__device__ __forceinline__ int w1col(int n) { const int pn = n >> 8, cl = n & 255; return cl < 128 ? 2 * (128 * pn + cl) : 2 * (128 * pn + cl - 128) + 1; }
template <bool W1MAP, bool FP8>
__device__ __forceinline__ void p0_transpose_item(const float* W, int K, int N, void* WTv, LAS float* scr, int item, int lane) {
    const int nblk = N / 32, kb = item / nblk, nb = item % nblk, k0 = 64 * kb, n0 = 32 * nb;
    const int sc = W1MAP ? w1col(n0 + (lane & 31)) : n0 + (lane & 31);
    float v[32];
#pragma unroll
    for (int i = 0; i < 32; ++i) v[i] = W[(size_t)(k0 + 2 * i + (lane >> 5)) * N + sc];
#pragma unroll
    for (int i = 0; i < 32; ++i) scr[(2 * i + (lane >> 5)) * 33 + (lane & 31)] = v[i];
    LDS_WAIT(); asm volatile("" ::: "memory");
    const int c = lane & 7;
#pragma unroll
    for (int j = 0; j < 4; ++j) { const int n = (lane >> 3) + 8 * j; const LAS float* s = scr + (8 * c) * 33 + n;
        if constexpr (FP8) { const f32x4 a = {s[0 * 33], s[1 * 33], s[2 * 33], s[3 * 33]}, b = {s[4 * 33], s[5 * 33], s[6 * 33], s[7 * 33]};
            *(GAS u32x2*)((unsigned char*)WTv + (size_t)(n0 + n) * K + k0 + 8 * c) = pg8::pack8_fp8(a * pg8::FP8_W_SCALE, b * pg8::FP8_W_SCALE); }
        else { u32x4 o; o.x = pg8::cvt_pk_bf16(s[0 * 33], s[1 * 33]); o.y = pg8::cvt_pk_bf16(s[2 * 33], s[3 * 33]); o.z = pg8::cvt_pk_bf16(s[4 * 33], s[5 * 33]); o.w = pg8::cvt_pk_bf16(s[6 * 33], s[7 * 33]);
            *(GAS u32x4*)((bf16_t*)WTv + (size_t)(n0 + n) * K + k0 + 8 * c) = o; } }
    LDS_WAIT(); asm volatile("" ::: "memory");
}
struct ConvItem { const float* W; unsigned char* WT; int N, k0, n0, map; };
__device__ __forceinline__ ConvItem conv_desc(Frame& F, int it) {
    constexpr int I_W1E = (DM / 128) * (2 * FF / 32), I_W2E = (FF / 128) * (DM / 32);
    ConvItem c;
    if (it < NE * I_W1E) { const int e = it / I_W1E, r = it % I_W1E, nblk = 2 * FF / 32; c.W = F.w1 + (size_t)e * DM * 2 * FF; c.WT = WSP(unsigned char, WS_W1T) + (size_t)e * 2 * FF * DM; c.N = 2 * FF; c.k0 = 128 * (r / nblk); c.n0 = 32 * (r % nblk); c.map = 1; }
    else { it -= NE * I_W1E; const int e = it / I_W2E, r = it % I_W2E, nblk = DM / 32; c.W = F.w2 + (size_t)e * FF * DM; c.WT = WSP(unsigned char, WS_W2T) + (size_t)e * DM * FF; c.N = DM; c.k0 = 128 * (r / nblk); c.n0 = 32 * (r % nblk); c.map = 0; }
    return c;
}
__device__ __forceinline__ void conv_item(const ConvItem& c, int lane, LAS float* scr) {
    const int sc = c.map ? w1col(c.n0 + (lane & 31)) : c.n0 + (lane & 31);
    const float* p = c.W + (size_t)(c.k0 + (lane >> 5)) * c.N + sc;
    float v[64];
#pragma unroll
    for (int i = 0; i < 64; ++i) v[i] = p[(size_t)(2 * i) * c.N];
#pragma unroll
    for (int i = 0; i < 64; ++i) scr[(2 * i + (lane >> 5)) * 33 + (lane & 31)] = v[i];
    LDS_WAIT(); asm volatile("" ::: "memory");
    const int cg = lane & 15;
#pragma unroll
    for (int j = 0; j < 8; ++j) { const int n = (lane >> 4) + 4 * j; const LAS float* s = scr + (8 * cg) * 33 + n;
        const f32x4 a = {s[0 * 33], s[1 * 33], s[2 * 33], s[3 * 33]}, b = {s[4 * 33], s[5 * 33], s[6 * 33], s[7 * 33]};
        *(GAS u32x2*)(c.WT + (size_t)(c.n0 + n) * DM + c.k0 + 8 * cg) = pg8::pack8_fp8(a * pg8::FP8_W_SCALE, b * pg8::FP8_W_SCALE); }
    LDS_WAIT(); asm volatile("" ::: "memory");
}
__device__ __forceinline__ void p_convert_experts(Frame& F, int rank, int nrank) {
    static_assert(DM == FF && RING_BYTES >= NWAVES * 128 * 33 * 4, "conv_item assumes K = 1024 for both expert matrices and a 16.5 KiB LDS tile per wave");
    LAS float* scr = (LAS float*)(F.lds + RING_OFF + F.wave * (128 * 33 * 4));
    constexpr int NITEMS = NE * (DM / 128) * (2 * FF / 32) + NE * (FF / 128) * (DM / 32);
    __syncthreads();
    for (int it = rank * NWAVES + F.wave; it < NITEMS; it += nrank * NWAVES) { const ConvItem c = conv_desc(F, it); conv_item(c, F.lane, scr); }
}
__device__ __forceinline__ void p_prologue(Frame& F) {
    LAS float* scr = (LAS float*)(F.lds + RING_OFF + F.wave * 16384);
    const int gw = F.vcu * NWAVES + F.wave, NGW = F.G * NWAVES;
    constexpr int I_IN = (DM / 64) * (INW / 32), I_OUT = (MIXW / 64) * (DM / 32), I_W1E = (DM / 64) * (2 * FF / 32), I_W2E = (FF / 64) * (DM / 32);
    constexpr int NITEMS = I_IN + I_OUT;
    bf16_t *WinT = WSP(bf16_t, WS_WINT), *WoutT = WSP(bf16_t, WS_WOUTT);
    for (int it = gw; it < NITEMS; it += NGW) {
        int r = it;
        if (r < I_IN) { p0_transpose_item<false, false>(F.w_in, DM, INW, WinT, scr, r, F.lane); continue; } r -= I_IN;
        p0_transpose_item<false, false>(F.w_out, MIXW, DM, WoutT, scr, r, F.lane);
    }
    bf16_t* XN = WSP(bf16_t, WS_XN);
    for (int m = gw; m < T; m += NGW) {
        const GAS f32x4* xr = (const GAS f32x4*)(F.x + (size_t)m * DM) + F.lane;
        f32x4 v[4]; float s = 0.f;
#pragma unroll
        for (int j = 0; j < 4; ++j) { v[j] = xr[64 * j]; s += (v[j].x * v[j].x + v[j].y * v[j].y) + (v[j].z * v[j].z + v[j].w * v[j].w); }
        const float r = rsqrtf(wave_sum(s) * (1.f / DM) + EPS);
        GAS u32x2* o8 = (GAS u32x2*)(XN + (size_t)m * DM) + F.lane;
#pragma unroll
        for (int j = 0; j < 4; ++j) { const f32x4 g = *((const f32x4*)F.norm1_g + F.lane + 64 * j); u32x2 w; w.x = pg8::cvt_pk_bf16(v[j].x * r * g.x, v[j].y * r * g.y); w.y = pg8::cvt_pk_bf16(v[j].z * r * g.z, v[j].w * r * g.w); o8[64 * j] = w; }
    }
    if ((int)blockIdx.x == (F.G > 1 ? 1 : 0)) {
        bf16_t* RWF = WSP(bf16_t, WS_RWF);
        for (int i = F.tid; i < 64 * 64; i += NWAVES * 64) { const int ks = i >> 6, ln = i & 63, rr = ln & 31, hh = ln >> 5; float v[8];
#pragma unroll
            for (int j = 0; j < 8; ++j) v[j] = F.router_w[(size_t)(16 * ks + 8 * hh + j) * NE + rr];
            u32x4 hi, lo; hi.x = cvtpk(v[0], v[1]); hi.y = cvtpk(v[2], v[3]); hi.z = cvtpk(v[4], v[5]); hi.w = cvtpk(v[6], v[7]);
            lo.x = cvtpk(v[0] - bflo(hi.x), v[1] - bfhi(hi.x)); lo.y = cvtpk(v[2] - bflo(hi.y), v[3] - bfhi(hi.y)); lo.z = cvtpk(v[4] - bflo(hi.z), v[5] - bfhi(hi.z)); lo.w = cvtpk(v[6] - bflo(hi.w), v[7] - bfhi(hi.w));
            *(u32x4*)(RWF + ((size_t)(ks * 2 + 0) * 64 + ln) * 8) = hi; *(u32x4*)(RWF + ((size_t)(ks * 2 + 1) * 64 + ln) * 8) = lo; }
    }
    if (blockIdx.x == 0) { float* LB = WSP(float, WS_LB); for (int c = F.tid; c < HKW; c += NWAVES * 64) { const float a = F.lb_logits[c], b = F.lb_logits[HKW + c]; LB[c] = 1.f / (1.f + __expf(b - a)); } }
}

#ifdef TS_A
#define RSTAMP(k) do { if (blockIdx.x == 0 && F.tid == 0) ((volatile LAS unsigned long long*)(F.lds + LDSCTL_OFF + 2048))[k] = __builtin_amdgcn_s_memrealtime(); } while (0)
#else
#define RSTAMP(k) do { } while (0)
#endif
__device__ __forceinline__ void p_router(Frame& F) {
    LAS int* lcnt = (LAS int*)(F.lds + MOE_OFF + 512); LAS int* lbase = (LAS int*)(F.lds + MOE_OFF + 768);
    LAS float* part = (LAS float*)F.lds;
    LAS float* ssqp = (LAS float*)(F.lds + 32768);
    const float* X1 = WSP(float, WS_X1); unsigned char* H2 = WSP(unsigned char, WS_H2); float* GATE = WSP(float, WS_GATE); int* LIST = WSP(int, WS_LIST); float* RSTD = WSP(float, WS_RSTD);
    const bf16_t* RWF = WSP(bf16_t, WS_RWF);
    int* cnt = (int*)(F.ctl + CW_CNT);
    const int lane = F.lane, w = F.wave, r = lane & 31, h = lane >> 5, tile = w & 1, kq = w >> 1;
    constexpr int XP = 260;
    LAS float* xs = (LAS float*)(F.lds + 36864);
    for (int tb = blockIdx.x; tb < T / 64; tb += F.G) {
        if (F.tid < NE) lcnt[F.tid] = 0;
        const int t = tb * 64 + tile * 32 + r;
        f32x16 acc;
#pragma unroll
        for (int q = 0; q < 16; ++q) acc[q] = 0.f;
        float ssq = 0.f;
        f32x4 pre0[8], pre1[8];
#define RT_LOAD(P, c_) do { _Pragma("unroll") for (int i = 0; i < 8; ++i) P[i] = *(const f32x4*)(X1 + (size_t)(tb * 64 + 8 * w + i) * DM + 256 * (c_) + 4 * lane); } while (0)
#define RT_CHUNK(P, c_) do { const int c = (c_); \
            __syncthreads();                                     \
            _Pragma("unroll") for (int i = 0; i < 8; ++i) *(LAS f32x4*)(xs + (8 * w + i) * XP + 4 * lane) = P[i]; \
            if (c + 2 < 4) RT_LOAD(P, c + 2); \
            __syncthreads(); \
            _Pragma("unroll") for (int s4 = 0; s4 < 4; ++s4) {                     \
                const int ksl = 4 * kq + s4, ks = 16 * c + ksl, k0 = 16 * ks + 8 * h; \
                const f32x4 x0 = *(const LAS f32x4*)(xs + (32 * tile + r) * XP + 16 * ksl + 8 * h), x1v = *(const LAS f32x4*)(xs + (32 * tile + r) * XP + 16 * ksl + 8 * h + 4); \
                const f32x4 g0 = *(const f32x4*)(F.norm2_g + k0), g1 = *(const f32x4*)(F.norm2_g + k0 + 4); \
                const u32x4 ahi = *(const u32x4*)(RWF + ((size_t)(ks * 2 + 0) * 64 + lane) * 8), alo = *(const u32x4*)(RWF + ((size_t)(ks * 2 + 1) * 64 + lane) * 8); \
                float u[8]; \
                _Pragma("unroll") for (int q = 0; q < 4; ++q) { u[q] = x0[q] * g0[q]; u[4 + q] = x1v[q] * g1[q]; ssq += x0[q] * x0[q]; ssq += x1v[q] * x1v[q]; } \
                u32x4 bh, bl; \
                bh.x = cvtpk(u[0], u[1]); bh.y = cvtpk(u[2], u[3]); bh.z = cvtpk(u[4], u[5]); bh.w = cvtpk(u[6], u[7]); \
                bl.x = cvtpk(u[0] - bflo(bh.x), u[1] - bfhi(bh.x)); bl.y = cvtpk(u[2] - bflo(bh.y), u[3] - bfhi(bh.y)); \
                bl.z = cvtpk(u[4] - bflo(bh.z), u[5] - bfhi(bh.z)); bl.w = cvtpk(u[6] - bflo(bh.w), u[7] - bfhi(bh.w)); \
                *(u32x2*)(H2 + (size_t)t * DM + k0) = pg8::pack8_fp8((f32x4){u[0], u[1], u[2], u[3]} * pg8::FP8_ACT_SCALE, (f32x4){u[4], u[5], u[6], u[7]} * pg8::FP8_ACT_SCALE);     \
                acc = MFMA32(__builtin_bit_cast(bf16x8, ahi), __builtin_bit_cast(bf16x8, bh), acc); \
                acc = MFMA32(__builtin_bit_cast(bf16x8, alo), __builtin_bit_cast(bf16x8, bh), acc); \
                acc = MFMA32(__builtin_bit_cast(bf16x8, ahi), __builtin_bit_cast(bf16x8, bl), acc); \
            } } while (0)
        RT_LOAD(pre0, 0); RT_LOAD(pre1, 1);
#pragma unroll 1
        for (int cc = 0; cc < 4; cc += 2) { RT_CHUNK(pre0, cc); RT_CHUNK(pre1, cc + 1); }
#undef RT_LOAD
#undef RT_CHUNK
#pragma unroll
        for (int q = 0; q < 4; ++q) *(LAS f32x4*)(part + (w * 64 + lane) * 16 + 4 * q) = (f32x4){acc[4 * q], acc[4 * q + 1], acc[4 * q + 2], acc[4 * q + 3]};
        ssqp[w * 64 + lane] = ssq;
        RSTAMP(11);
        __syncthreads();
        RSTAMP(12);
        int my_e[TOPK], my_p[TOPK];
#pragma unroll
        for (int k = 0; k < TOPK; ++k) { my_e[k] = 0; my_p[k] = 0; }
        if (w < 2) {
            float lg[16];
#pragma unroll
            for (int q = 0; q < 16; ++q) lg[q] = 0.f;
            float s2 = 0.f;
#pragma unroll
            for (int k4 = 0; k4 < 4; ++k4) { const int ww = k4 * 2 + tile;
#pragma unroll
                for (int q = 0; q < 4; ++q) { const f32x4 p = *(const LAS f32x4*)(part + (ww * 64 + lane) * 16 + 4 * q); lg[4 * q] += p[0]; lg[4 * q + 1] += p[1]; lg[4 * q + 2] += p[2]; lg[4 * q + 3] += p[3]; }
                s2 += ssqp[ww * 64 + lane] + ssqp[ww * 64 + (lane ^ 32)]; }
            const float rstd = rsqrtf(s2 * (1.f / DM) + EPS);
#pragma unroll
            for (int q = 0; q < 16; ++q) lg[q] = lg[q] * rstd + F.router_b[crow(q, h)];
            float cv[8]; int ci[8];
#pragma unroll
            for (int k = 0; k < TOPK; ++k) {
                float bv = -INFINITY; int bi = 1 << 20;
#pragma unroll
                for (int q = 0; q < 16; ++q) { const int e = crow(q, h); const bool better = (lg[q] > bv) || (lg[q] == bv && e < bi); bv = better ? lg[q] : bv; bi = better ? e : bi; }
#pragma unroll
                for (int q = 0; q < 16; ++q) if (crow(q, h) == bi) lg[q] = -INFINITY;
                cv[k] = bv; ci[k] = bi;
            }
#pragma unroll
            for (int k = 0; k < TOPK; ++k) { cv[4 + k] = __shfl_xor(cv[k], 32); ci[4 + k] = __shfl_xor(ci[k], 32); }
            float tv[TOPK]; int te[TOPK];
#pragma unroll
            for (int k = 0; k < TOPK; ++k) {
                float bv = -INFINITY; int bi = 1 << 20;
#pragma unroll
                for (int q = 0; q < 8; ++q) { const bool better = (cv[q] > bv) || (cv[q] == bv && ci[q] < bi); bv = better ? cv[q] : bv; bi = better ? ci[q] : bi; }
#pragma unroll
                for (int q = 0; q < 8; ++q) if (ci[q] == bi) cv[q] = -INFINITY;
                tv[k] = bv; te[k] = bi;
            }
            const float e1 = __expf(tv[1] - tv[0]), e2 = __expf(tv[2] - tv[0]), e3 = __expf(tv[3] - tv[0]), inv = 1.f / (1.f + e1 + e2 + e3);
            if (h == 0) {
                RSTD[t] = rstd;
                *(f32x4*)(GATE + (size_t)t * TOPK) = (f32x4){inv, e1 * inv, e2 * inv, e3 * inv};
#pragma unroll
                for (int k = 0; k < TOPK; ++k) { my_e[k] = te[k]; my_p[k] = __hip_atomic_fetch_add(&lcnt[te[k]], 1, __ATOMIC_RELAXED, __HIP_MEMORY_SCOPE_WORKGROUP); }
            }
        }
        RSTAMP(13);
        __syncthreads();
        if (F.tid < NE) lbase[F.tid] = atomicAdd(&cnt[F.tid * 64], (int)lcnt[F.tid]);
        __syncthreads();
        if (w < 2 && h == 0) {
#pragma unroll
            for (int k = 0; k < TOPK; ++k) LIST[(size_t)my_e[k] * T + lbase[my_e[k]] + my_p[k]] = t * TOPK + k;
        }
        __syncthreads();
        RSTAMP(14);
    }
}
__device__ __forceinline__ void moe_setup(Frame& F) {
    LAS int* pre = (LAS int*)(F.lds + MOE_OFF); LAS int* lc = (LAS int*)(F.lds + MOE_OFF + 256);
    if (F.tid < 64) {
        const int c = F.lane < NE ? (int)__hip_atomic_load((int*)(F.ctl + CW_CNT) + F.lane * 64, RLX_AGENT) : 0;
        int s = (c + 255) >> 8;
#pragma unroll
        for (int o = 1; o < 32; o <<= 1) { const int v = __shfl_up(s, o); if ((F.lane & 31) >= o) s += v; }
        if (F.lane < NE) { pre[F.lane + 1] = s; lc[F.lane] = c; }
        if (F.lane == 0) pre[0] = 0;
    }
    __syncthreads();
}
__device__ __forceinline__ void p_final(Frame& F) {
    const float* X1 = WSP(float, WS_X1); const bf16_t* Y = WSP(bf16_t, WS_Y);
    const int gw = F.vcu * NWAVES + F.wave, NGW = F.G * NWAVES;
    for (int t = gw; t < T; t += NGW) {
        const GAS f32x4* xr = (const GAS f32x4*)(X1 + (size_t)t * DM) + F.lane;
        f32x4 v[4]; float s = 0.f;
#pragma unroll
        for (int j = 0; j < 4; ++j) {
            v[j] = xr[64 * j];
#pragma unroll
            for (int k = 0; k < TOPK; ++k) { const u32x2 y = *((const GAS u32x2*)(Y + ((size_t)t * TOPK + k) * DM) + F.lane + 64 * j);
                v[j].x += __builtin_bit_cast(float, y.x << 16); v[j].y += __builtin_bit_cast(float, y.x & 0xffff0000u); v[j].z += __builtin_bit_cast(float, y.y << 16); v[j].w += __builtin_bit_cast(float, y.y & 0xffff0000u); }
            s += (v[j].x * v[j].x + v[j].y * v[j].y) + (v[j].z * v[j].z + v[j].w * v[j].w);
        }
        const float r = rsqrtf(wave_sum(s) * (1.f / DM) + EPS);
        GAS f32x4* o = (GAS f32x4*)(F.out + (size_t)t * DM) + F.lane;
#pragma unroll
        for (int j = 0; j < 4; ++j) { const f32x4 g = *((const f32x4*)F.final_g + F.lane + 64 * j); o[64 * j] = (f32x4){v[j].x * r * g.x, v[j].y * r * g.y, v[j].z * r * g.z, v[j].w * r * g.w}; }
    }
}


__device__ __forceinline__ void p_attn_simple(Frame& F) {
    const bf16_t* AQ = WSP(bf16_t, WS_AQ); const bf16_t* AK = WSP(bf16_t, WS_AK); const bf16_t* AV = WSP(bf16_t, WS_AV); float* ATT = WSP(float, WS_ATT);
    const int gw0 = F.vcu * NWAVES + F.wave, NGW = F.G * NWAVES, lane = F.lane;
    for (int gw = gw0; gw < T * 8; gw += NGW) {
        const int t = gw >> 3, hq = gw & 7, kvh = hq >> 2, b = t / SEQ, tp = t % SEQ;
        const float slope = exp2f(-(float)(hq + 1)), sink = F.sinks[hq];
        const float qd = bf2f(AQ[(size_t)t * AW + hq * 64 + lane]);
        const int s0 = tp >= 127 ? tp - 127 : 0, nk = tp - s0 + 1;
        const bf16_t* kb = AK + ((size_t)b * SEQ + s0) * AKW + kvh * 64 + lane;
        const bf16_t* vb = AV + ((size_t)b * SEQ + s0) * AKW + kvh * 64 + lane;
        float slo = -INFINITY, shi = -INFINITY;
        for (int i = 0; i < nk; ++i) {
            const float d = wave_sum(qd * bf2f(kb[(size_t)i * AKW]));
            const float sc = d * 0.125f - slope * (float)(tp - (s0 + i));
            if ((i & 63) == lane) { if (i < 64) slo = sc; else shi = sc; }
        }
        const float m = fmaxf(wave_max(fmaxf(slo, shi)), sink);
        const float plo = __expf(slo - m), phi = __expf(shi - m);
        const float den = wave_sum(plo + phi) + __expf(sink - m);
        float o = 0.f;
        for (int i = 0; i < nk; ++i) { const float p = __shfl(i < 64 ? plo : phi, i & 63); o += p * bf2f(vb[(size_t)i * AKW]); }
        ATT[(size_t)t * AW + hq * 64 + lane] = o / den;
    }
}
__device__ __forceinline__ void p_hgrn_simple(Frame& F) {
    constexpr int TT = 16;
    LAS float* sf = (LAS float*)(F.lds); LAS float* sk = sf + TT * 128; LAS float* sq = sk + TT * 128; LAS float* po = sq + TT * 128;
    const bf16_t* HQ = WSP(bf16_t, WS_HQ); const float* G = WSP(float, WS_G); const bf16_t* KK = WSP(bf16_t, WS_KK); const bf16_t* HI = WSP(bf16_t, WS_HI); float* ORAW = WSP(float, WS_ORAW);
    for (int u = blockIdx.x; u < BATCH * 4; u += F.G) {
        const int b = u >> 2, h = u & 3, v = F.tid & 127, kq = F.tid >> 7;
        float S[32];
#pragma unroll
        for (int k = 0; k < 32; ++k) S[k] = 0.f;
        for (int t0 = 0; t0 < SEQ; t0 += TT) {
            __syncthreads();
            for (int i = F.tid; i < TT * 128; i += NWAVES * 64) {
                const int tt = i >> 7, k = i & 127; const size_t idx = ((size_t)b * SEQ + t0 + tt) * HKW + h * 128 + k;
                sf[i] = __expf(G[idx]); sk[i] = bf2f(KK[idx]); sq[i] = bf2f(HQ[idx]);
            }
            __syncthreads();
            for (int tt = 0; tt < TT; ++tt) {
                const float vv = bf2f(HI[((size_t)b * SEQ + t0 + tt) * HW + h * 128 + v]);
                float o = 0.f;
#pragma unroll
                for (int k = 0; k < 32; ++k) { const int kk = tt * 128 + kq * 32 + k; S[k] = sf[kk] * S[k] + sk[kk] * vv; o += sq[kk] * S[k]; }
                po[(tt * 4 + kq) * 128 + v] = o;
            }
            __syncthreads();
            for (int i = F.tid; i < TT * 128; i += NWAVES * 64) {
                const int tt = i >> 7, vv = i & 127;
                ORAW[((size_t)b * SEQ + t0 + tt) * HW + h * 128 + vv] = (po[(tt * 4 + 0) * 128 + vv] + po[(tt * 4 + 1) * 128 + vv]) + (po[(tt * 4 + 2) * 128 + vv] + po[(tt * 4 + 3) * 128 + vv]);
            }
        }
        __syncthreads();
    }
}
__device__ __forceinline__ void p_mix_simple(Frame& F, bool do_attn, bool do_hgrn) {
    const float* ATT = WSP(float, WS_ATT); const float* ORAW = WSP(float, WS_ORAW); const bf16_t* HG = WSP(bf16_t, WS_HG); bf16_t* MIX = WSP(bf16_t, WS_MIX);
    const int gw0 = F.vcu * NWAVES + F.wave, NGW = F.G * NWAVES, lane = F.lane;
    for (int t = gw0; t < T; t += NGW) {
        if (do_attn) {
        float a[8]; float ss = 0.f;
#pragma unroll
        for (int j = 0; j < 8; ++j) { a[j] = ATT[(size_t)t * AW + lane + 64 * j]; ss += a[j] * a[j]; }
        const float r = rsqrtf(wave_sum(ss) * (1.f / AW) + EPS);
#pragma unroll
        for (int j = 0; j < 8; ++j) MIX[(size_t)t * MIXW + lane + 64 * j] = f2bf(a[j] * r * F.attn_g[lane + 64 * j]);
        }
        if (do_hgrn)
#pragma unroll
        for (int h = 0; h < 4; ++h) {
            const int c0 = h * 128 + lane, c1 = c0 + 64;
            const float o0 = ORAW[(size_t)t * HW + c0], o1 = ORAW[(size_t)t * HW + c1];
            const float rr = rsqrtf(wave_sum(o0 * o0 + o1 * o1) * (1.f / 128.f) + EPS);
            MIX[(size_t)t * MIXW + AW + c0] = f2bf(o0 * rr * F.hgrn_g[c0] * bf2f(HG[(size_t)t * HW + c0]));
            MIX[(size_t)t * MIXW + AW + c1] = f2bf(o1 * rr * F.hgrn_g[c1] * bf2f(HG[(size_t)t * HW + c1]));
        }
    }
}

struct Args { const float* in[18]; float* out; unsigned char* ws; int ph_lo, ph_hi, li, dry; };
__global__ void __launch_bounds__(NWAVES * 64, 2) mega_fwd(Args args) {
    extern __shared__ __attribute__((aligned(16))) unsigned char lds[];
    Frame F;
    F.lds = (LAS unsigned char*)lds; F.MISC = (volatile LAS unsigned*)(F.lds + MISC_OFF);
    F.tid = threadIdx.x; F.lane = F.tid & 63; F.wave = __builtin_amdgcn_readfirstlane(F.tid >> 6);
    F.G = gridDim.x; { const int bx = blockIdx.x; F.vcu = (F.G % 8 == 0) ? (bx % 8) * (F.G / 8) + bx / 8 : bx; }
    F.ws = args.ws; F.ctl = (gu32*)(args.ws + WS_CTL); F.out = args.out;
    F.x = args.in[0]; F.norm1_g = args.in[1]; F.w_in = args.in[2]; F.b_in = args.in[3]; F.sinks = args.in[4]; F.attn_g = args.in[5]; F.lb_logits = args.in[6]; F.hgrn_g = args.in[7];
    F.w_out = args.in[8]; F.b_out = args.in[9]; F.norm2_g = args.in[10]; F.router_w = args.in[11]; F.router_b = args.in[12]; F.w1 = args.in[13]; F.b1 = args.in[14]; F.w2 = args.in[15];
    F.b2 = args.in[16]; F.final_g = args.in[17];
    for (int u = F.tid; u < (LDS_BYTES - LDSCTL_OFF) / 4; u += NWAVES * 64) ((LAS unsigned*)(F.lds + LDSCTL_OFF))[u] = 0u;
    __syncthreads();
    XcdBarrier bar = xcd_barrier_post((unsigned*)(F.ctl + CW_BAR) + args.li * XCD_BAR_WORDS, F.MISC + 8);
    const int lo = args.ph_lo, hi = args.ph_hi;
#ifdef TS_A
    volatile LAS unsigned long long* ts_ = (volatile LAS unsigned long long*)(F.lds + LDSCTL_OFF + 2048);
    const bool stamper = (blockIdx.x == 0 && F.tid == 0);
    if (stamper) ts_[0] = __builtin_amdgcn_s_memrealtime();
#define STAMP(k) do { if (stamper) ts_[(k) + 1] = __builtin_amdgcn_s_memrealtime(); } while (0)
#else
#define STAMP(k) do { } while (0)
#endif
#define IN(k) (lo <= (k) && (k) < hi)
#define SEAM(k) do { if (IN(k) && IN((k) + 1)) xcd_barrier(bar); } while (0)

    if (IN(0)) { p_prologue(F); SEAM(0); } STAMP(0);
    if (IN(1)) {
        pg8::DenseOrder S; S.init(WSP(bf16_t, WS_XN), WSP(bf16_t, WS_WINT), T, INW, DM, F.G, (int)blockIdx.x);
        pg8::EpiInProj E{F.b_in, WSP(float, WS_LB), WSP(bf16_t, WS_AQ), WSP(bf16_t, WS_AK), WSP(bf16_t, WS_AV), WSP(bf16_t, WS_HQ), WSP(bf16_t, WS_KK), WSP(bf16_t, WS_HI), WSP(bf16_t, WS_HG), WSP(float, WS_G)};
        pg8::gemm_phase<pg8::EpiInProj, pg8::DenseOrder, false, true>(F.lds + RING_OFF, DM, S, E, args.dry);
        SEAM(1);
    } STAMP(1);
#ifndef NEW_ATTN
#define NEW_ATTN 1
#endif
#ifndef NEW_HGRN
#define NEW_HGRN 1
#endif
    if (IN(2)) { if (!NEW_ATTN) p_attn_simple(F); if (NEW_HGRN) p_hgrn_prep(F); SEAM(2); } STAMP(2);
    if (IN(3)) { if (!NEW_HGRN) p_hgrn_simple(F); p_scan_attn(F, NEW_HGRN, NEW_ATTN); SEAM(3); } STAMP(3);
    if (IN(4)) { if (!NEW_ATTN || !NEW_HGRN) p_mix_simple(F, !NEW_ATTN, !NEW_HGRN); SEAM(4); } STAMP(4);
    if (IN(5)) {
        pg8::DenseOrder S; S.init(WSP(bf16_t, WS_MIX), WSP(bf16_t, WS_WOUTT), T, DM, MIXW, F.G, (int)blockIdx.x);
        pg8::EpiOutProj E{F.b_out, F.x, WSP(float, WS_X1)};
        pg8::gemm_phase<pg8::EpiOutProj, pg8::DenseOrder, false, true>(F.lds + RING_OFF, MIXW, S, E);
        SEAM(5);
    } STAMP(5);
    if (IN(6)) { p_router(F); SEAM(6); } STAMP(6);
    if (IN(7)) {
        moe_setup(F);
        LAS const int* pre = (LAS const int*)(F.lds + MOE_OFF); LAS const int* lc = (LAS const int*)(F.lds + MOE_OFF + 256);
        pg8::MoeOrder<true, 1> S{(const char*)WSP(unsigned char, WS_H2), (const char*)WSP(unsigned char, WS_W1T), WSP(int, WS_LIST), pre, lc, DM, 2 * FF, 2 * FF / 256, pre[NE] * (2 * FF / 256), F.G, (int)blockIdx.x};
        pg8::EpiMoe1 E{F.b1, WSP(unsigned char, WS_ACT), WSP(int, WS_LIST), WSP(float, WS_RSTD)};
        pg8::gemm_phase<pg8::EpiMoe1, pg8::MoeOrder<true, 1>, true, true, 1>(F.lds + RING_OFF, DM, S, E, args.dry);
        SEAM(7);
    } STAMP(7);
    if (IN(8)) {
        if (!IN(7)) moe_setup(F);
        LAS const int* pre = (LAS const int*)(F.lds + MOE_OFF); LAS const int* lc = (LAS const int*)(F.lds + MOE_OFF + 256);
        pg8::MoeOrder<false, 1> S{(const char*)WSP(unsigned char, WS_ACT), (const char*)WSP(unsigned char, WS_W2T), WSP(int, WS_LIST), pre, lc, FF, DM, DM / 256, pre[NE] * (DM / 256), F.G, (int)blockIdx.x};
        pg8::EpiMoe2 E{F.b2, WSP(int, WS_LIST), WSP(float, WS_GATE), WSP(bf16_t, WS_Y)};
        pg8::gemm_phase<pg8::EpiMoe2, pg8::MoeOrder<false, 1>, false, true, 1>(F.lds + RING_OFF, FF, S, E, args.dry);
        SEAM(8);
    } STAMP(8);
    if (IN(9)) p_final(F);
    STAMP(9);
#ifdef TS_A
    if (stamper) { const unsigned long long t_end = ts_[10], dly = (unsigned long long)(TS_MULT) * (ts_[TS_B] - ts_[TS_A]); while (__builtin_amdgcn_s_memrealtime() - t_end < dly) __builtin_amdgcn_s_sleep(4); }
#endif
#undef IN
#undef SEAM
}

static int mega_grid() {
    static int grid = 0;
    if (grid == 0) {
        int dev = 0, cus = 0;
        if (hipGetDevice(&dev) != hipSuccess || hipDeviceGetAttribute(&cus, hipDeviceAttributeMultiprocessorCount, dev) != hipSuccess) { grid = -1; return grid; }
        if (hipFuncSetAttribute((const void*)mega_fwd, hipFuncAttributeMaxDynamicSharedMemorySize, LDS_BYTES) != hipSuccess) { grid = -1; return grid; }
        (void)hipGetLastError();
        grid = cus;
    }
    return grid;
}
extern "C" void kernel_launch(void* const* d_in, const int* in_sizes, int n_in, void* d_out, int out_size, void* d_ws, size_t ws_size, hipStream_t stream) {
    if (n_in != 18 || ws_size < WS_END) return;
    const int grid = mega_grid(); if (grid <= 0) return;
    unsigned char* ws = (unsigned char*)d_ws;
    (void)hipMemsetAsync(ws + WS_CTL, 0, 262144, stream);
    Args a{};
    for (int i = 0; i < 18; ++i) a.in[i] = (const float*)d_in[i];
    a.out = (float*)d_out; a.ws = ws;
#ifndef PLAN
#define PLAN {{0, N_PHASES, 0}}
#endif
    static const int plan[][3] = PLAN;
    for (int li = 0; li < (int)(sizeof(plan) / sizeof(plan[0])); ++li) {
        a.ph_lo = plan[li][0]; a.ph_hi = plan[li][1]; a.li = li; a.dry = plan[li][2];
        hipLaunchKernelGGL(mega_fwd, dim3(grid), dim3(NWAVES * 64), LDS_BYTES, stream, a);
    }
}
```

```cpp
#include <hip/hip_runtime.h>
#include <stdint.h>

typedef unsigned short bf16_t;
typedef short bf16x8 __attribute__((ext_vector_type(8)));
typedef float f32x4 __attribute__((ext_vector_type(4)));

constexpr int BATCH = 8, SEQ = 2048, DM = 1024, T = BATCH * SEQ;
constexpr int AW = 512, AKW = 128, HKW = 512, HW = 512, INW = 2816, MIXW = 1024;
constexpr int NE = 32, TOPK = 4, FF = 1024;
constexpr int C_AQ = 0, C_AK = 512, C_AV = 640, C_HQ = 768, C_HF = 1280, C_HI = 1792, C_HG = 2304;
constexpr float EPS = 1e-5f;
constexpr int ACT_ROWS = T * TOPK + NE * 256;

constexpr size_t MiB = 1u << 20;
constexpr size_t al(size_t x) { return (x + 255) & ~(size_t)255; }
constexpr size_t WS_CTL = 0;
constexpr size_t WS_LB = 1 * MiB;
constexpr size_t WS_WINT = 2 * MiB;
constexpr size_t WS_WOUTT = WS_WINT + al((size_t)INW * DM * 2);
constexpr size_t WS_W1T = WS_WOUTT + al((size_t)DM * MIXW * 2);
constexpr size_t WS_W2T = WS_W1T + al((size_t)NE * 2 * FF * DM * 2);
constexpr size_t WS_XN = WS_W2T + al((size_t)NE * DM * FF * 2);
constexpr size_t WS_AQ = WS_XN + al((size_t)T * DM * 2);
constexpr size_t WS_AK = WS_AQ + al((size_t)T * AW * 2);
constexpr size_t WS_AV = WS_AK + al((size_t)T * AKW * 2);
constexpr size_t WS_HQ = WS_AV + al((size_t)T * AKW * 2);
constexpr size_t WS_G = WS_HQ + al((size_t)T * HKW * 2);
constexpr size_t WS_KK = WS_G + al((size_t)T * HKW * 4);
constexpr size_t WS_HI = WS_KK + al((size_t)T * HKW * 2);
constexpr size_t WS_HG = WS_HI + al((size_t)T * HW * 2);
constexpr size_t WS_ATT = WS_HG + al((size_t)T * HW * 2);
constexpr size_t WS_ORAW = WS_ATT + al((size_t)T * AW * 4);
constexpr size_t WS_MIX = WS_ORAW + al((size_t)T * HW * 4);
constexpr size_t WS_X1 = WS_MIX + al((size_t)T * MIXW * 2);
constexpr size_t WS_H2 = WS_X1 + al((size_t)T * DM * 4);
constexpr size_t WS_GATE = WS_H2 + al((size_t)T * DM * 2);
constexpr size_t WS_LIST = WS_GATE + al((size_t)T * TOPK * 4);
constexpr size_t WS_ACT = WS_LIST + al((size_t)NE * T * 4);
constexpr size_t WS_Y = WS_ACT + al((size_t)ACT_ROWS * FF * 2);
constexpr size_t WS_QF = WS_Y + al((size_t)T * TOPK * DM * 2);
constexpr size_t WS_KF = WS_QF + al((size_t)1024 * 16 * 512 * 2);
constexpr size_t WS_VF = WS_KF + al((size_t)1024 * 16 * 512 * 2);
constexpr size_t WS_INTRA = WS_VF + al((size_t)1024 * 16 * 512 * 2);
constexpr size_t WS_DEC = WS_INTRA + al((size_t)T * HW * 2);
constexpr size_t WS_RWF = WS_DEC + al((size_t)1024 * 128 * 4);
constexpr size_t WS_RSTD = WS_RWF + al((size_t)64 * 2 * 512 * 2);
constexpr size_t WS_LRS = WS_RSTD + al((size_t)T * 4);
constexpr size_t WS_LGT = WS_LRS + al((size_t)NE * T * 4);
constexpr size_t WS_END = WS_LGT + al((size_t)NE * T * 4);
static_assert(WS_END <= ((size_t)1 << 30), "workspace map exceeds 1 GiB");
constexpr int CW_CNT = 64;
constexpr int CW_CONV = 2240;

__device__ __forceinline__ bf16_t f2bf(float f) { unsigned u = __builtin_bit_cast(unsigned, f); return (bf16_t)((u + 0x7fffu + ((u >> 16) & 1u)) >> 16); }
__device__ __forceinline__ float bf2f(bf16_t b) { return __builtin_bit_cast(float, (unsigned)b << 16); }
__device__ __forceinline__ float wave_sum(float v) {
#pragma unroll
    for (int o = 1; o < 64; o <<= 1) v += __shfl_xor(v, o);
    return v;
}
__device__ __forceinline__ float wave_max(float v) {
#pragma unroll
    for (int o = 1; o < 64; o <<= 1) v = fmaxf(v, __shfl_xor(v, o));
    return v;
}
__device__ __forceinline__ float sigmoidf_(float x) { return 1.f / (1.f + __expf(-x)); }
__device__ __forceinline__ float siluf_(float x) { return x / (1.f + __expf(-x)); }

#define LAS __attribute__((address_space(3)))
#define GAS __attribute__((address_space(1)))
typedef unsigned u32x4 __attribute__((ext_vector_type(4)));
typedef unsigned u32x2 __attribute__((ext_vector_type(2)));
typedef float f32x2 __attribute__((ext_vector_type(2)));

namespace pg8 {
constexpr int BM = 256, BK = 64, HALF = 128, HTB = HALF * BK * 2  , STAGE_BYTES = 8 * HTB, NXCD = 8, WGM = 8;
__host__ __device__ __forceinline__ int lds_byte(int r, int c) { const int st = (r >> 4) * 2 + (c >> 5), rr = r & 15, cc = c & 31, ob = rr * 64 + cc * 2; return st * 1024 + (ob ^ (((ob >> 9) & 1) << 5)); }
__host__ __device__ __forceinline__ void stage_rc(int b, int& R, int& C) { const int st = b / 1024, sb = b % 1024, swz = sb ^ (((sb >> 9) & 1) << 5); R = (st >> 1) * 16 + swz / 64; C = (st & 1) * 32 + (swz % 64) / 2; }
__host__ __device__ __forceinline__ int perm32(int rho) { const int n = rho >> 4, i = rho & 15; return 8 * (i >> 2) + 4 * n + (i & 3); }
__device__ __forceinline__ unsigned cvt_pk_bf16(float lo, float hi) { unsigned r; asm volatile("v_cvt_pk_bf16_f32 %0, %1, %2" : "=v"(r) : "v"(lo), "v"(hi)); return r; }

struct Unit { const char* A; const char* B; int pm, pn, e, rows, arow, lbase; };

struct DenseOrder {
    const char* A; const char* Bt; int K, nM, nN, nwg, G, c;
    __device__ void init(const void* A_, const void* Bt_, int M, int N, int K_, int G_, int c_) { A = (const char*)A_; Bt = (const char*)Bt_; K = K_; nM = M / BM; nN = N / BM; nwg = nM * nN; G = G_; c = c_; }
    __device__ __forceinline__ bool next(int i, Unit& u) const {
        const long L = (long)i * G + c; if (L >= nwg) return false;
        int wgid = (int)L; { const int q = nwg / NXCD, r = nwg % NXCD, xcd = wgid % NXCD, off = wgid / NXCD; wgid = (xcd < r ? xcd * (q + 1) : r * (q + 1) + (xcd - r) * q) + off; }
        const int nig = WGM * nN, gid = wgid / nig, fm = gid * WGM, gsz = (nM - fm) < WGM ? (nM - fm) : WGM;
        u.pm = fm + ((wgid % nig) % gsz); u.pn = (wgid % nig) / gsz; u.e = 0; u.rows = BM; u.arow = u.pm * BM; u.lbase = 0;
        u.A = A + (size_t)u.pm * BM * K * 2; u.B = Bt + (size_t)u.pn * BM * K * 2; return true;
    }
    __device__ __forceinline__ int row(const Unit&, int r) const { return r; }
};
template <bool G1, int ES>
struct MoeOrder {
    const char* A; const char* Bt; const int* list; LAS const int* pre; LAS const int* cnt; int K, N, nN, nwg, G, c;
    __device__ __forceinline__ bool next(int i, Unit& u) const {
        const long L = (long)i * G + c; if (L >= nwg) return false;
        int wgid = (int)L; { const int q = nwg / NXCD, r = nwg % NXCD, xcd = wgid % NXCD, off = wgid / NXCD; wgid = (xcd < r ? xcd * (q + 1) : r * (q + 1) + (xcd - r) * q) + off; }
        const int tau = wgid / nN; u.pn = wgid % nN;
        const int p = pre[(threadIdx.x & 31) + 1];
        const int e = __builtin_popcountll(__ballot(p <= tau) & 0xffffffffull);
        const int mt = tau - pre[e];
        u.e = e; u.pm = mt; const int left = cnt[e] - mt * BM; u.rows = left < BM ? left : BM;
        u.arow = tau * BM; u.lbase = e * T + mt * BM;
        u.A = G1 ? A : A + (size_t)u.arow * K * ES;
        u.B = Bt + ((size_t)e * N + (size_t)u.pn * BM) * K * ES; return true;
    }
    __device__ __forceinline__ int row(const Unit& u, int r) const { const int rr = r < u.rows ? r : u.rows - 1; return list[u.lbase + rr] >> 2; }
};

__device__ __forceinline__ u32x4 pack8(f32x4 v0, f32x4 v1) { u32x4 w; w.x = cvt_pk_bf16(v0[0], v0[1]); w.y = cvt_pk_bf16(v0[2], v0[3]); w.z = cvt_pk_bf16(v1[0], v1[1]); w.w = cvt_pk_bf16(v1[2], v1[3]); return w; }
__device__ __forceinline__ f32x4 silu4(f32x4 v) { f32x4 r; for (int i = 0; i < 4; ++i) r[i] = v[i] * __builtin_amdgcn_rcpf(1.f + __expf(-v[i])); return r; }

typedef int v8i32 __attribute__((ext_vector_type(8)));
__device__ __forceinline__ u32x2 pack8_fp8(f32x4 v0, f32x4 v1) {
#pragma unroll
    for (int i = 0; i < 4; ++i) { v0[i] = __builtin_amdgcn_fmed3f(v0[i], -448.f, 448.f); v1[i] = __builtin_amdgcn_fmed3f(v1[i], -448.f, 448.f); }
    int a = 0, b = 0; a = __builtin_amdgcn_cvt_pk_fp8_f32(v0[0], v0[1], a, false); a = __builtin_amdgcn_cvt_pk_fp8_f32(v0[2], v0[3], a, true);
    b = __builtin_amdgcn_cvt_pk_fp8_f32(v1[0], v1[1], b, false); b = __builtin_amdgcn_cvt_pk_fp8_f32(v1[2], v1[3], b, true);
    return (u32x2){(unsigned)a, (unsigned)b};
}
constexpr float FP8_Y_SCALE = 16.f;
constexpr float FP8_ACT_SCALE = 4.f, FP8_W_SCALE = 64.f, FP8_DESCALE = 1.f / (FP8_ACT_SCALE * FP8_W_SCALE);
struct EpiInProj {
    static constexpr bool PERM = true;
    const float* bias; const float* lb; bf16_t *AQ, *AK, *AV, *HQ, *KK, *HI, *HG, *G;
    __device__ __forceinline__ void operator()(const f32x4 (&acc)[2][2][4][2], const Unit& u, int wr, int wc, int fr, int fq) const {
        const int row0 = u.pm * BM + wr * 64 + fr, cl = wc * 32 + 8 * fq;
#pragma unroll
        for (int bj = 0; bj < 2; ++bj) {
            const int cb = u.pn * BM + bj * HALF;
            const f32x4 b0 = *(const f32x4*)(bias + cb + cl), b1 = *(const f32x4*)(bias + cb + cl + 4);
            if (cb >= C_HF && cb < C_HI) {
                const int cc = cb - C_HF + cl;
                const f32x4 l0 = *(const f32x4*)(lb + cc), l1 = *(const f32x4*)(lb + cc + 4);
#pragma unroll
                for (int ai = 0; ai < 2; ++ai)
#pragma unroll
                    for (int m = 0; m < 4; ++m) {
                        const size_t r = (size_t)(row0 + ai * HALF + m * 16);
                        f32x4 v0 = acc[ai][bj][m][0] + b0, v1 = acc[ai][bj][m][1] + b1, g0, g1, k0, k1;
#pragma unroll
                        for (int i = 0; i < 4; ++i) {
                            const float f0 = l0[i] + (1.f - l0[i]) * __builtin_amdgcn_rcpf(1.f + __expf(-v0[i])); g0[i] = __logf(f0); k0[i] = 1.f - f0;
                            const float f1 = l1[i] + (1.f - l1[i]) * __builtin_amdgcn_rcpf(1.f + __expf(-v1[i])); g1[i] = __logf(f1); k1[i] = 1.f - f1;
                        }
                        *(u32x4*)(G + r * HKW + cc) = pack8(g0, g1);
                        *(u32x4*)(KK + r * HKW + cc) = pack8(k0, k1);
                    }
            } else {
                bf16_t* dst; int ld, cc; bool act = false;
                if (cb < C_AK) { dst = AQ; ld = AW; cc = cb - C_AQ; }
                else if (cb < C_AV) { dst = AK; ld = AKW; cc = cb - C_AK; }
                else if (cb < C_HQ) { dst = AV; ld = AKW; cc = cb - C_AV; }
                else if (cb < C_HF) { dst = HQ; ld = HKW; cc = cb - C_HQ; act = true; }
                else if (cb < C_HG) { dst = HI; ld = HW; cc = cb - C_HI; }
                else { dst = HG; ld = HW; cc = cb - C_HG; act = true; }
                cc += cl;
#pragma unroll
                for (int ai = 0; ai < 2; ++ai)
#pragma unroll
                    for (int m = 0; m < 4; ++m) {
                        const size_t r = (size_t)(row0 + ai * HALF + m * 16);
                        f32x4 v0 = acc[ai][bj][m][0] + b0, v1 = acc[ai][bj][m][1] + b1;
                        if (act) { v0 = silu4(v0); v1 = silu4(v1); }
                        *(u32x4*)(dst + r * ld + cc) = pack8(v0, v1);
                    }
            }
        }
    }
};
struct EpiOutProj {
    static constexpr bool PERM = true;
    const float* bias; const float* x; bf16_t* X1;
    __device__ __forceinline__ void operator()(const f32x4 (&acc)[2][2][4][2], const Unit& u, int wr, int wc, int fr, int fq) const {
        const int row0 = u.pm * BM + wr * 64 + fr, col0 = u.pn * BM + wc * 32 + 8 * fq;
#pragma unroll
        for (int bj = 0; bj < 2; ++bj) {
            const int c = col0 + bj * HALF; const f32x4 b0 = *(const f32x4*)(bias + c), b1 = *(const f32x4*)(bias + c + 4);
#pragma unroll
            for (int ai = 0; ai < 2; ++ai)
#pragma unroll
                for (int m = 0; m < 4; ++m) { const size_t o = (size_t)(row0 + ai * HALF + m * 16) * DM + c;
                    const f32x4 v0 = acc[ai][bj][m][0] + b0 + *(const f32x4*)(x + o), v1 = acc[ai][bj][m][1] + b1 + *(const f32x4*)(x + o + 4);
                    *(u32x4*)(X1 + o) = pack8(v0, v1); }
        }
    }
};
struct EpiMoe1 {
    static constexpr bool PERM = true;
    const float* b1; unsigned char* ACT; const float* lrs;
    __device__ __forceinline__ void operator()(const f32x4 (&acc)[2][2][4][2], const Unit& u, int wr, int wc, int fr, int fq) const {
        const int ac0 = u.pn * HALF + wc * 32 + 8 * fq;
        const float* bp = b1 + (size_t)u.e * 2 * FF + 2 * ac0;
        const f32x4 q0 = *(const f32x4*)bp, q1 = *(const f32x4*)(bp + 4), q2 = *(const f32x4*)(bp + 8), q3 = *(const f32x4*)(bp + 12);
        const f32x4 bg0 = {q0[0], q0[2], q1[0], q1[2]}, bg1 = {q2[0], q2[2], q3[0], q3[2]}, bl0 = {q0[1], q0[3], q1[1], q1[3]}, bl1 = {q2[1], q2[3], q3[1], q3[3]};
        float rss[8];
#pragma unroll
        for (int q = 0; q < 8; ++q) { const int r = (q >> 2) * HALF + wr * 64 + (q & 3) * 16 + fr, rc = r < u.rows ? r : u.rows - 1; rss[q] = lrs[u.lbase + rc] * FP8_DESCALE; }
#pragma unroll
        for (int ai = 0; ai < 2; ++ai)
#pragma unroll
            for (int m = 0; m < 4; ++m) {
                const int r = ai * HALF + wr * 64 + m * 16 + fr;
                const float rs = rss[ai * 4 + m];
                const f32x4 g0 = acc[ai][0][m][0] * rs + bg0, g1 = acc[ai][0][m][1] * rs + bg1, l0 = acc[ai][1][m][0] * rs + bl0, l1 = acc[ai][1][m][1] * rs + bl1;
                f32x4 a0, a1;
#pragma unroll
                for (int i = 0; i < 4; ++i) {
                    const float u0 = fminf(g0[i], 7.f), u1 = fminf(g1[i], 7.f), w0 = fminf(fmaxf(l0[i], -7.f), 7.f), w1 = fminf(fmaxf(l1[i], -7.f), 7.f);
                    a0[i] = u0 * __builtin_amdgcn_rcpf(1.f + __expf(-1.702f * u0)) * (w0 + 1.f);
                    a1[i] = u1 * __builtin_amdgcn_rcpf(1.f + __expf(-1.702f * u1)) * (w1 + 1.f);
                }
                if (r < u.rows) *(u32x2*)(ACT + (size_t)(u.arow + r) * FF + ac0) = pack8_fp8(a0 * FP8_ACT_SCALE, a1 * FP8_ACT_SCALE);
            }
    }
};
struct EpiMoe2 {
    static constexpr bool PERM = true;
    const float* b2; const int* list; const float* lgt; unsigned char* Y;
    __device__ __forceinline__ void operator()(const f32x4 (&acc)[2][2][4][2], const Unit& u, int wr, int wc, int fr, int fq) const {
        const int c0 = u.pn * BM + wc * 64 + 16 * fq;
        f32x4 bv[4];
#pragma unroll
        for (int q = 0; q < 4; ++q) bv[q] = *(const f32x4*)(b2 + (size_t)u.e * DM + c0 + 4 * q);
        int slots[8]; float gts[8];
#pragma unroll
        for (int q = 0; q < 8; ++q) { const int r = (q >> 2) * HALF + wr * 64 + (q & 3) * 16 + fr, rc = r < u.rows ? r : u.rows - 1; slots[q] = list[u.lbase + rc]; gts[q] = lgt[u.lbase + rc]; }
#pragma unroll
        for (int ai = 0; ai < 2; ++ai)
#pragma unroll
            for (int m = 0; m < 4; ++m) {
                const int r = ai * HALF + wr * 64 + m * 16 + fr;
                if (r < u.rows) {
                    const int slot = slots[ai * 4 + m]; const float gt = gts[ai * 4 + m];
                    const u32x2 lo = pack8_fp8((acc[ai][0][m][0] * FP8_DESCALE + bv[0]) * (gt * FP8_Y_SCALE), (acc[ai][0][m][1] * FP8_DESCALE + bv[1]) * (gt * FP8_Y_SCALE));
                    const u32x2 hi = pack8_fp8((acc[ai][1][m][0] * FP8_DESCALE + bv[2]) * (gt * FP8_Y_SCALE), (acc[ai][1][m][1] * FP8_DESCALE + bv[3]) * (gt * FP8_Y_SCALE));
                    *(u32x4*)(Y + (size_t)slot * DM + c0) = (u32x4){lo.x, lo.y, hi.x, hi.y};
                }
            }
    }
};

template <class Epi, class Sched, bool GATHER, bool ALIGN_EPI, int ES = 2, int VAR = 0>
__device__ __forceinline__ void gemm_phase(LAS unsigned char* lds, const int K, const Sched& S, const Epi& E, const int DRY_FLAG = 0) {
    const int tid = threadIdx.x, wid = __builtin_amdgcn_readfirstlane(tid >> 6), lane = tid & 63, wr = wid >> 2, wc = wid & 3, fr = lane & 15, fq = lane >> 4;
    int nt = K * ES / (BK * 2); asm volatile("" : "+s"(nt));
    unsigned voffB[2];
#pragma unroll
    for (int i = 0; i < 2; ++i) { int R, C; stage_rc(tid * 16 + i * 8192, R, C); const int Rb = Epi::PERM ? ((R & ~31) + perm32(R & 31)) : R; voffB[i] = (unsigned)(Rb * K * ES + C * 2); }
    const size_t kstep = (size_t)(BK * 2);
    const size_t hstep = (size_t)HALF * K * ES;
    const unsigned ldsw = (unsigned)wid * 1024u;
    const int aoff = lds_byte(wr * 64 + fr, fq * 8), boff = lds_byte(wc * 32 + fr, fq * 8);
#define PG8_SA(b, h) (((b) * 2 + (h)) * HTB)
#define PG8_SB(b, h) ((4 + (b) * 2 + (h)) * HTB)
#define PG8_STAGE(bufoff, gbase, voff) do { if constexpr (VAR < 2) _Pragma("unroll") for (int _i = 0; _i < 2; ++_i) \
        __builtin_amdgcn_global_load_lds((const unsigned*)((const char*)(gbase) + (voff)[_i]), (LAS unsigned*)(lds + (bufoff) + ldsw + _i * 8192), 16, 0, 0); } while (0)
#define PG8_LD8(dst, off) do { if constexpr (VAR == 3) { asm volatile("" : "+v"(dst)); break; } const u32x4 lo_ = *(const LAS u32x4*)(lds + (off)), hi_ = *(const LAS u32x4*)(lds + (off) + 1024); \
        dst = (v8i32){(int)lo_.x, (int)lo_.y, (int)lo_.z, (int)lo_.w, (int)hi_.x, (int)hi_.y, (int)hi_.z, (int)hi_.w}; } while (0)
#define PG8_LDA(dst, b, h) do { _Pragma("unroll") for (int m = 0; m < 4; ++m) PG8_LD8(dst[m], PG8_SA(b, h) + aoff + m * 2048); } while (0)
#define PG8_LDB(dst, b, h) do { _Pragma("unroll") for (int n = 0; n < 2; ++n) PG8_LD8(dst[n], PG8_SB(b, h) + boff + n * 2048); } while (0)
#define PG8_LO(x) __builtin_bit_cast(bf16x8, __builtin_shufflevector(x, x, 0, 1, 2, 3))
#define PG8_HI(x) __builtin_bit_cast(bf16x8, __builtin_shufflevector(x, x, 4, 5, 6, 7))
#define PG8_MMA(ai, bj, At, Bt) do { if constexpr (VAR == 1) { _Pragma("unroll") for (int m = 0; m < 4; ++m) asm volatile("" :: "v"(At[m])); _Pragma("unroll") for (int n = 0; n < 2; ++n) asm volatile("" :: "v"(Bt[n])); break; } __builtin_amdgcn_s_setprio(1); _Pragma("unroll") for (int m = 0; m < 4; ++m) _Pragma("unroll") for (int n = 0; n < 2; ++n) { \
        if constexpr (ES == 2) { acc[ai][bj][m][n] = __builtin_amdgcn_mfma_f32_16x16x32_bf16(PG8_LO(Bt[n]), PG8_LO(At[m]), acc[ai][bj][m][n], 0, 0, 0); \
                                 acc[ai][bj][m][n] = __builtin_amdgcn_mfma_f32_16x16x32_bf16(PG8_HI(Bt[n]), PG8_HI(At[m]), acc[ai][bj][m][n], 0, 0, 0); } \
        else asm volatile("v_mfma_scale_f32_16x16x128_f8f6f4 %0, %1, %2, %0, %3, %3 op_sel_hi:[0,0,0]" : "+v"(acc[ai][bj][m][n]) : "v"(Bt[n]), "v"(At[m]), "v"(unit_scale)); } \
          \
        __builtin_amdgcn_s_setprio(0); } while (0)
#define PG8_WAIT_V(n) asm volatile("s_waitcnt vmcnt(" #n ")" ::: "memory")
#define PG8_WAIT_L(n) asm volatile("s_waitcnt lgkmcnt(" #n ")" ::: "memory")
#define PG8_BAR __builtin_amdgcn_s_barrier()
#define PG8_SCHED __builtin_amdgcn_sched_barrier(0)
#define PG8_VOFFA(dst, u) do { int _t = tid; if (GATHER) asm volatile("" : "+v"(_t));     \
        _Pragma("unroll") for (int _i = 0; _i < 2; ++_i) { int _R, _C; stage_rc(_t * 16 + _i * 8192, _R, _C); _Pragma("unroll") for (int _h = 0; _h < 2; ++_h) { const int _r = _h * HALF + _R; \
        const unsigned _row = GATHER ? (unsigned)S.row(u, _r) : (unsigned)_r; dst[_h][_i] = _row * (unsigned)(K * ES) + (unsigned)_C * 2u; } } } while (0)
    Unit cur, nxt; int ui = 0;
    if (!S.next(0, cur)) return;
    f32x4 acc[2][2][4][2];
#pragma unroll
    for (int a = 0; a < 2; ++a)
#pragma unroll
        for (int b = 0; b < 2; ++b)
#pragma unroll
            for (int m = 0; m < 4; ++m)
#pragma unroll
                for (int n = 0; n < 2; ++n) acc[a][b][m][n] = (f32x4){0.f, 0.f, 0.f, 0.f};
    v8i32 At[4], B0[2], B1[2];
    const int unit_scale = 0x7F7F7F7F;
    constexpr bool GATHER_TAIL_SKIP = (ES == 1);
    unsigned vA[2][2], nvA[2][2];
    PG8_VOFFA(vA, cur);
    const char* cA = cur.A; const char* cB = cur.B;
    PG8_STAGE(PG8_SB(0, 0), cB, voffB); PG8_STAGE(PG8_SB(0, 1), cB + hstep, voffB); PG8_STAGE(PG8_SA(0, 0), cA, vA[0]); PG8_STAGE(PG8_SA(0, 1), cA, vA[1]);
    if (wr == 1) PG8_BAR;
    PG8_WAIT_V(2); PG8_BAR;
    PG8_STAGE(PG8_SB(1, 0), cB + kstep, voffB); PG8_STAGE(PG8_SA(1, 0), cA + kstep, vA[0]); PG8_STAGE(PG8_SB(1, 1), cB + hstep + kstep, voffB);
    PG8_WAIT_V(6); PG8_BAR;
    for (;;) {
        const bool has_next = S.next(ui + 1, nxt);
        const char* nA = has_next ? nxt.A : cA; const char* nB = has_next ? nxt.B : cB;
        if (has_next) { PG8_VOFFA(nvA, nxt); } else {
#pragma unroll
            for (int h = 0; h < 2; ++h)
#pragma unroll
                for (int i = 0; i < 2; ++i) nvA[h][i] = vA[h][i]; }
#pragma unroll 1
        for (int t = 0; t < nt; t += 2) {
            const bool last = (t == nt - 2);
            const char* a1 = cA + (size_t)(t + 1) * kstep;
            const char* a2 = last ? nA : cA + (size_t)(t + 2) * kstep; const char* b2 = last ? nB : cB + (size_t)(t + 2) * kstep;
            const char* a3 = a2 + kstep; const char* b3 = b2 + kstep;
            unsigned s0[2], s1[2];
#pragma unroll
            for (int i = 0; i < 2; ++i) { s0[i] = last ? nvA[0][i] : vA[0][i]; s1[i] = last ? nvA[1][i] : vA[1][i]; }
            PG8_LDB(B0, 0, 0); PG8_LDB(B1, 0, 1); PG8_SCHED; PG8_LDA(At, 0, 0); PG8_STAGE(PG8_SA(1, 1), a1, vA[1]);
            PG8_WAIT_V(8); PG8_WAIT_L(0); PG8_BAR; PG8_MMA(0, 0, At, B0); PG8_MMA(0, 1, At, B1); PG8_BAR; PG8_SCHED;
            PG8_LDA(At, 0, 1); PG8_STAGE(PG8_SB(0, 0), b2, voffB); PG8_STAGE(PG8_SB(0, 1), b2 + hstep, voffB); PG8_STAGE(PG8_SA(0, 0), a2, s0);
            PG8_WAIT_V(8); PG8_WAIT_L(0); PG8_BAR; if (!GATHER_TAIL_SKIP || cur.rows > HALF) { PG8_MMA(1, 0, At, B0); PG8_MMA(1, 1, At, B1); } PG8_BAR; PG8_SCHED;
            PG8_LDB(B0, 1, 0); PG8_LDB(B1, 1, 1); PG8_SCHED; PG8_LDA(At, 1, 0); PG8_STAGE(PG8_SA(0, 1), a2, s1);
            PG8_WAIT_V(8); PG8_WAIT_L(0); PG8_BAR; PG8_MMA(0, 0, At, B0); PG8_MMA(0, 1, At, B1); PG8_BAR; PG8_SCHED;
            PG8_LDA(At, 1, 1); PG8_STAGE(PG8_SB(1, 0), b3, voffB); PG8_STAGE(PG8_SB(1, 1), b3 + hstep, voffB); PG8_STAGE(PG8_SA(1, 0), a3, s0);
            PG8_WAIT_V(8); PG8_WAIT_L(0); PG8_BAR; if (!GATHER_TAIL_SKIP || cur.rows > HALF) { PG8_MMA(1, 0, At, B0); PG8_MMA(1, 1, At, B1); } PG8_BAR; PG8_SCHED;
        }
        if constexpr (ALIGN_EPI) { if (wr == 0) PG8_BAR; }
        if constexpr (ES == 1) asm volatile("s_nop 15\n\ts_nop 7" ::: "memory");
        if (!DRY_FLAG) { int l2 = lane; asm volatile("" : "+v"(l2)); E(acc, cur, wr, wc, l2 & 15, l2 >> 4); }
        if (!has_next) break;
#pragma unroll
        for (int a = 0; a < 2; ++a)
#pragma unroll
            for (int b = 0; b < 2; ++b)
#pragma unroll
                for (int m = 0; m < 4; ++m)
#pragma unroll
                    for (int n = 0; n < 2; ++n) acc[a][b][m][n] = (f32x4){0.f, 0.f, 0.f, 0.f};
        cur = nxt; cA = nA; cB = nB; ++ui;
#pragma unroll
        for (int h = 0; h < 2; ++h)
#pragma unroll
            for (int i = 0; i < 2; ++i) vA[h][i] = nvA[h][i];
        if constexpr (ALIGN_EPI) { if (wr == 1) PG8_BAR; }
    }
    PG8_WAIT_V(0);
    if constexpr (!ALIGN_EPI) { if (wr == 0) PG8_BAR; }
    PG8_BAR;
#undef PG8_SA
#undef PG8_SB
#undef PG8_STAGE
#undef PG8_LDA
#undef PG8_LDB
#undef PG8_MMA
#undef PG8_LD8
#undef PG8_LO
#undef PG8_HI
#undef PG8_WAIT_V
#undef PG8_WAIT_L
#undef PG8_BAR
#undef PG8_SCHED
#undef PG8_VOFFA
}
}

constexpr int NWAVES = 8;
constexpr int RING_OFF = 0, RING_BYTES = 139264;
constexpr int LDSCTL_OFF = RING_BYTES, MISC_OFF = LDSCTL_OFF + 320;
constexpr int MOE_OFF = LDSCTL_OFF + 1024;
constexpr int LDS_BYTES = RING_BYTES + 16384;
constexpr int CW_TMO = 0, CW_CODE = 1, CW_BAR = 4096;
constexpr int N_PHASES = 10;

typedef GAS unsigned gu32;
#define RLX_AGENT __ATOMIC_RELAXED, __HIP_MEMORY_SCOPE_AGENT
#define LDS_WAIT() asm volatile("s_waitcnt lgkmcnt(0)" ::: "memory")
#define VM_WAIT() asm volatile("s_waitcnt vmcnt(0)" ::: "memory")

#define XB_TMO      128
#define XB_XCNT(j)  (256  + 64 * (j))
#define XB_XSUB(j)  (1280 + 64 * (j))
#define XB_XGEN(j)  (2304 + 64 * (j))
#define XB_TOP      3328
#define XB_TOPGEN   3392
#define XCD_BAR_WORDS 3456
#define XB_SPIN_CAP (1u << 18)
__device__ __forceinline__ unsigned xb_ld(unsigned* p)              { return __hip_atomic_load(p, __ATOMIC_RELAXED, __HIP_MEMORY_SCOPE_AGENT); }
__device__ __forceinline__ unsigned xb_add(unsigned* p, unsigned v) { return __hip_atomic_fetch_add(p, v, __ATOMIC_RELAXED, __HIP_MEMORY_SCOPE_AGENT); }
__device__ __forceinline__ unsigned xb_xcc_id() { return (unsigned)__builtin_amdgcn_s_getreg((3 << 11) | 20) & 0xFu; }
#define XB_SPIN(cond, bar) do { unsigned _sp = 0; while (cond) { __builtin_amdgcn_s_sleep(1); \
    if ((++_sp & 255u) == 0u) { if (xb_ld(&(bar)[XB_TMO])) break; if (_sp > XB_SPIN_CAP) { atomicAdd(&(bar)[XB_TMO], 1u); break; } } } } while (0)
struct XcdBarrier { unsigned* bar; unsigned x; volatile LAS unsigned* st; };
__device__ __forceinline__ XcdBarrier xcd_barrier_post(unsigned* bar, volatile LAS unsigned* st) {
    XcdBarrier b; b.bar = bar; b.x = xb_xcc_id(); b.st = st;
    if (threadIdx.x == 0) (void)xb_add(&bar[XB_XCNT(b.x)], 1u);
    return b;
}
__device__ __forceinline__ void xcd_barrier_complete(unsigned* bar, unsigned x, unsigned& nloc, unsigned& nx) {
    const unsigned G = gridDim.x * gridDim.y * gridDim.z;
    unsigned sum, cnt, mine, sp = 0u;
    for (;;) {
        sum = 0u; cnt = 0u; mine = 0u;
#pragma unroll
        for (unsigned j = 0; j < 16; ++j) { const unsigned c = xb_ld(&bar[XB_XCNT(j)]); sum += c; cnt += (c > 0u) ? 1u : 0u; mine = (j == x) ? c : mine; }
        if (sum == G) break;
        __builtin_amdgcn_s_sleep(1);
        if ((++sp & 255u) == 0u) { if (xb_ld(&bar[XB_TMO])) break; if (sp > XB_SPIN_CAP) { atomicAdd(&bar[XB_TMO], 1u); break; } }
    }
    nloc = mine > 0u ? mine : 1u; nx = cnt > 0u ? cnt : 1u;
}
__device__ __forceinline__ void xcd_barrier(const XcdBarrier& b) {
    asm volatile("s_waitcnt vmcnt(0)" ::: "memory");
    __syncthreads();
    if (threadIdx.x == 0) {
        unsigned* bar = b.bar;
        __builtin_amdgcn_s_waitcnt(0);
        unsigned nloc = b.st[0], nx = b.st[1];
        if (nloc == 0u) { xcd_barrier_complete(bar, b.x, nloc, nx); b.st[0] = nloc; b.st[1] = nx; }
        const unsigned old = xb_add(&bar[XB_XSUB(b.x)], 1u);
        const unsigned gen = old / nloc;
        if (old + 1u == (gen + 1u) * nloc) {
            __builtin_amdgcn_fence(__ATOMIC_RELEASE, "agent");
            asm volatile("s_waitcnt vmcnt(0)" ::: "memory");
            const unsigned og = xb_add(&bar[XB_TOP], 1u);
            const unsigned tg = og / nx;
            if (og + 1u == (tg + 1u) * nx) xb_add(&bar[XB_TOPGEN], 1u);
            else XB_SPIN(xb_ld(&bar[XB_TOPGEN]) == tg, bar);
            __builtin_amdgcn_fence(__ATOMIC_ACQUIRE, "agent");
            xb_add(&bar[XB_XGEN(b.x)], 1u);
            asm volatile("s_waitcnt vmcnt(0)" ::: "memory");
        } else {
            XB_SPIN(xb_ld(&bar[XB_XGEN(b.x)]) == gen, bar);
            __builtin_amdgcn_fence(__ATOMIC_ACQUIRE, "agent");
            asm volatile("s_waitcnt vmcnt(0)" ::: "memory");
        }
    }
    __syncthreads();
}

struct Frame {
    LAS unsigned char* lds; volatile LAS unsigned* MISC; gu32* ctl;
    int tid, lane, wave, vcu, G;
    const float *x, *norm1_g, *w_in, *b_in, *sinks, *attn_g, *lb_logits, *hgrn_g, *w_out, *b_out, *norm2_g, *router_w, *router_b, *w1, *b1, *w2, *b2, *final_g;
    float* out; unsigned char* ws;
};
#define WSP(type, off) ((type*)(F.ws + (off)))

typedef float f32x16 __attribute__((ext_vector_type(16)));
typedef __bf16 bf16x2_t __attribute__((ext_vector_type(2)));
__device__ __forceinline__ unsigned cvtpk(float lo, float hi) { f32x2 v = {lo, hi}; bf16x2_t b = __builtin_convertvector(v, bf16x2_t); return __builtin_bit_cast(unsigned, b); }
__device__ __forceinline__ int crow(int reg, int h) { return (reg & 3) + 8 * (reg >> 2) + 4 * h; }
__device__ __forceinline__ float bflo(unsigned u) { return __builtin_bit_cast(float, u << 16); }
__device__ __forceinline__ float bfhi(unsigned u) { return __builtin_bit_cast(float, u & 0xffff0000u); }
__device__ __forceinline__ bf16x8 pack_step(const f32x16& x, int s) {
    u32x4 p; p.x = cvtpk(x[8 * s], x[8 * s + 1]); p.y = cvtpk(x[8 * s + 2], x[8 * s + 3]); p.z = cvtpk(x[8 * s + 4], x[8 * s + 5]); p.w = cvtpk(x[8 * s + 6], x[8 * s + 7]);
    return __builtin_bit_cast(bf16x8, p);
}
#define MFMA32(a, b, c) __builtin_amdgcn_mfma_f32_32x32x16_bf16((a), (b), (c), 0, 0, 0)
#define MFMA16(a, b, c) __builtin_amdgcn_mfma_f32_16x16x32_bf16((a), (b), (c), 0, 0, 0)

__device__ __forceinline__ void p_hgrn_prep(Frame& F) {
    constexpr int GP = 132, QP = 136, VP = 72, AP = 72;
    LAS float* Gs = (LAS float*)F.lds;
    LAS bf16_t* Qs = (LAS bf16_t*)(F.lds + 33792);
    LAS bf16_t* Ks = (LAS bf16_t*)(F.lds + 33792 + 17408);
    LAS bf16_t* Vt = (LAS bf16_t*)(F.lds + 33792 + 2 * 17408);
    LAS bf16_t* At = (LAS bf16_t*)(F.lds + 33792 + 2 * 17408 + 18432);
    LAS float* Tot = (LAS float*)(F.lds + 96256);
    LAS float* Bl = Tot + 8 * 128;
    const bf16_t* HQ = WSP(bf16_t, WS_HQ); const bf16_t* G = WSP(bf16_t, WS_G); const bf16_t* KK = WSP(bf16_t, WS_KK); const bf16_t* HI = WSP(bf16_t, WS_HI);
    bf16_t* QF = WSP(bf16_t, WS_QF); bf16_t* KF = WSP(bf16_t, WS_KF); bf16_t* VF = WSP(bf16_t, WS_VF); bf16_t* INTRA = WSP(bf16_t, WS_INTRA); float* DEC = WSP(float, WS_DEC);
    const int tid = F.tid, lane = F.lane, w = F.wave, r = lane & 31, h = lane >> 5, fr = lane & 15, fq = lane >> 4;
    u32x4 pg[2], pq[2], pk[2], pv[2];
#define HP_LOAD(ch_) do { const int bh_ = (ch_) >> 5, c_ = (ch_) & 31; const size_t t0_ = (size_t)(bh_ >> 2) * SEQ + 64 * c_; const int col0_ = (bh_ & 3) * 128; \
        _Pragma("unroll") for (int i = 0; i < 2; ++i) { const int idx = tid + 512 * i, row = idx >> 4, c8 = idx & 15; const size_t go = (t0_ + row) * HKW + col0_ + 8 * c8; \
            pg[i] = *(const u32x4*)(G + go); pq[i] = *(const u32x4*)(HQ + go); pk[i] = *(const u32x4*)(KK + go); pv[i] = *(const u32x4*)(HI + go); } } while (0)
    if ((int)blockIdx.x < BATCH * 4 * 32) HP_LOAD((int)blockIdx.x);
    for (int ch = blockIdx.x; ch < BATCH * 4 * 32; ch += F.G) {
        const int bh = ch >> 5, c = ch & 31, b = bh >> 2, hd = bh & 3;
        const size_t t0 = (size_t)b * SEQ + 64 * c; const int col0 = hd * 128;
#pragma unroll
        for (int i = 0; i < 2; ++i) { const int idx = tid + 512 * i, row = idx >> 4, c8 = idx & 15;
            *(LAS u32x4*)(Qs + row * QP + 8 * c8) = pq[i]; *(LAS u32x4*)(Ks + row * QP + 8 * c8) = pk[i];
            *(LAS f32x4*)(Gs + row * GP + 8 * c8) = (f32x4){bflo(pg[i].x), bfhi(pg[i].x), bflo(pg[i].y), bfhi(pg[i].y)}; *(LAS f32x4*)(Gs + row * GP + 8 * c8 + 4) = (f32x4){bflo(pg[i].z), bfhi(pg[i].z), bflo(pg[i].w), bfhi(pg[i].w)};
            const u32x4 vv = pv[i];
#pragma unroll
            for (int q = 0; q < 4; ++q) { Vt[(8 * c8 + 2 * q) * VP + row] = (bf16_t)(vv[q] & 0xffffu); Vt[(8 * c8 + 2 * q + 1) * VP + row] = (bf16_t)(vv[q] >> 16); } }
        if (ch + F.G < BATCH * 4 * 32) HP_LOAD(ch + F.G);
        for (int i = tid; i < 64 * AP / 8; i += 512) *(LAS u32x4*)(At + 8 * i) = (u32x4){0u, 0u, 0u, 0u};
        __syncthreads();
#pragma unroll
        for (int q = 0; q < 2; ++q) { const int kk = lane + 64 * q; float run = 0.f;
#pragma unroll
            for (int i = 0; i < 8; ++i) { run += Gs[(8 * w + i) * GP + kk]; Gs[(8 * w + i) * GP + kk] = run; }
            Tot[w * 128 + kk] = run; }
        __syncthreads();
#pragma unroll
        for (int q = 0; q < 2; ++q) { const int kk = lane + 64 * q; float off = 0.f, tot = 0.f;
#pragma unroll
            for (int i = 0; i < 8; ++i) { const float tv = Tot[i * 128 + kk]; tot += tv; if (i < w) off += tv; }
#pragma unroll
            for (int i = 0; i < 8; ++i) Gs[(8 * w + i) * GP + kk] += off;
            if (w == 0) Bl[kk] = tot; }
        __syncthreads();
#pragma unroll
        for (int q = 0; q < 2; ++q) {
            const int f = w + 8 * q;
            {
                const int tt = f >> 3, kt = (f >> 1) & 3, ks = f & 1, t = 32 * tt + r, kb = 32 * kt + 16 * ks + 4 * h;
                const u32x2 qa = *(const LAS u32x2*)(Qs + t * QP + kb), qb = *(const LAS u32x2*)(Qs + t * QP + kb + 8);
                const f32x4 ba = *(const LAS f32x4*)(Gs + t * GP + kb), bb = *(const LAS f32x4*)(Gs + t * GP + kb + 8);
                u32x4 o; o.x = cvtpk(bflo(qa.x) * __expf(ba[0]), bfhi(qa.x) * __expf(ba[1])); o.y = cvtpk(bflo(qa.y) * __expf(ba[2]), bfhi(qa.y) * __expf(ba[3]));
                o.z = cvtpk(bflo(qb.x) * __expf(bb[0]), bfhi(qb.x) * __expf(bb[1])); o.w = cvtpk(bflo(qb.y) * __expf(bb[2]), bfhi(qb.y) * __expf(bb[3]));
                *(u32x4*)(QF + (((size_t)ch * 16 + f) * 64 + lane) * 8) = o;
            }
            {
                const int kt = f >> 2, ss = f & 3, kc = 32 * kt + r, s0 = 16 * ss + 8 * h; const float bl = Bl[kc];
                float v[8];
#pragma unroll
                for (int j = 0; j < 8; ++j) v[j] = bf2f(Ks[(s0 + j) * QP + kc]) * __expf(bl - Gs[(s0 + j) * GP + kc]);
                u32x4 o; o.x = cvtpk(v[0], v[1]); o.y = cvtpk(v[2], v[3]); o.z = cvtpk(v[4], v[5]); o.w = cvtpk(v[6], v[7]);
                *(u32x4*)(KF + (((size_t)ch * 16 + f) * 64 + lane) * 8) = o;
            }
            {
                const int ss = f >> 2, dt = f & 3;
                *(u32x4*)(VF + (((size_t)ch * 16 + f) * 64 + lane) * 8) = *(const LAS u32x4*)(Vt + (32 * dt + r) * VP + 16 * ss + 8 * h);
            }
        }
        if (tid < 128) DEC[(size_t)ch * 128 + tid] = __expf(Bl[tid]);
        {
            const int i = w >> 1;
            for (int j = w & 1; j <= i; j += 2) {
                f32x4 acc = {0.f, 0.f, 0.f, 0.f};
                const int t = 16 * i + fr, s = 16 * j + fr;
#pragma unroll
                for (int k4 = 0; k4 < 4; ++k4) {
                    const int k0 = 32 * k4 + 8 * fq;
                    f32x4 r0 = {0.f, 0.f, 0.f, 0.f}, r1 = {0.f, 0.f, 0.f, 0.f};
                    if (i > 0) { r0 = *(const LAS f32x4*)(Gs + (16 * i - 1) * GP + k0); r1 = *(const LAS f32x4*)(Gs + (16 * i - 1) * GP + k0 + 4); }
                    const u32x4 q8 = *(const LAS u32x4*)(Qs + t * QP + k0), k8 = *(const LAS u32x4*)(Ks + s * QP + k0);
                    const f32x4 bt0 = *(const LAS f32x4*)(Gs + t * GP + k0), bt1 = *(const LAS f32x4*)(Gs + t * GP + k0 + 4);
                    const f32x4 bs0 = *(const LAS f32x4*)(Gs + s * GP + k0), bs1 = *(const LAS f32x4*)(Gs + s * GP + k0 + 4);
                    u32x4 a, bb;
                    a.x = cvtpk(bflo(q8.x) * __expf(bt0[0] - r0[0]), bfhi(q8.x) * __expf(bt0[1] - r0[1])); a.y = cvtpk(bflo(q8.y) * __expf(bt0[2] - r0[2]), bfhi(q8.y) * __expf(bt0[3] - r0[3]));
                    a.z = cvtpk(bflo(q8.z) * __expf(bt1[0] - r1[0]), bfhi(q8.z) * __expf(bt1[1] - r1[1])); a.w = cvtpk(bflo(q8.w) * __expf(bt1[2] - r1[2]), bfhi(q8.w) * __expf(bt1[3] - r1[3]));
                    bb.x = cvtpk(bflo(k8.x) * __expf(r0[0] - bs0[0]), bfhi(k8.x) * __expf(r0[1] - bs0[1])); bb.y = cvtpk(bflo(k8.y) * __expf(r0[2] - bs0[2]), bfhi(k8.y) * __expf(r0[3] - bs0[3]));
                    bb.z = cvtpk(bflo(k8.z) * __expf(r1[0] - bs1[0]), bfhi(k8.z) * __expf(r1[1] - bs1[1])); bb.w = cvtpk(bflo(k8.w) * __expf(r1[2] - bs1[2]), bfhi(k8.w) * __expf(r1[3] - bs1[3]));
                    acc = MFMA16(__builtin_bit_cast(bf16x8, a), __builtin_bit_cast(bf16x8, bb), acc);
                }
#pragma unroll
                for (int q = 0; q < 4; ++q) { const float v = (j < i || (4 * fq + q) >= fr) ? acc[q] : 0.f; At[(16 * i + 4 * fq + q) * AP + 16 * j + fr] = f2bf(v); }
            }
        }
        __syncthreads();
        {
            const int tt = w & 1, dt = w >> 1;
            f32x16 acc;
#pragma unroll
            for (int q = 0; q < 16; ++q) acc[q] = 0.f;
#pragma unroll
            for (int ss = 0; ss < 4; ++ss) if (ss < 2 * (tt + 1)) {
                const bf16x8 a = *(const LAS bf16x8*)(At + (32 * tt + r) * AP + 16 * ss + 8 * h), bv = *(const LAS bf16x8*)(Vt + (32 * dt + r) * VP + 16 * ss + 8 * h);
                acc = MFMA32(a, bv, acc);
            }
#pragma unroll
            for (int q = 0; q < 16; ++q) INTRA[(t0 + 32 * tt + crow(q, h)) * HW + col0 + 32 * dt + r] = f2bf(acc[q]);
        }
        __syncthreads();
    }
#undef HP_LOAD
}

constexpr int SC_OPB = 0, SC_OBUF = 65536, SC_OBP = 132, SC_OBB = 64 * SC_OBP * 4, SC_DEC = SC_OBUF + 2 * SC_OBB;
__device__ __forceinline__ void scan_unit(Frame& F, int bh) {
    const bf16_t* QF = WSP(bf16_t, WS_QF); const bf16_t* KF = WSP(bf16_t, WS_KF); const bf16_t* VF = WSP(bf16_t, WS_VF); const bf16_t* INTRA = WSP(bf16_t, WS_INTRA); const float* DEC = WSP(float, WS_DEC);
    const bf16_t* HG = WSP(bf16_t, WS_HG); bf16_t* MIX = WSP(bf16_t, WS_MIX);
    const int tid = F.tid, lane = F.lane, w = F.wave, r = lane & 31, h = lane >> 5, tt = w & 1, d = w >> 1, b = bh >> 2, hd = bh & 3;
    LAS unsigned char* lds = F.lds;
    f32x16 S[4];
#pragma unroll
    for (int kt = 0; kt < 4; ++kt)
#pragma unroll
        for (int q = 0; q < 16; ++q) S[kt][q] = 0.f;
#define SC_DMA(c_) do { const size_t chn = (size_t)bh * 32 + (c_); const int slot = ((c_) & 1) * 32768; _Pragma("unroll") for (int i_ = 0; i_ < 2; ++i_) { \
        __builtin_amdgcn_global_load_lds((const unsigned*)(QF + ((chn * 16 + 2 * w + i_) * 64 + lane) * 8), (LAS unsigned*)(lds + SC_OPB + slot + (2 * w + i_) * 1024), 16, 0, 0); \
        __builtin_amdgcn_global_load_lds((const unsigned*)(KF + ((chn * 16 + 2 * w + i_) * 64 + lane) * 8), (LAS unsigned*)(lds + SC_OPB + slot + 16384 + (2 * w + i_) * 1024), 16, 0, 0); } \
        } while (0)
#define SC_DEC_LD(c_) (*(const f32x4*)(DEC + ((size_t)bh * 32 + (c_)) * 128 + (tid & 31) * 4))
#define SC_DEC_ST(c_, v_) do { if (tid < 32) *(LAS f32x4*)(lds + SC_DEC + ((c_) & 1) * 512 + tid * 16) = (v_); } while (0)
    bf16x8 Vf[4], Vn[4];
#pragma unroll
    for (int ss = 0; ss < 4; ++ss) Vf[ss] = *(const bf16x8*)(VF + ((((size_t)bh * 32) * 16 + ss * 4 + d) * 64 + lane) * 8);
    SC_DMA(0);
    { const f32x4 dv0 = SC_DEC_LD(0); SC_DEC_ST(0, dv0); }
    __syncthreads();
    const int ft = tid >> 3, fs = tid & 7;
    const int ocol = hd * 128 + 16 * fs;
    for (int c = 0; c < 32; ++c) {
        const int slot = (c & 1) * 32768;
        f32x4 dnext = {0.f, 0.f, 0.f, 0.f};
        if (c + 1 < 32) {
            SC_DMA(c + 1);
            dnext = SC_DEC_LD(c + 1);
#pragma unroll
            for (int ss = 0; ss < 4; ++ss) Vn[ss] = *(const bf16x8*)(VF + ((((size_t)bh * 32 + c + 1) * 16 + ss * 4 + d) * 64 + lane) * 8);
        }
        const size_t trow = (size_t)b * SEQ + 64 * c + ft;
        const u32x4 in0 = *(const u32x4*)(INTRA + trow * HW + ocol), in1 = *(const u32x4*)(INTRA + trow * HW + ocol + 8);
        const u32x4 hg0 = *(const u32x4*)(HG + trow * HW + ocol), hg1 = *(const u32x4*)(HG + trow * HW + ocol + 8);
        f32x16 P;
#pragma unroll
        for (int q = 0; q < 16; ++q) P[q] = 0.f;
#pragma unroll
        for (int kt = 0; kt < 4; ++kt)
#pragma unroll
            for (int ks = 0; ks < 2; ++ks) {
                const bf16x8 qf = *(const LAS bf16x8*)(lds + SC_OPB + slot + ((tt * 4 + kt) * 2 + ks) * 1024 + lane * 16);
                P = MFMA32(qf, pack_step(S[kt], ks), P);
            }
        {   LAS float* ob = (LAS float*)(lds + SC_OBUF + (c & 1) * SC_OBB);
#pragma unroll
            for (int q = 0; q < 16; ++q) ob[(32 * tt + crow(q, h)) * SC_OBP + 32 * d + r] = P[q]; }
#pragma unroll
        for (int kt = 0; kt < 4; ++kt) {
#pragma unroll
            for (int g = 0; g < 4; ++g) { const f32x4 dc = *(const LAS f32x4*)(lds + SC_DEC + (c & 1) * 512 + (32 * kt + 8 * g + 4 * h) * 4);
#pragma unroll
                for (int q = 0; q < 4; ++q) S[kt][4 * g + q] *= dc[q]; }
#pragma unroll
            for (int ss = 0; ss < 4; ++ss) {
                const bf16x8 kf = *(const LAS bf16x8*)(lds + SC_OPB + slot + 16384 + (kt * 4 + ss) * 1024 + lane * 16);
                S[kt] = MFMA32(kf, Vf[ss], S[kt]);
            }
        }
        SC_DEC_ST(c + 1, dnext);
        __syncthreads();
        {
            const LAS float* ob = (const LAS float*)(lds + SC_OBUF + (c & 1) * SC_OBB) + ft * SC_OBP + 16 * fs;
            const f32x4 p0 = *(const LAS f32x4*)ob, p1 = *(const LAS f32x4*)(ob + 4), p2 = *(const LAS f32x4*)(ob + 8), p3 = *(const LAS f32x4*)(ob + 12);
            float o[16];
            o[0] = p0[0] + bflo(in0.x); o[1] = p0[1] + bfhi(in0.x); o[2] = p0[2] + bflo(in0.y); o[3] = p0[3] + bfhi(in0.y);
            o[4] = p1[0] + bflo(in0.z); o[5] = p1[1] + bfhi(in0.z); o[6] = p1[2] + bflo(in0.w); o[7] = p1[3] + bfhi(in0.w);
            o[8] = p2[0] + bflo(in1.x); o[9] = p2[1] + bfhi(in1.x); o[10] = p2[2] + bflo(in1.y); o[11] = p2[3] + bfhi(in1.y);
            o[12] = p3[0] + bflo(in1.z); o[13] = p3[1] + bfhi(in1.z); o[14] = p3[2] + bflo(in1.w); o[15] = p3[3] + bfhi(in1.w);
            float ss2 = 0.f;
#pragma unroll
            for (int q = 0; q < 16; ++q) ss2 += o[q] * o[q];
            ss2 += __shfl_xor(ss2, 1); ss2 += __shfl_xor(ss2, 2); ss2 += __shfl_xor(ss2, 4);
            const float rs = rsqrtf(ss2 * (1.f / 128.f) + EPS);
            const float* gh = F.hgrn_g + ocol;
            const unsigned hgw[8] = {hg0.x, hg0.y, hg0.z, hg0.w, hg1.x, hg1.y, hg1.z, hg1.w};
            unsigned ow[8];
#pragma unroll
            for (int q = 0; q < 8; ++q) ow[q] = cvtpk(o[2 * q] * rs * gh[2 * q] * bflo(hgw[q]), o[2 * q + 1] * rs * gh[2 * q + 1] * bfhi(hgw[q]));
            bf16_t* mo = MIX + trow * MIXW + AW + ocol;
            *(u32x4*)mo = (u32x4){ow[0], ow[1], ow[2], ow[3]}; *(u32x4*)(mo + 8) = (u32x4){ow[4], ow[5], ow[6], ow[7]};
        }
#pragma unroll
        for (int ss = 0; ss < 4; ++ss) Vf[ss] = Vn[ss];
    }
    __syncthreads();
#undef SC_DMA
#undef SC_DEC_LD
#undef SC_DEC_ST
}

constexpr int AT_KP = 72, AT_VP = 260;
__device__ __forceinline__ void attn_stage(Frame& F, int kvh, int n, size_t t0, LAS bf16_t* Ks, LAS bf16_t* Vt) {
    const bf16_t* AK = WSP(bf16_t, WS_AK); const bf16_t* AV = WSP(bf16_t, WS_AV);
    __syncthreads();
    int tid_ = F.tid; asm volatile("" : "+v"(tid_));
#pragma unroll
    for (int i = 0; i < 4; ++i) {
        const int idx = tid_ + 512 * i, row = idx >> 3, c8 = idx & 7;
        u32x4 kv = {0u, 0u, 0u, 0u}, vv = {0u, 0u, 0u, 0u};
        if (n > 0 || row >= 128) { const size_t go = (t0 - 128 + row) * AKW + kvh * 64 + 8 * c8; kv = *(const u32x4*)(AK + go); vv = *(const u32x4*)(AV + go); }
        *(LAS u32x4*)(Ks + row * AT_KP + 8 * c8) = kv;
#pragma unroll
        for (int q = 0; q < 4; ++q) { Vt[(8 * c8 + 2 * q) * AT_VP + row] = (bf16_t)(vv[q] & 0xffffu); Vt[(8 * c8 + 2 * q + 1) * AT_VP + row] = (bf16_t)(vv[q] >> 16); }
    }
    __syncthreads();
}
__device__ __forceinline__ void attn_item(Frame& F, int hq, int rt, int n, size_t t0, const LAS bf16_t* Ks, const LAS bf16_t* Vt, LAS float* ssq, unsigned (&okp)[16]) {
    const bf16_t* AQ = WSP(bf16_t, WS_AQ);
    int lane = F.lane; asm volatile("" : "+v"(lane));
    const int r = lane & 31, h = lane >> 5;
    constexpr float L2E = 1.4426950408889634f;
    const float slope2 = exp2f(-(float)(hq + 1)) * L2E, sink2 = F.sinks[hq] * L2E;
    bf16x8 qf[4];
#pragma unroll
    for (int ds = 0; ds < 4; ++ds) qf[ds] = *(const bf16x8*)(AQ + (t0 + 32 * rt + r) * AW + hq * 64 + 16 * ds + 8 * h);
    float m = sink2;
#define AT_SCORE(SC, j) do { const int kt = rt + (j); int rq = r - 4 * h - 32 * (j); asm volatile("" : "+v"(rq));     \
        _Pragma("unroll") for (int q = 0; q < 16; ++q) SC[q] = 0.f; \
        _Pragma("unroll") for (int ds = 0; ds < 4; ++ds) SC = MFMA32(*(const LAS bf16x8*)(Ks + (32 * kt + r) * AT_KP + 16 * ds + 8 * h), qf[ds], SC); \
        const float base = -slope2 * (float)(128 + rq); const int rel = rq + 32 * (j);            \
        if (n == 0 && kt < 4) { _Pragma("unroll") for (int q = 0; q < 16; ++q) SC[q] = -INFINITY; } \
        else { _Pragma("unroll") for (int q = 0; q < 16; ++q) { const int cq = (q & 3) + 8 * (q >> 2); float v = __builtin_fmaf(slope2, (float)cq, __builtin_fmaf(SC[q], 0.125f * L2E, base)); \
            if ((j) == 0) v = (cq > rel) ? v : -INFINITY; if ((j) == 4) v = (cq <= rel) ? v : -INFINITY; SC[q] = v; } } } while (0)
#pragma unroll
    for (int j = 0; j < 5; ++j) { f32x16 sc; AT_SCORE(sc, j);
#pragma unroll
        for (int q = 0; q < 16; ++q) m = fmaxf(m, sc[q]); }
    m = fmaxf(m, __shfl_xor(m, 32));
    float l = 0.f; unsigned pp[5][8];
#pragma unroll
    for (int j = 0; j < 5; ++j) { f32x16 sc; AT_SCORE(sc, j);
#pragma unroll
        for (int q = 0; q < 16; ++q) { sc[q] = exp2f(sc[q] - m); l += sc[q]; }
#pragma unroll
        for (int q = 0; q < 8; ++q) pp[j][q] = cvtpk(sc[2 * q], sc[2 * q + 1]); }
#undef AT_SCORE
    l += __shfl_xor(l, 32); l += exp2f(sink2 - m);
    const float rl = 1.f / l;
    float sq = 0.f;
#pragma unroll
    for (int dt = 0; dt < 2; ++dt) {
        f32x16 o;
#pragma unroll
        for (int q = 0; q < 16; ++q) o[q] = 0.f;
        const LAS bf16_t* vrow = Vt + (32 * dt + r) * AT_VP + 4 * h;
#pragma unroll
        for (int j = 0; j < 5; ++j)
#pragma unroll
            for (int s = 0; s < 2; ++s) { const LAS bf16_t* vp = vrow + 32 * (rt + j) + 16 * s;
                const u32x2 va = *(const LAS u32x2*)vp, vb = *(const LAS u32x2*)(vp + 8); const u32x4 pa = {va.x, va.y, vb.x, vb.y};
                const u32x4 pb = {pp[j][4 * s], pp[j][4 * s + 1], pp[j][4 * s + 2], pp[j][4 * s + 3]};
                o = MFMA32(__builtin_bit_cast(bf16x8, pa), __builtin_bit_cast(bf16x8, pb), o); }
#pragma unroll
        for (int q = 0; q < 16; ++q) { o[q] *= rl; sq += o[q] * o[q]; }
#pragma unroll
        for (int q = 0; q < 8; ++q) okp[dt * 8 + q] = cvtpk(o[2 * q], o[2 * q + 1]);
    }
    sq += __shfl_xor(sq, 32);
    if (h == 0) __hip_atomic_fetch_add(&ssq[32 * rt + r], sq, __ATOMIC_RELAXED, __HIP_MEMORY_SCOPE_WORKGROUP);
}
__device__ __forceinline__ void attn_store(Frame& F, int hq, int rt, size_t t0, const LAS float* ssq, const unsigned (&okp)[16]) {
    bf16_t* MIX = WSP(bf16_t, WS_MIX);
    int lane = F.lane; asm volatile("" : "+v"(lane));
    const int r = lane & 31, h = lane >> 5;
    const float rs = rsqrtf(ssq[32 * rt + r] * (1.f / AW) + EPS);
    bf16_t* mo = MIX + (t0 + 32 * rt + r) * MIXW + hq * 64;
#pragma unroll
    for (int dt = 0; dt < 2; ++dt)
#pragma unroll
        for (int g4 = 0; g4 < 4; ++g4) {
            const int d0 = 32 * dt + 8 * g4 + 4 * h; const f32x4 ga = *(const f32x4*)(F.attn_g + hq * 64 + d0);
            const unsigned p0 = okp[dt * 8 + 2 * g4], p1 = okp[dt * 8 + 2 * g4 + 1];
            u32x2 ow; ow.x = cvtpk(bflo(p0) * rs * ga[0], bfhi(p0) * rs * ga[1]); ow.y = cvtpk(bflo(p1) * rs * ga[2], bfhi(p1) * rs * ga[3]);
            *(u32x2*)(mo + d0) = ow;
        }
}
__device__ __forceinline__ void attn_unit(Frame& F, int u) {
    LAS bf16_t* Ks = (LAS bf16_t*)F.lds;
    LAS bf16_t* Vt = (LAS bf16_t*)(F.lds + 36864);
    LAS float* ssq = (LAS float*)(F.lds + 36864 + 33280);
    const int w = F.wave, b = u >> 4, n = u & 15; const size_t t0 = (size_t)b * SEQ + 128 * n;
    if (F.tid < 128) ssq[F.tid] = 0.f;
    const int g0 = (2 * w) >> 2, rt0 = (2 * w) & 3, g1 = (2 * w + 1) >> 2, rt1 = (2 * w + 1) & 3;
    unsigned ok0[16], ok1[16], ok2[16], ok3[16];
    attn_stage(F, 0, n, t0, Ks, Vt);
    attn_item(F, g0, rt0, n, t0, Ks, Vt, ssq, ok0);
    attn_item(F, g1, rt1, n, t0, Ks, Vt, ssq, ok1);
    attn_stage(F, 1, n, t0, Ks, Vt);
    attn_item(F, 4 + g0, rt0, n, t0, Ks, Vt, ssq, ok2);
    attn_item(F, 4 + g1, rt1, n, t0, Ks, Vt, ssq, ok3);
    __syncthreads();
    attn_store(F, g0, rt0, t0, ssq, ok0); attn_store(F, g1, rt1, t0, ssq, ok1); attn_store(F, 4 + g0, rt0, t0, ssq, ok2); attn_store(F, 4 + g1, rt1, t0, ssq, ok3);
    __syncthreads();
}
__device__ __forceinline__ void p_convert_experts(Frame& F, int rank, int nrank, int max_chunks = 1 << 30);
#ifdef TS_A
#ifndef TS_BLK
#define TS_BLK 0
#endif
#define RSTAMP(k) do { if (blockIdx.x == TS_BLK && F.tid == 0) ((volatile LAS unsigned long long*)(F.lds + LDSCTL_OFF + 2048))[k] = __builtin_amdgcn_s_memrealtime(); } while (0)
#else
#define RSTAMP(k) do { } while (0)
#endif
__device__ __forceinline__ void p_scan_attn(Frame& F, bool do_scan, bool do_attn) {
    const int G = F.G, bx = blockIdx.x, nscan = (do_scan && do_attn && G >= 64) ? 32 : 0;
    if (do_scan) { if (nscan) { if (bx < nscan) scan_unit(F, bx); } else for (int u = bx; u < BATCH * 4; u += G) scan_unit(F, u); }
    if (do_attn) { if (nscan) { for (int u = bx - nscan; u >= 0 && u < BATCH * 16; u += G - nscan) attn_unit(F, u); } else for (int u = bx; u < BATCH * 16; u += G) attn_unit(F, u); }
    RSTAMP(15);
    p_convert_experts(F, 0, 0);
    RSTAMP(16);
}

__device__ __forceinline__ int w2col(int n) { const int c = n & 255; return (n & ~255) + 64 * ((c >> 5) & 3) + 16 * ((c >> 3) & 3) + 8 * (c >> 7) + (c & 7); }
__device__ __forceinline__ int w1col(int n) { const int pn = n >> 8, cl = n & 255; return cl < 128 ? 2 * (128 * pn + cl) : 2 * (128 * pn + cl - 128) + 1; }
template <bool W1MAP, bool FP8>
__device__ __forceinline__ void p0_transpose_item(const float* W, int K, int N, void* WTv, LAS float* scr, int item, int lane) {
    const int nblk = N / 32, kb = item / nblk, nb = item % nblk, k0 = 64 * kb, n0 = 32 * nb;
    const int sc = W1MAP ? w1col(n0 + (lane & 31)) : n0 + (lane & 31);
    float v[32];
#pragma unroll
    for (int i = 0; i < 32; ++i) v[i] = W[(size_t)(k0 + 2 * i + (lane >> 5)) * N + sc];
#pragma unroll
    for (int i = 0; i < 32; ++i) scr[(2 * i + (lane >> 5)) * 33 + (lane & 31)] = v[i];
    LDS_WAIT(); asm volatile("" ::: "memory");
    const int c = lane & 7;
#pragma unroll
    for (int j = 0; j < 4; ++j) { const int n = (lane >> 3) + 8 * j; const LAS float* s = scr + (8 * c) * 33 + n;
        if constexpr (FP8) { const f32x4 a = {s[0 * 33], s[1 * 33], s[2 * 33], s[3 * 33]}, b = {s[4 * 33], s[5 * 33], s[6 * 33], s[7 * 33]};
            *(GAS u32x2*)((unsigned char*)WTv + (size_t)(n0 + n) * K + k0 + 8 * c) = pg8::pack8_fp8(a * pg8::FP8_W_SCALE, b * pg8::FP8_W_SCALE); }
        else { u32x4 o; o.x = pg8::cvt_pk_bf16(s[0 * 33], s[1 * 33]); o.y = pg8::cvt_pk_bf16(s[2 * 33], s[3 * 33]); o.z = pg8::cvt_pk_bf16(s[4 * 33], s[5 * 33]); o.w = pg8::cvt_pk_bf16(s[6 * 33], s[7 * 33]);
            *(GAS u32x4*)((bf16_t*)WTv + (size_t)(n0 + n) * K + k0 + 8 * c) = o; } }
    LDS_WAIT(); asm volatile("" ::: "memory");
}
struct ConvItem { const float* W; unsigned char* WT; int N, k0, n0, map; };
__device__ __forceinline__ ConvItem conv_desc(Frame& F, int it) {
    constexpr int I_W1E = (DM / 128) * (2 * FF / 32), I_W2E = (FF / 128) * (DM / 32);
    ConvItem c;
    if (it < NE * I_W1E) { const int e = it / I_W1E, r = it % I_W1E, nblk = 2 * FF / 32; c.W = F.w1 + (size_t)e * DM * 2 * FF; c.WT = WSP(unsigned char, WS_W1T) + (size_t)e * 2 * FF * DM; c.N = 2 * FF; c.k0 = 128 * (r / nblk); c.n0 = 32 * (r % nblk); c.map = 1; }
    else { it -= NE * I_W1E; const int e = it / I_W2E, r = it % I_W2E, nblk = DM / 32; c.W = F.w2 + (size_t)e * FF * DM; c.WT = WSP(unsigned char, WS_W2T) + (size_t)e * DM * FF; c.N = DM; c.k0 = 128 * (r / nblk); c.n0 = 32 * (r % nblk); c.map = 2; }
    return c;
}
__device__ __forceinline__ void conv_item(const ConvItem& c, int lane, LAS float* scr) {
    const int sc = c.map == 1 ? w1col(c.n0 + (lane & 31)) : w2col(c.n0 + (lane & 31));
    const float* p = c.W + (size_t)(c.k0 + (lane >> 5)) * c.N + sc;
    float v[64];
#pragma unroll
    for (int i = 0; i < 64; ++i) v[i] = p[(size_t)(2 * i) * c.N];
#pragma unroll
    for (int i = 0; i < 64; ++i) scr[(2 * i + (lane >> 5)) * 33 + (lane & 31)] = v[i];
    LDS_WAIT(); asm volatile("" ::: "memory");
    const int cg = lane & 15;
#pragma unroll
    for (int j = 0; j < 8; ++j) { const int n = (lane >> 4) + 4 * j; const LAS float* s = scr + (8 * cg) * 33 + n;
        const f32x4 a = {s[0 * 33], s[1 * 33], s[2 * 33], s[3 * 33]}, b = {s[4 * 33], s[5 * 33], s[6 * 33], s[7 * 33]};
        *(GAS u32x2*)(c.WT + (size_t)(c.n0 + n) * DM + c.k0 + 8 * cg) = pg8::pack8_fp8(a * pg8::FP8_W_SCALE, b * pg8::FP8_W_SCALE); }
    LDS_WAIT(); asm volatile("" ::: "memory");
}
__device__ __forceinline__ void p_convert_experts(Frame& F, int rank, int nrank, int max_chunks) {
    static_assert(DM == FF && RING_BYTES >= NWAVES * 128 * 33 * 4, "conv_item assumes K = 1024 for both expert matrices and a 16.5 KiB LDS tile per wave");
    LAS float* scr = (LAS float*)(F.lds + RING_OFF + F.wave * (128 * 33 * 4));
    constexpr int NITEMS = NE * (DM / 128) * (2 * FF / 32) + NE * (FF / 128) * (DM / 32);
    __syncthreads();
    if (nrank > 0) { for (int it = rank * NWAVES + F.wave; it < NITEMS; it += nrank * NWAVES) { const ConvItem c = conv_desc(F, it); conv_item(c, F.lane, scr); } return; }
    volatile LAS int* slot = (volatile LAS int*)(F.lds + LDSCTL_OFF + 4096);
    int* ctr = (int*)(F.ctl + CW_CONV);
    if (F.tid == 0) slot[0] = atomicAdd(ctr, 16);
    __syncthreads();
    for (int cur = 0, nch = 1;; cur ^= 1, ++nch) {
        const int base = slot[cur];
        if (base >= NITEMS) break;
        const bool more = nch < max_chunks;
        if (F.tid == 0 && more) slot[cur ^ 1] = atomicAdd(ctr, 16);
#pragma unroll 1
        for (int j = 0; j < 2; ++j) { const int it = base + 8 * j + F.wave; if (it < NITEMS) { const ConvItem c = conv_desc(F, it); conv_item(c, F.lane, scr); } }
        __syncthreads();
        if (!more) break;
    }
}
__device__ __forceinline__ void p_prologue(Frame& F) {
    LAS float* scr = (LAS float*)(F.lds + RING_OFF + F.wave * 16384);
    const int gw = F.vcu * NWAVES + F.wave, NGW = F.G * NWAVES;
    constexpr int I_IN = (DM / 64) * (INW / 32), I_OUT = (MIXW / 64) * (DM / 32), I_W1E = (DM / 64) * (2 * FF / 32), I_W2E = (FF / 64) * (DM / 32);
    constexpr int NITEMS = I_IN + I_OUT;
    bf16_t *WinT = WSP(bf16_t, WS_WINT), *WoutT = WSP(bf16_t, WS_WOUTT);
    for (int it = gw; it < NITEMS; it += NGW) {
        int r = it;
        if (r < I_IN) { p0_transpose_item<false, false>(F.w_in, DM, INW, WinT, scr, r, F.lane); continue; } r -= I_IN;
        p0_transpose_item<false, false>(F.w_out, MIXW, DM, WoutT, scr, r, F.lane);
    }
    bf16_t* XN = WSP(bf16_t, WS_XN);
    for (int m = gw; m < T; m += NGW) {
        const GAS f32x4* xr = (const GAS f32x4*)(F.x + (size_t)m * DM) + F.lane;
        f32x4 v[4]; float s = 0.f;
#pragma unroll
        for (int j = 0; j < 4; ++j) { v[j] = xr[64 * j]; s += (v[j].x * v[j].x + v[j].y * v[j].y) + (v[j].z * v[j].z + v[j].w * v[j].w); }
        const float r = rsqrtf(wave_sum(s) * (1.f / DM) + EPS);
        GAS u32x2* o8 = (GAS u32x2*)(XN + (size_t)m * DM) + F.lane;
#pragma unroll
        for (int j = 0; j < 4; ++j) { const f32x4 g = *((const f32x4*)F.norm1_g + F.lane + 64 * j); u32x2 w; w.x = pg8::cvt_pk_bf16(v[j].x * r * g.x, v[j].y * r * g.y); w.y = pg8::cvt_pk_bf16(v[j].z * r * g.z, v[j].w * r * g.w); o8[64 * j] = w; }
    }
    {
        bf16_t* RWF = WSP(bf16_t, WS_RWF);
        for (int i = (NGW - 1 - gw) * 64 + F.lane; i < 64 * 64; i += NGW * 64) { const int ks = i >> 6, ln = i & 63, rr = ln & 31, hh = ln >> 5; float v[8];
#pragma unroll
            for (int j = 0; j < 8; ++j) v[j] = F.router_w[(size_t)(16 * ks + 8 * hh + j) * NE + rr];
            u32x4 hi, lo; hi.x = cvtpk(v[0], v[1]); hi.y = cvtpk(v[2], v[3]); hi.z = cvtpk(v[4], v[5]); hi.w = cvtpk(v[6], v[7]);
            lo.x = cvtpk(v[0] - bflo(hi.x), v[1] - bfhi(hi.x)); lo.y = cvtpk(v[2] - bflo(hi.y), v[3] - bfhi(hi.y)); lo.z = cvtpk(v[4] - bflo(hi.z), v[5] - bfhi(hi.z)); lo.w = cvtpk(v[6] - bflo(hi.w), v[7] - bfhi(hi.w));
            *(u32x4*)(RWF + ((size_t)(ks * 2 + 0) * 64 + ln) * 8) = hi; *(u32x4*)(RWF + ((size_t)(ks * 2 + 1) * 64 + ln) * 8) = lo; }
    }
    if (blockIdx.x == 0) { float* LB = WSP(float, WS_LB); for (int c = F.tid; c < HKW; c += NWAVES * 64) { const float a = F.lb_logits[c], b = F.lb_logits[HKW + c]; LB[c] = 1.f / (1.f + __expf(b - a)); } }
}

__device__ __forceinline__ void p_router(Frame& F) {
    LAS int* lcnt = (LAS int*)(F.lds + MOE_OFF + 512); LAS int* lbase = (LAS int*)(F.lds + MOE_OFF + 768);
    LAS float* part = (LAS float*)F.lds;
    LAS float* ssqp = (LAS float*)(F.lds + 32768);
    const bf16_t* X1 = WSP(bf16_t, WS_X1); unsigned char* H2 = WSP(unsigned char, WS_H2); int* LIST = WSP(int, WS_LIST); float* LRS = WSP(float, WS_LRS); float* LGT = WSP(float, WS_LGT);
    const bf16_t* RWF = WSP(bf16_t, WS_RWF);
    int* cnt = (int*)(F.ctl + CW_CNT);
    const int lane = F.lane, w = F.wave, r = lane & 31, h = lane >> 5, tile = w & 1, kq = w >> 1;
    constexpr int XP = 260;
    LAS float* xs = (LAS float*)(F.lds + 36864);
    for (int tb = blockIdx.x; tb < T / 64; tb += F.G) {
        if (F.tid < NE) lcnt[F.tid] = 0;
        const int t = tb * 64 + tile * 32 + r;
        f32x16 acc;
#pragma unroll
        for (int q = 0; q < 16; ++q) acc[q] = 0.f;
        float ssq = 0.f;
        u32x4 pre0[4], pre1[4];
#define RT_LOAD(P, c_) do { _Pragma("unroll") for (int i = 0; i < 4; ++i) P[i] = *(const u32x4*)(X1 + (size_t)(tb * 64 + 8 * w + 2 * i + (lane >> 5)) * DM + 256 * (c_) + 8 * (lane & 31)); } while (0)
#define RT_CHUNK(P, c_) do { const int c = (c_); \
            __syncthreads();                                     \
            _Pragma("unroll") for (int i = 0; i < 4; ++i) { LAS float* d_ = xs + (8 * w + 2 * i + (lane >> 5)) * XP + 8 * (lane & 31); \
                *(LAS f32x4*)d_ = (f32x4){bflo(P[i].x), bfhi(P[i].x), bflo(P[i].y), bfhi(P[i].y)}; *(LAS f32x4*)(d_ + 4) = (f32x4){bflo(P[i].z), bfhi(P[i].z), bflo(P[i].w), bfhi(P[i].w)}; } \
            if (c + 2 < 4) RT_LOAD(P, c + 2); \
            __syncthreads(); \
            _Pragma("unroll 2") for (int s4 = 0; s4 < 4; ++s4) {                   \
                const int ksl = 4 * kq + s4, ks = 16 * c + ksl, k0 = 16 * ks + 8 * h; \
                const f32x4 x0 = *(const LAS f32x4*)(xs + (32 * tile + r) * XP + 16 * ksl + 8 * h), x1v = *(const LAS f32x4*)(xs + (32 * tile + r) * XP + 16 * ksl + 8 * h + 4); \
                const f32x4 g0 = *(const f32x4*)(F.norm2_g + k0), g1 = *(const f32x4*)(F.norm2_g + k0 + 4); \
                const u32x4 ahi = *(const u32x4*)(RWF + ((size_t)(ks * 2 + 0) * 64 + lane) * 8), alo = *(const u32x4*)(RWF + ((size_t)(ks * 2 + 1) * 64 + lane) * 8); \
                float u[8]; \
                _Pragma("unroll") for (int q = 0; q < 4; ++q) { u[q] = x0[q] * g0[q]; u[4 + q] = x1v[q] * g1[q]; ssq += x0[q] * x0[q]; ssq += x1v[q] * x1v[q]; } \
                u32x4 bh, bl; \
                bh.x = cvtpk(u[0], u[1]); bh.y = cvtpk(u[2], u[3]); bh.z = cvtpk(u[4], u[5]); bh.w = cvtpk(u[6], u[7]); \
                bl.x = cvtpk(u[0] - bflo(bh.x), u[1] - bfhi(bh.x)); bl.y = cvtpk(u[2] - bflo(bh.y), u[3] - bfhi(bh.y)); \
                bl.z = cvtpk(u[4] - bflo(bh.z), u[5] - bfhi(bh.z)); bl.w = cvtpk(u[6] - bflo(bh.w), u[7] - bfhi(bh.w)); \
                *(u32x2*)(H2 + (size_t)t * DM + k0) = pg8::pack8_fp8((f32x4){u[0], u[1], u[2], u[3]} * pg8::FP8_ACT_SCALE, (f32x4){u[4], u[5], u[6], u[7]} * pg8::FP8_ACT_SCALE);     \
                acc = MFMA32(__builtin_bit_cast(bf16x8, ahi), __builtin_bit_cast(bf16x8, bh), acc); \
                acc = MFMA32(__builtin_bit_cast(bf16x8, alo), __builtin_bit_cast(bf16x8, bh), acc); \
                acc = MFMA32(__builtin_bit_cast(bf16x8, ahi), __builtin_bit_cast(bf16x8, bl), acc); \
            } } while (0)
        RT_LOAD(pre0, 0); RT_LOAD(pre1, 1);
#pragma unroll 1
        for (int cc = 0; cc < 4; cc += 2) { RT_CHUNK(pre0, cc); RT_CHUNK(pre1, cc + 1); }
#undef RT_LOAD
#undef RT_CHUNK
#pragma unroll
        for (int q = 0; q < 4; ++q) *(LAS f32x4*)(part + (w * 64 + lane) * 16 + 4 * q) = (f32x4){acc[4 * q], acc[4 * q + 1], acc[4 * q + 2], acc[4 * q + 3]};
        ssqp[w * 64 + lane] = ssq;
        RSTAMP(11);
        __syncthreads();
        RSTAMP(12);
        int my_e[TOPK], my_p[TOPK]; float my_g[TOPK], my_rs = 0.f;
#pragma unroll
        for (int k = 0; k < TOPK; ++k) { my_e[k] = 0; my_p[k] = 0; my_g[k] = 0.f; }
        if (w < 2) {
            float lg[16];
#pragma unroll
            for (int q = 0; q < 16; ++q) lg[q] = 0.f;
            float s2 = 0.f;
#pragma unroll
            for (int k4 = 0; k4 < 4; ++k4) { const int ww = k4 * 2 + tile;
#pragma unroll
                for (int q = 0; q < 4; ++q) { const f32x4 p = *(const LAS f32x4*)(part + (ww * 64 + lane) * 16 + 4 * q); lg[4 * q] += p[0]; lg[4 * q + 1] += p[1]; lg[4 * q + 2] += p[2]; lg[4 * q + 3] += p[3]; }
                s2 += ssqp[ww * 64 + lane] + ssqp[ww * 64 + (lane ^ 32)]; }
            const float rstd = rsqrtf(s2 * (1.f / DM) + EPS);
#pragma unroll
            for (int q = 0; q < 16; ++q) lg[q] = lg[q] * rstd + F.router_b[crow(q, h)];
            float cv[8]; int ci[8];
#pragma unroll
            for (int k = 0; k < TOPK; ++k) {
                float bv = -INFINITY; int bi = 1 << 20;
#pragma unroll
                for (int q = 0; q < 16; ++q) { const int e = crow(q, h); const bool better = (lg[q] > bv) || (lg[q] == bv && e < bi); bv = better ? lg[q] : bv; bi = better ? e : bi; }
#pragma unroll
                for (int q = 0; q < 16; ++q) if (crow(q, h) == bi) lg[q] = -INFINITY;
                cv[k] = bv; ci[k] = bi;
            }
#pragma unroll
            for (int k = 0; k < TOPK; ++k) { cv[4 + k] = __shfl_xor(cv[k], 32); ci[4 + k] = __shfl_xor(ci[k], 32); }
            float tv[TOPK]; int te[TOPK];
#pragma unroll
            for (int k = 0; k < TOPK; ++k) {
                float bv = -INFINITY; int bi = 1 << 20;
#pragma unroll
                for (int q = 0; q < 8; ++q) { const bool better = (cv[q] > bv) || (cv[q] == bv && ci[q] < bi); bv = better ? cv[q] : bv; bi = better ? ci[q] : bi; }
#pragma unroll
                for (int q = 0; q < 8; ++q) if (ci[q] == bi) cv[q] = -INFINITY;
                tv[k] = bv; te[k] = bi;
            }
            const float e1 = __expf(tv[1] - tv[0]), e2 = __expf(tv[2] - tv[0]), e3 = __expf(tv[3] - tv[0]), inv = 1.f / (1.f + e1 + e2 + e3);
            if (h == 0) {
                my_rs = rstd; my_g[0] = inv; my_g[1] = e1 * inv; my_g[2] = e2 * inv; my_g[3] = e3 * inv;
#pragma unroll
                for (int k = 0; k < TOPK; ++k) { my_e[k] = te[k]; my_p[k] = __hip_atomic_fetch_add(&lcnt[te[k]], 1, __ATOMIC_RELAXED, __HIP_MEMORY_SCOPE_WORKGROUP); }
            }
        }
        RSTAMP(13);
        __syncthreads();
        if (F.tid < NE) lbase[F.tid] = atomicAdd(&cnt[F.tid * 64], (int)lcnt[F.tid]);
        __syncthreads();
        if (w < 2 && h == 0) {
#pragma unroll
            for (int k = 0; k < TOPK; ++k) { const size_t li = (size_t)my_e[k] * T + lbase[my_e[k]] + my_p[k]; LIST[li] = t * TOPK + k; LRS[li] = my_rs; LGT[li] = my_g[k]; }
        }
        __syncthreads();
        RSTAMP(14);
    }
}
__device__ __forceinline__ void moe_setup(Frame& F) {
    LAS int* pre = (LAS int*)(F.lds + MOE_OFF); LAS int* lc = (LAS int*)(F.lds + MOE_OFF + 256);
    if (F.tid < 64) {
        const int c = F.lane < NE ? (int)__hip_atomic_load((int*)(F.ctl + CW_CNT) + F.lane * 64, RLX_AGENT) : 0;
        int s = (c + 255) >> 8;
#pragma unroll
        for (int o = 1; o < 32; o <<= 1) { const int v = __shfl_up(s, o); if ((F.lane & 31) >= o) s += v; }
        if (F.lane < NE) { pre[F.lane + 1] = s; lc[F.lane] = c; }
        if (F.lane == 0) pre[0] = 0;
    }
    __syncthreads();
}
__device__ __forceinline__ void p_final(Frame& F) {
    const bf16_t* X1 = WSP(bf16_t, WS_X1); const unsigned char* Y = WSP(unsigned char, WS_Y);
    const int gw = F.vcu * NWAVES + F.wave, NGW = F.G * NWAVES;
    for (int t = gw; t < T; t += NGW) {
        const GAS u32x2* xr = (const GAS u32x2*)(X1 + (size_t)t * DM) + F.lane;
        f32x4 v[4]; float s = 0.f;
#pragma unroll
        for (int j = 0; j < 4; ++j) {
            { const u32x2 xb = xr[64 * j]; v[j] = (f32x4){bflo(xb.x), bfhi(xb.x), bflo(xb.y), bfhi(xb.y)}; }
#pragma unroll
            for (int k = 0; k < TOPK; ++k) { const int y = *((const GAS int*)(Y + ((size_t)t * TOPK + k) * DM) + F.lane + 64 * j);
                const f32x2 lo = __builtin_amdgcn_cvt_pk_f32_fp8(y, false), hi = __builtin_amdgcn_cvt_pk_f32_fp8(y, true);
                v[j].x += lo[0] * (1.f / pg8::FP8_Y_SCALE); v[j].y += lo[1] * (1.f / pg8::FP8_Y_SCALE); v[j].z += hi[0] * (1.f / pg8::FP8_Y_SCALE); v[j].w += hi[1] * (1.f / pg8::FP8_Y_SCALE); }
            s += (v[j].x * v[j].x + v[j].y * v[j].y) + (v[j].z * v[j].z + v[j].w * v[j].w);
        }
        const float r = rsqrtf(wave_sum(s) * (1.f / DM) + EPS);
        GAS f32x4* o = (GAS f32x4*)(F.out + (size_t)t * DM) + F.lane;
#pragma unroll
        for (int j = 0; j < 4; ++j) { const f32x4 g = *((const f32x4*)F.final_g + F.lane + 64 * j); o[64 * j] = (f32x4){v[j].x * r * g.x, v[j].y * r * g.y, v[j].z * r * g.z, v[j].w * r * g.w}; }
    }
}


struct Args { const float* in[18]; float* out; unsigned char* ws; int ph_lo, ph_hi, li, dry; };
__global__ void __launch_bounds__(NWAVES * 64, 2) mega_fwd(Args args) {
    extern __shared__ __attribute__((aligned(16))) unsigned char lds[];
    Frame F;
    F.lds = (LAS unsigned char*)lds; F.MISC = (volatile LAS unsigned*)(F.lds + MISC_OFF);
    F.tid = threadIdx.x; F.lane = F.tid & 63; F.wave = __builtin_amdgcn_readfirstlane(F.tid >> 6);
    F.G = gridDim.x; { const int bx = blockIdx.x; F.vcu = (F.G % 8 == 0) ? (bx % 8) * (F.G / 8) + bx / 8 : bx; }
    F.ws = args.ws; F.ctl = (gu32*)(args.ws + WS_CTL); F.out = args.out;
    F.x = args.in[0]; F.norm1_g = args.in[1]; F.w_in = args.in[2]; F.b_in = args.in[3]; F.sinks = args.in[4]; F.attn_g = args.in[5]; F.lb_logits = args.in[6]; F.hgrn_g = args.in[7];
    F.w_out = args.in[8]; F.b_out = args.in[9]; F.norm2_g = args.in[10]; F.router_w = args.in[11]; F.router_b = args.in[12]; F.w1 = args.in[13]; F.b1 = args.in[14]; F.w2 = args.in[15];
    F.b2 = args.in[16]; F.final_g = args.in[17];
    for (int u = F.tid; u < (LDS_BYTES - LDSCTL_OFF) / 4; u += NWAVES * 64) ((LAS unsigned*)(F.lds + LDSCTL_OFF))[u] = 0u;
    __syncthreads();
    XcdBarrier bar = xcd_barrier_post((unsigned*)(F.ctl + CW_BAR) + args.li * XCD_BAR_WORDS, F.MISC + 8);
    const int lo = args.ph_lo, hi = args.ph_hi;
#ifdef TS_A
    volatile LAS unsigned long long* ts_ = (volatile LAS unsigned long long*)(F.lds + LDSCTL_OFF + 2048);
#ifndef TS_BLK
#define TS_BLK 0
#endif
    const bool stamper = (blockIdx.x == TS_BLK && F.tid == 0);
    if (stamper) ts_[0] = __builtin_amdgcn_s_memrealtime();
#define STAMP(k) do { if (stamper) ts_[(k) + 1] = __builtin_amdgcn_s_memrealtime(); } while (0)
#else
#define STAMP(k) do { } while (0)
#endif
#define IN(k) (lo <= (k) && (k) < hi)
#define SEAM(k) do { if (IN(k) && IN((k) + 1)) xcd_barrier(bar); } while (0)

    if (IN(0)) { p_prologue(F); SEAM(0); } STAMP(0);
    if (IN(1)) {
        pg8::DenseOrder S; S.init(WSP(bf16_t, WS_XN), WSP(bf16_t, WS_WINT), T, INW, DM, F.G, (int)blockIdx.x);
        pg8::EpiInProj E{F.b_in, WSP(float, WS_LB), WSP(bf16_t, WS_AQ), WSP(bf16_t, WS_AK), WSP(bf16_t, WS_AV), WSP(bf16_t, WS_HQ), WSP(bf16_t, WS_KK), WSP(bf16_t, WS_HI), WSP(bf16_t, WS_HG), WSP(bf16_t, WS_G)};
#ifdef PROBE_VARIANTS
        if (args.dry == 2) pg8::gemm_phase<pg8::EpiInProj, pg8::DenseOrder, false, true, 2, 1>(F.lds + RING_OFF, DM, S, E, args.dry);
        else if (args.dry == 3) pg8::gemm_phase<pg8::EpiInProj, pg8::DenseOrder, false, true, 2, 2>(F.lds + RING_OFF, DM, S, E, args.dry);
        else if (args.dry == 4) pg8::gemm_phase<pg8::EpiInProj, pg8::DenseOrder, false, true, 2, 3>(F.lds + RING_OFF, DM, S, E, args.dry);
        else
#endif
        pg8::gemm_phase<pg8::EpiInProj, pg8::DenseOrder, false, true>(F.lds + RING_OFF, DM, S, E, args.dry);
        SEAM(1);
    } STAMP(1);
    if (IN(2)) { p_hgrn_prep(F); SEAM(2); } STAMP(2);
    if (IN(3)) { p_scan_attn(F, true, true); SEAM(3); } STAMP(3);
    STAMP(4);
    if (IN(5)) {
        pg8::DenseOrder S; S.init(WSP(bf16_t, WS_MIX), WSP(bf16_t, WS_WOUTT), T, DM, MIXW, F.G, (int)blockIdx.x);
        pg8::EpiOutProj E{F.b_out, F.x, WSP(bf16_t, WS_X1)};
        pg8::gemm_phase<pg8::EpiOutProj, pg8::DenseOrder, false, true>(F.lds + RING_OFF, MIXW, S, E);
        SEAM(5);
    } STAMP(5);
    if (IN(6)) { p_router(F); SEAM(6); } STAMP(6);
    if (IN(7)) {
        moe_setup(F);
        LAS const int* pre = (LAS const int*)(F.lds + MOE_OFF); LAS const int* lc = (LAS const int*)(F.lds + MOE_OFF + 256);
        pg8::MoeOrder<true, 1> S{(const char*)WSP(unsigned char, WS_H2), (const char*)WSP(unsigned char, WS_W1T), WSP(int, WS_LIST), pre, lc, DM, 2 * FF, 2 * FF / 256, pre[NE] * (2 * FF / 256), F.G, (int)blockIdx.x};
        pg8::EpiMoe1 E{F.b1, WSP(unsigned char, WS_ACT), WSP(float, WS_LRS)};
#ifdef PROBE_VARIANTS
        if (args.dry == 2) pg8::gemm_phase<pg8::EpiMoe1, pg8::MoeOrder<true, 1>, true, true, 1, 1>(F.lds + RING_OFF, DM, S, E, args.dry);
        else if (args.dry == 3) pg8::gemm_phase<pg8::EpiMoe1, pg8::MoeOrder<true, 1>, true, true, 1, 2>(F.lds + RING_OFF, DM, S, E, args.dry);
        else if (args.dry == 4) pg8::gemm_phase<pg8::EpiMoe1, pg8::MoeOrder<true, 1>, true, true, 1, 3>(F.lds + RING_OFF, DM, S, E, args.dry);
        else
#endif
        pg8::gemm_phase<pg8::EpiMoe1, pg8::MoeOrder<true, 1>, true, true, 1>(F.lds + RING_OFF, DM, S, E, args.dry);
        SEAM(7);
    } STAMP(7);
    if (IN(8)) {
        if (!IN(7)) moe_setup(F);
        LAS const int* pre = (LAS const int*)(F.lds + MOE_OFF); LAS const int* lc = (LAS const int*)(F.lds + MOE_OFF + 256);
        pg8::MoeOrder<false, 1> S{(const char*)WSP(unsigned char, WS_ACT), (const char*)WSP(unsigned char, WS_W2T), WSP(int, WS_LIST), pre, lc, FF, DM, DM / 256, pre[NE] * (DM / 256), F.G, (int)blockIdx.x};
        pg8::EpiMoe2 E{F.b2, WSP(int, WS_LIST), WSP(float, WS_LGT), WSP(unsigned char, WS_Y)};
        pg8::gemm_phase<pg8::EpiMoe2, pg8::MoeOrder<false, 1>, false, true, 1>(F.lds + RING_OFF, FF, S, E, args.dry);
        SEAM(8);
    } STAMP(8);
    if (IN(9)) p_final(F);
    STAMP(9);
#ifdef TS_A
    if (stamper) { const unsigned long long t_end = ts_[10], dly = (unsigned long long)(TS_MULT) * (ts_[TS_B] - ts_[TS_A]); while (__builtin_amdgcn_s_memrealtime() - t_end < dly) __builtin_amdgcn_s_sleep(4); }
#endif
#undef IN
#undef SEAM
}

static int mega_grid() {
    static int grid = 0;
    if (grid == 0) {
        int dev = 0, cus = 0;
        if (hipGetDevice(&dev) != hipSuccess || hipDeviceGetAttribute(&cus, hipDeviceAttributeMultiprocessorCount, dev) != hipSuccess) { grid = -1; return grid; }
        if (hipFuncSetAttribute((const void*)mega_fwd, hipFuncAttributeMaxDynamicSharedMemorySize, LDS_BYTES) != hipSuccess) { grid = -1; return grid; }
        (void)hipGetLastError();
        grid = cus;
    }
    return grid;
}
extern "C" void kernel_launch(void* const* d_in, const int* in_sizes, int n_in, void* d_out, int out_size, void* d_ws, size_t ws_size, hipStream_t stream) {
#ifndef PLAN
#define PLAN {{0, N_PHASES, 0}}
#endif
    if (n_in != 18 || ws_size < WS_END) return;
    const int grid = mega_grid(); if (grid <= 0) return;
    unsigned char* ws = (unsigned char*)d_ws;
    static const int plan[][3] = PLAN;
    constexpr int n_launch = (int)(sizeof(plan) / sizeof(plan[0]));
    (void)hipMemsetAsync(ws + WS_CTL, 0, (size_t)(CW_BAR + n_launch * XCD_BAR_WORDS) * 4, stream);
    Args a{};
    for (int i = 0; i < 18; ++i) a.in[i] = (const float*)d_in[i];
    a.out = (float*)d_out; a.ws = ws;
    for (int li = 0; li < (int)(sizeof(plan) / sizeof(plan[0])); ++li) {
        a.ph_lo = plan[li][0]; a.ph_hi = plan[li][1]; a.li = li; a.dry = plan[li][2];
        hipLaunchKernelGGL(mega_fwd, dim3(grid), dim3(NWAVES * 64), LDS_BYTES, stream, a);
    }
}
```

```cpp
#include <hip/hip_runtime.h>
#include <stdint.h>

typedef unsigned short bf16_t;
typedef short bf16x8 __attribute__((ext_vector_type(8)));
typedef float f32x4 __attribute__((ext_vector_type(4)));

constexpr int BATCH = 8, SEQ = 2048, DM = 1024, T = BATCH * SEQ;
constexpr int AW = 512, AKW = 128, HKW = 512, HW = 512, INW = 2816, MIXW = 1024;
constexpr int NE = 32, TOPK = 4, FF = 1024;
constexpr int C_AQ = 0, C_AK = 512, C_AV = 640, C_HQ = 768, C_HF = 1280, C_HI = 1792, C_HG = 2304;
constexpr float EPS = 1e-5f;
constexpr int ACT_ROWS = T * TOPK + NE * 256;

constexpr size_t MiB = 1u << 20;
constexpr size_t al(size_t x) { return (x + 255) & ~(size_t)255; }
constexpr size_t WS_CTL = 0;
constexpr size_t WS_LB = 1 * MiB;
constexpr size_t WS_WINT = 2 * MiB;
constexpr size_t WS_WOUTT = WS_WINT + al((size_t)INW * DM * 2);
constexpr size_t WS_W1T = WS_WOUTT + al((size_t)DM * MIXW * 2);
constexpr size_t WS_W2T = WS_W1T + al((size_t)NE * 2 * FF * DM * 2);
constexpr size_t WS_XN = WS_W2T + al((size_t)NE * DM * FF * 2);
constexpr size_t WS_AQ = WS_XN + al((size_t)T * DM * 2);
constexpr size_t WS_AK = WS_AQ + al((size_t)T * AW * 2);
constexpr size_t WS_AV = WS_AK + al((size_t)T * AKW * 2);
constexpr size_t WS_HQ = WS_AV + al((size_t)T * AKW * 2);
constexpr size_t WS_G = WS_HQ + al((size_t)T * HKW * 2);
constexpr size_t WS_KK = WS_G + al((size_t)T * HKW * 4);
constexpr size_t WS_HI = WS_KK + al((size_t)T * HKW * 2);
constexpr size_t WS_HG = WS_HI + al((size_t)T * HW * 2);
constexpr size_t WS_ATT = WS_HG + al((size_t)T * HW * 2);
constexpr size_t WS_ORAW = WS_ATT + al((size_t)T * AW * 4);
constexpr size_t WS_MIX = WS_ORAW + al((size_t)T * HW * 4);
constexpr size_t WS_X1 = WS_MIX + al((size_t)T * MIXW * 2);
constexpr size_t WS_H2 = WS_X1 + al((size_t)T * DM * 4);
constexpr size_t WS_GATE = WS_H2 + al((size_t)T * DM * 2);
constexpr size_t WS_LIST = WS_GATE + al((size_t)T * TOPK * 4);
constexpr size_t WS_ACT = WS_LIST + al((size_t)NE * T * 4);
constexpr size_t WS_Y = WS_ACT + al((size_t)ACT_ROWS * FF * 2);
constexpr size_t WS_QF = WS_Y + al((size_t)T * TOPK * DM * 2);
constexpr size_t WS_KF = WS_QF + al((size_t)1024 * 16 * 512 * 2);
constexpr size_t WS_VF = WS_KF + al((size_t)1024 * 16 * 512 * 2);
constexpr size_t WS_INTRA = WS_VF + al((size_t)1024 * 16 * 512 * 2);
constexpr size_t WS_DEC = WS_INTRA + al((size_t)T * HW * 2);
constexpr size_t WS_RWF = WS_DEC + al((size_t)1024 * 128 * 4);
constexpr size_t WS_RSTD = WS_RWF + al((size_t)64 * 2 * 512 * 2);
constexpr size_t WS_LRS = WS_RSTD + al((size_t)T * 4);
constexpr size_t WS_LGT = WS_LRS + al((size_t)NE * T * 4);
constexpr size_t WS_END = WS_LGT + al((size_t)NE * T * 4);
static_assert(WS_END <= ((size_t)1 << 30), "workspace map exceeds 1 GiB");
constexpr int CW_CNT = 64;
constexpr int CW_CONV = 2240;

__device__ __forceinline__ bf16_t f2bf(float f) { unsigned u = __builtin_bit_cast(unsigned, f); return (bf16_t)((u + 0x7fffu + ((u >> 16) & 1u)) >> 16); }
__device__ __forceinline__ float bf2f(bf16_t b) { return __builtin_bit_cast(float, (unsigned)b << 16); }
__device__ __forceinline__ float wave_sum(float v) {
#pragma unroll
    for (int o = 1; o < 64; o <<= 1) v += __shfl_xor(v, o);
    return v;
}
__device__ __forceinline__ float wave_max(float v) {
#pragma unroll
    for (int o = 1; o < 64; o <<= 1) v = fmaxf(v, __shfl_xor(v, o));
    return v;
}
__device__ __forceinline__ float sigmoidf_(float x) { return 1.f / (1.f + __expf(-x)); }
__device__ __forceinline__ float siluf_(float x) { return x / (1.f + __expf(-x)); }

#define LAS __attribute__((address_space(3)))
#define GAS __attribute__((address_space(1)))
typedef unsigned u32x4 __attribute__((ext_vector_type(4)));
typedef unsigned u32x2 __attribute__((ext_vector_type(2)));
typedef float f32x2 __attribute__((ext_vector_type(2)));

namespace pg8 {
constexpr int BM = 256, BK = 64, HALF = 128, HTB = HALF * BK * 2  , STAGE_BYTES = 8 * HTB, NXCD = 8, WGM = 8;
__host__ __device__ __forceinline__ int lds_byte(int r, int c) { const int st = (r >> 4) * 2 + (c >> 5), rr = r & 15, cc = c & 31, ob = rr * 64 + cc * 2; return st * 1024 + (ob ^ (((ob >> 9) & 1) << 5)); }
__host__ __device__ __forceinline__ void stage_rc(int b, int& R, int& C) { const int st = b / 1024, sb = b % 1024, swz = sb ^ (((sb >> 9) & 1) << 5); R = (st >> 1) * 16 + swz / 64; C = (st & 1) * 32 + (swz % 64) / 2; }
__host__ __device__ __forceinline__ int perm32(int rho) { const int n = rho >> 4, i = rho & 15; return 8 * (i >> 2) + 4 * n + (i & 3); }
__device__ __forceinline__ unsigned cvt_pk_bf16(float lo, float hi) { unsigned r; asm volatile("v_cvt_pk_bf16_f32 %0, %1, %2" : "=v"(r) : "v"(lo), "v"(hi)); return r; }

struct Unit { const char* A; const char* B; int pm, pn, e, rows, arow, lbase; };

struct DenseOrder {
    const char* A; const char* Bt; int K, nM, nN, nwg, G, c;
    __device__ void init(const void* A_, const void* Bt_, int M, int N, int K_, int G_, int c_) { A = (const char*)A_; Bt = (const char*)Bt_; K = K_; nM = M / BM; nN = N / BM; nwg = nM * nN; G = G_; c = c_; }
    __device__ __forceinline__ bool next(int i, Unit& u) const {
        const long L = (long)i * G + c; if (L >= nwg) return false;
        int wgid = (int)L; { const int q = nwg / NXCD, r = nwg % NXCD, xcd = wgid % NXCD, off = wgid / NXCD; wgid = (xcd < r ? xcd * (q + 1) : r * (q + 1) + (xcd - r) * q) + off; }
        const int nig = WGM * nN, gid = wgid / nig, fm = gid * WGM, gsz = (nM - fm) < WGM ? (nM - fm) : WGM;
        u.pm = fm + ((wgid % nig) % gsz); u.pn = (wgid % nig) / gsz; u.e = 0; u.rows = BM; u.arow = u.pm * BM; u.lbase = 0;
        u.A = A + (size_t)u.pm * BM * K * 2; u.B = Bt + (size_t)u.pn * BM * K * 2; return true;
    }
    __device__ __forceinline__ int row(const Unit&, int r) const { return r; }
};
template <bool G1, int ES>
struct MoeOrder {
    const char* A; const char* Bt; const int* list; LAS const int* pre; LAS const int* cnt; int K, N, nN, nwg, G, c;
    __device__ __forceinline__ bool next(int i, Unit& u) const {
        const long L = (long)i * G + c; if (L >= nwg) return false;
        int wgid = (int)L; { const int q = nwg / NXCD, r = nwg % NXCD, xcd = wgid % NXCD, off = wgid / NXCD; wgid = (xcd < r ? xcd * (q + 1) : r * (q + 1) + (xcd - r) * q) + off; }
        const int tau = wgid / nN; u.pn = wgid % nN;
        const int p = pre[(threadIdx.x & 31) + 1];
        const int e = __builtin_popcountll(__ballot(p <= tau) & 0xffffffffull);
        const int mt = tau - pre[e];
        u.e = e; u.pm = mt; const int left = cnt[e] - mt * BM; u.rows = left < BM ? left : BM;
        u.arow = tau * BM; u.lbase = e * T + mt * BM;
        u.A = G1 ? A : A + (size_t)u.arow * K * ES;
        u.B = Bt + ((size_t)e * N + (size_t)u.pn * BM) * K * ES; return true;
    }
    __device__ __forceinline__ int row(const Unit& u, int r) const { const int rr = r < u.rows ? r : u.rows - 1; return list[u.lbase + rr] >> 2; }
};

__device__ __forceinline__ u32x4 pack8(f32x4 v0, f32x4 v1) { u32x4 w; w.x = cvt_pk_bf16(v0[0], v0[1]); w.y = cvt_pk_bf16(v0[2], v0[3]); w.z = cvt_pk_bf16(v1[0], v1[1]); w.w = cvt_pk_bf16(v1[2], v1[3]); return w; }
__device__ __forceinline__ f32x4 silu4(f32x4 v) { f32x4 r; for (int i = 0; i < 4; ++i) r[i] = v[i] * __builtin_amdgcn_rcpf(1.f + __expf(-v[i])); return r; }

typedef int v8i32 __attribute__((ext_vector_type(8)));
template <bool SAT = true>
__device__ __forceinline__ u32x2 pack8_fp8(f32x4 v0, f32x4 v1) {
    if (SAT) {
#pragma unroll
        for (int i = 0; i < 4; ++i) { v0[i] = __builtin_amdgcn_fmed3f(v0[i], -448.f, 448.f); v1[i] = __builtin_amdgcn_fmed3f(v1[i], -448.f, 448.f); } }
    int a = 0, b = 0; a = __builtin_amdgcn_cvt_pk_fp8_f32(v0[0], v0[1], a, false); a = __builtin_amdgcn_cvt_pk_fp8_f32(v0[2], v0[3], a, true);
    b = __builtin_amdgcn_cvt_pk_fp8_f32(v1[0], v1[1], b, false); b = __builtin_amdgcn_cvt_pk_fp8_f32(v1[2], v1[3], b, true);
    return (u32x2){(unsigned)a, (unsigned)b};
}
constexpr float FP8_Y_SCALE = 16.f;
constexpr float FP8_ACT_SCALE = 4.f, FP8_W_SCALE = 64.f, FP8_DESCALE = 1.f / (FP8_ACT_SCALE * FP8_W_SCALE);
struct EpiInProj {
    static constexpr bool PERM = true;
    const float* bias; const float* lb; bf16_t *AQ, *AK, *AV, *HQ, *KK, *HI, *HG, *G;
    __device__ __forceinline__ void operator()(const f32x4 (&acc)[2][2][4][2], const Unit& u, int wr, int wc, int fr, int fq) const {
        const int row0 = u.pm * BM + wr * 64 + fr, cl = wc * 32 + 8 * fq;
#pragma unroll
        for (int bj = 0; bj < 2; ++bj) {
            const int cb = u.pn * BM + bj * HALF;
            const f32x4 b0 = *(const f32x4*)(bias + cb + cl), b1 = *(const f32x4*)(bias + cb + cl + 4);
            if (cb >= C_HF && cb < C_HI) {
                const int cc = cb - C_HF + cl;
                const f32x4 l0 = *(const f32x4*)(lb + cc), l1 = *(const f32x4*)(lb + cc + 4);
#pragma unroll
                for (int ai = 0; ai < 2; ++ai)
#pragma unroll
                    for (int m = 0; m < 4; ++m) {
                        const size_t r = (size_t)(row0 + ai * HALF + m * 16);
                        f32x4 v0 = acc[ai][bj][m][0] + b0, v1 = acc[ai][bj][m][1] + b1, g0, g1, k0, k1;
#pragma unroll
                        for (int i = 0; i < 4; ++i) {
                            const float f0 = l0[i] + (1.f - l0[i]) * __builtin_amdgcn_rcpf(1.f + __expf(-v0[i])); g0[i] = __logf(f0); k0[i] = 1.f - f0;
                            const float f1 = l1[i] + (1.f - l1[i]) * __builtin_amdgcn_rcpf(1.f + __expf(-v1[i])); g1[i] = __logf(f1); k1[i] = 1.f - f1;
                        }
                        *(u32x4*)(G + r * HKW + cc) = pack8(g0, g1);
                        *(u32x4*)(KK + r * HKW + cc) = pack8(k0, k1);
                    }
            } else {
                bf16_t* dst; int ld, cc; bool act = false;
                if (cb < C_AK) { dst = AQ; ld = AW; cc = cb - C_AQ; }
                else if (cb < C_AV) { dst = AK; ld = AKW; cc = cb - C_AK; }
                else if (cb < C_HQ) { dst = AV; ld = AKW; cc = cb - C_AV; }
                else if (cb < C_HF) { dst = HQ; ld = HKW; cc = cb - C_HQ; act = true; }
                else if (cb < C_HG) { dst = HI; ld = HW; cc = cb - C_HI; }
                else { dst = HG; ld = HW; cc = cb - C_HG; act = true; }
                cc += cl;
#pragma unroll
                for (int ai = 0; ai < 2; ++ai)
#pragma unroll
                    for (int m = 0; m < 4; ++m) {
                        const size_t r = (size_t)(row0 + ai * HALF + m * 16);
                        f32x4 v0 = acc[ai][bj][m][0] + b0, v1 = acc[ai][bj][m][1] + b1;
                        if (act) { v0 = silu4(v0); v1 = silu4(v1); }
                        *(u32x4*)(dst + r * ld + cc) = pack8(v0, v1);
                    }
            }
        }
    }
};
struct EpiOutProj {
    static constexpr bool PERM = true;
    const float* bias; const float* x; bf16_t* X1;
    __device__ __forceinline__ void operator()(const f32x4 (&acc)[2][2][4][2], const Unit& u, int wr, int wc, int fr, int fq) const {
        const int row0 = u.pm * BM + wr * 64 + fr, col0 = u.pn * BM + wc * 32 + 8 * fq;
#pragma unroll
        for (int bj = 0; bj < 2; ++bj) {
            const int c = col0 + bj * HALF; const f32x4 b0 = *(const f32x4*)(bias + c), b1 = *(const f32x4*)(bias + c + 4);
#pragma unroll
            for (int ai = 0; ai < 2; ++ai)
#pragma unroll
                for (int m = 0; m < 4; ++m) { const size_t o = (size_t)(row0 + ai * HALF + m * 16) * DM + c;
                    const f32x4 v0 = acc[ai][bj][m][0] + b0 + *(const f32x4*)(x + o), v1 = acc[ai][bj][m][1] + b1 + *(const f32x4*)(x + o + 4);
                    *(u32x4*)(X1 + o) = pack8(v0, v1); }
        }
    }
};
struct EpiMoe1 {
    static constexpr bool PERM = true;
    const float* b1; unsigned char* ACT; const float* lrs;
    __device__ __forceinline__ void operator()(const f32x4 (&acc)[2][2][4][2], const Unit& u, int wr, int wc, int fr, int fq) const {
        const int ac0 = u.pn * HALF + wc * 32 + 8 * fq;
        const float* bp = b1 + (size_t)u.e * 2 * FF + 2 * ac0;
        const f32x4 q0 = *(const f32x4*)bp, q1 = *(const f32x4*)(bp + 4), q2 = *(const f32x4*)(bp + 8), q3 = *(const f32x4*)(bp + 12);
        const f32x4 bg0 = {q0[0], q0[2], q1[0], q1[2]}, bg1 = {q2[0], q2[2], q3[0], q3[2]}, bl0 = {q0[1], q0[3], q1[1], q1[3]}, bl1 = {q2[1], q2[3], q3[1], q3[3]};
        float rss[8];
#pragma unroll
        for (int q = 0; q < 8; ++q) { const int r = (q >> 2) * HALF + wr * 64 + (q & 3) * 16 + fr, rc = r < u.rows ? r : u.rows - 1; rss[q] = lrs[u.lbase + rc] * FP8_DESCALE; }
#pragma unroll
        for (int ai = 0; ai < 2; ++ai)
#pragma unroll
            for (int m = 0; m < 4; ++m) {
                const int r = ai * HALF + wr * 64 + m * 16 + fr;
                const float rs = rss[ai * 4 + m];
                const f32x4 g0 = acc[ai][0][m][0] * rs + bg0, g1 = acc[ai][0][m][1] * rs + bg1, l0 = acc[ai][1][m][0] * rs + bl0, l1 = acc[ai][1][m][1] * rs + bl1;
                f32x4 a0, a1;
#pragma unroll
                for (int i = 0; i < 4; ++i) {
                    const float u0 = fminf(g0[i], 7.f), u1 = fminf(g1[i], 7.f), w0 = fminf(fmaxf(l0[i], -7.f), 7.f), w1 = fminf(fmaxf(l1[i], -7.f), 7.f);
                    a0[i] = (u0 * __builtin_amdgcn_rcpf(1.f + __builtin_amdgcn_exp2f(u0 * (-1.702f * 1.4426950408889634f)))) * __builtin_fmaf(w0, FP8_ACT_SCALE, FP8_ACT_SCALE);
                    a1[i] = (u1 * __builtin_amdgcn_rcpf(1.f + __builtin_amdgcn_exp2f(u1 * (-1.702f * 1.4426950408889634f)))) * __builtin_fmaf(w1, FP8_ACT_SCALE, FP8_ACT_SCALE);
                }
                if (r < u.rows) *(u32x2*)(ACT + (size_t)(u.arow + r) * FF + ac0) = pack8_fp8<false>(a0, a1);
            }
    }
};
struct EpiMoe2 {
    static constexpr bool PERM = true;
    const float* b2; const int* list; const float* lgt; unsigned char* Y;
    __device__ __forceinline__ void operator()(const f32x4 (&acc)[2][2][4][2], const Unit& u, int wr, int wc, int fr, int fq) const {
        const int c0 = u.pn * BM + wc * 64 + 16 * fq;
        f32x4 bv[4];
#pragma unroll
        for (int q = 0; q < 4; ++q) bv[q] = *(const f32x4*)(b2 + (size_t)u.e * DM + c0 + 4 * q);
        int slots[8]; float gts[8];
#pragma unroll
        for (int q = 0; q < 8; ++q) { const int r = (q >> 2) * HALF + wr * 64 + (q & 3) * 16 + fr, rc = r < u.rows ? r : u.rows - 1; slots[q] = list[u.lbase + rc]; gts[q] = lgt[u.lbase + rc]; }
#pragma unroll
        for (int ai = 0; ai < 2; ++ai)
#pragma unroll
            for (int m = 0; m < 4; ++m) {
                const int r = ai * HALF + wr * 64 + m * 16 + fr;
                if (r < u.rows) {
                    const int slot = slots[ai * 4 + m]; const float gt = gts[ai * 4 + m];
                    const u32x2 lo = pack8_fp8((acc[ai][0][m][0] * FP8_DESCALE + bv[0]) * (gt * FP8_Y_SCALE), (acc[ai][0][m][1] * FP8_DESCALE + bv[1]) * (gt * FP8_Y_SCALE));
                    const u32x2 hi = pack8_fp8((acc[ai][1][m][0] * FP8_DESCALE + bv[2]) * (gt * FP8_Y_SCALE), (acc[ai][1][m][1] * FP8_DESCALE + bv[3]) * (gt * FP8_Y_SCALE));
                    *(u32x4*)(Y + (size_t)slot * DM + c0) = (u32x4){lo.x, lo.y, hi.x, hi.y};
                }
            }
    }
};

template <class Epi, class Sched, bool GATHER, bool ALIGN_EPI, int ES = 2, int VAR = 0>
__device__ __forceinline__ void gemm_phase(LAS unsigned char* lds, const int K, const Sched& S, const Epi& E, const int DRY_FLAG = 0) {
    const int tid = threadIdx.x, wid = __builtin_amdgcn_readfirstlane(tid >> 6), lane = tid & 63, wr = wid >> 2, wc = wid & 3, fr = lane & 15, fq = lane >> 4;
    int nt = K * ES / (BK * 2); asm volatile("" : "+s"(nt));
    unsigned voffB[2];
#pragma unroll
    for (int i = 0; i < 2; ++i) { int R, C; stage_rc(tid * 16 + i * 8192, R, C); const int Rb = Epi::PERM ? ((R & ~31) + perm32(R & 31)) : R; voffB[i] = (unsigned)(Rb * K * ES + C * 2); }
    const size_t kstep = (size_t)(BK * 2);
    const size_t hstep = (size_t)HALF * K * ES;
    const unsigned ldsw = (unsigned)wid * 1024u;
    const int aoff = lds_byte(wr * 64 + fr, fq * 8), boff = lds_byte(wc * 32 + fr, fq * 8);
#define PG8_SA(b, h) (((b) * 2 + (h)) * HTB)
#define PG8_SB(b, h) ((4 + (b) * 2 + (h)) * HTB)
#define PG8_STAGE(bufoff, gbase, voff) do { if constexpr (VAR < 2) _Pragma("unroll") for (int _i = 0; _i < 2; ++_i) \
        __builtin_amdgcn_global_load_lds((const unsigned*)((const char*)(gbase) + (voff)[_i]), (LAS unsigned*)(lds + (bufoff) + ldsw + _i * 8192), 16, 0, 0); } while (0)
#define PG8_LD8(dst, off) do { if constexpr (VAR == 3) { asm volatile("" : "+v"(dst)); break; } const u32x4 lo_ = *(const LAS u32x4*)(lds + (off)), hi_ = *(const LAS u32x4*)(lds + (off) + 1024); \
        dst = (v8i32){(int)lo_.x, (int)lo_.y, (int)lo_.z, (int)lo_.w, (int)hi_.x, (int)hi_.y, (int)hi_.z, (int)hi_.w}; } while (0)
#define PG8_LDA(dst, b, h) do { _Pragma("unroll") for (int m = 0; m < 4; ++m) PG8_LD8(dst[m], PG8_SA(b, h) + aoff + m * 2048); } while (0)
#define PG8_LDB(dst, b, h) do { _Pragma("unroll") for (int n = 0; n < 2; ++n) PG8_LD8(dst[n], PG8_SB(b, h) + boff + n * 2048); } while (0)
#define PG8_LO(x) __builtin_bit_cast(bf16x8, __builtin_shufflevector(x, x, 0, 1, 2, 3))
#define PG8_HI(x) __builtin_bit_cast(bf16x8, __builtin_shufflevector(x, x, 4, 5, 6, 7))
#define PG8_MMA(ai, bj, At, Bt) do { if constexpr (VAR == 1) { _Pragma("unroll") for (int m = 0; m < 4; ++m) asm volatile("" :: "v"(At[m])); _Pragma("unroll") for (int n = 0; n < 2; ++n) asm volatile("" :: "v"(Bt[n])); break; } __builtin_amdgcn_s_setprio(1); _Pragma("unroll") for (int m = 0; m < 4; ++m) _Pragma("unroll") for (int n = 0; n < 2; ++n) { \
        if constexpr (ES == 2) { acc[ai][bj][m][n] = __builtin_amdgcn_mfma_f32_16x16x32_bf16(PG8_LO(Bt[n]), PG8_LO(At[m]), acc[ai][bj][m][n], 0, 0, 0); \
                                 acc[ai][bj][m][n] = __builtin_amdgcn_mfma_f32_16x16x32_bf16(PG8_HI(Bt[n]), PG8_HI(At[m]), acc[ai][bj][m][n], 0, 0, 0); } \
        else asm volatile("v_mfma_scale_f32_16x16x128_f8f6f4 %0, %1, %2, %0, %3, %3 op_sel_hi:[0,0,0]" : "+v"(acc[ai][bj][m][n]) : "v"(Bt[n]), "v"(At[m]), "v"(unit_scale)); } \
          \
        __builtin_amdgcn_s_setprio(0); } while (0)
#define PG8_WAIT_V(n) asm volatile("s_waitcnt vmcnt(" #n ")" ::: "memory")
#define PG8_WAIT_L(n) asm volatile("s_waitcnt lgkmcnt(" #n ")" ::: "memory")
#define PG8_BAR __builtin_amdgcn_s_barrier()
#define PG8_SCHED __builtin_amdgcn_sched_barrier(0)
#define PG8_VOFFA(dst, u) do { int _t = tid; if (GATHER) asm volatile("" : "+v"(_t));     \
        _Pragma("unroll") for (int _i = 0; _i < 2; ++_i) { int _R, _C; stage_rc(_t * 16 + _i * 8192, _R, _C); _Pragma("unroll") for (int _h = 0; _h < 2; ++_h) { const int _r = _h * HALF + _R; \
        const unsigned _row = GATHER ? (unsigned)S.row(u, _r) : (unsigned)_r; dst[_h][_i] = _row * (unsigned)(K * ES) + (unsigned)_C * 2u; } } } while (0)
    Unit cur, nxt; int ui = 0;
    if (!S.next(0, cur)) return;
    f32x4 acc[2][2][4][2];
#pragma unroll
    for (int a = 0; a < 2; ++a)
#pragma unroll
        for (int b = 0; b < 2; ++b)
#pragma unroll
            for (int m = 0; m < 4; ++m)
#pragma unroll
                for (int n = 0; n < 2; ++n) acc[a][b][m][n] = (f32x4){0.f, 0.f, 0.f, 0.f};
    v8i32 At[4], B0[2], B1[2];
    const int unit_scale = 0x7F7F7F7F;
    constexpr bool GATHER_TAIL_SKIP = (ES == 1);
    unsigned vA[2][2], nvA[2][2];
    PG8_VOFFA(vA, cur);
    const char* cA = cur.A; const char* cB = cur.B;
    PG8_STAGE(PG8_SB(0, 0), cB, voffB); PG8_STAGE(PG8_SB(0, 1), cB + hstep, voffB); PG8_STAGE(PG8_SA(0, 0), cA, vA[0]); PG8_STAGE(PG8_SA(0, 1), cA, vA[1]);
    if (wr == 1) PG8_BAR;
    PG8_WAIT_V(2); PG8_BAR;
    PG8_STAGE(PG8_SB(1, 0), cB + kstep, voffB); PG8_STAGE(PG8_SA(1, 0), cA + kstep, vA[0]); PG8_STAGE(PG8_SB(1, 1), cB + hstep + kstep, voffB);
    PG8_WAIT_V(6); PG8_BAR;
    for (;;) {
        const bool has_next = S.next(ui + 1, nxt);
        const char* nA = has_next ? nxt.A : cA; const char* nB = has_next ? nxt.B : cB;
        if (has_next) { PG8_VOFFA(nvA, nxt); } else {
#pragma unroll
            for (int h = 0; h < 2; ++h)
#pragma unroll
                for (int i = 0; i < 2; ++i) nvA[h][i] = vA[h][i]; }
#pragma unroll 1
        for (int t = 0; t < nt; t += 2) {
            const bool last = (t == nt - 2);
            const char* a1 = cA + (size_t)(t + 1) * kstep;
            const char* a2 = last ? nA : cA + (size_t)(t + 2) * kstep; const char* b2 = last ? nB : cB + (size_t)(t + 2) * kstep;
            const char* a3 = a2 + kstep; const char* b3 = b2 + kstep;
            unsigned s0[2], s1[2];
#pragma unroll
            for (int i = 0; i < 2; ++i) { s0[i] = last ? nvA[0][i] : vA[0][i]; s1[i] = last ? nvA[1][i] : vA[1][i]; }
            PG8_LDB(B0, 0, 0); PG8_LDB(B1, 0, 1); PG8_SCHED; PG8_LDA(At, 0, 0); PG8_STAGE(PG8_SA(1, 1), a1, vA[1]);
            PG8_WAIT_V(8); PG8_WAIT_L(0); PG8_BAR; PG8_MMA(0, 0, At, B0); PG8_MMA(0, 1, At, B1); PG8_BAR; PG8_SCHED;
            PG8_LDA(At, 0, 1); PG8_STAGE(PG8_SB(0, 0), b2, voffB); PG8_STAGE(PG8_SB(0, 1), b2 + hstep, voffB); PG8_STAGE(PG8_SA(0, 0), a2, s0);
            PG8_WAIT_V(8); PG8_WAIT_L(0); PG8_BAR; if (!GATHER_TAIL_SKIP || cur.rows > HALF) { PG8_MMA(1, 0, At, B0); PG8_MMA(1, 1, At, B1); } PG8_BAR; PG8_SCHED;
            PG8_LDB(B0, 1, 0); PG8_LDB(B1, 1, 1); PG8_SCHED; PG8_LDA(At, 1, 0); PG8_STAGE(PG8_SA(0, 1), a2, s1);
            PG8_WAIT_V(8); PG8_WAIT_L(0); PG8_BAR; PG8_MMA(0, 0, At, B0); PG8_MMA(0, 1, At, B1); PG8_BAR; PG8_SCHED;
            PG8_LDA(At, 1, 1); PG8_STAGE(PG8_SB(1, 0), b3, voffB); PG8_STAGE(PG8_SB(1, 1), b3 + hstep, voffB); PG8_STAGE(PG8_SA(1, 0), a3, s0);
            PG8_WAIT_V(8); PG8_WAIT_L(0); PG8_BAR; if (!GATHER_TAIL_SKIP || cur.rows > HALF) { PG8_MMA(1, 0, At, B0); PG8_MMA(1, 1, At, B1); } PG8_BAR; PG8_SCHED;
        }
        if constexpr (ALIGN_EPI) { if (wr == 0) PG8_BAR; }
        if constexpr (ES == 1) asm volatile("s_nop 15\n\ts_nop 7" ::: "memory");
        if (!DRY_FLAG) { int l2 = lane; asm volatile("" : "+v"(l2)); E(acc, cur, wr, wc, l2 & 15, l2 >> 4); }
        if (!has_next) break;
#pragma unroll
        for (int a = 0; a < 2; ++a)
#pragma unroll
            for (int b = 0; b < 2; ++b)
#pragma unroll
                for (int m = 0; m < 4; ++m)
#pragma unroll
                    for (int n = 0; n < 2; ++n) acc[a][b][m][n] = (f32x4){0.f, 0.f, 0.f, 0.f};
        cur = nxt; cA = nA; cB = nB; ++ui;
#pragma unroll
        for (int h = 0; h < 2; ++h)
#pragma unroll
            for (int i = 0; i < 2; ++i) vA[h][i] = nvA[h][i];
        if constexpr (ALIGN_EPI) { if (wr == 1) PG8_BAR; }
    }
    PG8_WAIT_V(0);
    if constexpr (!ALIGN_EPI) { if (wr == 0) PG8_BAR; }
    PG8_BAR;
#undef PG8_SA
#undef PG8_SB
#undef PG8_STAGE
#undef PG8_LDA
#undef PG8_LDB
#undef PG8_MMA
#undef PG8_LD8
#undef PG8_LO
#undef PG8_HI
#undef PG8_WAIT_V
#undef PG8_WAIT_L
#undef PG8_BAR
#undef PG8_SCHED
#undef PG8_VOFFA
}
}

constexpr int NWAVES = 8;
constexpr int RING_OFF = 0, RING_BYTES = 139264;
constexpr int LDSCTL_OFF = RING_BYTES, MISC_OFF = LDSCTL_OFF + 320;
constexpr int MOE_OFF = LDSCTL_OFF + 1024;
constexpr int LDS_BYTES = RING_BYTES + 16384;
constexpr int CW_TMO = 0, CW_CODE = 1, CW_BAR = 4096;
constexpr int N_PHASES = 10;

typedef GAS unsigned gu32;
#define RLX_AGENT __ATOMIC_RELAXED, __HIP_MEMORY_SCOPE_AGENT
#define LDS_WAIT() asm volatile("s_waitcnt lgkmcnt(0)" ::: "memory")
#define VM_WAIT() asm volatile("s_waitcnt vmcnt(0)" ::: "memory")

#define XB_TMO      128
#define XB_XCNT(j)  (256  + 64 * (j))
#define XB_XSUB(j)  (1280 + 64 * (j))
#define XB_XGEN(j)  (2304 + 64 * (j))
#define XB_TOP      3328
#define XB_TOPGEN   3392
#define XCD_BAR_WORDS 3456
#define XB_SPIN_CAP (1u << 18)
__device__ __forceinline__ unsigned xb_ld(unsigned* p)              { return __hip_atomic_load(p, __ATOMIC_RELAXED, __HIP_MEMORY_SCOPE_AGENT); }
__device__ __forceinline__ unsigned xb_add(unsigned* p, unsigned v) { return __hip_atomic_fetch_add(p, v, __ATOMIC_RELAXED, __HIP_MEMORY_SCOPE_AGENT); }
__device__ __forceinline__ unsigned xb_xcc_id() { return (unsigned)__builtin_amdgcn_s_getreg((3 << 11) | 20) & 0xFu; }
#define XB_SPIN(cond, bar) do { unsigned _sp = 0; while (cond) { __builtin_amdgcn_s_sleep(1); \
    if ((++_sp & 255u) == 0u) { if (xb_ld(&(bar)[XB_TMO])) break; if (_sp > XB_SPIN_CAP) { atomicAdd(&(bar)[XB_TMO], 1u); break; } } } } while (0)
struct XcdBarrier { unsigned* bar; unsigned x; volatile LAS unsigned* st; };
__device__ __forceinline__ XcdBarrier xcd_barrier_post(unsigned* bar, volatile LAS unsigned* st) {
    XcdBarrier b; b.bar = bar; b.x = xb_xcc_id(); b.st = st;
    if (threadIdx.x == 0) (void)xb_add(&bar[XB_XCNT(b.x)], 1u);
    return b;
}
__device__ __forceinline__ void xcd_barrier_complete(unsigned* bar, unsigned x, unsigned& nloc, unsigned& nx) {
    const unsigned G = gridDim.x * gridDim.y * gridDim.z;
    unsigned sum, cnt, mine, sp = 0u;
    for (;;) {
        sum = 0u; cnt = 0u; mine = 0u;
#pragma unroll
        for (unsigned j = 0; j < 16; ++j) { const unsigned c = xb_ld(&bar[XB_XCNT(j)]); sum += c; cnt += (c > 0u) ? 1u : 0u; mine = (j == x) ? c : mine; }
        if (sum == G) break;
        __builtin_amdgcn_s_sleep(1);
        if ((++sp & 255u) == 0u) { if (xb_ld(&bar[XB_TMO])) break; if (sp > XB_SPIN_CAP) { atomicAdd(&bar[XB_TMO], 1u); break; } }
    }
    nloc = mine > 0u ? mine : 1u; nx = cnt > 0u ? cnt : 1u;
}
__device__ __forceinline__ void xcd_barrier(const XcdBarrier& b) {
    asm volatile("s_waitcnt vmcnt(0)" ::: "memory");
    __syncthreads();
    if (threadIdx.x == 0) {
        unsigned* bar = b.bar;
        __builtin_amdgcn_s_waitcnt(0);
        unsigned nloc = b.st[0], nx = b.st[1];
        if (nloc == 0u) { xcd_barrier_complete(bar, b.x, nloc, nx); b.st[0] = nloc; b.st[1] = nx; }
        const unsigned old = xb_add(&bar[XB_XSUB(b.x)], 1u);
        const unsigned gen = old / nloc;
        if (old + 1u == (gen + 1u) * nloc) {
            __builtin_amdgcn_fence(__ATOMIC_RELEASE, "agent");
            asm volatile("s_waitcnt vmcnt(0)" ::: "memory");
            const unsigned og = xb_add(&bar[XB_TOP], 1u);
            const unsigned tg = og / nx;
            if (og + 1u == (tg + 1u) * nx) xb_add(&bar[XB_TOPGEN], 1u);
            else XB_SPIN(xb_ld(&bar[XB_TOPGEN]) == tg, bar);
            __builtin_amdgcn_fence(__ATOMIC_ACQUIRE, "agent");
            xb_add(&bar[XB_XGEN(b.x)], 1u);
            asm volatile("s_waitcnt vmcnt(0)" ::: "memory");
        } else {
            XB_SPIN(xb_ld(&bar[XB_XGEN(b.x)]) == gen, bar);
            __builtin_amdgcn_fence(__ATOMIC_ACQUIRE, "agent");
            asm volatile("s_waitcnt vmcnt(0)" ::: "memory");
        }
    }
    __syncthreads();
}

struct Frame {
    LAS unsigned char* lds; volatile LAS unsigned* MISC; gu32* ctl;
    int tid, lane, wave, vcu, G;
    const float *x, *norm1_g, *w_in, *b_in, *sinks, *attn_g, *lb_logits, *hgrn_g, *w_out, *b_out, *norm2_g, *router_w, *router_b, *w1, *b1, *w2, *b2, *final_g;
    float* out; unsigned char* ws;
};
#define WSP(type, off) ((type*)(F.ws + (off)))

typedef float f32x16 __attribute__((ext_vector_type(16)));
typedef __bf16 bf16x2_t __attribute__((ext_vector_type(2)));
__device__ __forceinline__ unsigned cvtpk(float lo, float hi) { f32x2 v = {lo, hi}; bf16x2_t b = __builtin_convertvector(v, bf16x2_t); return __builtin_bit_cast(unsigned, b); }
__device__ __forceinline__ int crow(int reg, int h) { return (reg & 3) + 8 * (reg >> 2) + 4 * h; }
__device__ __forceinline__ float bflo(unsigned u) { return __builtin_bit_cast(float, u << 16); }
__device__ __forceinline__ float bfhi(unsigned u) { return __builtin_bit_cast(float, u & 0xffff0000u); }
__device__ __forceinline__ bf16x8 pack_step(const f32x16& x, int s) {
    u32x4 p; p.x = cvtpk(x[8 * s], x[8 * s + 1]); p.y = cvtpk(x[8 * s + 2], x[8 * s + 3]); p.z = cvtpk(x[8 * s + 4], x[8 * s + 5]); p.w = cvtpk(x[8 * s + 6], x[8 * s + 7]);
    return __builtin_bit_cast(bf16x8, p);
}
#define MFMA32(a, b, c) __builtin_amdgcn_mfma_f32_32x32x16_bf16((a), (b), (c), 0, 0, 0)
#define MFMA16(a, b, c) __builtin_amdgcn_mfma_f32_16x16x32_bf16((a), (b), (c), 0, 0, 0)

__device__ __forceinline__ void p_hgrn_prep(Frame& F) {
    constexpr int GP = 132, QP = 136, VP = 72, AP = 72;
    LAS float* Gs = (LAS float*)F.lds;
    LAS bf16_t* Qs = (LAS bf16_t*)(F.lds + 33792);
    LAS bf16_t* Ks = (LAS bf16_t*)(F.lds + 33792 + 17408);
    LAS bf16_t* Vt = (LAS bf16_t*)(F.lds + 33792 + 2 * 17408);
    LAS bf16_t* At = (LAS bf16_t*)(F.lds + 33792 + 2 * 17408 + 18432);
    LAS float* Tot = (LAS float*)(F.lds + 96256);
    LAS float* Bl = Tot + 8 * 128;
    const bf16_t* HQ = WSP(bf16_t, WS_HQ); const bf16_t* G = WSP(bf16_t, WS_G); const bf16_t* KK = WSP(bf16_t, WS_KK); const bf16_t* HI = WSP(bf16_t, WS_HI);
    bf16_t* QF = WSP(bf16_t, WS_QF); bf16_t* KF = WSP(bf16_t, WS_KF); bf16_t* VF = WSP(bf16_t, WS_VF); bf16_t* INTRA = WSP(bf16_t, WS_INTRA); float* DEC = WSP(float, WS_DEC);
    const int tid = F.tid, lane = F.lane, w = F.wave, r = lane & 31, h = lane >> 5, fr = lane & 15, fq = lane >> 4;
    u32x4 pg[2], pq[2], pk[2], pv[2];
#define HP_LOAD(ch_) do { const int bh_ = (ch_) >> 5, c_ = (ch_) & 31; const size_t t0_ = (size_t)(bh_ >> 2) * SEQ + 64 * c_; const int col0_ = (bh_ & 3) * 128; \
        _Pragma("unroll") for (int i = 0; i < 2; ++i) { const int idx = tid + 512 * i, row = idx >> 4, c8 = idx & 15; const size_t go = (t0_ + row) * HKW + col0_ + 8 * c8; \
            pg[i] = *(const u32x4*)(G + go); pq[i] = *(const u32x4*)(HQ + go); pk[i] = *(const u32x4*)(KK + go); pv[i] = *(const u32x4*)(HI + go); } } while (0)
    if ((int)blockIdx.x < BATCH * 4 * 32) HP_LOAD((int)blockIdx.x);
    for (int ch = blockIdx.x; ch < BATCH * 4 * 32; ch += F.G) {
        const int bh = ch >> 5, c = ch & 31, b = bh >> 2, hd = bh & 3;
        const size_t t0 = (size_t)b * SEQ + 64 * c; const int col0 = hd * 128;
#pragma unroll
        for (int i = 0; i < 2; ++i) { const int idx = tid + 512 * i, row = idx >> 4, c8 = idx & 15;
            *(LAS u32x4*)(Qs + row * QP + 8 * c8) = pq[i]; *(LAS u32x4*)(Ks + row * QP + 8 * c8) = pk[i];
            *(LAS f32x4*)(Gs + row * GP + 8 * c8) = (f32x4){bflo(pg[i].x), bfhi(pg[i].x), bflo(pg[i].y), bfhi(pg[i].y)}; *(LAS f32x4*)(Gs + row * GP + 8 * c8 + 4) = (f32x4){bflo(pg[i].z), bfhi(pg[i].z), bflo(pg[i].w), bfhi(pg[i].w)};
            const u32x4 vv = pv[i];
#pragma unroll
            for (int q = 0; q < 4; ++q) { Vt[(8 * c8 + 2 * q) * VP + row] = (bf16_t)(vv[q] & 0xffffu); Vt[(8 * c8 + 2 * q + 1) * VP + row] = (bf16_t)(vv[q] >> 16); } }
        if (ch + F.G < BATCH * 4 * 32) HP_LOAD(ch + F.G);
        for (int i = tid; i < 64 * AP / 8; i += 512) *(LAS u32x4*)(At + 8 * i) = (u32x4){0u, 0u, 0u, 0u};
        __syncthreads();
#pragma unroll
        for (int q = 0; q < 2; ++q) { const int kk = lane + 64 * q; float run = 0.f;
#pragma unroll
            for (int i = 0; i < 8; ++i) { run += Gs[(8 * w + i) * GP + kk]; Gs[(8 * w + i) * GP + kk] = run; }
            Tot[w * 128 + kk] = run; }
        __syncthreads();
#pragma unroll
        for (int q = 0; q < 2; ++q) { const int kk = lane + 64 * q; float off = 0.f, tot = 0.f;
#pragma unroll
            for (int i = 0; i < 8; ++i) { const float tv = Tot[i * 128 + kk]; tot += tv; if (i < w) off += tv; }
#pragma unroll
            for (int i = 0; i < 8; ++i) Gs[(8 * w + i) * GP + kk] += off;
            if (w == 0) Bl[kk] = tot; }
        __syncthreads();
#pragma unroll
        for (int q = 0; q < 2; ++q) {
            const int f = w + 8 * q;
            {
                const int tt = f >> 3, kt = (f >> 1) & 3, ks = f & 1, t = 32 * tt + r, kb = 32 * kt + 16 * ks + 4 * h;
                const u32x2 qa = *(const LAS u32x2*)(Qs + t * QP + kb), qb = *(const LAS u32x2*)(Qs + t * QP + kb + 8);
                const f32x4 ba = *(const LAS f32x4*)(Gs + t * GP + kb), bb = *(const LAS f32x4*)(Gs + t * GP + kb + 8);
                u32x4 o; o.x = cvtpk(bflo(qa.x) * __expf(ba[0]), bfhi(qa.x) * __expf(ba[1])); o.y = cvtpk(bflo(qa.y) * __expf(ba[2]), bfhi(qa.y) * __expf(ba[3]));
                o.z = cvtpk(bflo(qb.x) * __expf(bb[0]), bfhi(qb.x) * __expf(bb[1])); o.w = cvtpk(bflo(qb.y) * __expf(bb[2]), bfhi(qb.y) * __expf(bb[3]));
                *(u32x4*)(QF + (((size_t)ch * 16 + f) * 64 + lane) * 8) = o;
            }
            {
                const int kt = f >> 2, ss = f & 3, kc = 32 * kt + r, s0 = 16 * ss + 8 * h; const float bl = Bl[kc];
                float v[8];
#pragma unroll
                for (int j = 0; j < 8; ++j) v[j] = bf2f(Ks[(s0 + j) * QP + kc]) * __expf(bl - Gs[(s0 + j) * GP + kc]);
                u32x4 o; o.x = cvtpk(v[0], v[1]); o.y = cvtpk(v[2], v[3]); o.z = cvtpk(v[4], v[5]); o.w = cvtpk(v[6], v[7]);
                *(u32x4*)(KF + (((size_t)ch * 16 + f) * 64 + lane) * 8) = o;
            }
            {
                const int ss = f >> 2, dt = f & 3;
                *(u32x4*)(VF + (((size_t)ch * 16 + f) * 64 + lane) * 8) = *(const LAS u32x4*)(Vt + (32 * dt + r) * VP + 16 * ss + 8 * h);
            }
        }
        if (tid < 128) DEC[(size_t)ch * 128 + tid] = __expf(Bl[tid]);
        {
            const int i = w >> 1;
            for (int j = w & 1; j <= i; j += 2) {
                f32x4 acc = {0.f, 0.f, 0.f, 0.f};
                const int t = 16 * i + fr, s = 16 * j + fr;
#pragma unroll
                for (int k4 = 0; k4 < 4; ++k4) {
                    const int k0 = 32 * k4 + 8 * fq;
                    f32x4 r0 = {0.f, 0.f, 0.f, 0.f}, r1 = {0.f, 0.f, 0.f, 0.f};
                    if (i > 0) { r0 = *(const LAS f32x4*)(Gs + (16 * i - 1) * GP + k0); r1 = *(const LAS f32x4*)(Gs + (16 * i - 1) * GP + k0 + 4); }
                    const u32x4 q8 = *(const LAS u32x4*)(Qs + t * QP + k0), k8 = *(const LAS u32x4*)(Ks + s * QP + k0);
                    const f32x4 bt0 = *(const LAS f32x4*)(Gs + t * GP + k0), bt1 = *(const LAS f32x4*)(Gs + t * GP + k0 + 4);
                    const f32x4 bs0 = *(const LAS f32x4*)(Gs + s * GP + k0), bs1 = *(const LAS f32x4*)(Gs + s * GP + k0 + 4);
                    u32x4 a, bb;
                    a.x = cvtpk(bflo(q8.x) * __expf(bt0[0] - r0[0]), bfhi(q8.x) * __expf(bt0[1] - r0[1])); a.y = cvtpk(bflo(q8.y) * __expf(bt0[2] - r0[2]), bfhi(q8.y) * __expf(bt0[3] - r0[3]));
                    a.z = cvtpk(bflo(q8.z) * __expf(bt1[0] - r1[0]), bfhi(q8.z) * __expf(bt1[1] - r1[1])); a.w = cvtpk(bflo(q8.w) * __expf(bt1[2] - r1[2]), bfhi(q8.w) * __expf(bt1[3] - r1[3]));
                    bb.x = cvtpk(bflo(k8.x) * __expf(r0[0] - bs0[0]), bfhi(k8.x) * __expf(r0[1] - bs0[1])); bb.y = cvtpk(bflo(k8.y) * __expf(r0[2] - bs0[2]), bfhi(k8.y) * __expf(r0[3] - bs0[3]));
                    bb.z = cvtpk(bflo(k8.z) * __expf(r1[0] - bs1[0]), bfhi(k8.z) * __expf(r1[1] - bs1[1])); bb.w = cvtpk(bflo(k8.w) * __expf(r1[2] - bs1[2]), bfhi(k8.w) * __expf(r1[3] - bs1[3]));
                    acc = MFMA16(__builtin_bit_cast(bf16x8, a), __builtin_bit_cast(bf16x8, bb), acc);
                }
#pragma unroll
                for (int q = 0; q < 4; ++q) { const float v = (j < i || (4 * fq + q) >= fr) ? acc[q] : 0.f; At[(16 * i + 4 * fq + q) * AP + 16 * j + fr] = f2bf(v); }
            }
        }
        __syncthreads();
        {
            const int tt = w & 1, dt = w >> 1;
            f32x16 acc;
#pragma unroll
            for (int q = 0; q < 16; ++q) acc[q] = 0.f;
#pragma unroll
            for (int ss = 0; ss < 4; ++ss) if (ss < 2 * (tt + 1)) {
                const bf16x8 a = *(const LAS bf16x8*)(At + (32 * tt + r) * AP + 16 * ss + 8 * h), bv = *(const LAS bf16x8*)(Vt + (32 * dt + r) * VP + 16 * ss + 8 * h);
                acc = MFMA32(a, bv, acc);
            }
#pragma unroll
            for (int q = 0; q < 16; ++q) INTRA[(t0 + 32 * tt + crow(q, h)) * HW + col0 + 32 * dt + r] = f2bf(acc[q]);
        }
        __syncthreads();
    }
#undef HP_LOAD
}

constexpr int SC_OPB = 0, SC_OBUF = 65536, SC_OBP = 132, SC_OBB = 64 * SC_OBP * 4, SC_DEC = SC_OBUF + 2 * SC_OBB;
__device__ __forceinline__ void scan_unit(Frame& F, int bh) {
    const bf16_t* QF = WSP(bf16_t, WS_QF); const bf16_t* KF = WSP(bf16_t, WS_KF); const bf16_t* VF = WSP(bf16_t, WS_VF); const bf16_t* INTRA = WSP(bf16_t, WS_INTRA); const float* DEC = WSP(float, WS_DEC);
    const bf16_t* HG = WSP(bf16_t, WS_HG); bf16_t* MIX = WSP(bf16_t, WS_MIX);
    const int tid = F.tid, lane = F.lane, w = F.wave, r = lane & 31, h = lane >> 5, tt = w & 1, d = w >> 1, b = bh >> 2, hd = bh & 3;
    LAS unsigned char* lds = F.lds;
    f32x16 S[4];
#pragma unroll
    for (int kt = 0; kt < 4; ++kt)
#pragma unroll
        for (int q = 0; q < 16; ++q) S[kt][q] = 0.f;
#define SC_DMA(c_) do { const size_t chn = (size_t)bh * 32 + (c_); const int slot = ((c_) & 1) * 32768; _Pragma("unroll") for (int i_ = 0; i_ < 2; ++i_) { \
        __builtin_amdgcn_global_load_lds((const unsigned*)(QF + ((chn * 16 + 2 * w + i_) * 64 + lane) * 8), (LAS unsigned*)(lds + SC_OPB + slot + (2 * w + i_) * 1024), 16, 0, 0); \
        __builtin_amdgcn_global_load_lds((const unsigned*)(KF + ((chn * 16 + 2 * w + i_) * 64 + lane) * 8), (LAS unsigned*)(lds + SC_OPB + slot + 16384 + (2 * w + i_) * 1024), 16, 0, 0); } \
        } while (0)
#define SC_DEC_LD(c_) (*(const f32x4*)(DEC + ((size_t)bh * 32 + (c_)) * 128 + (tid & 31) * 4))
#define SC_DEC_ST(c_, v_) do { if (tid < 32) *(LAS f32x4*)(lds + SC_DEC + ((c_) & 1) * 512 + tid * 16) = (v_); } while (0)
    bf16x8 Vf[4], Vn[4];
#pragma unroll
    for (int ss = 0; ss < 4; ++ss) Vf[ss] = *(const bf16x8*)(VF + ((((size_t)bh * 32) * 16 + ss * 4 + d) * 64 + lane) * 8);
    SC_DMA(0);
    { const f32x4 dv0 = SC_DEC_LD(0); SC_DEC_ST(0, dv0); }
    __syncthreads();
    const int ft = tid >> 3, fs = tid & 7;
    const int ocol = hd * 128 + 16 * fs;
    for (int c = 0; c < 32; ++c) {
        const int slot = (c & 1) * 32768;
        f32x4 dnext = {0.f, 0.f, 0.f, 0.f};
        if (c + 1 < 32) {
            SC_DMA(c + 1);
            dnext = SC_DEC_LD(c + 1);
#pragma unroll
            for (int ss = 0; ss < 4; ++ss) Vn[ss] = *(const bf16x8*)(VF + ((((size_t)bh * 32 + c + 1) * 16 + ss * 4 + d) * 64 + lane) * 8);
        }
        const size_t trow = (size_t)b * SEQ + 64 * c + ft;
        const u32x4 in0 = *(const u32x4*)(INTRA + trow * HW + ocol), in1 = *(const u32x4*)(INTRA + trow * HW + ocol + 8);
        const u32x4 hg0 = *(const u32x4*)(HG + trow * HW + ocol), hg1 = *(const u32x4*)(HG + trow * HW + ocol + 8);
        f32x16 P;
#pragma unroll
        for (int q = 0; q < 16; ++q) P[q] = 0.f;
#pragma unroll
        for (int kt = 0; kt < 4; ++kt)
#pragma unroll
            for (int ks = 0; ks < 2; ++ks) {
                const bf16x8 qf = *(const LAS bf16x8*)(lds + SC_OPB + slot + ((tt * 4 + kt) * 2 + ks) * 1024 + lane * 16);
                P = MFMA32(qf, pack_step(S[kt], ks), P);
            }
        {   LAS float* ob = (LAS float*)(lds + SC_OBUF + (c & 1) * SC_OBB);
#pragma unroll
            for (int q = 0; q < 16; ++q) ob[(32 * tt + crow(q, h)) * SC_OBP + 32 * d + r] = P[q]; }
#pragma unroll
        for (int kt = 0; kt < 4; ++kt) {
#pragma unroll
            for (int g = 0; g < 4; ++g) { const f32x4 dc = *(const LAS f32x4*)(lds + SC_DEC + (c & 1) * 512 + (32 * kt + 8 * g + 4 * h) * 4);
#pragma unroll
                for (int q = 0; q < 4; ++q) S[kt][4 * g + q] *= dc[q]; }
#pragma unroll
            for (int ss = 0; ss < 4; ++ss) {
                const bf16x8 kf = *(const LAS bf16x8*)(lds + SC_OPB + slot + 16384 + (kt * 4 + ss) * 1024 + lane * 16);
                S[kt] = MFMA32(kf, Vf[ss], S[kt]);
            }
        }
        SC_DEC_ST(c + 1, dnext);
        __syncthreads();
        {
            const LAS float* ob = (const LAS float*)(lds + SC_OBUF + (c & 1) * SC_OBB) + ft * SC_OBP + 16 * fs;
            const f32x4 p0 = *(const LAS f32x4*)ob, p1 = *(const LAS f32x4*)(ob + 4), p2 = *(const LAS f32x4*)(ob + 8), p3 = *(const LAS f32x4*)(ob + 12);
            float o[16];
            o[0] = p0[0] + bflo(in0.x); o[1] = p0[1] + bfhi(in0.x); o[2] = p0[2] + bflo(in0.y); o[3] = p0[3] + bfhi(in0.y);
            o[4] = p1[0] + bflo(in0.z); o[5] = p1[1] + bfhi(in0.z); o[6] = p1[2] + bflo(in0.w); o[7] = p1[3] + bfhi(in0.w);
            o[8] = p2[0] + bflo(in1.x); o[9] = p2[1] + bfhi(in1.x); o[10] = p2[2] + bflo(in1.y); o[11] = p2[3] + bfhi(in1.y);
            o[12] = p3[0] + bflo(in1.z); o[13] = p3[1] + bfhi(in1.z); o[14] = p3[2] + bflo(in1.w); o[15] = p3[3] + bfhi(in1.w);
            float ss2 = 0.f;
#pragma unroll
            for (int q = 0; q < 16; ++q) ss2 += o[q] * o[q];
            ss2 += __shfl_xor(ss2, 1); ss2 += __shfl_xor(ss2, 2); ss2 += __shfl_xor(ss2, 4);
            const float rs = rsqrtf(ss2 * (1.f / 128.f) + EPS);
            const float* gh = F.hgrn_g + ocol;
            const unsigned hgw[8] = {hg0.x, hg0.y, hg0.z, hg0.w, hg1.x, hg1.y, hg1.z, hg1.w};
            unsigned ow[8];
#pragma unroll
            for (int q = 0; q < 8; ++q) ow[q] = cvtpk(o[2 * q] * rs * gh[2 * q] * bflo(hgw[q]), o[2 * q + 1] * rs * gh[2 * q + 1] * bfhi(hgw[q]));
            bf16_t* mo = MIX + trow * MIXW + AW + ocol;
            *(u32x4*)mo = (u32x4){ow[0], ow[1], ow[2], ow[3]}; *(u32x4*)(mo + 8) = (u32x4){ow[4], ow[5], ow[6], ow[7]};
        }
#pragma unroll
        for (int ss = 0; ss < 4; ++ss) Vf[ss] = Vn[ss];
    }
    __syncthreads();
#undef SC_DMA
#undef SC_DEC_LD
#undef SC_DEC_ST
}

constexpr int AT_KP = 72, AT_VP = 260;
__device__ __forceinline__ void attn_stage(Frame& F, int kvh, int n, size_t t0, LAS bf16_t* Ks, LAS bf16_t* Vt) {
    const bf16_t* AK = WSP(bf16_t, WS_AK); const bf16_t* AV = WSP(bf16_t, WS_AV);
    __syncthreads();
    int tid_ = F.tid; asm volatile("" : "+v"(tid_));
#pragma unroll
    for (int i = 0; i < 4; ++i) {
        const int idx = tid_ + 512 * i, row = idx >> 3, c8 = idx & 7;
        u32x4 kv = {0u, 0u, 0u, 0u}, vv = {0u, 0u, 0u, 0u};
        if (n > 0 || row >= 128) { const size_t go = (t0 - 128 + row) * AKW + kvh * 64 + 8 * c8; kv = *(const u32x4*)(AK + go); vv = *(const u32x4*)(AV + go); }
        *(LAS u32x4*)(Ks + row * AT_KP + 8 * c8) = kv;
#pragma unroll
        for (int q = 0; q < 4; ++q) { Vt[(8 * c8 + 2 * q) * AT_VP + row] = (bf16_t)(vv[q] & 0xffffu); Vt[(8 * c8 + 2 * q + 1) * AT_VP + row] = (bf16_t)(vv[q] >> 16); }
    }
    __syncthreads();
}
__device__ __forceinline__ void attn_item(Frame& F, int hq, int rt, int n, size_t t0, const LAS bf16_t* Ks, const LAS bf16_t* Vt, LAS float* ssq, unsigned (&okp)[16]) {
    const bf16_t* AQ = WSP(bf16_t, WS_AQ);
    int lane = F.lane; asm volatile("" : "+v"(lane));
    const int r = lane & 31, h = lane >> 5;
    constexpr float L2E = 1.4426950408889634f;
    const float slope2 = exp2f(-(float)(hq + 1)) * L2E, sink2 = F.sinks[hq] * L2E;
    bf16x8 qf[4];
#pragma unroll
    for (int ds = 0; ds < 4; ++ds) qf[ds] = *(const bf16x8*)(AQ + (t0 + 32 * rt + r) * AW + hq * 64 + 16 * ds + 8 * h);
    float m = sink2;
#define AT_SCORE(SC, j) do { const int kt = rt + (j); int rq = r - 4 * h - 32 * (j); asm volatile("" : "+v"(rq));     \
        _Pragma("unroll") for (int q = 0; q < 16; ++q) SC[q] = 0.f; \
        _Pragma("unroll") for (int ds = 0; ds < 4; ++ds) SC = MFMA32(*(const LAS bf16x8*)(Ks + (32 * kt + r) * AT_KP + 16 * ds + 8 * h), qf[ds], SC); \
        const float base = -slope2 * (float)(128 + rq); const int rel = rq + 32 * (j);            \
        if (n == 0 && kt < 4) { _Pragma("unroll") for (int q = 0; q < 16; ++q) SC[q] = -INFINITY; } \
        else { _Pragma("unroll") for (int q = 0; q < 16; ++q) { const int cq = (q & 3) + 8 * (q >> 2); float v = __builtin_fmaf(slope2, (float)cq, __builtin_fmaf(SC[q], 0.125f * L2E, base)); \
            if ((j) == 0) v = (cq > rel) ? v : -INFINITY; if ((j) == 4) v = (cq <= rel) ? v : -INFINITY; SC[q] = v; } } } while (0)
#pragma unroll
    for (int j = 0; j < 5; ++j) { f32x16 sc; AT_SCORE(sc, j);
#pragma unroll
        for (int q = 0; q < 16; ++q) m = fmaxf(m, sc[q]); }
    m = fmaxf(m, __shfl_xor(m, 32));
    float l = 0.f; unsigned pp[5][8];
#pragma unroll
    for (int j = 0; j < 5; ++j) { f32x16 sc; AT_SCORE(sc, j);
#pragma unroll
        for (int q = 0; q < 16; ++q) { sc[q] = exp2f(sc[q] - m); l += sc[q]; }
#pragma unroll
        for (int q = 0; q < 8; ++q) pp[j][q] = cvtpk(sc[2 * q], sc[2 * q + 1]); }
#undef AT_SCORE
    l += __shfl_xor(l, 32); l += exp2f(sink2 - m);
    const float rl = 1.f / l;
    float sq = 0.f;
#pragma unroll
    for (int dt = 0; dt < 2; ++dt) {
        f32x16 o;
#pragma unroll
        for (int q = 0; q < 16; ++q) o[q] = 0.f;
        const LAS bf16_t* vrow = Vt + (32 * dt + r) * AT_VP + 4 * h;
#pragma unroll
        for (int j = 0; j < 5; ++j)
#pragma unroll
            for (int s = 0; s < 2; ++s) { const LAS bf16_t* vp = vrow + 32 * (rt + j) + 16 * s;
                const u32x2 va = *(const LAS u32x2*)vp, vb = *(const LAS u32x2*)(vp + 8); const u32x4 pa = {va.x, va.y, vb.x, vb.y};
                const u32x4 pb = {pp[j][4 * s], pp[j][4 * s + 1], pp[j][4 * s + 2], pp[j][4 * s + 3]};
                o = MFMA32(__builtin_bit_cast(bf16x8, pa), __builtin_bit_cast(bf16x8, pb), o); }
#pragma unroll
        for (int q = 0; q < 16; ++q) { o[q] *= rl; sq += o[q] * o[q]; }
#pragma unroll
        for (int q = 0; q < 8; ++q) okp[dt * 8 + q] = cvtpk(o[2 * q], o[2 * q + 1]);
    }
    sq += __shfl_xor(sq, 32);
    if (h == 0) __hip_atomic_fetch_add(&ssq[32 * rt + r], sq, __ATOMIC_RELAXED, __HIP_MEMORY_SCOPE_WORKGROUP);
}
__device__ __forceinline__ void attn_store(Frame& F, int hq, int rt, size_t t0, const LAS float* ssq, const unsigned (&okp)[16]) {
    bf16_t* MIX = WSP(bf16_t, WS_MIX);
    int lane = F.lane; asm volatile("" : "+v"(lane));
    const int r = lane & 31, h = lane >> 5;
    const float rs = rsqrtf(ssq[32 * rt + r] * (1.f / AW) + EPS);
    bf16_t* mo = MIX + (t0 + 32 * rt + r) * MIXW + hq * 64;
#pragma unroll
    for (int dt = 0; dt < 2; ++dt)
#pragma unroll
        for (int g4 = 0; g4 < 4; ++g4) {
            const int d0 = 32 * dt + 8 * g4 + 4 * h; const f32x4 ga = *(const f32x4*)(F.attn_g + hq * 64 + d0);
            const unsigned p0 = okp[dt * 8 + 2 * g4], p1 = okp[dt * 8 + 2 * g4 + 1];
            u32x2 ow; ow.x = cvtpk(bflo(p0) * rs * ga[0], bfhi(p0) * rs * ga[1]); ow.y = cvtpk(bflo(p1) * rs * ga[2], bfhi(p1) * rs * ga[3]);
            *(u32x2*)(mo + d0) = ow;
        }
}
__device__ __forceinline__ void attn_unit(Frame& F, int u) {
    LAS bf16_t* Ks = (LAS bf16_t*)F.lds;
    LAS bf16_t* Vt = (LAS bf16_t*)(F.lds + 36864);
    LAS float* ssq = (LAS float*)(F.lds + 36864 + 33280);
    const int w = F.wave, b = u >> 4, n = u & 15; const size_t t0 = (size_t)b * SEQ + 128 * n;
    if (F.tid < 128) ssq[F.tid] = 0.f;
    const int g0 = (2 * w) >> 2, rt0 = (2 * w) & 3, g1 = (2 * w + 1) >> 2, rt1 = (2 * w + 1) & 3;
    unsigned ok0[16], ok1[16], ok2[16], ok3[16];
    attn_stage(F, 0, n, t0, Ks, Vt);
    attn_item(F, g0, rt0, n, t0, Ks, Vt, ssq, ok0);
    attn_item(F, g1, rt1, n, t0, Ks, Vt, ssq, ok1);
    attn_stage(F, 1, n, t0, Ks, Vt);
    attn_item(F, 4 + g0, rt0, n, t0, Ks, Vt, ssq, ok2);
    attn_item(F, 4 + g1, rt1, n, t0, Ks, Vt, ssq, ok3);
    __syncthreads();
    attn_store(F, g0, rt0, t0, ssq, ok0); attn_store(F, g1, rt1, t0, ssq, ok1); attn_store(F, 4 + g0, rt0, t0, ssq, ok2); attn_store(F, 4 + g1, rt1, t0, ssq, ok3);
    __syncthreads();
}
__device__ __forceinline__ void p_convert_experts(Frame& F, int rank, int nrank, int max_chunks = 1 << 30);
#ifdef TS_A
#ifndef TS_BLK
#define TS_BLK 0
#endif
#define RSTAMP(k) do { if (blockIdx.x == TS_BLK && F.tid == 0) ((volatile LAS unsigned long long*)(F.lds + LDSCTL_OFF + 2048))[k] = __builtin_amdgcn_s_memrealtime(); } while (0)
#else
#define RSTAMP(k) do { } while (0)
#endif
__device__ __forceinline__ void p_scan_attn(Frame& F, bool do_scan, bool do_attn) {
    const int G = F.G, bx = blockIdx.x, nscan = (do_scan && do_attn && G >= 64) ? 32 : 0;
    if (do_scan) { if (nscan) { if (bx < nscan) scan_unit(F, bx); } else for (int u = bx; u < BATCH * 4; u += G) scan_unit(F, u); }
    if (do_attn) { if (nscan) { for (int u = bx - nscan; u >= 0 && u < BATCH * 16; u += G - nscan) attn_unit(F, u); } else for (int u = bx; u < BATCH * 16; u += G) attn_unit(F, u); }
    RSTAMP(15);
    p_convert_experts(F, 0, 0);
    RSTAMP(16);
}

__device__ __forceinline__ int w2col(int n) { const int c = n & 255; return (n & ~255) + 64 * ((c >> 5) & 3) + 16 * ((c >> 3) & 3) + 8 * (c >> 7) + (c & 7); }
__device__ __forceinline__ int w1col(int n) { const int pn = n >> 8, cl = n & 255; return cl < 128 ? 2 * (128 * pn + cl) : 2 * (128 * pn + cl - 128) + 1; }
template <bool W1MAP, bool FP8>
__device__ __forceinline__ void p0_transpose_item(const float* W, int K, int N, void* WTv, LAS float* scr, int item, int lane) {
    const int nblk = N / 32, kb = item / nblk, nb = item % nblk, k0 = 64 * kb, n0 = 32 * nb;
    const int sc = W1MAP ? w1col(n0 + (lane & 31)) : n0 + (lane & 31);
    float v[32];
#pragma unroll
    for (int i = 0; i < 32; ++i) v[i] = W[(size_t)(k0 + 2 * i + (lane >> 5)) * N + sc];
#pragma unroll
    for (int i = 0; i < 32; ++i) scr[(2 * i + (lane >> 5)) * 33 + (lane & 31)] = v[i];
    LDS_WAIT(); asm volatile("" ::: "memory");
    const int c = lane & 7;
#pragma unroll
    for (int j = 0; j < 4; ++j) { const int n = (lane >> 3) + 8 * j; const LAS float* s = scr + (8 * c) * 33 + n;
        if constexpr (FP8) { const f32x4 a = {s[0 * 33], s[1 * 33], s[2 * 33], s[3 * 33]}, b = {s[4 * 33], s[5 * 33], s[6 * 33], s[7 * 33]};
            *(GAS u32x2*)((unsigned char*)WTv + (size_t)(n0 + n) * K + k0 + 8 * c) = pg8::pack8_fp8(a * pg8::FP8_W_SCALE, b * pg8::FP8_W_SCALE); }
        else { u32x4 o; o.x = pg8::cvt_pk_bf16(s[0 * 33], s[1 * 33]); o.y = pg8::cvt_pk_bf16(s[2 * 33], s[3 * 33]); o.z = pg8::cvt_pk_bf16(s[4 * 33], s[5 * 33]); o.w = pg8::cvt_pk_bf16(s[6 * 33], s[7 * 33]);
            *(GAS u32x4*)((bf16_t*)WTv + (size_t)(n0 + n) * K + k0 + 8 * c) = o; } }
    LDS_WAIT(); asm volatile("" ::: "memory");
}
struct ConvItem { const float* W; unsigned char* WT; int N, k0, n0, map; };
__device__ __forceinline__ ConvItem conv_desc(Frame& F, int it) {
    constexpr int I_W1E = (DM / 128) * (2 * FF / 32), I_W2E = (FF / 128) * (DM / 32);
    ConvItem c;
    if (it < NE * I_W1E) { const int e = it / I_W1E, r = it % I_W1E, nblk = 2 * FF / 32; c.W = F.w1 + (size_t)e * DM * 2 * FF; c.WT = WSP(unsigned char, WS_W1T) + (size_t)e * 2 * FF * DM; c.N = 2 * FF; c.k0 = 128 * (r / nblk); c.n0 = 32 * (r % nblk); c.map = 1; }
    else { it -= NE * I_W1E; const int e = it / I_W2E, r = it % I_W2E, nblk = DM / 32; c.W = F.w2 + (size_t)e * FF * DM; c.WT = WSP(unsigned char, WS_W2T) + (size_t)e * DM * FF; c.N = DM; c.k0 = 128 * (r / nblk); c.n0 = 32 * (r % nblk); c.map = 2; }
    return c;
}
__device__ __forceinline__ void conv_item(const ConvItem& c, int lane, LAS float* scr) {
    const int sc = c.map == 1 ? w1col(c.n0 + (lane & 31)) : w2col(c.n0 + (lane & 31));
    const float* p = c.W + (size_t)(c.k0 + (lane >> 5)) * c.N + sc;
    float v[64];
#pragma unroll
    for (int i = 0; i < 64; ++i) v[i] = p[(size_t)(2 * i) * c.N];
#pragma unroll
    for (int i = 0; i < 64; ++i) scr[(2 * i + (lane >> 5)) * 33 + (lane & 31)] = v[i];
    LDS_WAIT(); asm volatile("" ::: "memory");
    const int cg = lane & 15;
#pragma unroll
    for (int j = 0; j < 8; ++j) { const int n = (lane >> 4) + 4 * j; const LAS float* s = scr + (8 * cg) * 33 + n;
        const f32x4 a = {s[0 * 33], s[1 * 33], s[2 * 33], s[3 * 33]}, b = {s[4 * 33], s[5 * 33], s[6 * 33], s[7 * 33]};
        *(GAS u32x2*)(c.WT + (size_t)(c.n0 + n) * DM + c.k0 + 8 * cg) = pg8::pack8_fp8(a * pg8::FP8_W_SCALE, b * pg8::FP8_W_SCALE); }
    LDS_WAIT(); asm volatile("" ::: "memory");
}
__device__ __forceinline__ void p_convert_experts(Frame& F, int rank, int nrank, int max_chunks) {
    static_assert(DM == FF && RING_BYTES >= NWAVES * 128 * 33 * 4, "conv_item assumes K = 1024 for both expert matrices and a 16.5 KiB LDS tile per wave");
    LAS float* scr = (LAS float*)(F.lds + RING_OFF + F.wave * (128 * 33 * 4));
    constexpr int NITEMS = NE * (DM / 128) * (2 * FF / 32) + NE * (FF / 128) * (DM / 32);
    __syncthreads();
    if (nrank > 0) { for (int it = rank * NWAVES + F.wave; it < NITEMS; it += nrank * NWAVES) { const ConvItem c = conv_desc(F, it); conv_item(c, F.lane, scr); } return; }
    volatile LAS int* slot = (volatile LAS int*)(F.lds + LDSCTL_OFF + 4096);
    int* ctr = (int*)(F.ctl + CW_CONV);
    if (F.tid == 0) slot[0] = atomicAdd(ctr, 16);
    __syncthreads();
    for (int cur = 0, nch = 1;; cur ^= 1, ++nch) {
        const int base = slot[cur];
        if (base >= NITEMS) break;
        const bool more = nch < max_chunks;
        if (F.tid == 0 && more) slot[cur ^ 1] = atomicAdd(ctr, 16);
#pragma unroll 1
        for (int j = 0; j < 2; ++j) { const int it = base + 8 * j + F.wave; if (it < NITEMS) { const ConvItem c = conv_desc(F, it); conv_item(c, F.lane, scr); } }
        __syncthreads();
        if (!more) break;
    }
}
__device__ __forceinline__ void p_prologue(Frame& F) {
    LAS float* scr = (LAS float*)(F.lds + RING_OFF + F.wave * 16384);
    const int gw = F.vcu * NWAVES + F.wave, NGW = F.G * NWAVES;
    constexpr int I_IN = (DM / 64) * (INW / 32), I_OUT = (MIXW / 64) * (DM / 32), I_W1E = (DM / 64) * (2 * FF / 32), I_W2E = (FF / 64) * (DM / 32);
    constexpr int NITEMS = I_IN + I_OUT;
    bf16_t *WinT = WSP(bf16_t, WS_WINT), *WoutT = WSP(bf16_t, WS_WOUTT);
    for (int it = gw; it < NITEMS; it += NGW) {
        int r = it;
        if (r < I_IN) { p0_transpose_item<false, false>(F.w_in, DM, INW, WinT, scr, r, F.lane); continue; } r -= I_IN;
        p0_transpose_item<false, false>(F.w_out, MIXW, DM, WoutT, scr, r, F.lane);
    }
    bf16_t* XN = WSP(bf16_t, WS_XN);
    for (int m = gw; m < T; m += NGW) {
        const GAS f32x4* xr = (const GAS f32x4*)(F.x + (size_t)m * DM) + F.lane;
        f32x4 v[4]; float s = 0.f;
#pragma unroll
        for (int j = 0; j < 4; ++j) { v[j] = xr[64 * j]; s += (v[j].x * v[j].x + v[j].y * v[j].y) + (v[j].z * v[j].z + v[j].w * v[j].w); }
        const float r = rsqrtf(wave_sum(s) * (1.f / DM) + EPS);
        GAS u32x2* o8 = (GAS u32x2*)(XN + (size_t)m * DM) + F.lane;
#pragma unroll
        for (int j = 0; j < 4; ++j) { const f32x4 g = *((const f32x4*)F.norm1_g + F.lane + 64 * j); u32x2 w; w.x = pg8::cvt_pk_bf16(v[j].x * r * g.x, v[j].y * r * g.y); w.y = pg8::cvt_pk_bf16(v[j].z * r * g.z, v[j].w * r * g.w); o8[64 * j] = w; }
    }
    {
        bf16_t* RWF = WSP(bf16_t, WS_RWF);
        for (int i = (NGW - 1 - gw) * 64 + F.lane; i < 64 * 64; i += NGW * 64) { const int ks = i >> 6, ln = i & 63, rr = ln & 31, hh = ln >> 5; float v[8];
#pragma unroll
            for (int j = 0; j < 8; ++j) v[j] = F.router_w[(size_t)(16 * ks + 8 * hh + j) * NE + rr];
            u32x4 hi, lo; hi.x = cvtpk(v[0], v[1]); hi.y = cvtpk(v[2], v[3]); hi.z = cvtpk(v[4], v[5]); hi.w = cvtpk(v[6], v[7]);
            lo.x = cvtpk(v[0] - bflo(hi.x), v[1] - bfhi(hi.x)); lo.y = cvtpk(v[2] - bflo(hi.y), v[3] - bfhi(hi.y)); lo.z = cvtpk(v[4] - bflo(hi.z), v[5] - bfhi(hi.z)); lo.w = cvtpk(v[6] - bflo(hi.w), v[7] - bfhi(hi.w));
            *(u32x4*)(RWF + ((size_t)(ks * 2 + 0) * 64 + ln) * 8) = hi; *(u32x4*)(RWF + ((size_t)(ks * 2 + 1) * 64 + ln) * 8) = lo; }
    }
    if (blockIdx.x == 0) { float* LB = WSP(float, WS_LB); for (int c = F.tid; c < HKW; c += NWAVES * 64) { const float a = F.lb_logits[c], b = F.lb_logits[HKW + c]; LB[c] = 1.f / (1.f + __expf(b - a)); } }
}

__device__ __forceinline__ void p_router(Frame& F) {
    LAS int* lcnt = (LAS int*)(F.lds + MOE_OFF + 512); LAS int* lbase = (LAS int*)(F.lds + MOE_OFF + 768);
    LAS float* part = (LAS float*)F.lds;
    LAS float* ssqp = (LAS float*)(F.lds + 32768);
    const bf16_t* X1 = WSP(bf16_t, WS_X1); unsigned char* H2 = WSP(unsigned char, WS_H2); int* LIST = WSP(int, WS_LIST); float* LRS = WSP(float, WS_LRS); float* LGT = WSP(float, WS_LGT);
    const bf16_t* RWF = WSP(bf16_t, WS_RWF);
    int* cnt = (int*)(F.ctl + CW_CNT);
    const int lane = F.lane, w = F.wave, r = lane & 31, h = lane >> 5, tile = w & 1, kq = w >> 1;
    constexpr int XP = 260;
    LAS float* xs = (LAS float*)(F.lds + 36864);
    for (int tb = blockIdx.x; tb < T / 64; tb += F.G) {
        if (F.tid < NE) lcnt[F.tid] = 0;
        const int t = tb * 64 + tile * 32 + r;
        f32x16 acc;
#pragma unroll
        for (int q = 0; q < 16; ++q) acc[q] = 0.f;
        float ssq = 0.f;
        u32x4 pre0[4], pre1[4];
#define RT_LOAD(P, c_) do { _Pragma("unroll") for (int i = 0; i < 4; ++i) P[i] = *(const u32x4*)(X1 + (size_t)(tb * 64 + 8 * w + 2 * i + (lane >> 5)) * DM + 256 * (c_) + 8 * (lane & 31)); } while (0)
#define RT_CHUNK(P, c_) do { const int c = (c_); \
            __syncthreads();                                     \
            _Pragma("unroll") for (int i = 0; i < 4; ++i) { LAS float* d_ = xs + (8 * w + 2 * i + (lane >> 5)) * XP + 8 * (lane & 31); \
                *(LAS f32x4*)d_ = (f32x4){bflo(P[i].x), bfhi(P[i].x), bflo(P[i].y), bfhi(P[i].y)}; *(LAS f32x4*)(d_ + 4) = (f32x4){bflo(P[i].z), bfhi(P[i].z), bflo(P[i].w), bfhi(P[i].w)}; } \
            if (c + 2 < 4) RT_LOAD(P, c + 2); \
            __syncthreads(); \
            _Pragma("unroll 2") for (int s4 = 0; s4 < 4; ++s4) {                   \
                const int ksl = 4 * kq + s4, ks = 16 * c + ksl, k0 = 16 * ks + 8 * h; \
                const f32x4 x0 = *(const LAS f32x4*)(xs + (32 * tile + r) * XP + 16 * ksl + 8 * h), x1v = *(const LAS f32x4*)(xs + (32 * tile + r) * XP + 16 * ksl + 8 * h + 4); \
                const f32x4 g0 = *(const f32x4*)(F.norm2_g + k0), g1 = *(const f32x4*)(F.norm2_g + k0 + 4); \
                const u32x4 ahi = *(const u32x4*)(RWF + ((size_t)(ks * 2 + 0) * 64 + lane) * 8), alo = *(const u32x4*)(RWF + ((size_t)(ks * 2 + 1) * 64 + lane) * 8); \
                float u[8]; \
                _Pragma("unroll") for (int q = 0; q < 4; ++q) { u[q] = x0[q] * g0[q]; u[4 + q] = x1v[q] * g1[q]; ssq += x0[q] * x0[q]; ssq += x1v[q] * x1v[q]; } \
                u32x4 bh, bl; \
                bh.x = cvtpk(u[0], u[1]); bh.y = cvtpk(u[2], u[3]); bh.z = cvtpk(u[4], u[5]); bh.w = cvtpk(u[6], u[7]); \
                bl.x = cvtpk(u[0] - bflo(bh.x), u[1] - bfhi(bh.x)); bl.y = cvtpk(u[2] - bflo(bh.y), u[3] - bfhi(bh.y)); \
                bl.z = cvtpk(u[4] - bflo(bh.z), u[5] - bfhi(bh.z)); bl.w = cvtpk(u[6] - bflo(bh.w), u[7] - bfhi(bh.w)); \
                *(u32x2*)(H2 + (size_t)t * DM + k0) = pg8::pack8_fp8((f32x4){u[0], u[1], u[2], u[3]} * pg8::FP8_ACT_SCALE, (f32x4){u[4], u[5], u[6], u[7]} * pg8::FP8_ACT_SCALE);     \
                acc = MFMA32(__builtin_bit_cast(bf16x8, ahi), __builtin_bit_cast(bf16x8, bh), acc); \
                acc = MFMA32(__builtin_bit_cast(bf16x8, alo), __builtin_bit_cast(bf16x8, bh), acc); \
                acc = MFMA32(__builtin_bit_cast(bf16x8, ahi), __builtin_bit_cast(bf16x8, bl), acc); \
            } } while (0)
        RT_LOAD(pre0, 0); RT_LOAD(pre1, 1);
#pragma unroll 1
        for (int cc = 0; cc < 4; cc += 2) { RT_CHUNK(pre0, cc); RT_CHUNK(pre1, cc + 1); }
#undef RT_LOAD
#undef RT_CHUNK
#pragma unroll
        for (int q = 0; q < 4; ++q) *(LAS f32x4*)(part + (w * 64 + lane) * 16 + 4 * q) = (f32x4){acc[4 * q], acc[4 * q + 1], acc[4 * q + 2], acc[4 * q + 3]};
        ssqp[w * 64 + lane] = ssq;
        RSTAMP(11);
        __syncthreads();
        RSTAMP(12);
        int my_e[TOPK], my_p[TOPK]; float my_g[TOPK], my_rs = 0.f;
#pragma unroll
        for (int k = 0; k < TOPK; ++k) { my_e[k] = 0; my_p[k] = 0; my_g[k] = 0.f; }
        if (w < 2) {
            float lg[16];
#pragma unroll
            for (int q = 0; q < 16; ++q) lg[q] = 0.f;
            float s2 = 0.f;
#pragma unroll
            for (int k4 = 0; k4 < 4; ++k4) { const int ww = k4 * 2 + tile;
#pragma unroll
                for (int q = 0; q < 4; ++q) { const f32x4 p = *(const LAS f32x4*)(part + (ww * 64 + lane) * 16 + 4 * q); lg[4 * q] += p[0]; lg[4 * q + 1] += p[1]; lg[4 * q + 2] += p[2]; lg[4 * q + 3] += p[3]; }
                s2 += ssqp[ww * 64 + lane] + ssqp[ww * 64 + (lane ^ 32)]; }
            const float rstd = rsqrtf(s2 * (1.f / DM) + EPS);
#pragma unroll
            for (int q = 0; q < 16; ++q) lg[q] = lg[q] * rstd + F.router_b[crow(q, h)];
            float cv[8]; int ci[8];
#pragma unroll
            for (int k = 0; k < TOPK; ++k) {
                float bv = -INFINITY; int bi = 1 << 20;
#pragma unroll
                for (int q = 0; q < 16; ++q) { const int e = crow(q, h); const bool better = (lg[q] > bv) || (lg[q] == bv && e < bi); bv = better ? lg[q] : bv; bi = better ? e : bi; }
#pragma unroll
                for (int q = 0; q < 16; ++q) if (crow(q, h) == bi) lg[q] = -INFINITY;
                cv[k] = bv; ci[k] = bi;
            }
#pragma unroll
            for (int k = 0; k < TOPK; ++k) { cv[4 + k] = __shfl_xor(cv[k], 32); ci[4 + k] = __shfl_xor(ci[k], 32); }
            float tv[TOPK]; int te[TOPK];
#pragma unroll
            for (int k = 0; k < TOPK; ++k) {
                float bv = -INFINITY; int bi = 1 << 20;
#pragma unroll
                for (int q = 0; q < 8; ++q) { const bool better = (cv[q] > bv) || (cv[q] == bv && ci[q] < bi); bv = better ? cv[q] : bv; bi = better ? ci[q] : bi; }
#pragma unroll
                for (int q = 0; q < 8; ++q) if (ci[q] == bi) cv[q] = -INFINITY;
                tv[k] = bv; te[k] = bi;
            }
            const float e1 = __expf(tv[1] - tv[0]), e2 = __expf(tv[2] - tv[0]), e3 = __expf(tv[3] - tv[0]), inv = 1.f / (1.f + e1 + e2 + e3);
            if (h == 0) {
                my_rs = rstd; my_g[0] = inv; my_g[1] = e1 * inv; my_g[2] = e2 * inv; my_g[3] = e3 * inv;
#pragma unroll
                for (int k = 0; k < TOPK; ++k) { my_e[k] = te[k]; my_p[k] = __hip_atomic_fetch_add(&lcnt[te[k]], 1, __ATOMIC_RELAXED, __HIP_MEMORY_SCOPE_WORKGROUP); }
            }
        }
        RSTAMP(13);
        __syncthreads();
        if (F.tid < NE) lbase[F.tid] = atomicAdd(&cnt[F.tid * 64], (int)lcnt[F.tid]);
        __syncthreads();
        if (w < 2 && h == 0) {
#pragma unroll
            for (int k = 0; k < TOPK; ++k) { const size_t li = (size_t)my_e[k] * T + lbase[my_e[k]] + my_p[k]; LIST[li] = t * TOPK + k; LRS[li] = my_rs; LGT[li] = my_g[k]; }
        }
        __syncthreads();
        RSTAMP(14);
    }
}
__device__ __forceinline__ void moe_setup(Frame& F) {
    LAS int* pre = (LAS int*)(F.lds + MOE_OFF); LAS int* lc = (LAS int*)(F.lds + MOE_OFF + 256);
    if (F.tid < 64) {
        const int c = F.lane < NE ? (int)__hip_atomic_load((int*)(F.ctl + CW_CNT) + F.lane * 64, RLX_AGENT) : 0;
        int s = (c + 255) >> 8;
#pragma unroll
        for (int o = 1; o < 32; o <<= 1) { const int v = __shfl_up(s, o); if ((F.lane & 31) >= o) s += v; }
        if (F.lane < NE) { pre[F.lane + 1] = s; lc[F.lane] = c; }
        if (F.lane == 0) pre[0] = 0;
    }
    __syncthreads();
}
__device__ __forceinline__ void p_final(Frame& F) {
    const bf16_t* X1 = WSP(bf16_t, WS_X1); const unsigned char* Y = WSP(unsigned char, WS_Y);
    const int gw = F.vcu * NWAVES + F.wave, NGW = F.G * NWAVES;
    for (int t = gw; t < T; t += NGW) {
        const GAS u32x2* xr = (const GAS u32x2*)(X1 + (size_t)t * DM) + F.lane;
        f32x4 v[4]; float s = 0.f;
#pragma unroll
        for (int j = 0; j < 4; ++j) {
            { const u32x2 xb = xr[64 * j]; v[j] = (f32x4){bflo(xb.x), bfhi(xb.x), bflo(xb.y), bfhi(xb.y)}; }
#pragma unroll
            for (int k = 0; k < TOPK; ++k) { const int y = *((const GAS int*)(Y + ((size_t)t * TOPK + k) * DM) + F.lane + 64 * j);
                const f32x2 lo = __builtin_amdgcn_cvt_pk_f32_fp8(y, false), hi = __builtin_amdgcn_cvt_pk_f32_fp8(y, true);
                v[j].x += lo[0] * (1.f / pg8::FP8_Y_SCALE); v[j].y += lo[1] * (1.f / pg8::FP8_Y_SCALE); v[j].z += hi[0] * (1.f / pg8::FP8_Y_SCALE); v[j].w += hi[1] * (1.f / pg8::FP8_Y_SCALE); }
            s += (v[j].x * v[j].x + v[j].y * v[j].y) + (v[j].z * v[j].z + v[j].w * v[j].w);
        }
        const float r = rsqrtf(wave_sum(s) * (1.f / DM) + EPS);
        GAS f32x4* o = (GAS f32x4*)(F.out + (size_t)t * DM) + F.lane;
#pragma unroll
        for (int j = 0; j < 4; ++j) { const f32x4 g = *((const f32x4*)F.final_g + F.lane + 64 * j); o[64 * j] = (f32x4){v[j].x * r * g.x, v[j].y * r * g.y, v[j].z * r * g.z, v[j].w * r * g.w}; }
    }
}


struct Args { const float* in[18]; float* out; unsigned char* ws; int ph_lo, ph_hi, li, dry; };
__global__ void __launch_bounds__(NWAVES * 64, 2) mega_fwd(Args args) {
    extern __shared__ __attribute__((aligned(16))) unsigned char lds[];
    Frame F;
    F.lds = (LAS unsigned char*)lds; F.MISC = (volatile LAS unsigned*)(F.lds + MISC_OFF);
    F.tid = threadIdx.x; F.lane = F.tid & 63; F.wave = __builtin_amdgcn_readfirstlane(F.tid >> 6);
    F.G = gridDim.x; { const int bx = blockIdx.x; F.vcu = (F.G % 8 == 0) ? (bx % 8) * (F.G / 8) + bx / 8 : bx; }
    F.ws = args.ws; F.ctl = (gu32*)(args.ws + WS_CTL); F.out = args.out;
    F.x = args.in[0]; F.norm1_g = args.in[1]; F.w_in = args.in[2]; F.b_in = args.in[3]; F.sinks = args.in[4]; F.attn_g = args.in[5]; F.lb_logits = args.in[6]; F.hgrn_g = args.in[7];
    F.w_out = args.in[8]; F.b_out = args.in[9]; F.norm2_g = args.in[10]; F.router_w = args.in[11]; F.router_b = args.in[12]; F.w1 = args.in[13]; F.b1 = args.in[14]; F.w2 = args.in[15];
    F.b2 = args.in[16]; F.final_g = args.in[17];
    for (int u = F.tid; u < (LDS_BYTES - LDSCTL_OFF) / 4; u += NWAVES * 64) ((LAS unsigned*)(F.lds + LDSCTL_OFF))[u] = 0u;
    __syncthreads();
    XcdBarrier bar = xcd_barrier_post((unsigned*)(F.ctl + CW_BAR) + args.li * XCD_BAR_WORDS, F.MISC + 8);
    const int lo = args.ph_lo, hi = args.ph_hi;
#ifdef TS_A
    volatile LAS unsigned long long* ts_ = (volatile LAS unsigned long long*)(F.lds + LDSCTL_OFF + 2048);
#ifndef TS_BLK
#define TS_BLK 0
#endif
    const bool stamper = (blockIdx.x == TS_BLK && F.tid == 0);
    if (stamper) ts_[0] = __builtin_amdgcn_s_memrealtime();
#define STAMP(k) do { if (stamper) ts_[(k) + 1] = __builtin_amdgcn_s_memrealtime(); } while (0)
#else
#define STAMP(k) do { } while (0)
#endif
#define IN(k) (lo <= (k) && (k) < hi)
#define SEAM(k) do { if (IN(k) && IN((k) + 1)) xcd_barrier(bar); } while (0)

    if (IN(0)) { p_prologue(F); SEAM(0); } STAMP(0);
    if (IN(1)) {
        pg8::DenseOrder S; S.init(WSP(bf16_t, WS_XN), WSP(bf16_t, WS_WINT), T, INW, DM, F.G, (int)blockIdx.x);
        pg8::EpiInProj E{F.b_in, WSP(float, WS_LB), WSP(bf16_t, WS_AQ), WSP(bf16_t, WS_AK), WSP(bf16_t, WS_AV), WSP(bf16_t, WS_HQ), WSP(bf16_t, WS_KK), WSP(bf16_t, WS_HI), WSP(bf16_t, WS_HG), WSP(bf16_t, WS_G)};
#ifdef PROBE_VARIANTS
        if (args.dry == 2) pg8::gemm_phase<pg8::EpiInProj, pg8::DenseOrder, false, true, 2, 1>(F.lds + RING_OFF, DM, S, E, args.dry);
        else if (args.dry == 3) pg8::gemm_phase<pg8::EpiInProj, pg8::DenseOrder, false, true, 2, 2>(F.lds + RING_OFF, DM, S, E, args.dry);
        else if (args.dry == 4) pg8::gemm_phase<pg8::EpiInProj, pg8::DenseOrder, false, true, 2, 3>(F.lds + RING_OFF, DM, S, E, args.dry);
        else
#endif
        pg8::gemm_phase<pg8::EpiInProj, pg8::DenseOrder, false, true>(F.lds + RING_OFF, DM, S, E, args.dry);
        SEAM(1);
    } STAMP(1);
    if (IN(2)) { p_hgrn_prep(F); SEAM(2); } STAMP(2);
    if (IN(3)) { p_scan_attn(F, true, true); SEAM(3); } STAMP(3);
    STAMP(4);
    if (IN(5)) {
        pg8::DenseOrder S; S.init(WSP(bf16_t, WS_MIX), WSP(bf16_t, WS_WOUTT), T, DM, MIXW, F.G, (int)blockIdx.x);
        pg8::EpiOutProj E{F.b_out, F.x, WSP(bf16_t, WS_X1)};
        pg8::gemm_phase<pg8::EpiOutProj, pg8::DenseOrder, false, true>(F.lds + RING_OFF, MIXW, S, E);
        SEAM(5);
    } STAMP(5);
    if (IN(6)) { p_router(F); SEAM(6); } STAMP(6);
    if (IN(7)) {
        moe_setup(F);
        LAS const int* pre = (LAS const int*)(F.lds + MOE_OFF); LAS const int* lc = (LAS const int*)(F.lds + MOE_OFF + 256);
        pg8::MoeOrder<true, 1> S{(const char*)WSP(unsigned char, WS_H2), (const char*)WSP(unsigned char, WS_W1T), WSP(int, WS_LIST), pre, lc, DM, 2 * FF, 2 * FF / 256, pre[NE] * (2 * FF / 256), F.G, (int)blockIdx.x};
        pg8::EpiMoe1 E{F.b1, WSP(unsigned char, WS_ACT), WSP(float, WS_LRS)};
#ifdef PROBE_VARIANTS
        if (args.dry == 2) pg8::gemm_phase<pg8::EpiMoe1, pg8::MoeOrder<true, 1>, true, true, 1, 1>(F.lds + RING_OFF, DM, S, E, args.dry);
        else if (args.dry == 3) pg8::gemm_phase<pg8::EpiMoe1, pg8::MoeOrder<true, 1>, true, true, 1, 2>(F.lds + RING_OFF, DM, S, E, args.dry);
        else if (args.dry == 4) pg8::gemm_phase<pg8::EpiMoe1, pg8::MoeOrder<true, 1>, true, true, 1, 3>(F.lds + RING_OFF, DM, S, E, args.dry);
        else
#endif
        pg8::gemm_phase<pg8::EpiMoe1, pg8::MoeOrder<true, 1>, true, true, 1>(F.lds + RING_OFF, DM, S, E, args.dry);
        SEAM(7);
    } STAMP(7);
    if (IN(8)) {
        if (!IN(7)) moe_setup(F);
        LAS const int* pre = (LAS const int*)(F.lds + MOE_OFF); LAS const int* lc = (LAS const int*)(F.lds + MOE_OFF + 256);
        pg8::MoeOrder<false, 1> S{(const char*)WSP(unsigned char, WS_ACT), (const char*)WSP(unsigned char, WS_W2T), WSP(int, WS_LIST), pre, lc, FF, DM, DM / 256, pre[NE] * (DM / 256), F.G, (int)blockIdx.x};
        pg8::EpiMoe2 E{F.b2, WSP(int, WS_LIST), WSP(float, WS_LGT), WSP(unsigned char, WS_Y)};
        pg8::gemm_phase<pg8::EpiMoe2, pg8::MoeOrder<false, 1>, false, true, 1>(F.lds + RING_OFF, FF, S, E, args.dry);
        SEAM(8);
    } STAMP(8);
    if (IN(9)) p_final(F);
    STAMP(9);
#ifdef TS_A
    if (stamper) { const unsigned long long t_end = ts_[10], dly = (unsigned long long)(TS_MULT) * (ts_[TS_B] - ts_[TS_A]); while (__builtin_amdgcn_s_memrealtime() - t_end < dly) __builtin_amdgcn_s_sleep(4); }
#endif
#undef IN
#undef SEAM
}

static int mega_grid() {
    static int grid = 0;
    if (grid == 0) {
        int dev = 0, cus = 0;
        if (hipGetDevice(&dev) != hipSuccess || hipDeviceGetAttribute(&cus, hipDeviceAttributeMultiprocessorCount, dev) != hipSuccess) { grid = -1; return grid; }
        if (hipFuncSetAttribute((const void*)mega_fwd, hipFuncAttributeMaxDynamicSharedMemorySize, LDS_BYTES) != hipSuccess) { grid = -1; return grid; }
        (void)hipGetLastError();
        grid = cus;
    }
    return grid;
}
extern "C" void kernel_launch(void* const* d_in, const int* in_sizes, int n_in, void* d_out, int out_size, void* d_ws, size_t ws_size, hipStream_t stream) {
#ifndef PLAN
#define PLAN {{0, N_PHASES, 0}}
#endif
    if (n_in != 18 || ws_size < WS_END) return;
    const int grid = mega_grid(); if (grid <= 0) return;
    unsigned char* ws = (unsigned char*)d_ws;
    static const int plan[][3] = PLAN;
    constexpr int n_launch = (int)(sizeof(plan) / sizeof(plan[0]));
    (void)hipMemsetAsync(ws + WS_CTL, 0, (size_t)(CW_BAR + n_launch * XCD_BAR_WORDS) * 4, stream);
    Args a{};
    for (int i = 0; i < 18; ++i) a.in[i] = (const float*)d_in[i];
    a.out = (float*)d_out; a.ws = ws;
    for (int li = 0; li < (int)(sizeof(plan) / sizeof(plan[0])); ++li) {
        a.ph_lo = plan[li][0]; a.ph_hi = plan[li][1]; a.li = li; a.dry = plan[li][2];
        hipLaunchKernelGGL(mega_fwd, dim3(grid), dim3(NWAVES * 64), LDS_BYTES, stream, a);
    }
}
```

```cpp
#include <hip/hip_runtime.h>
#include <stdint.h>

typedef unsigned short bf16_t;
typedef short bf16x8 __attribute__((ext_vector_type(8)));
typedef float f32x4 __attribute__((ext_vector_type(4)));

constexpr int BATCH = 8, SEQ = 2048, DM = 1024, T = BATCH * SEQ;
constexpr int AW = 512, AKW = 128, HKW = 512, HW = 512, INW = 2816, MIXW = 1024;
constexpr int NE = 32, TOPK = 4, FF = 1024;
constexpr int C_AQ = 0, C_AK = 512, C_AV = 640, C_HQ = 768, C_HF = 1280, C_HI = 1792, C_HG = 2304;
constexpr float EPS = 1e-5f;
constexpr int ACT_ROWS = T * TOPK + NE * 256;

constexpr size_t MiB = 1u << 20;
constexpr size_t al(size_t x) { return (x + 255) & ~(size_t)255; }
constexpr size_t WS_CTL = 0;
constexpr size_t WS_LB = 1 * MiB;
constexpr size_t WS_WINT = 2 * MiB;
constexpr size_t WS_WOUTT = WS_WINT + al((size_t)INW * DM * 2);
constexpr size_t WS_W1T = WS_WOUTT + al((size_t)DM * MIXW * 2);
constexpr size_t WS_W2T = WS_W1T + al((size_t)NE * 2 * FF * DM * 2);
constexpr size_t WS_XN = WS_W2T + al((size_t)NE * DM * FF * 2);
constexpr size_t WS_AQ = WS_XN + al((size_t)T * DM * 2);
constexpr size_t WS_AK = WS_AQ + al((size_t)T * AW * 2);
constexpr size_t WS_AV = WS_AK + al((size_t)T * AKW * 2);
constexpr size_t WS_HQ = WS_AV + al((size_t)T * AKW * 2);
constexpr size_t WS_G = WS_HQ + al((size_t)T * HKW * 2);
constexpr size_t WS_KK = WS_G + al((size_t)T * HKW * 4);
constexpr size_t WS_HI = WS_KK + al((size_t)T * HKW * 2);
constexpr size_t WS_HG = WS_HI + al((size_t)T * HW * 2);
constexpr size_t WS_ATT = WS_HG + al((size_t)T * HW * 2);
constexpr size_t WS_ORAW = WS_ATT + al((size_t)T * AW * 4);
constexpr size_t WS_MIX = WS_ORAW + al((size_t)T * HW * 4);
constexpr size_t WS_X1 = WS_MIX + al((size_t)T * MIXW * 2);
constexpr size_t WS_H2 = WS_X1 + al((size_t)T * DM * 4);
constexpr size_t WS_GATE = WS_H2 + al((size_t)T * DM * 2);
constexpr size_t WS_LIST = WS_GATE + al((size_t)T * TOPK * 4);
constexpr size_t WS_ACT = WS_LIST + al((size_t)NE * T * 4);
constexpr size_t WS_Y = WS_ACT + al((size_t)ACT_ROWS * FF * 2);
constexpr size_t WS_QF = WS_Y + al((size_t)T * TOPK * DM * 2);
constexpr size_t WS_KF = WS_QF + al((size_t)1024 * 16 * 512 * 2);
constexpr size_t WS_VF = WS_KF + al((size_t)1024 * 16 * 512 * 2);
constexpr size_t WS_INTRA = WS_VF + al((size_t)1024 * 16 * 512 * 2);
constexpr size_t WS_DEC = WS_INTRA + al((size_t)T * HW * 2);
constexpr size_t WS_RWF = WS_DEC + al((size_t)1024 * 128 * 4);
constexpr size_t WS_RSTD = WS_RWF + al((size_t)64 * 2 * 512 * 2);
constexpr size_t WS_LRS = WS_RSTD + al((size_t)T * 4);
constexpr size_t WS_LGT = WS_LRS + al((size_t)NE * T * 4);
constexpr size_t WS_END = WS_LGT + al((size_t)NE * T * 4);
static_assert(WS_END <= ((size_t)1 << 30), "workspace map exceeds 1 GiB");
constexpr int CW_CNT = 64;
constexpr int CW_CONV = 2240;

__device__ __forceinline__ bf16_t f2bf(float f) { unsigned u = __builtin_bit_cast(unsigned, f); return (bf16_t)((u + 0x7fffu + ((u >> 16) & 1u)) >> 16); }
__device__ __forceinline__ float bf2f(bf16_t b) { return __builtin_bit_cast(float, (unsigned)b << 16); }
__device__ __forceinline__ float wave_sum(float v) {
#pragma unroll
    for (int o = 1; o < 64; o <<= 1) v += __shfl_xor(v, o);
    return v;
}
__device__ __forceinline__ float wave_max(float v) {
#pragma unroll
    for (int o = 1; o < 64; o <<= 1) v = fmaxf(v, __shfl_xor(v, o));
    return v;
}
__device__ __forceinline__ float sigmoidf_(float x) { return 1.f / (1.f + __expf(-x)); }
__device__ __forceinline__ float siluf_(float x) { return x / (1.f + __expf(-x)); }

#define LAS __attribute__((address_space(3)))
#define GAS __attribute__((address_space(1)))
typedef unsigned u32x4 __attribute__((ext_vector_type(4)));
typedef unsigned u32x2 __attribute__((ext_vector_type(2)));
typedef float f32x2 __attribute__((ext_vector_type(2)));

#ifndef FP8_INPROJ
#define FP8_INPROJ 0
#endif
#ifndef INPROJ_PMAP
#define INPROJ_PMAP 0xA8769435210ull
#endif
#ifndef FP8_OUTPROJ
#define FP8_OUTPROJ 1
#endif
constexpr float FP8_MIX_SCALE = 8.f;
constexpr float FP8_XN_SCALE = 8.f;
namespace pg8 {
constexpr int BM = 256, BK = 64, HALF = 128, HTB = HALF * BK * 2  , STAGE_BYTES = 8 * HTB, NXCD = 8, WGM = 8;
__host__ __device__ __forceinline__ int lds_byte(int r, int c) { const int chunk = c >> 3, f = (r >> 1) & 7; return r * 128 + ((chunk ^ f) << 4) + ((c & 7) << 1); }
__host__ __device__ __forceinline__ void stage_rc(int b, int& R, int& C) { const int r = b >> 7, phys = (b >> 4) & 7, f = (r >> 1) & 7; R = r; C = ((phys ^ f) << 3) + ((b & 15) >> 1); }
__host__ __device__ __forceinline__ int perm32(int rho) { const int n = rho >> 4, i = rho & 15; return 8 * (i >> 2) + 4 * n + (i & 3); }
__device__ __forceinline__ unsigned cvt_pk_bf16(float lo, float hi) { unsigned r; asm volatile("v_cvt_pk_bf16_f32 %0, %1, %2" : "=v"(r) : "v"(lo), "v"(hi)); return r; }

struct Unit { const char* A; const char* B; int pm, pn, e, rows, arow, lbase; };

struct DenseOrder {
    const char* A; const char* Bt; int K, nM, nN, nwg, G, c; unsigned long long pmap;
    __device__ void init(const void* A_, const void* Bt_, int M, int N, int K_, int G_, int c_, int es = 2, unsigned long long pmap_ = 0xFEDCBA9876543210ull) { A = (const char*)A_; Bt = (const char*)Bt_; K = K_ * es; nM = M / BM; nN = N / BM; nwg = nM * nN; G = G_; c = c_; pmap = pmap_; }
    __device__ __forceinline__ bool next(int i, Unit& u) const {
        const long L = (long)i * G + c; if (L >= nwg) return false;
        int wgid = (int)L; { const int q = nwg / NXCD, r = nwg % NXCD, xcd = wgid % NXCD, off = wgid / NXCD; wgid = (xcd < r ? xcd * (q + 1) : r * (q + 1) + (xcd - r) * q) + off; }
        const int nig = WGM * nN, gid = wgid / nig, fm = gid * WGM, gsz = (nM - fm) < WGM ? (nM - fm) : WGM;
        u.pm = fm + ((wgid % nig) % gsz); u.pn = (int)((pmap >> (4 * ((wgid % nig) / gsz))) & 15); u.e = 0; u.rows = BM; u.arow = u.pm * BM; u.lbase = 0;
        u.A = A + (size_t)u.pm * BM * K; u.B = Bt + (size_t)u.pn * BM * K; return true;
    }
    __device__ __forceinline__ int row(const Unit&, int r) const { return r; }
};
template <bool G1, int ES, bool BKN = false>
struct MoeOrder {
    const char* A; const char* Bt; const int* list; LAS const int* pre; LAS const int* cnt; LAS const int* tailE; int K, N, nN, NF, NT, G, c;
    __device__ __forceinline__ bool next(int i, Unit& u) const {
        const int L = i * G + c, X = (G % NXCD == 0) ? NXCD : 1, x = L % X, off = L / X;
        const int NFu = NF * nN, qF = NFu / X, rF = NFu % X, nfx = qF + (x < rF ? 1 : 0);
        int e, mt, slot, rows;
        if (off < nfx) {
            const int fu = x * qF + (x < rF ? x : rF) + off, tau = fu / nN; u.pn = fu % nN;
            const int p = pre[(threadIdx.x & 31) + 1];
            e = __builtin_popcountll(__ballot(p <= tau) & 0xffffffffull); mt = tau - pre[e]; slot = tau; rows = BM;
        } else {
            const int t = off - nfx, j = x + X * (t / nN); u.pn = t % nN;
            if (j >= NT) return false;
            e = tailE[j]; const int ce = cnt[e]; mt = ce >> 8; rows = ce & 255; slot = NF + j;
        }
        u.e = e; u.pm = mt; u.rows = rows; u.arow = slot * BM; u.lbase = e * T + mt * BM;
        u.A = G1 ? A : A + (size_t)u.arow * K * ES;
        u.B = BKN ? Bt + (size_t)e * K * N + (size_t)u.pn * BM : Bt + ((size_t)e * N + (size_t)u.pn * BM) * K * ES; return true;
    }
    __device__ __forceinline__ int row(const Unit& u, int r) const { const int rr = r < u.rows ? r : u.rows - 1; return list[u.lbase + rr] >> 2; }
    __device__ __forceinline__ void prefetch_rows(LAS unsigned char* g, const Unit& u) const {
        const int tid = threadIdx.x, w = __builtin_amdgcn_readfirstlane(tid >> 6), rc = tid < u.rows ? tid : u.rows - 1;
        if (w < 4) __builtin_amdgcn_global_load_lds((const unsigned*)(list + u.lbase + rc), (LAS unsigned*)(g + w * 256), 4, 0, 0);
    }
};

__device__ __forceinline__ u32x4 pack8(f32x4 v0, f32x4 v1) { u32x4 w; w.x = cvt_pk_bf16(v0[0], v0[1]); w.y = cvt_pk_bf16(v0[2], v0[3]); w.z = cvt_pk_bf16(v1[0], v1[1]); w.w = cvt_pk_bf16(v1[2], v1[3]); return w; }
__device__ __forceinline__ f32x4 silu4(f32x4 v) { f32x4 r; for (int i = 0; i < 4; ++i) r[i] = v[i] * __builtin_amdgcn_rcpf(1.f + __expf(-v[i])); return r; }

typedef int v8i32 __attribute__((ext_vector_type(8)));
template <bool SAT = true>
__device__ __forceinline__ u32x2 pack8_fp8(f32x4 v0, f32x4 v1) {
    if (SAT) {
#pragma unroll
        for (int i = 0; i < 4; ++i) { v0[i] = __builtin_amdgcn_fmed3f(v0[i], -448.f, 448.f); v1[i] = __builtin_amdgcn_fmed3f(v1[i], -448.f, 448.f); } }
    int a = 0, b = 0; a = __builtin_amdgcn_cvt_pk_fp8_f32(v0[0], v0[1], a, false); a = __builtin_amdgcn_cvt_pk_fp8_f32(v0[2], v0[3], a, true);
    b = __builtin_amdgcn_cvt_pk_fp8_f32(v1[0], v1[1], b, false); b = __builtin_amdgcn_cvt_pk_fp8_f32(v1[2], v1[3], b, true);
    return (u32x2){(unsigned)a, (unsigned)b};
}
constexpr float FP8_Y_SCALE = 16.f;
constexpr float FP8_ACT_SCALE = 4.f, FP8_W_SCALE = 64.f, FP8_DESCALE = 1.f / (FP8_ACT_SCALE * FP8_W_SCALE);
struct EpiInProj {
    static constexpr bool PERM = true;
    const float* bias; const float* lb; bf16_t *AQ, *AK, *AV, *HQ, *KK, *HI, *HG, *G; float ds;
    __device__ __forceinline__ void prefetch(LAS unsigned char* pf, const Unit& u) const {
        const int tid = threadIdx.x, w = __builtin_amdgcn_readfirstlane(tid >> 6), cb = u.pn * BM;
        const float* src = (w >= 4 && cb >= C_HF && cb < C_HI) ? lb + (cb - C_HF) + (tid - 256) : bias + cb + (tid & 255);
        __builtin_amdgcn_global_load_lds((const unsigned*)src, (LAS unsigned*)(pf + w * 256), 4, 0, 0);
    }
    __device__ __forceinline__ void operator()(const f32x4 (&acc)[2][2][4][2], const Unit& u, int wr, int wc, int fr, int fq, const LAS unsigned char* pf) const {
        const int row0 = u.pm * BM + wr * 64 + fr, cl = wc * 32 + 8 * fq;
        const LAS float* pfl = (const LAS float*)pf;
#pragma unroll
        for (int bj = 0; bj < 2; ++bj) {
            const int cb = u.pn * BM + bj * HALF;
            const f32x4 b0 = *(const LAS f32x4*)(pfl + bj * HALF + cl), b1 = *(const LAS f32x4*)(pfl + bj * HALF + cl + 4);
            if (cb >= C_HF && cb < C_HI) {
                const int cc = cb - C_HF + cl;
                const f32x4 l0 = *(const LAS f32x4*)(pfl + 256 + bj * HALF + cl), l1 = *(const LAS f32x4*)(pfl + 256 + bj * HALF + cl + 4);
#pragma unroll
                for (int ai = 0; ai < 2; ++ai)
#pragma unroll
                    for (int m = 0; m < 4; ++m) {
                        const size_t r = (size_t)(row0 + ai * HALF + m * 16);
                        f32x4 v0 = acc[ai][bj][m][0] * ds + b0, v1 = acc[ai][bj][m][1] * ds + b1, g0, g1, k0, k1;
#pragma unroll
                        for (int i = 0; i < 4; ++i) {
                            const float f0 = l0[i] + (1.f - l0[i]) * __builtin_amdgcn_rcpf(1.f + __expf(-v0[i])); g0[i] = __builtin_amdgcn_logf(f0) * 0.6931471805599453f; k0[i] = 1.f - f0;
                            const float f1 = l1[i] + (1.f - l1[i]) * __builtin_amdgcn_rcpf(1.f + __expf(-v1[i])); g1[i] = __builtin_amdgcn_logf(f1) * 0.6931471805599453f; k1[i] = 1.f - f1;
                        }
                        *(u32x4*)(G + r * HKW + cc) = pack8(g0, g1);
                        *(u32x4*)(KK + r * HKW + cc) = pack8(k0, k1);
                    }
            } else {
                bf16_t* dst; int ld, cc; bool act = false;
                if (cb < C_AK) { dst = AQ; ld = AW; cc = cb - C_AQ; }
                else if (cb < C_AV) { dst = AK; ld = AKW; cc = cb - C_AK; }
                else if (cb < C_HQ) { dst = AV; ld = AKW; cc = cb - C_AV; }
                else if (cb < C_HF) { dst = HQ; ld = HKW; cc = cb - C_HQ; act = true; }
                else if (cb < C_HG) { dst = HI; ld = HW; cc = cb - C_HI; }
                else { dst = HG; ld = HW; cc = cb - C_HG; act = true; }
                cc += cl;
#pragma unroll
                for (int ai = 0; ai < 2; ++ai)
#pragma unroll
                    for (int m = 0; m < 4; ++m) {
                        const size_t r = (size_t)(row0 + ai * HALF + m * 16);
                        f32x4 v0 = acc[ai][bj][m][0] * ds + b0, v1 = acc[ai][bj][m][1] * ds + b1;
                        if (act) { v0 = silu4(v0); v1 = silu4(v1); }
                        *(u32x4*)(dst + r * ld + cc) = pack8(v0, v1);
                    }
            }
        }
    }
};
struct EpiOutProj {
    static constexpr bool PERM = true;
    const float* bias; const float* x; bf16_t* X1; float ds;
    __device__ __forceinline__ void prefetch(LAS unsigned char* pf, const Unit& u) const {
        const int tid = threadIdx.x, w = __builtin_amdgcn_readfirstlane(tid >> 6);
        if (w < 4) __builtin_amdgcn_global_load_lds((const unsigned*)(bias + u.pn * BM + tid), (LAS unsigned*)(pf + w * 256), 4, 0, 0);
    }
    __device__ __forceinline__ void operator()(const f32x4 (&acc)[2][2][4][2], const Unit& u, int wr, int wc, int fr, int fq, const LAS unsigned char* pf) const {
        const int row0 = u.pm * BM + wr * 64 + fr, col0 = u.pn * BM + wc * 32 + 8 * fq;
        const LAS float* pfl = (const LAS float*)pf + wc * 32 + 8 * fq;
        const unsigned eo = (unsigned)(row0 * DM + col0);
        const char* xc = (const char*)x; char* oc = (char*)X1;
#define OP_XLD(k_, bj_, j_) (*(const f32x4*)(xc + (size_t)((eo + (unsigned)((((k_) >> 2) * HALF + ((k_) & 3) * 16) * DM + (bj_) * HALF + 4 * (j_))) * 4u)))
        f32x4 xv[8][2];
#pragma unroll
        for (int k = 0; k < 8; ++k) { xv[k][0] = OP_XLD(k, 0, 0); xv[k][1] = OP_XLD(k, 0, 1); }
        __builtin_amdgcn_sched_barrier(0);
#pragma unroll
        for (int bj = 0; bj < 2; ++bj) {
            const f32x4 b0 = *(const LAS f32x4*)(pfl + bj * HALF), b1 = *(const LAS f32x4*)(pfl + bj * HALF + 4);
#pragma unroll
            for (int k = 0; k < 8; ++k) {
                const f32x4 v0 = acc[k >> 2][bj][k & 3][0] * ds + b0 + xv[k][0], v1 = acc[k >> 2][bj][k & 3][1] * ds + b1 + xv[k][1];
                *(u32x4*)(oc + (size_t)((eo + (unsigned)(((k >> 2) * HALF + (k & 3) * 16) * DM + bj * HALF)) * 2u)) = pack8(v0, v1);
                if (bj == 0) { xv[k][0] = OP_XLD(k, 1, 0); xv[k][1] = OP_XLD(k, 1, 1); } }
        }
#undef OP_XLD
    }
};
struct EpiMoe1 {
    static constexpr bool PERM = true;
    const float* b1; unsigned char* ACT; const float* lrs;
    __device__ __forceinline__ void prefetch(LAS unsigned char* pf, const Unit& u) const {
        const int tid = threadIdx.x, w = __builtin_amdgcn_readfirstlane(tid >> 6), r = tid & 255, rc = r < u.rows ? r : u.rows - 1;
        const float* src = w < 4 ? lrs + u.lbase + rc : b1 + (size_t)u.e * 2 * FF + 2 * (u.pn * HALF) + r;
        __builtin_amdgcn_global_load_lds((const unsigned*)src, (LAS unsigned*)(pf + w * 256), 4, 0, 0);
    }
    __device__ __forceinline__ void operator()(const f32x4 (&acc)[2][2][4][2], const Unit& u, int wr, int wc, int fr, int fq, const LAS unsigned char* pf) const {
        const int ac0 = u.pn * HALF + wc * 32 + 8 * fq;
        const LAS float* pfl = (const LAS float*)pf; const LAS float* bp = pfl + 256 + 2 * (wc * 32 + 8 * fq);
        const f32x4 q0 = *(const LAS f32x4*)bp, q1 = *(const LAS f32x4*)(bp + 4), q2 = *(const LAS f32x4*)(bp + 8), q3 = *(const LAS f32x4*)(bp + 12);
        const f32x4 bg0 = {q0[0], q0[2], q1[0], q1[2]}, bg1 = {q2[0], q2[2], q3[0], q3[2]}, bl0 = {q0[1], q0[3], q1[1], q1[3]}, bl1 = {q2[1], q2[3], q3[1], q3[3]};
        float rss[8];
#pragma unroll
        for (int q = 0; q < 8; ++q) { const int r = (q >> 2) * HALF + wr * 64 + (q & 3) * 16 + fr, rc = r < u.rows ? r : u.rows - 1; rss[q] = pfl[r] * FP8_DESCALE; (void)rc; }
#pragma unroll
        for (int ai = 0; ai < 2; ++ai)
#pragma unroll
            for (int m = 0; m < 4; ++m) {
                const int r = ai * HALF + wr * 64 + m * 16 + fr;
                const float rs = rss[ai * 4 + m];
                const f32x4 g0 = acc[ai][0][m][0] * rs + bg0, g1 = acc[ai][0][m][1] * rs + bg1, l0 = acc[ai][1][m][0] * rs + bl0, l1 = acc[ai][1][m][1] * rs + bl1;
                f32x4 a0, a1, u0, u1, w0, w1, e0, e1;
#pragma unroll
                for (int i = 0; i < 4; ++i) { u0[i] = fminf(g0[i], 7.f); u1[i] = fminf(g1[i], 7.f); w0[i] = __builtin_amdgcn_fmed3f(l0[i], -7.f, 7.f); w1[i] = __builtin_amdgcn_fmed3f(l1[i], -7.f, 7.f); }
                const f32x4 t0 = u0 * (-1.702f * 1.4426950408889634f), t1 = u1 * (-1.702f * 1.4426950408889634f);
#pragma unroll
                for (int i = 0; i < 4; ++i) { e0[i] = __builtin_amdgcn_exp2f(t0[i]); e1[i] = __builtin_amdgcn_exp2f(t1[i]); }
                const f32x4 d0 = e0 + 1.f, d1 = e1 + 1.f;
#pragma unroll
                for (int i = 0; i < 4; ++i) { e0[i] = __builtin_amdgcn_rcpf(d0[i]); e1[i] = __builtin_amdgcn_rcpf(d1[i]); }
                a0 = (u0 * e0) * (w0 * FP8_ACT_SCALE + FP8_ACT_SCALE); a1 = (u1 * e1) * (w1 * FP8_ACT_SCALE + FP8_ACT_SCALE);
                if (r < u.rows) *(u32x2*)(ACT + (size_t)(u.arow + r) * FF + ac0) = pack8_fp8<false>(a0, a1);
            }
    }
};
struct EpiMoe2 {
    static constexpr bool PERM = true;
    const float* b2; const int* list; const float* lgt; unsigned char* Y;
    __device__ __forceinline__ void prefetch(LAS unsigned char* pf, const Unit& u) const {
        const int tid = threadIdx.x, w = __builtin_amdgcn_readfirstlane(tid >> 6), r = tid & 255, rc = r < u.rows ? r : u.rows - 1;
        const void* src = w < 4 ? (const void*)(list + u.lbase + rc) : (const void*)(lgt + u.lbase + rc);
        __builtin_amdgcn_global_load_lds((const unsigned*)src, (LAS unsigned*)(pf + w * 256), 4, 0, 0);
        if (w < 4) __builtin_amdgcn_global_load_lds((const unsigned*)(b2 + (size_t)u.e * DM + u.pn * BM + r), (LAS unsigned*)(pf + 2048 + w * 256), 4, 0, 0);
    }
    __device__ __forceinline__ void operator()(const f32x4 (&acc)[2][2][4][2], const Unit& u, int wr, int wc, int fr, int fq, const LAS unsigned char* pf) const {
        const int c0 = u.pn * BM + wc * 64 + 16 * fq;
        const LAS float* pfl = (const LAS float*)pf;
        f32x4 bv[4];
#pragma unroll
        for (int q = 0; q < 4; ++q) bv[q] = *(const LAS f32x4*)(pfl + 512 + wc * 64 + 16 * fq + 4 * q);
        int slots[8]; float gts[8];
#pragma unroll
        for (int q = 0; q < 8; ++q) { const int r = (q >> 2) * HALF + wr * 64 + (q & 3) * 16 + fr, rc = r < u.rows ? r : u.rows - 1; slots[q] = ((const LAS int*)pf)[r]; gts[q] = pfl[256 + r]; (void)rc; }
#pragma unroll
        for (int ai = 0; ai < 2; ++ai)
#pragma unroll
            for (int m = 0; m < 4; ++m) {
                const int r = ai * HALF + wr * 64 + m * 16 + fr;
                if (r < u.rows) {
                    const int slot = slots[ai * 4 + m]; const float gt = gts[ai * 4 + m];
                    const u32x2 lo = pack8_fp8((acc[ai][0][m][0] * FP8_DESCALE + bv[0]) * (gt * FP8_Y_SCALE), (acc[ai][0][m][1] * FP8_DESCALE + bv[1]) * (gt * FP8_Y_SCALE));
                    const u32x2 hi = pack8_fp8((acc[ai][1][m][0] * FP8_DESCALE + bv[2]) * (gt * FP8_Y_SCALE), (acc[ai][1][m][1] * FP8_DESCALE + bv[3]) * (gt * FP8_Y_SCALE));
                    *(u32x4*)(Y + (size_t)slot * DM + c0) = (u32x4){lo.x, lo.y, hi.x, hi.y};
                }
            }
    }
};

template <class Epi, class Sched, bool GATHER, bool ALIGN_EPI, int ES = 2, int VAR = 0, bool BKN = false>
__device__ __forceinline__ void gemm_phase(LAS unsigned char* lds, const int K, const Sched& S, const Epi& E, const int DRY_FLAG = 0) {
    const int tid = threadIdx.x, wid = __builtin_amdgcn_readfirstlane(tid >> 6), lane = tid & 63, wr = wid >> 2, wc = wid & 3, fr = lane & 15, fq = lane >> 4;
    int nt = K * ES / (BK * 2); asm volatile("" : "+s"(nt));
    u32x2 voffB;
#pragma unroll
    for (int i = 0; i < 2; ++i) { int R, C; stage_rc(tid * 16 + i * 8192, R, C); const int Rb = Epi::PERM ? ((R & ~31) + perm32(R & 31)) : R; voffB[i] = (unsigned)(Rb * K * ES + C * 2);
        if constexpr (BKN) { const int b = tid * 16 + i * 8192, row = b >> 7, phys = (b >> 4) & 7, f = ((row >> 1) & 3) | (((row >> 4) & 1) << 2); voffB[i] = (unsigned)(row * S.N + ((phys ^ f) << 4)); } }
    const size_t kstep = (size_t)(BK * 2);
    size_t kstepB = kstep; if constexpr (BKN) kstepB = (size_t)128 * S.N;
    const size_t hstep = BKN ? (size_t)HALF : (size_t)HALF * K * ES;
    const unsigned ldsw = (unsigned)wid * 1024u;
    const int aoff = lds_byte(wr * 64 + fr, fq * 8), boff = lds_byte(wc * 32 + fr, fq * 8);
    const int aoff1 = lds_byte(wr * 64 + fr, fq * 8 + 32), boff1 = lds_byte(wc * 32 + fr, fq * 8 + 32);
    typedef int v2i32_t __attribute__((ext_vector_type(2)));
    int btr[2];
#pragma unroll
    for (int n = 0; n < 2; ++n) { const int fB = ((fr >> 2) & 3) | ((fq & 1) << 2); btr[n] = (16 * fq + (fr >> 1)) * 128 + ((((2 * wc + n) ^ fB)) << 4) + 8 * (fr & 1); }
#define PG8_SA(b, h) (((b) * 2 + (h)) * HTB)
#define PG8_SB(b, h) ((4 + (b) * 2 + (h)) * HTB)
#define PG8_STAGE(bufoff, gbase, voff) do { if constexpr (VAR < 2) _Pragma("unroll") for (int _i = 0; _i < 2; ++_i) \
        __builtin_amdgcn_global_load_lds((const unsigned*)((const char*)(gbase) + (voff)[_i]), (LAS unsigned*)(lds + (bufoff) + ldsw + _i * 8192), 16, 0, 0); } while (0)
#define PG8_LD8(dst, off, off1) do { if constexpr (VAR == 3) { asm volatile("" : "+v"(dst)); break; } const u32x4 lo_ = *(const LAS u32x4*)(lds + (off)), hi_ = *(const LAS u32x4*)(lds + (off1)); \
        dst = (v8i32){(int)lo_.x, (int)lo_.y, (int)lo_.z, (int)lo_.w, (int)hi_.x, (int)hi_.y, (int)hi_.z, (int)hi_.w}; } while (0)
#define PG8_LDA(dst, b, h) do { _Pragma("unroll") for (int m = 0; m < 4; ++m) PG8_LD8(dst[m], PG8_SA(b, h) + aoff + m * 2048, PG8_SA(b, h) + aoff1 + m * 2048); } while (0)
#define PG8_TR8(off) __builtin_amdgcn_ds_read_tr8_b64_v2i32((LAS v2i32_t*)(lds + (off)))
#define PG8_LDB(dst, b, h) do { if constexpr (BKN) { _Pragma("unroll") for (int n = 0; n < 2; ++n) { int o_ = btr[n]; asm volatile("" : "+v"(o_)); o_ += PG8_SB(b, h);     \
            const v2i32_t t0_ = PG8_TR8(o_), t1_ = PG8_TR8(o_ + 1024), t2_ = PG8_TR8(o_ + 8192), t3_ = PG8_TR8(o_ + 9216);        \
            dst[n] = (v8i32){t0_[0], t0_[1], t1_[0], t1_[1], t2_[0], t2_[1], t3_[0], t3_[1]}; } } \
        else { _Pragma("unroll") for (int n = 0; n < 2; ++n) PG8_LD8(dst[n], PG8_SB(b, h) + boff + n * 2048, PG8_SB(b, h) + boff1 + n * 2048); } } while (0)
#define PG8_LO(x) __builtin_bit_cast(bf16x8, __builtin_shufflevector(x, x, 0, 1, 2, 3))
#define PG8_HI(x) __builtin_bit_cast(bf16x8, __builtin_shufflevector(x, x, 4, 5, 6, 7))
#define PG8_MMA(ai, bj, At, Bt) do { if constexpr (VAR == 1) { _Pragma("unroll") for (int m = 0; m < 4; ++m) asm volatile("" :: "v"(At[m])); _Pragma("unroll") for (int n = 0; n < 2; ++n) asm volatile("" :: "v"(Bt[n])); break; } __builtin_amdgcn_s_setprio(1); _Pragma("unroll") for (int m = 0; m < 4; ++m) _Pragma("unroll") for (int n = 0; n < 2; ++n) { \
        if constexpr (ES == 2) { acc[ai][bj][m][n] = __builtin_amdgcn_mfma_f32_16x16x32_bf16(PG8_LO(Bt[n]), PG8_LO(At[m]), acc[ai][bj][m][n], 0, 0, 0); \
                                 acc[ai][bj][m][n] = __builtin_amdgcn_mfma_f32_16x16x32_bf16(PG8_HI(Bt[n]), PG8_HI(At[m]), acc[ai][bj][m][n], 0, 0, 0); } \
        else asm volatile("v_mfma_scale_f32_16x16x128_f8f6f4 %0, %1, %2, %0, %3, %3 op_sel_hi:[0,0,0]" : "+v"(acc[ai][bj][m][n]) : "v"(Bt[n]), "v"(At[m]), "v"(unit_scale)); } \
          \
        __builtin_amdgcn_s_setprio(0); } while (0)
#define PG8_WAIT_V(n) asm volatile("s_waitcnt vmcnt(" #n ")" ::: "memory")
#define PG8_WAIT_L(n) asm volatile("s_waitcnt lgkmcnt(" #n ")" ::: "memory")
#define PG8_BAR __builtin_amdgcn_s_barrier()
#define PG8_SCHED __builtin_amdgcn_sched_barrier(0)
#define PG8_VOFFA(d0, d1, u) do { int _t = tid; if (GATHER) asm volatile("" : "+v"(_t));     \
        _Pragma("unroll") for (int _i = 0; _i < 2; ++_i) { int _R, _C; stage_rc(_t * 16 + _i * 8192, _R, _C); _Pragma("unroll") for (int _h = 0; _h < 2; ++_h) { const int _r = _h * HALF + _R; \
        const unsigned _row = GATHER ? (unsigned)S.row(u, _r) : (unsigned)_r; const unsigned _v = _row * (unsigned)(K * ES) + (unsigned)_C * 2u; if (_h == 0) d0[_i] = _v; else d1[_i] = _v; } } } while (0)
    Unit cur, nxt; int ui = 0;
    if (!S.next(0, cur)) return;
    f32x4 acc[2][2][4][2];
#pragma unroll
    for (int a = 0; a < 2; ++a)
#pragma unroll
        for (int b = 0; b < 2; ++b)
#pragma unroll
            for (int m = 0; m < 4; ++m)
#pragma unroll
                for (int n = 0; n < 2; ++n) acc[a][b][m][n] = (f32x4){0.f, 0.f, 0.f, 0.f};
    v8i32 At[4], B0[2], B1[2];
    const int unit_scale = 0x7F7F7F7F;
    constexpr bool GATHER_TAIL_SKIP = (ES == 1);
    u32x2 vA0, vA1, nvA0, nvA1;
    PG8_VOFFA(vA0, vA1, cur);
    const char* cA = cur.A; const char* cB = cur.B;
    constexpr int PF_BYTES = 3072;
    E.prefetch(lds + STAGE_BYTES, cur);
    PG8_STAGE(PG8_SB(0, 0), cB, voffB); PG8_STAGE(PG8_SB(0, 1), cB + hstep, voffB); PG8_STAGE(PG8_SA(0, 0), cA, vA0); PG8_STAGE(PG8_SA(0, 1), cA, vA1);
    if (wr == 1) PG8_BAR;
    PG8_WAIT_V(2); PG8_BAR;
    PG8_STAGE(PG8_SB(1, 0), cB + kstepB, voffB); PG8_STAGE(PG8_SA(1, 0), cA + kstep, vA0); PG8_STAGE(PG8_SB(1, 1), cB + hstep + kstepB, voffB);
    PG8_WAIT_V(6); PG8_BAR;
    for (;;) {
        const bool has_next = S.next(ui + 1, nxt);
        const char* nA = has_next ? nxt.A : cA; const char* nB = has_next ? nxt.B : cB;
        if constexpr (GATHER) { nvA0 = vA0; nvA1 = vA1; if (has_next) S.prefetch_rows(lds + STAGE_BYTES + ((ui + 1) & 1) * PF_BYTES + 2048, nxt); }
        else { if (has_next) { PG8_VOFFA(nvA0, nvA1, nxt); } else { nvA0 = vA0; nvA1 = vA1; } }
#pragma unroll 1
        for (int t = 0; t < nt; t += 2) {
            const bool last = (t == nt - 2);
            const char* a1 = cA + (size_t)(t + 1) * kstep;
            const char* a2 = last ? nA : cA + (size_t)(t + 2) * kstep; const char* b2 = last ? nB : cB + (size_t)(t + 2) * kstepB;
            const char* a3 = a2 + kstep; const char* b3 = b2 + kstepB;
            if constexpr (GATHER) { if (last && has_next) {
                const LAS int* g_ = (const LAS int*)(lds + STAGE_BYTES + ((ui + 1) & 1) * PF_BYTES + 2048); int _t = tid; asm volatile("" : "+v"(_t));
#pragma unroll
                for (int _i = 0; _i < 2; ++_i) { int _R, _C; stage_rc(_t * 16 + _i * 8192, _R, _C);
                    nvA0[_i] = (unsigned)(g_[_R] >> 2) * (unsigned)(K * ES) + (unsigned)_C * 2u; nvA1[_i] = (unsigned)(g_[HALF + _R] >> 2) * (unsigned)(K * ES) + (unsigned)_C * 2u; } } }
            const u32x2 s0 = last ? nvA0 : vA0, s1 = last ? nvA1 : vA1;
            PG8_LDB(B0, 0, 0); PG8_LDB(B1, 0, 1); PG8_SCHED; PG8_LDA(At, 0, 0); PG8_STAGE(PG8_SA(1, 1), a1, vA1);
            PG8_WAIT_V(8); PG8_WAIT_L(0); PG8_BAR; PG8_MMA(0, 0, At, B0); PG8_MMA(0, 1, At, B1); PG8_BAR; PG8_SCHED;
            PG8_LDA(At, 0, 1); PG8_STAGE(PG8_SB(0, 0), b2, voffB); PG8_STAGE(PG8_SB(0, 1), b2 + hstep, voffB); PG8_STAGE(PG8_SA(0, 0), a2, s0);
            PG8_WAIT_V(8); PG8_WAIT_L(0); PG8_BAR; if (!GATHER_TAIL_SKIP || cur.rows > HALF) { PG8_MMA(1, 0, At, B0); PG8_MMA(1, 1, At, B1); } PG8_BAR; PG8_SCHED;
            PG8_LDB(B0, 1, 0); PG8_LDB(B1, 1, 1); PG8_SCHED; PG8_LDA(At, 1, 0); PG8_STAGE(PG8_SA(0, 1), a2, s1);
            PG8_WAIT_V(8); PG8_WAIT_L(0); PG8_BAR; PG8_MMA(0, 0, At, B0); PG8_MMA(0, 1, At, B1); PG8_BAR; PG8_SCHED;
            PG8_LDA(At, 1, 1); PG8_STAGE(PG8_SB(1, 0), b3, voffB); PG8_STAGE(PG8_SB(1, 1), b3 + hstep, voffB); PG8_STAGE(PG8_SA(1, 0), a3, s0);
            PG8_WAIT_V(8); PG8_WAIT_L(0); PG8_BAR; if (!GATHER_TAIL_SKIP || cur.rows > HALF) { PG8_MMA(1, 0, At, B0); PG8_MMA(1, 1, At, B1); } PG8_BAR; PG8_SCHED;
        }
        if constexpr (ALIGN_EPI) { if (wr == 0) PG8_BAR; }
        if constexpr (ES == 1) asm volatile("s_nop 15\n\ts_nop 7" ::: "memory");
        if (!DRY_FLAG) { int l2 = lane; asm volatile("" : "+v"(l2)); E(acc, cur, wr, wc, l2 & 15, l2 >> 4, lds + STAGE_BYTES + (ui & 1) * PF_BYTES); }
        if (!has_next) break;
#pragma unroll
        for (int a = 0; a < 2; ++a)
#pragma unroll
            for (int b = 0; b < 2; ++b)
#pragma unroll
                for (int m = 0; m < 4; ++m)
#pragma unroll
                    for (int n = 0; n < 2; ++n) acc[a][b][m][n] = (f32x4){0.f, 0.f, 0.f, 0.f};
        cur = nxt; cA = nA; cB = nB; ++ui; vA0 = nvA0; vA1 = nvA1;
        E.prefetch(lds + STAGE_BYTES + (ui & 1) * PF_BYTES, cur);
        if constexpr (ALIGN_EPI) { if (wr == 1) PG8_BAR; }
    }
    PG8_WAIT_V(0);
    if constexpr (!ALIGN_EPI) { if (wr == 0) PG8_BAR; }
    PG8_BAR;
#undef PG8_SA
#undef PG8_SB
#undef PG8_STAGE
#undef PG8_LDA
#undef PG8_LDB
#undef PG8_MMA
#undef PG8_LD8
#undef PG8_TR8
#undef PG8_LO
#undef PG8_HI
#undef PG8_WAIT_V
#undef PG8_WAIT_L
#undef PG8_BAR
#undef PG8_SCHED
#undef PG8_VOFFA
}
}

constexpr int NWAVES = 8;
constexpr int RING_OFF = 0, RING_BYTES = 139264;
constexpr int LDSCTL_OFF = RING_BYTES, MISC_OFF = LDSCTL_OFF + 320;
constexpr int MOE_OFF = LDSCTL_OFF + 1024;
constexpr int LDS_BYTES = RING_BYTES + 16384;
constexpr int CW_TMO = 0, CW_CODE = 1, CW_BAR = 4096;
constexpr int N_PHASES = 10;

typedef GAS unsigned gu32;
#define RLX_AGENT __ATOMIC_RELAXED, __HIP_MEMORY_SCOPE_AGENT
#define LDS_WAIT() asm volatile("s_waitcnt lgkmcnt(0)" ::: "memory")
#define VM_WAIT() asm volatile("s_waitcnt vmcnt(0)" ::: "memory")

#define XB_TMO      128
#define XB_XCNT(j)  (256  + 64 * (j))
#define XB_XSUB(j)  (1280 + 64 * (j))
#define XB_XGEN(j)  (2304 + 64 * (j))
#define XB_TOP      3328
#define XB_TOPGEN   3392
#define XCD_BAR_WORDS 3456
#define XB_SPIN_CAP (1u << 18)
__device__ __forceinline__ unsigned xb_ld(unsigned* p)              { return __hip_atomic_load(p, __ATOMIC_RELAXED, __HIP_MEMORY_SCOPE_AGENT); }
__device__ __forceinline__ unsigned xb_add(unsigned* p, unsigned v) { return __hip_atomic_fetch_add(p, v, __ATOMIC_RELAXED, __HIP_MEMORY_SCOPE_AGENT); }
__device__ __forceinline__ unsigned xb_xcc_id() { return (unsigned)__builtin_amdgcn_s_getreg((3 << 11) | 20) & 0xFu; }
#define XB_SPIN(cond, bar) do { unsigned _sp = 0; while (cond) { __builtin_amdgcn_s_sleep(1); \
    if ((++_sp & 255u) == 0u) { if (xb_ld(&(bar)[XB_TMO])) break; if (_sp > XB_SPIN_CAP) { atomicAdd(&(bar)[XB_TMO], 1u); break; } } } } while (0)
struct XcdBarrier { unsigned* bar; unsigned x; volatile LAS unsigned* st; };
__device__ __forceinline__ XcdBarrier xcd_barrier_post(unsigned* bar, volatile LAS unsigned* st) {
    XcdBarrier b; b.bar = bar; b.x = xb_xcc_id(); b.st = st;
    if (threadIdx.x == 0) (void)xb_add(&bar[XB_XCNT(b.x)], 1u);
    return b;
}
__device__ __forceinline__ void xcd_barrier_complete(unsigned* bar, unsigned x, unsigned& nloc, unsigned& nx) {
    const unsigned G = gridDim.x * gridDim.y * gridDim.z;
    unsigned sum, cnt, mine, sp = 0u;
    for (;;) {
        sum = 0u; cnt = 0u; mine = 0u;
#pragma unroll
        for (unsigned j = 0; j < 16; ++j) { const unsigned c = xb_ld(&bar[XB_XCNT(j)]); sum += c; cnt += (c > 0u) ? 1u : 0u; mine = (j == x) ? c : mine; }
        if (sum == G) break;
        __builtin_amdgcn_s_sleep(1);
        if ((++sp & 255u) == 0u) { if (xb_ld(&bar[XB_TMO])) break; if (sp > XB_SPIN_CAP) { atomicAdd(&bar[XB_TMO], 1u); break; } }
    }
    nloc = mine > 0u ? mine : 1u; nx = cnt > 0u ? cnt : 1u;
}
__device__ __forceinline__ void xcd_barrier(const XcdBarrier& b) {
    asm volatile("s_waitcnt vmcnt(0)" ::: "memory");
    __syncthreads();
    if (threadIdx.x == 0) {
        unsigned* bar = b.bar;
        __builtin_amdgcn_s_waitcnt(0);
        unsigned nloc = b.st[0], nx = b.st[1];
        if (nloc == 0u) { xcd_barrier_complete(bar, b.x, nloc, nx); b.st[0] = nloc; b.st[1] = nx; }
        const unsigned old = xb_add(&bar[XB_XSUB(b.x)], 1u);
        const unsigned gen = old / nloc;
        if (old + 1u == (gen + 1u) * nloc) {
            __builtin_amdgcn_fence(__ATOMIC_RELEASE, "agent");
            asm volatile("s_waitcnt vmcnt(0)" ::: "memory");
            const unsigned og = xb_add(&bar[XB_TOP], 1u);
            const unsigned tg = og / nx;
            if (og + 1u == (tg + 1u) * nx) xb_add(&bar[XB_TOPGEN], 1u);
            else XB_SPIN(xb_ld(&bar[XB_TOPGEN]) == tg, bar);
            __builtin_amdgcn_fence(__ATOMIC_ACQUIRE, "agent");
            xb_add(&bar[XB_XGEN(b.x)], 1u);
            asm volatile("s_waitcnt vmcnt(0)" ::: "memory");
        } else {
            XB_SPIN(xb_ld(&bar[XB_XGEN(b.x)]) == gen, bar);
            __builtin_amdgcn_fence(__ATOMIC_ACQUIRE, "agent");
            asm volatile("s_waitcnt vmcnt(0)" ::: "memory");
        }
    }
    __syncthreads();
}

struct Frame {
    LAS unsigned char* lds; volatile LAS unsigned* MISC; gu32* ctl;
    int tid, lane, wave, vcu, G, probe;
    const float *x, *norm1_g, *w_in, *b_in, *sinks, *attn_g, *lb_logits, *hgrn_g, *w_out, *b_out, *norm2_g, *router_w, *router_b, *w1, *b1, *w2, *b2, *final_g;
    float* out; unsigned char* ws;
};
#define WSP(type, off) ((type*)(F.ws + (off)))

#ifdef TS_A
#ifndef TS_BLK
#define TS_BLK 0
#endif
#define RSTAMP(k) do { if (blockIdx.x == TS_BLK && F.tid == 0) ((volatile LAS unsigned long long*)(F.lds + LDSCTL_OFF + 2048))[k] = __builtin_amdgcn_s_memrealtime(); } while (0)
#else
#define RSTAMP(k) do { } while (0)
#endif
typedef float f32x16 __attribute__((ext_vector_type(16)));
typedef __bf16 bf16x2_t __attribute__((ext_vector_type(2)));
__device__ __forceinline__ unsigned cvtpk(float lo, float hi) { f32x2 v = {lo, hi}; bf16x2_t b = __builtin_convertvector(v, bf16x2_t); return __builtin_bit_cast(unsigned, b); }
__device__ __forceinline__ int crow(int reg, int h) { return (reg & 3) + 8 * (reg >> 2) + 4 * h; }
__device__ __forceinline__ float bflo(unsigned u) { return __builtin_bit_cast(float, u << 16); }
__device__ __forceinline__ float bfhi(unsigned u) { return __builtin_bit_cast(float, u & 0xffff0000u); }
__device__ __forceinline__ bf16x8 pack_step(const f32x16& x, int s) {
    u32x4 p; p.x = cvtpk(x[8 * s], x[8 * s + 1]); p.y = cvtpk(x[8 * s + 2], x[8 * s + 3]); p.z = cvtpk(x[8 * s + 4], x[8 * s + 5]); p.w = cvtpk(x[8 * s + 6], x[8 * s + 7]);
    return __builtin_bit_cast(bf16x8, p);
}
#define MFMA32(a, b, c) __builtin_amdgcn_mfma_f32_32x32x16_bf16((a), (b), (c), 0, 0, 0)
#define MFMA16(a, b, c) __builtin_amdgcn_mfma_f32_16x16x32_bf16((a), (b), (c), 0, 0, 0)

__device__ __forceinline__ void p_hgrn_prep(Frame& F) {
    constexpr int GP = 132, QP = 136, VP = 72, AP = 72;
    LAS float* Gs = (LAS float*)F.lds;
    LAS bf16_t* Qs = (LAS bf16_t*)(F.lds + 33792);
    LAS bf16_t* Ks = (LAS bf16_t*)(F.lds + 33792 + 17408);
    LAS bf16_t* Vt = (LAS bf16_t*)(F.lds + 33792 + 2 * 17408);
    LAS bf16_t* At = (LAS bf16_t*)(F.lds + 33792 + 2 * 17408 + 18432);
    LAS float* Tot = (LAS float*)(F.lds + 96256);
    LAS float* Bl = Tot + 8 * 128;
    const bf16_t* HQ = WSP(bf16_t, WS_HQ); const bf16_t* G = WSP(bf16_t, WS_G); const bf16_t* KK = WSP(bf16_t, WS_KK); const bf16_t* HI = WSP(bf16_t, WS_HI);
    bf16_t* QF = WSP(bf16_t, WS_QF); bf16_t* KF = WSP(bf16_t, WS_KF); bf16_t* VF = WSP(bf16_t, WS_VF); bf16_t* INTRA = WSP(bf16_t, WS_INTRA); float* DEC = WSP(float, WS_DEC);
    const int tid = F.tid, lane = F.lane, w = F.wave, r = lane & 31, h = lane >> 5, fr = lane & 15, fq = lane >> 4;
    u32x4 pg[2], pq[2], pk[2], pv[2];
#define HP_LOAD(ch_) do { const int bh_ = (ch_) >> 5, c_ = (ch_) & 31; const size_t t0_ = (size_t)(bh_ >> 2) * SEQ + 64 * c_; const int col0_ = (bh_ & 3) * 128; \
        _Pragma("unroll") for (int i = 0; i < 2; ++i) { const int idx = tid + 512 * i, row = idx >> 4, c8 = idx & 15; const size_t go = (t0_ + row) * HKW + col0_ + 8 * c8; \
            pg[i] = *(const u32x4*)(G + go); pq[i] = *(const u32x4*)(HQ + go); pk[i] = *(const u32x4*)(KK + go); pv[i] = *(const u32x4*)(HI + go); } } while (0)
    if ((int)blockIdx.x < BATCH * 4 * 32) HP_LOAD((int)blockIdx.x);
    for (int ch = blockIdx.x; ch < BATCH * 4 * 32; ch += F.G) {
        const int bh = ch >> 5, c = ch & 31, b = bh >> 2, hd = bh & 3;
        const size_t t0 = (size_t)b * SEQ + 64 * c; const int col0 = hd * 128;
#pragma unroll
        for (int i = 0; i < 2; ++i) { const int idx = tid + 512 * i, row = idx >> 4, c8 = idx & 15;
            *(LAS u32x4*)(Qs + row * QP + 8 * c8) = pq[i]; *(LAS u32x4*)(Ks + row * QP + 8 * c8) = pk[i];
            *(LAS f32x4*)(Gs + row * GP + 8 * c8) = (f32x4){bflo(pg[i].x), bfhi(pg[i].x), bflo(pg[i].y), bfhi(pg[i].y)}; *(LAS f32x4*)(Gs + row * GP + 8 * c8 + 4) = (f32x4){bflo(pg[i].z), bfhi(pg[i].z), bflo(pg[i].w), bfhi(pg[i].w)};
            const u32x4 vv = pv[i];
#pragma unroll
            for (int q = 0; q < 4; ++q) { Vt[(8 * c8 + 2 * q) * VP + row] = (bf16_t)(vv[q] & 0xffffu); Vt[(8 * c8 + 2 * q + 1) * VP + row] = (bf16_t)(vv[q] >> 16); } }
        if (ch + F.G < BATCH * 4 * 32) HP_LOAD(ch + F.G);
        for (int i = tid; i < 64 * AP / 8; i += 512) *(LAS u32x4*)(At + 8 * i) = (u32x4){0u, 0u, 0u, 0u};
        __syncthreads();
#pragma unroll
        for (int q = 0; q < 2; ++q) { const int kk = lane + 64 * q; float run = 0.f;
#pragma unroll
            for (int i = 0; i < 8; ++i) { run += Gs[(8 * w + i) * GP + kk]; Gs[(8 * w + i) * GP + kk] = run; }
            Tot[w * 128 + kk] = run; }
        __syncthreads();
#pragma unroll
        for (int q = 0; q < 2; ++q) { const int kk = lane + 64 * q; float off = 0.f, tot = 0.f;
#pragma unroll
            for (int i = 0; i < 8; ++i) { const float tv = Tot[i * 128 + kk]; tot += tv; if (i < w) off += tv; }
#pragma unroll
            for (int i = 0; i < 8; ++i) Gs[(8 * w + i) * GP + kk] += off;
            if (w == 0) Bl[kk] = tot; }
        __syncthreads();
#pragma unroll
        for (int q = 0; q < 2; ++q) {
            const int f = w + 8 * q;
            {
                const int tt = f >> 3, kt = (f >> 1) & 3, ks = f & 1, t = 32 * tt + r, kb = 32 * kt + 16 * ks + 4 * h;
                const u32x2 qa = *(const LAS u32x2*)(Qs + t * QP + kb), qb = *(const LAS u32x2*)(Qs + t * QP + kb + 8);
                const f32x4 ba = *(const LAS f32x4*)(Gs + t * GP + kb), bb = *(const LAS f32x4*)(Gs + t * GP + kb + 8);
                u32x4 o; o.x = cvtpk(bflo(qa.x) * __expf(ba[0]), bfhi(qa.x) * __expf(ba[1])); o.y = cvtpk(bflo(qa.y) * __expf(ba[2]), bfhi(qa.y) * __expf(ba[3]));
                o.z = cvtpk(bflo(qb.x) * __expf(bb[0]), bfhi(qb.x) * __expf(bb[1])); o.w = cvtpk(bflo(qb.y) * __expf(bb[2]), bfhi(qb.y) * __expf(bb[3]));
                *(u32x4*)(QF + (((size_t)ch * 16 + f) * 64 + lane) * 8) = o;
            }
            {
                const int kt = f >> 2, ss = f & 3, kc = 32 * kt + r, s0 = 16 * ss + 8 * h; const float bl = Bl[kc];
                float v[8];
#pragma unroll
                for (int j = 0; j < 8; ++j) v[j] = bf2f(Ks[(s0 + j) * QP + kc]) * __expf(bl - Gs[(s0 + j) * GP + kc]);
                u32x4 o; o.x = cvtpk(v[0], v[1]); o.y = cvtpk(v[2], v[3]); o.z = cvtpk(v[4], v[5]); o.w = cvtpk(v[6], v[7]);
                *(u32x4*)(KF + (((size_t)ch * 16 + f) * 64 + lane) * 8) = o;
            }
            {
                const int ss = f >> 2, dt = f & 3;
                *(u32x4*)(VF + (((size_t)ch * 16 + f) * 64 + lane) * 8) = *(const LAS u32x4*)(Vt + (32 * dt + r) * VP + 16 * ss + 8 * h);
            }
        }
        if (tid < 128) DEC[(size_t)ch * 128 + tid] = __expf(Bl[tid]);
        {
            const int i = w >> 1;
            for (int j = w & 1; j <= i; j += 2) {
                f32x4 acc = {0.f, 0.f, 0.f, 0.f};
                const int t = 16 * i + fr, s = 16 * j + fr;
#pragma unroll
                for (int k4 = 0; k4 < 4; ++k4) {
                    const int k0 = 32 * k4 + 8 * fq;
                    f32x4 r0 = {0.f, 0.f, 0.f, 0.f}, r1 = {0.f, 0.f, 0.f, 0.f};
                    if (i > 0) { r0 = *(const LAS f32x4*)(Gs + (16 * i - 1) * GP + k0); r1 = *(const LAS f32x4*)(Gs + (16 * i - 1) * GP + k0 + 4); }
                    const u32x4 q8 = *(const LAS u32x4*)(Qs + t * QP + k0), k8 = *(const LAS u32x4*)(Ks + s * QP + k0);
                    const f32x4 bt0 = *(const LAS f32x4*)(Gs + t * GP + k0), bt1 = *(const LAS f32x4*)(Gs + t * GP + k0 + 4);
                    const f32x4 bs0 = *(const LAS f32x4*)(Gs + s * GP + k0), bs1 = *(const LAS f32x4*)(Gs + s * GP + k0 + 4);
                    u32x4 a, bb;
                    a.x = cvtpk(bflo(q8.x) * __expf(bt0[0] - r0[0]), bfhi(q8.x) * __expf(bt0[1] - r0[1])); a.y = cvtpk(bflo(q8.y) * __expf(bt0[2] - r0[2]), bfhi(q8.y) * __expf(bt0[3] - r0[3]));
                    a.z = cvtpk(bflo(q8.z) * __expf(bt1[0] - r1[0]), bfhi(q8.z) * __expf(bt1[1] - r1[1])); a.w = cvtpk(bflo(q8.w) * __expf(bt1[2] - r1[2]), bfhi(q8.w) * __expf(bt1[3] - r1[3]));
                    bb.x = cvtpk(bflo(k8.x) * __expf(r0[0] - bs0[0]), bfhi(k8.x) * __expf(r0[1] - bs0[1])); bb.y = cvtpk(bflo(k8.y) * __expf(r0[2] - bs0[2]), bfhi(k8.y) * __expf(r0[3] - bs0[3]));
                    bb.z = cvtpk(bflo(k8.z) * __expf(r1[0] - bs1[0]), bfhi(k8.z) * __expf(r1[1] - bs1[1])); bb.w = cvtpk(bflo(k8.w) * __expf(r1[2] - bs1[2]), bfhi(k8.w) * __expf(r1[3] - bs1[3]));
                    acc = MFMA16(__builtin_bit_cast(bf16x8, a), __builtin_bit_cast(bf16x8, bb), acc);
                }
#pragma unroll
                for (int q = 0; q < 4; ++q) { const float v = (j < i || (4 * fq + q) >= fr) ? acc[q] : 0.f; At[(16 * i + 4 * fq + q) * AP + 16 * j + fr] = f2bf(v); }
            }
        }
        __syncthreads();
        {
            const int tt = w & 1, dt = w >> 1;
            f32x16 acc;
#pragma unroll
            for (int q = 0; q < 16; ++q) acc[q] = 0.f;
#pragma unroll
            for (int ss = 0; ss < 4; ++ss) if (ss < 2 * (tt + 1)) {
                const bf16x8 a = *(const LAS bf16x8*)(At + (32 * tt + r) * AP + 16 * ss + 8 * h), bv = *(const LAS bf16x8*)(Vt + (32 * dt + r) * VP + 16 * ss + 8 * h);
                acc = MFMA32(a, bv, acc);
            }
#pragma unroll
            for (int q = 0; q < 16; ++q) INTRA[(t0 + 32 * tt + crow(q, h)) * HW + col0 + 32 * dt + r] = f2bf(acc[q]);
        }
        __syncthreads();
    }
#undef HP_LOAD
}

constexpr int SC_OPB = 0, SC_OBUF = 65536, SC_OBP = 132, SC_OBB = 64 * SC_OBP * 4, SC_DEC = SC_OBUF + 2 * SC_OBB;
__device__ __forceinline__ void scan_unit(Frame& F, int bh) {
    const bf16_t* QF = WSP(bf16_t, WS_QF); const bf16_t* KF = WSP(bf16_t, WS_KF); const bf16_t* VF = WSP(bf16_t, WS_VF); const bf16_t* INTRA = WSP(bf16_t, WS_INTRA); const float* DEC = WSP(float, WS_DEC);
    const bf16_t* HG = WSP(bf16_t, WS_HG); bf16_t* MIX = WSP(bf16_t, WS_MIX);
    const int tid = F.tid, lane = F.lane, w = F.wave, r = lane & 31, h = lane >> 5, tt = w & 1, d = w >> 1, b = bh >> 2, hd = bh & 3;
    LAS unsigned char* lds = F.lds;
    f32x16 S[4];
#pragma unroll
    for (int kt = 0; kt < 4; ++kt)
#pragma unroll
        for (int q = 0; q < 16; ++q) S[kt][q] = 0.f;
#define SC_DMA(c_) do { const size_t chn = (size_t)bh * 32 + (c_); const int slot = ((c_) & 1) * 32768; _Pragma("unroll") for (int i_ = 0; i_ < 2; ++i_) { \
        __builtin_amdgcn_global_load_lds((const unsigned*)(QF + ((chn * 16 + 2 * w + i_) * 64 + lane) * 8), (LAS unsigned*)(lds + SC_OPB + slot + (2 * w + i_) * 1024), 16, 0, 0); \
        __builtin_amdgcn_global_load_lds((const unsigned*)(KF + ((chn * 16 + 2 * w + i_) * 64 + lane) * 8), (LAS unsigned*)(lds + SC_OPB + slot + 16384 + (2 * w + i_) * 1024), 16, 0, 0); } \
        } while (0)
#define SC_DEC_LD(c_) (*(const f32x4*)(DEC + ((size_t)bh * 32 + (c_)) * 128 + (tid & 31) * 4))
#define SC_DEC_ST(c_, v_) do { if (tid < 32) *(LAS f32x4*)(lds + SC_DEC + ((c_) & 1) * 512 + tid * 16) = (v_); } while (0)
    bf16x8 Vf[4], Vn[4];
#pragma unroll
    for (int ss = 0; ss < 4; ++ss) Vf[ss] = *(const bf16x8*)(VF + ((((size_t)bh * 32) * 16 + ss * 4 + d) * 64 + lane) * 8);
    SC_DMA(0);
    { const f32x4 dv0 = SC_DEC_LD(0); SC_DEC_ST(0, dv0); }
    __syncthreads();
    const int ft = tid >> 3, fs = tid & 7;
    const int ocol = hd * 128 + 16 * fs;
    f32x4 ghv[4];
#pragma unroll
    for (int q = 0; q < 4; ++q) ghv[q] = *(const f32x4*)(F.hgrn_g + ocol + 4 * q);
    for (int c = 0; c < 32; ++c) {
        const int slot = (c & 1) * 32768;
        f32x4 dnext = {0.f, 0.f, 0.f, 0.f};
        if (c + 1 < 32) {
            SC_DMA(c + 1);
            dnext = SC_DEC_LD(c + 1);
#pragma unroll
            for (int ss = 0; ss < 4; ++ss) Vn[ss] = *(const bf16x8*)(VF + ((((size_t)bh * 32 + c + 1) * 16 + ss * 4 + d) * 64 + lane) * 8);
        }
        const size_t trow = (size_t)b * SEQ + 64 * c + ft;
        const u32x4 in0 = *(const u32x4*)(INTRA + trow * HW + ocol), in1 = *(const u32x4*)(INTRA + trow * HW + ocol + 8);
        const u32x4 hg0 = *(const u32x4*)(HG + trow * HW + ocol), hg1 = *(const u32x4*)(HG + trow * HW + ocol + 8);
        f32x16 P;
#pragma unroll
        for (int q = 0; q < 16; ++q) P[q] = 0.f;
#pragma unroll
        for (int kt = 0; kt < 4; ++kt)
#pragma unroll
            for (int ks = 0; ks < 2; ++ks) {
                const bf16x8 qf = *(const LAS bf16x8*)(lds + SC_OPB + slot + ((tt * 4 + kt) * 2 + ks) * 1024 + lane * 16);
                P = MFMA32(qf, pack_step(S[kt], ks), P);
            }
        {   LAS float* ob = (LAS float*)(lds + SC_OBUF + (c & 1) * SC_OBB);
#pragma unroll
            for (int q = 0; q < 16; ++q) ob[(32 * tt + crow(q, h)) * SC_OBP + 32 * d + r] = P[q]; }
#pragma unroll
        for (int kt = 0; kt < 4; ++kt) {
#pragma unroll
            for (int g = 0; g < 4; ++g) { const f32x4 dc = *(const LAS f32x4*)(lds + SC_DEC + (c & 1) * 512 + (32 * kt + 8 * g + 4 * h) * 4);
#pragma unroll
                for (int q = 0; q < 4; ++q) S[kt][4 * g + q] *= dc[q]; }
#pragma unroll
            for (int ss = 0; ss < 4; ++ss) {
                const bf16x8 kf = *(const LAS bf16x8*)(lds + SC_OPB + slot + 16384 + (kt * 4 + ss) * 1024 + lane * 16);
                S[kt] = MFMA32(kf, Vf[ss], S[kt]);
            }
        }
        SC_DEC_ST(c + 1, dnext);
        __syncthreads();
        {
            const LAS float* ob = (const LAS float*)(lds + SC_OBUF + (c & 1) * SC_OBB) + ft * SC_OBP + 16 * fs;
            const f32x4 p0 = *(const LAS f32x4*)ob, p1 = *(const LAS f32x4*)(ob + 4), p2 = *(const LAS f32x4*)(ob + 8), p3 = *(const LAS f32x4*)(ob + 12);
            float o[16];
            o[0] = p0[0] + bflo(in0.x); o[1] = p0[1] + bfhi(in0.x); o[2] = p0[2] + bflo(in0.y); o[3] = p0[3] + bfhi(in0.y);
            o[4] = p1[0] + bflo(in0.z); o[5] = p1[1] + bfhi(in0.z); o[6] = p1[2] + bflo(in0.w); o[7] = p1[3] + bfhi(in0.w);
            o[8] = p2[0] + bflo(in1.x); o[9] = p2[1] + bfhi(in1.x); o[10] = p2[2] + bflo(in1.y); o[11] = p2[3] + bfhi(in1.y);
            o[12] = p3[0] + bflo(in1.z); o[13] = p3[1] + bfhi(in1.z); o[14] = p3[2] + bflo(in1.w); o[15] = p3[3] + bfhi(in1.w);
            float ss2 = 0.f;
#pragma unroll
            for (int q = 0; q < 16; ++q) ss2 += o[q] * o[q];
            ss2 += __shfl_xor(ss2, 1); ss2 += __shfl_xor(ss2, 2); ss2 += __shfl_xor(ss2, 4);
            const float rs = rsqrtf(ss2 * (1.f / 128.f) + EPS);
            const unsigned hgw[8] = {hg0.x, hg0.y, hg0.z, hg0.w, hg1.x, hg1.y, hg1.z, hg1.w};
#if FP8_OUTPROJ
            float of[16];
#pragma unroll
            for (int q = 0; q < 8; ++q) { of[2 * q] = o[2 * q] * rs * ghv[q >> 1][(2 * q) & 3] * bflo(hgw[q]); of[2 * q + 1] = o[2 * q + 1] * rs * ghv[q >> 1][(2 * q + 1) & 3] * bfhi(hgw[q]); }
            const u32x2 w0 = pg8::pack8_fp8((f32x4){of[0], of[1], of[2], of[3]} * FP8_MIX_SCALE, (f32x4){of[4], of[5], of[6], of[7]} * FP8_MIX_SCALE);
            const u32x2 w1 = pg8::pack8_fp8((f32x4){of[8], of[9], of[10], of[11]} * FP8_MIX_SCALE, (f32x4){of[12], of[13], of[14], of[15]} * FP8_MIX_SCALE);
            *(u32x4*)((unsigned char*)MIX + trow * MIXW + AW + ocol) = (u32x4){w0.x, w0.y, w1.x, w1.y};
#else
            unsigned ow[8];
#pragma unroll
            for (int q = 0; q < 8; ++q) ow[q] = cvtpk(o[2 * q] * rs * ghv[q >> 1][(2 * q) & 3] * bflo(hgw[q]), o[2 * q + 1] * rs * ghv[q >> 1][(2 * q + 1) & 3] * bfhi(hgw[q]));
            bf16_t* mo = MIX + trow * MIXW + AW + ocol;
            *(u32x4*)mo = (u32x4){ow[0], ow[1], ow[2], ow[3]}; *(u32x4*)(mo + 8) = (u32x4){ow[4], ow[5], ow[6], ow[7]};
#endif
        }
#pragma unroll
        for (int ss = 0; ss < 4; ++ss) Vf[ss] = Vn[ss];
    }
    __syncthreads();
#undef SC_DMA
#undef SC_DEC_LD
#undef SC_DEC_ST
}

constexpr int AT_KP = 72, AT_VP = 260;
__device__ __forceinline__ void attn_stage(Frame& F, int kvh, int n, size_t t0, LAS bf16_t* Ks, LAS bf16_t* Vt) {
    const bf16_t* AK = WSP(bf16_t, WS_AK); const bf16_t* AV = WSP(bf16_t, WS_AV);
    __syncthreads();
    int tid_ = F.tid; asm volatile("" : "+v"(tid_));
#pragma unroll
    for (int i = 0; i < 4; ++i) {
        const int idx = tid_ + 512 * i, row = idx >> 3, c8 = idx & 7;
        u32x4 kv = {0u, 0u, 0u, 0u}, vv = {0u, 0u, 0u, 0u};
        if (n > 0 || row >= 128) { const size_t go = (t0 - 128 + row) * AKW + kvh * 64 + 8 * c8; kv = *(const u32x4*)(AK + go); vv = *(const u32x4*)(AV + go); }
        *(LAS u32x4*)(Ks + row * AT_KP + 8 * c8) = kv;
#pragma unroll
        for (int q = 0; q < 4; ++q) { Vt[(8 * c8 + 2 * q) * AT_VP + row] = (bf16_t)(vv[q] & 0xffffu); Vt[(8 * c8 + 2 * q + 1) * AT_VP + row] = (bf16_t)(vv[q] >> 16); }
    }
    __syncthreads();
}
__device__ __forceinline__ void attn_item(Frame& F, int hq, int rt, int n, size_t t0, const LAS bf16_t* Ks, const LAS bf16_t* Vt, LAS float* ssq, unsigned (&okp)[16]) {
    const bf16_t* AQ = WSP(bf16_t, WS_AQ);
    int lane = F.lane; asm volatile("" : "+v"(lane));
    const int r = lane & 31, h = lane >> 5;
    constexpr float L2E = 1.4426950408889634f;
    const float slope2 = exp2f(-(float)(hq + 1)) * L2E, sink2 = F.sinks[hq] * L2E;
    bf16x8 qf[4];
#pragma unroll
    for (int ds = 0; ds < 4; ++ds) qf[ds] = *(const bf16x8*)(AQ + (t0 + 32 * rt + r) * AW + hq * 64 + 16 * ds + 8 * h);
    float m = sink2;
#define AT_SCORE(SC, j) do { const int kt = rt + (j); int rq = r - 4 * h - 32 * (j); asm volatile("" : "+v"(rq));     \
        _Pragma("unroll") for (int q = 0; q < 16; ++q) SC[q] = 0.f; \
        _Pragma("unroll") for (int ds = 0; ds < 4; ++ds) SC = MFMA32(*(const LAS bf16x8*)(Ks + (32 * kt + r) * AT_KP + 16 * ds + 8 * h), qf[ds], SC); \
        const float base = -slope2 * (float)(128 + rq); const int rel = rq + 32 * (j);            \
        if (n == 0 && kt < 4) { _Pragma("unroll") for (int q = 0; q < 16; ++q) SC[q] = -INFINITY; } \
        else { _Pragma("unroll") for (int q = 0; q < 16; ++q) { const int cq = (q & 3) + 8 * (q >> 2); float v = __builtin_fmaf(slope2, (float)cq, __builtin_fmaf(SC[q], 0.125f * L2E, base)); \
            if ((j) == 0) v = (cq > rel) ? v : -INFINITY; if ((j) == 4) v = (cq <= rel) ? v : -INFINITY; SC[q] = v; } } } while (0)
#pragma unroll
    for (int j = 0; j < 5; ++j) { f32x16 sc; AT_SCORE(sc, j);
#pragma unroll
        for (int q = 0; q < 16; ++q) m = fmaxf(m, sc[q]); }
    m = fmaxf(m, __shfl_xor(m, 32));
    float l = 0.f; unsigned pp[5][8];
#pragma unroll
    for (int j = 0; j < 5; ++j) { f32x16 sc; AT_SCORE(sc, j);
#pragma unroll
        for (int q = 0; q < 16; ++q) { sc[q] = exp2f(sc[q] - m); l += sc[q]; }
#pragma unroll
        for (int q = 0; q < 8; ++q) pp[j][q] = cvtpk(sc[2 * q], sc[2 * q + 1]); }
#undef AT_SCORE
    l += __shfl_xor(l, 32); l += exp2f(sink2 - m);
    const float rl = 1.f / l;
    float sq = 0.f;
#pragma unroll
    for (int dt = 0; dt < 2; ++dt) {
        f32x16 o;
#pragma unroll
        for (int q = 0; q < 16; ++q) o[q] = 0.f;
        const LAS bf16_t* vrow = Vt + (32 * dt + r) * AT_VP + 4 * h;
#pragma unroll
        for (int j = 0; j < 5; ++j)
#pragma unroll
            for (int s = 0; s < 2; ++s) { const LAS bf16_t* vp = vrow + 32 * (rt + j) + 16 * s;
                const u32x2 va = *(const LAS u32x2*)vp, vb = *(const LAS u32x2*)(vp + 8); const u32x4 pa = {va.x, va.y, vb.x, vb.y};
                const u32x4 pb = {pp[j][4 * s], pp[j][4 * s + 1], pp[j][4 * s + 2], pp[j][4 * s + 3]};
                o = MFMA32(__builtin_bit_cast(bf16x8, pa), __builtin_bit_cast(bf16x8, pb), o); }
#pragma unroll
        for (int q = 0; q < 16; ++q) { o[q] *= rl; sq += o[q] * o[q]; }
#pragma unroll
        for (int q = 0; q < 8; ++q) okp[dt * 8 + q] = cvtpk(o[2 * q], o[2 * q + 1]);
    }
    sq += __shfl_xor(sq, 32);
    if (h == 0) __hip_atomic_fetch_add(&ssq[32 * rt + r], sq, __ATOMIC_RELAXED, __HIP_MEMORY_SCOPE_WORKGROUP);
}
__device__ __forceinline__ void attn_store(Frame& F, int hq, int rt, size_t t0, const LAS float* ssq, const LAS float* ags, const unsigned (&okp)[16]) {
    bf16_t* MIX = WSP(bf16_t, WS_MIX);
    int lane = F.lane; asm volatile("" : "+v"(lane));
    const int r = lane & 31, h = lane >> 5;
    const float rs = rsqrtf(ssq[32 * rt + r] * (1.f / AW) + EPS);
    bf16_t* mo = MIX + (t0 + 32 * rt + r) * MIXW + hq * 64;
#pragma unroll
    for (int dt = 0; dt < 2; ++dt)
#pragma unroll
        for (int g4 = 0; g4 < 4; ++g4) {
            const int d0 = 32 * dt + 8 * g4 + 4 * h; const f32x4 ga = *(const LAS f32x4*)(ags + hq * 64 + d0);
            const unsigned p0 = okp[dt * 8 + 2 * g4], p1 = okp[dt * 8 + 2 * g4 + 1];
#if FP8_OUTPROJ
            int a8 = 0; const float rs8 = rs * FP8_MIX_SCALE;
            a8 = __builtin_amdgcn_cvt_pk_fp8_f32(__builtin_amdgcn_fmed3f(bflo(p0) * rs8 * ga[0], -448.f, 448.f), __builtin_amdgcn_fmed3f(bfhi(p0) * rs8 * ga[1], -448.f, 448.f), a8, false);
            a8 = __builtin_amdgcn_cvt_pk_fp8_f32(__builtin_amdgcn_fmed3f(bflo(p1) * rs8 * ga[2], -448.f, 448.f), __builtin_amdgcn_fmed3f(bfhi(p1) * rs8 * ga[3], -448.f, 448.f), a8, true);
            *(unsigned*)((unsigned char*)MIX + (t0 + 32 * rt + r) * MIXW + hq * 64 + d0) = (unsigned)a8;
#else
            u32x2 ow; ow.x = cvtpk(bflo(p0) * rs * ga[0], bfhi(p0) * rs * ga[1]); ow.y = cvtpk(bflo(p1) * rs * ga[2], bfhi(p1) * rs * ga[3]);
            *(u32x2*)(mo + d0) = ow;
#endif
        }
}
__device__ __forceinline__ void attn_unit(Frame& F, int u) {
    LAS bf16_t* Ks = (LAS bf16_t*)F.lds;
    LAS bf16_t* Vt = (LAS bf16_t*)(F.lds + 36864);
    LAS float* ssq = (LAS float*)(F.lds + 36864 + 33280);
    const int w = F.wave, b = u >> 4, n = u & 15; const size_t t0 = (size_t)b * SEQ + 128 * n;
    LAS float* ags = ssq + 128;
    if (F.tid < 128) ssq[F.tid] = 0.f;
    ags[F.tid] = F.attn_g[F.tid];
    const int g0 = (2 * w) >> 2, rt0 = (2 * w) & 3, g1 = (2 * w + 1) >> 2, rt1 = (2 * w + 1) & 3;
    unsigned ok0[16], ok1[16], ok2[16], ok3[16];
    RSTAMP(17);
    attn_stage(F, 0, n, t0, Ks, Vt);
    RSTAMP(18);
    attn_item(F, g0, rt0, n, t0, Ks, Vt, ssq, ok0);
    RSTAMP(19);
    attn_item(F, g1, rt1, n, t0, Ks, Vt, ssq, ok1);
    attn_stage(F, 1, n, t0, Ks, Vt);
    attn_item(F, 4 + g0, rt0, n, t0, Ks, Vt, ssq, ok2);
    attn_item(F, 4 + g1, rt1, n, t0, Ks, Vt, ssq, ok3);
    RSTAMP(22);
    __syncthreads();
    attn_store(F, g0, rt0, t0, ssq, ags, ok0); attn_store(F, g1, rt1, t0, ssq, ags, ok1); attn_store(F, 4 + g0, rt0, t0, ssq, ags, ok2); attn_store(F, 4 + g1, rt1, t0, ssq, ags, ok3);
    __syncthreads();
}
__device__ __forceinline__ void p_convert_experts(Frame& F, int rank, int nrank, int max_chunks = 1 << 30);
__device__ __forceinline__ void p_scan_attn(Frame& F, bool do_scan, bool do_attn, int conv_mask = 0) {
    const int G = F.G, bx = blockIdx.x, nscan = (do_scan && do_attn && G >= 64) ? 32 : 0;
    if (do_scan) { if (nscan) { if (bx < nscan) scan_unit(F, bx); } else for (int u = bx; u < BATCH * 4; u += G) scan_unit(F, u); }
    if (do_attn) { if (nscan) { for (int u = bx - nscan; u >= 0 && u < BATCH * 16; u += G - nscan) attn_unit(F, u); } else for (int u = bx; u < BATCH * 16; u += G) attn_unit(F, u); }
    RSTAMP(15);
    if (!(blockIdx.x & conv_mask)) p_convert_experts(F, 0, 0);
    RSTAMP(16);
}


__device__ __forceinline__ int w2col(int n) { const int c = n & 255; return (n & ~255) + 64 * ((c >> 5) & 3) + 16 * ((c >> 3) & 3) + 8 * (c >> 7) + (c & 7); }
__device__ __forceinline__ int w1col(int n) { const int pn = n >> 8, cl = n & 255; return cl < 128 ? 2 * (128 * pn + cl) : 2 * (128 * pn + cl - 128) + 1; }
template <bool W1MAP, bool FP8>
__device__ __forceinline__ void p0_transpose_item(const float* W, int K, int N, void* WTv, LAS float* scr, int item, int lane) {
    const int nblk = N / 32, kb = item / nblk, nb = item % nblk, k0 = 64 * kb, n0 = 32 * nb;
    const int sc = W1MAP ? w1col(n0 + (lane & 31)) : n0 + (lane & 31);
    float v[32];
#pragma unroll
    for (int i = 0; i < 32; ++i) v[i] = W[(size_t)(k0 + 2 * i + (lane >> 5)) * N + sc];
#pragma unroll
    for (int i = 0; i < 32; ++i) scr[(2 * i + (lane >> 5)) * 33 + (lane & 31)] = v[i];
    LDS_WAIT(); asm volatile("" ::: "memory");
    const int c = lane & 7;
#pragma unroll
    for (int j = 0; j < 4; ++j) { const int n = (lane >> 3) + 8 * j; const LAS float* s = scr + (8 * c) * 33 + n;
        if constexpr (FP8) { const f32x4 a = {s[0 * 33], s[1 * 33], s[2 * 33], s[3 * 33]}, b = {s[4 * 33], s[5 * 33], s[6 * 33], s[7 * 33]};
            *(GAS u32x2*)((unsigned char*)WTv + (size_t)(n0 + n) * K + k0 + 8 * c) = pg8::pack8_fp8(a * pg8::FP8_W_SCALE, b * pg8::FP8_W_SCALE); }
        else { u32x4 o; o.x = pg8::cvt_pk_bf16(s[0 * 33], s[1 * 33]); o.y = pg8::cvt_pk_bf16(s[2 * 33], s[3 * 33]); o.z = pg8::cvt_pk_bf16(s[4 * 33], s[5 * 33]); o.w = pg8::cvt_pk_bf16(s[6 * 33], s[7 * 33]);
            *(GAS u32x4*)((bf16_t*)WTv + (size_t)(n0 + n) * K + k0 + 8 * c) = o; } }
    LDS_WAIT(); asm volatile("" ::: "memory");
}
#ifndef BKN_MOE
#define BKN_MOE 0
#endif
#if BKN_MOE
struct ConvItem { const float* W; unsigned char* WF; int N, map; };
__device__ __forceinline__ ConvItem conv_desc(Frame& F, int it) {
    constexpr int I_W1E = (DM / 16) * (2 * FF / 256), I_W2E = (FF / 16) * (DM / 256);
    ConvItem c;
    if (it < NE * I_W1E) { const int e = it / I_W1E, r = it % I_W1E, nt = 2 * FF / 256; const size_t o = ((size_t)e * DM + 16 * (r / nt)) * (2 * FF) + 256 * (r % nt); c.W = F.w1 + o; c.WF = WSP(unsigned char, WS_W1T) + o; c.N = 2 * FF; c.map = 1; }
    else { it -= NE * I_W1E; const int e = it / I_W2E, r = it % I_W2E, nt = DM / 256; const size_t o = ((size_t)e * FF + 16 * (r / nt)) * DM + 256 * (r % nt); c.W = F.w2 + o; c.WF = WSP(unsigned char, WS_W2T) + o; c.N = DM; c.map = 2; }
    return c;
}
__device__ __forceinline__ int conv_pos(int tc) { const int r32 = tc & 31; return (tc & ~31) + 16 * ((r32 >> 2) & 1) + 4 * (r32 >> 3) + (r32 & 3); }
__device__ __forceinline__ void conv_item(const ConvItem& c, int lane, LAS unsigned char* scr) {
    const GAS f32x4* p = (const GAS f32x4*)c.W + lane;
    f32x4 v[16];
#pragma unroll
    for (int i = 0; i < 16; ++i) v[i] = p[(size_t)i * (c.N / 4)];
    if (c.map == 1) {
        const int pg = conv_pos(2 * lane);
#pragma unroll
        for (int i = 0; i < 16; ++i) { const f32x4 w = v[i] * pg8::FP8_W_SCALE; int a = 0;
            a = __builtin_amdgcn_cvt_pk_fp8_f32(__builtin_amdgcn_fmed3f(w[0], -448.f, 448.f), __builtin_amdgcn_fmed3f(w[2], -448.f, 448.f), a, false);
            a = __builtin_amdgcn_cvt_pk_fp8_f32(__builtin_amdgcn_fmed3f(w[1], -448.f, 448.f), __builtin_amdgcn_fmed3f(w[3], -448.f, 448.f), a, true);
            *(LAS unsigned short*)(scr + i * 256 + pg) = (unsigned short)a; *(LAS unsigned short*)(scr + i * 256 + 128 + pg) = (unsigned short)((unsigned)a >> 16); }
    } else {
        const int o = 4 * lane, pw = conv_pos(128 * ((o >> 3) & 1) + 32 * (o >> 6) + 8 * ((o >> 4) & 3) + (o & 7));
#pragma unroll
        for (int i = 0; i < 16; ++i) { const f32x4 w = v[i] * pg8::FP8_W_SCALE; int a = 0;
            a = __builtin_amdgcn_cvt_pk_fp8_f32(__builtin_amdgcn_fmed3f(w[0], -448.f, 448.f), __builtin_amdgcn_fmed3f(w[1], -448.f, 448.f), a, false);
            a = __builtin_amdgcn_cvt_pk_fp8_f32(__builtin_amdgcn_fmed3f(w[2], -448.f, 448.f), __builtin_amdgcn_fmed3f(w[3], -448.f, 448.f), a, true);
            *(LAS int*)(scr + i * 256 + pw) = a; }
    }
    LDS_WAIT(); asm volatile("" ::: "memory");
#pragma unroll
    for (int j = 0; j < 4; ++j) { const int r = 4 * j + (lane >> 4);
        *(GAS u32x4*)(c.WF + (size_t)r * c.N + 16 * (lane & 15)) = *(const LAS u32x4*)(scr + r * 256 + 16 * (lane & 15)); }
    LDS_WAIT(); asm volatile("" ::: "memory");
}
constexpr int CONV_NITEMS = NE * (DM / 16) * (2 * FF / 256) + NE * (FF / 16) * (DM / 256), CONV_SCR = 16 * 256;
typedef unsigned char conv_scr_t;
#else
struct ConvItem { const float* W; unsigned char* WT; int N, k0, n0, map; };
__device__ __forceinline__ ConvItem conv_desc(Frame& F, int it) {
    constexpr int I_W1E = (DM / 128) * (2 * FF / 32), I_W2E = (FF / 128) * (DM / 32);
    ConvItem c;
    if (it < NE * I_W1E) { const int e = it / I_W1E, r = it % I_W1E, nblk = 2 * FF / 32; c.W = F.w1 + (size_t)e * DM * 2 * FF; c.WT = WSP(unsigned char, WS_W1T) + (size_t)e * 2 * FF * DM; c.N = 2 * FF; c.k0 = 128 * (r / nblk); c.n0 = 32 * (r % nblk); c.map = 1; }
    else { it -= NE * I_W1E; const int e = it / I_W2E, r = it % I_W2E, nblk = DM / 32; c.W = F.w2 + (size_t)e * FF * DM; c.WT = WSP(unsigned char, WS_W2T) + (size_t)e * DM * FF; c.N = DM; c.k0 = 128 * (r / nblk); c.n0 = 32 * (r % nblk); c.map = 2; }
    return c;
}
__device__ __forceinline__ void conv_item(const ConvItem& c, int lane, LAS float* scr, int probe = 0) {
    const int sc = c.map == 1 ? w1col(c.n0 + (lane & 31)) : w2col(c.n0 + (lane & 31));
    const float* p = c.W + (size_t)(c.k0 + (lane >> 5)) * c.N + sc;
#ifndef CONV_INFL
#define CONV_INFL 32
#endif
    constexpr int CB = CONV_INFL;
    float v[CB];
#pragma unroll
    for (int i = 0; i < CB; ++i) v[i] = probe == 10 ? 0.f : p[(size_t)(2 * i) * c.N];
    int wb[8];
#pragma unroll
    for (int a = 0; a < 8; ++a) wb[a] = (lane >> 5) * 32 + (((lane & 31) + 4 * a) & 31);
#pragma unroll
    for (int g = 0; g + 1 < 64 / CB; ++g)
#pragma unroll
        for (int i = 0; i < CB; ++i) { scr[2 * (g * CB + i) * 32 + wb[((g * CB + i) >> 2) & 7]] = v[i]; v[i] = p[(size_t)(2 * ((g + 1) * CB + i)) * c.N]; __builtin_amdgcn_sched_barrier(0); }
#pragma unroll
    for (int i = 0; i < CB; ++i) scr[2 * ((64 / CB - 1) * CB + i) * 32 + wb[(((64 / CB - 1) * CB + i) >> 2) & 7]] = v[i];
    LDS_WAIT(); asm volatile("" ::: "memory");
    const int cg = lane & 15;
#pragma unroll
    for (int j = 0; j < 8; ++j) { const int n = (lane >> 4) + 4 * j; const LAS float* s = scr + (8 * cg) * 32 + ((n + 4 * cg) & 31);
        const f32x4 a = {s[0 * 32], s[1 * 32], s[2 * 32], s[3 * 32]}, b = {s[4 * 32], s[5 * 32], s[6 * 32], s[7 * 32]};
        if (probe != 9) *(GAS u32x2*)(c.WT + (size_t)(c.n0 + n) * DM + c.k0 + 8 * cg) = pg8::pack8_fp8(a * pg8::FP8_W_SCALE, b * pg8::FP8_W_SCALE);
        else if (a[0] + b[0] == 12345.678f) *(GAS float*)c.WT = 0.f; }
    LDS_WAIT(); asm volatile("" ::: "memory");
}
constexpr int CONV_NITEMS = NE * (DM / 128) * (2 * FF / 32) + NE * (FF / 128) * (DM / 32), CONV_SCR = 128 * 33 * 4;
typedef float conv_scr_t;
#endif
#ifndef CONV_CHUNK
#define CONV_CHUNK 8
#endif
#ifndef CONV_INFL
#define CONV_INFL 64
#endif
#ifndef CONV_PIPE
#define CONV_PIPE 0
#endif
#if CONV_PIPE && !BKN_MOE
__device__ __forceinline__ const float* conv_src(const ConvItem& c, int lane) { const int sc = c.map == 1 ? w1col(c.n0 + (lane & 31)) : w2col(c.n0 + (lane & 31)); return c.W + (size_t)(c.k0 + (lane >> 5)) * c.N + sc; }
__device__ __forceinline__ void p_convert_experts(Frame& F, int rank, int nrank, int max_chunks) {
    static_assert(DM == FF && RING_BYTES >= NWAVES * 128 * 33 * 4 && CONV_NITEMS % NWAVES == 0 && CONV_CHUNK == NWAVES, "one item per wave and chunk; K = 1024 for both expert matrices");
    LAS float* scr = (LAS float*)(F.lds + RING_OFF + F.wave * CONV_SCR);
    constexpr int NITEMS = CONV_NITEMS, CB = CONV_INFL < 64 ? CONV_INFL : 32, NG = 64 / CB;
    const int lane = F.lane, hi = lane >> 5, lo = lane & 31;
    __syncthreads();
    volatile LAS int* slot = (volatile LAS int*)(F.lds + LDSCTL_OFF + 4096);
    int* ctr = (int*)(F.ctl + CW_CONV);
    if (F.tid == 0) { const int b0 = atomicAdd(ctr, 2 * CONV_CHUNK); slot[0] = b0; slot[1] = b0 + CONV_CHUNK; }
    __syncthreads();
    if (slot[0] >= NITEMS) return;
    ConvItem c = conv_desc(F, slot[0] + F.wave);
    const float* p = conv_src(c, lane);
    float v[CB];
#pragma unroll
    for (int i = 0; i < CB; ++i) v[i] = p[(size_t)(2 * i) * c.N];
    int wb[8];
#pragma unroll
    for (int a = 0; a < 8; ++a) wb[a] = hi * 32 + ((lo + 4 * a) & 31);
#pragma unroll 1
    for (int n = 0;; ++n) {
        const int nbase = slot[(n + 1) % 3];
        const bool has_next = nbase < NITEMS;
        int nb2 = NITEMS; if (F.tid == 0 && has_next) nb2 = atomicAdd(ctr, CONV_CHUNK);
#pragma unroll
        for (int g = 0; g + 1 < NG; ++g)
#pragma unroll
            for (int i = 0; i < CB; ++i) { scr[2 * (g * CB + i) * 32 + wb[((g * CB + i) >> 2) & 7]] = v[i]; v[i] = p[(size_t)(2 * ((g + 1) * CB + i)) * c.N]; __builtin_amdgcn_sched_barrier(0); }
        ConvItem cn = c; const float* pn = p;
        if (has_next) { cn = conv_desc(F, nbase + F.wave); pn = conv_src(cn, lane); }
#pragma unroll
        for (int i = 0; i < CB; ++i) { scr[2 * ((NG - 1) * CB + i) * 32 + wb[(((NG - 1) * CB + i) >> 2) & 7]] = v[i]; if (has_next) v[i] = pn[(size_t)(2 * i) * cn.N]; __builtin_amdgcn_sched_barrier(0); }
        LDS_WAIT(); asm volatile("" ::: "memory");
        const int cg = lane & 15;
#pragma unroll
        for (int j = 0; j < 8; ++j) { const int nn = (lane >> 4) + 4 * j; const LAS float* s = scr + (8 * cg) * 32 + ((nn + 4 * cg) & 31);
            const f32x4 a = {s[0 * 32], s[1 * 32], s[2 * 32], s[3 * 32]}, b = {s[4 * 32], s[5 * 32], s[6 * 32], s[7 * 32]};
            *(GAS u32x2*)(c.WT + (size_t)(c.n0 + nn) * DM + c.k0 + 8 * cg) = pg8::pack8_fp8(a * pg8::FP8_W_SCALE, b * pg8::FP8_W_SCALE); }
        LDS_WAIT(); asm volatile("" ::: "memory");
        if (F.tid == 0) slot[(n + 2) % 3] = nb2;
        asm volatile("" ::: "memory"); LDS_WAIT(); __builtin_amdgcn_s_barrier(); asm volatile("" ::: "memory");
        if (!has_next) break;
        c = cn; p = pn;
    }
}
#else
__device__ __forceinline__ void p_convert_experts(Frame& F, int rank, int nrank, int max_chunks) {
    static_assert(DM == FF && RING_BYTES >= NWAVES * 128 * 33 * 4, "conv_item assumes K = 1024 for both expert matrices and a 16.5 KiB LDS tile per wave");
    LAS conv_scr_t* scr = (LAS conv_scr_t*)(F.lds + RING_OFF + F.wave * CONV_SCR);
    constexpr int NITEMS = CONV_NITEMS;
    __syncthreads();
    if (nrank > 0) { for (int it = rank * NWAVES + F.wave; it < NITEMS; it += nrank * NWAVES) { const ConvItem c = conv_desc(F, it); conv_item(c, F.lane, scr); } return; }
    volatile LAS int* slot = (volatile LAS int*)(F.lds + LDSCTL_OFF + 4096);
    int* ctr = (int*)(F.ctl + CW_CONV) + (F.probe ? 64 : 0);
    if (F.tid == 0) slot[0] = atomicAdd(ctr, CONV_CHUNK);
    __syncthreads();
    for (int cur = 0, nch = 1;; cur ^= 1, ++nch) {
        const int base = slot[cur];
        if (base >= NITEMS) break;
        const bool more = nch < max_chunks;
        if (F.tid == 0 && more) slot[cur ^ 1] = atomicAdd(ctr, CONV_CHUNK);
#pragma unroll 1
        for (int j = 0; j < CONV_CHUNK / 8; ++j) { const int it = base + 8 * j + F.wave; if (it < NITEMS) { const ConvItem c = conv_desc(F, it); conv_item(c, F.lane, scr, F.probe); } }
        __syncthreads();
        if (!more) break;
    }
}
#endif
__device__ __forceinline__ void p_prologue(Frame& F) {
    LAS float* scr = (LAS float*)(F.lds + RING_OFF + F.wave * 16384);
    const int gw = F.vcu * NWAVES + F.wave, NGW = F.G * NWAVES;
    constexpr int I_IN = (DM / 64) * (INW / 32), I_OUT = (MIXW / 64) * (DM / 32), I_W1E = (DM / 64) * (2 * FF / 32), I_W2E = (FF / 64) * (DM / 32);
    constexpr int NITEMS = I_IN + I_OUT;
    bf16_t *WinT = WSP(bf16_t, WS_WINT), *WoutT = WSP(bf16_t, WS_WOUTT);
    for (int it = gw; it < NITEMS; it += NGW) {
        int r = it;
        if (r < I_IN) { p0_transpose_item<false, FP8_INPROJ != 0>(F.w_in, DM, INW, WinT, scr, r, F.lane); continue; } r -= I_IN;
        p0_transpose_item<false, FP8_OUTPROJ != 0>(F.w_out, MIXW, DM, WoutT, scr, r, F.lane);
    }
    RSTAMP(24);
    bf16_t* XN = WSP(bf16_t, WS_XN);
    f32x4 g1v[4];
#pragma unroll
    for (int j = 0; j < 4; ++j) g1v[j] = *((const f32x4*)F.norm1_g + F.lane + 64 * j);
#ifdef P0_TWO
#define P0_LOAD(V, m_) do { const GAS f32x4* xr_ = (const GAS f32x4*)(F.x + (size_t)(m_) * DM) + F.lane; _Pragma("unroll") for (int j = 0; j < 4; ++j) V[j] = xr_[64 * j]; } while (0)
#define P0_STORE(V, m_, r_) do { GAS u32x2* o8 = (GAS u32x2*)(XN + (size_t)(m_) * DM) + F.lane; _Pragma("unroll") for (int j = 0; j < 4; ++j) { const f32x4 g = g1v[j]; u32x2 w; \
            w.x = pg8::cvt_pk_bf16(V[j].x * (r_) * g.x, V[j].y * (r_) * g.y); w.y = pg8::cvt_pk_bf16(V[j].z * (r_) * g.z, V[j].w * (r_) * g.w); o8[64 * j] = w; } } while (0)
#define P0_ROW(V, m_) do { float s = 0.f; _Pragma("unroll") for (int j = 0; j < 4; ++j) s += (V[j].x * V[j].x + V[j].y * V[j].y) + (V[j].z * V[j].z + V[j].w * V[j].w); \
        const float r = rsqrtf(wave_sum(s) * (1.f / DM) + EPS); P0_STORE(V, m_, r); } while (0)
    for (int m = 2 * gw; m < T; m += 2 * NGW) {
        f32x4 va[4], vb[4];
        P0_LOAD(va, m); P0_LOAD(vb, m + 1);
        P0_ROW(va, m); P0_ROW(vb, m + 1);
    }
#undef P0_LOAD
#undef P0_STORE
#undef P0_ROW
#else
    for (int m = gw; m < T; m += NGW) {
        const GAS f32x4* xr = (const GAS f32x4*)(F.x + (size_t)m * DM) + F.lane;
        f32x4 v[4]; float s = 0.f;
#pragma unroll
        for (int j = 0; j < 4; ++j) { v[j] = xr[64 * j]; s += (v[j].x * v[j].x + v[j].y * v[j].y) + (v[j].z * v[j].z + v[j].w * v[j].w); }
        const float r = rsqrtf(wave_sum(s) * (1.f / DM) + EPS);
#if FP8_INPROJ
        GAS unsigned* o4 = (GAS unsigned*)((unsigned char*)XN + (size_t)m * DM) + F.lane;
#pragma unroll
        for (int j = 0; j < 4; ++j) { const f32x4 g = g1v[j]; const float rr = r * FP8_XN_SCALE; int a = 0;
            a = __builtin_amdgcn_cvt_pk_fp8_f32(__builtin_amdgcn_fmed3f(v[j].x * rr * g.x, -448.f, 448.f), __builtin_amdgcn_fmed3f(v[j].y * rr * g.y, -448.f, 448.f), a, false);
            a = __builtin_amdgcn_cvt_pk_fp8_f32(__builtin_amdgcn_fmed3f(v[j].z * rr * g.z, -448.f, 448.f), __builtin_amdgcn_fmed3f(v[j].w * rr * g.w, -448.f, 448.f), a, true); o4[64 * j] = (unsigned)a; }
#else
        GAS u32x2* o8 = (GAS u32x2*)(XN + (size_t)m * DM) + F.lane;
#pragma unroll
        for (int j = 0; j < 4; ++j) { const f32x4 g = g1v[j]; u32x2 w; w.x = pg8::cvt_pk_bf16(v[j].x * r * g.x, v[j].y * r * g.y); w.y = pg8::cvt_pk_bf16(v[j].z * r * g.z, v[j].w * r * g.w); o8[64 * j] = w; }
#endif
    }
#endif
    RSTAMP(25);
    {
        bf16_t* RWF = WSP(bf16_t, WS_RWF);
        for (int i = (NGW - 1 - gw) * 64 + F.lane; i < 64 * 64; i += NGW * 64) { const int ks = i >> 6, ln = i & 63, rr = ln & 31, hh = ln >> 5; float v[8];
#pragma unroll
            for (int j = 0; j < 8; ++j) v[j] = F.router_w[(size_t)(16 * ks + 8 * hh + j) * NE + rr];
            u32x4 hi, lo; hi.x = cvtpk(v[0], v[1]); hi.y = cvtpk(v[2], v[3]); hi.z = cvtpk(v[4], v[5]); hi.w = cvtpk(v[6], v[7]);
            lo.x = cvtpk(v[0] - bflo(hi.x), v[1] - bfhi(hi.x)); lo.y = cvtpk(v[2] - bflo(hi.y), v[3] - bfhi(hi.y)); lo.z = cvtpk(v[4] - bflo(hi.z), v[5] - bfhi(hi.z)); lo.w = cvtpk(v[6] - bflo(hi.w), v[7] - bfhi(hi.w));
            *(u32x4*)(RWF + ((size_t)(ks * 2 + 0) * 64 + ln) * 8) = hi; *(u32x4*)(RWF + ((size_t)(ks * 2 + 1) * 64 + ln) * 8) = lo; }
    }
    if (blockIdx.x == 0) { float* LB = WSP(float, WS_LB); for (int c = F.tid; c < HKW; c += NWAVES * 64) { const float a = F.lb_logits[c], b = F.lb_logits[HKW + c]; LB[c] = 1.f / (1.f + __expf(b - a)); } }
}

__device__ __forceinline__ void p_router(Frame& F) {
    LAS int* lcnt = (LAS int*)(F.lds + MOE_OFF + 512); LAS int* lbase = (LAS int*)(F.lds + MOE_OFF + 768);
    LAS float* part = (LAS float*)F.lds;
    LAS float* ssqp = (LAS float*)(F.lds + 32768);
    const bf16_t* X1 = WSP(bf16_t, WS_X1); unsigned char* H2 = WSP(unsigned char, WS_H2); int* LIST = WSP(int, WS_LIST); float* LRS = WSP(float, WS_LRS); float* LGT = WSP(float, WS_LGT);
    const bf16_t* RWF = WSP(bf16_t, WS_RWF);
    int* cnt = (int*)(F.ctl + CW_CNT);
    const int lane = F.lane, w = F.wave, r = lane & 31, h = lane >> 5, tile = w & 1, kq = w >> 1;
    constexpr int XP = 260;
    LAS float* xs = (LAS float*)(F.lds + 36864);
    for (int tb = blockIdx.x; tb < T / 64; tb += F.G) {
        if (F.tid < NE) lcnt[F.tid] = 0;
        const int t = tb * 64 + tile * 32 + r;
        f32x16 acc;
#pragma unroll
        for (int q = 0; q < 16; ++q) acc[q] = 0.f;
        float ssq = 0.f;
        u32x4 pre0[4], pre1[4];
#define RT_LOAD(P, c_) do { _Pragma("unroll") for (int i = 0; i < 4; ++i) P[i] = *(const u32x4*)(X1 + (size_t)(tb * 64 + 8 * w + 2 * i + (lane >> 5)) * DM + 256 * (c_) + 8 * (lane & 31)); } while (0)
#define RT_CHUNK(P, c_) do { const int c = (c_); \
            __syncthreads();                                     \
            _Pragma("unroll") for (int i = 0; i < 4; ++i) { LAS float* d_ = xs + (8 * w + 2 * i + (lane >> 5)) * XP + 8 * (lane & 31); \
                *(LAS f32x4*)d_ = (f32x4){bflo(P[i].x), bfhi(P[i].x), bflo(P[i].y), bfhi(P[i].y)}; *(LAS f32x4*)(d_ + 4) = (f32x4){bflo(P[i].z), bfhi(P[i].z), bflo(P[i].w), bfhi(P[i].w)}; } \
            if (c + 2 < 4) RT_LOAD(P, c + 2); \
            __syncthreads(); \
            _Pragma("unroll 2") for (int s4 = 0; s4 < 4; ++s4) {                   \
                const int ksl = 4 * kq + s4, ks = 16 * c + ksl, k0 = 16 * ks + 8 * h; \
                const f32x4 x0 = *(const LAS f32x4*)(xs + (32 * tile + r) * XP + 16 * ksl + 8 * h), x1v = *(const LAS f32x4*)(xs + (32 * tile + r) * XP + 16 * ksl + 8 * h + 4); \
                const f32x4 g0 = *(const f32x4*)(F.norm2_g + k0), g1 = *(const f32x4*)(F.norm2_g + k0 + 4); \
                const u32x4 ahi = *(const u32x4*)(RWF + ((size_t)(ks * 2 + 0) * 64 + lane) * 8), alo = *(const u32x4*)(RWF + ((size_t)(ks * 2 + 1) * 64 + lane) * 8); \
                float u[8]; \
                _Pragma("unroll") for (int q = 0; q < 4; ++q) { u[q] = x0[q] * g0[q]; u[4 + q] = x1v[q] * g1[q]; ssq += x0[q] * x0[q]; ssq += x1v[q] * x1v[q]; } \
                u32x4 bh, bl; \
                bh.x = cvtpk(u[0], u[1]); bh.y = cvtpk(u[2], u[3]); bh.z = cvtpk(u[4], u[5]); bh.w = cvtpk(u[6], u[7]); \
                bl.x = cvtpk(u[0] - bflo(bh.x), u[1] - bfhi(bh.x)); bl.y = cvtpk(u[2] - bflo(bh.y), u[3] - bfhi(bh.y)); \
                bl.z = cvtpk(u[4] - bflo(bh.z), u[5] - bfhi(bh.z)); bl.w = cvtpk(u[6] - bflo(bh.w), u[7] - bfhi(bh.w)); \
                *(u32x2*)(H2 + (size_t)t * DM + k0) = pg8::pack8_fp8((f32x4){u[0], u[1], u[2], u[3]} * pg8::FP8_ACT_SCALE, (f32x4){u[4], u[5], u[6], u[7]} * pg8::FP8_ACT_SCALE);     \
                acc = MFMA32(__builtin_bit_cast(bf16x8, ahi), __builtin_bit_cast(bf16x8, bh), acc); \
                acc = MFMA32(__builtin_bit_cast(bf16x8, alo), __builtin_bit_cast(bf16x8, bh), acc); \
                acc = MFMA32(__builtin_bit_cast(bf16x8, ahi), __builtin_bit_cast(bf16x8, bl), acc); \
            } } while (0)
        RT_LOAD(pre0, 0); RT_LOAD(pre1, 1);
#pragma unroll 1
        for (int cc = 0; cc < 4; cc += 2) { RT_CHUNK(pre0, cc); RT_CHUNK(pre1, cc + 1); }
#undef RT_LOAD
#undef RT_CHUNK
#pragma unroll
        for (int q = 0; q < 4; ++q) *(LAS f32x4*)(part + (w * 64 + lane) * 16 + 4 * q) = (f32x4){acc[4 * q], acc[4 * q + 1], acc[4 * q + 2], acc[4 * q + 3]};
        ssqp[w * 64 + lane] = ssq;
        RSTAMP(11);
        __syncthreads();
        RSTAMP(12);
        int my_e[TOPK], my_p[TOPK]; float my_g[TOPK], my_rs = 0.f;
#pragma unroll
        for (int k = 0; k < TOPK; ++k) { my_e[k] = 0; my_p[k] = 0; my_g[k] = 0.f; }
        if (w < 2) {
            float lg[16];
#pragma unroll
            for (int q = 0; q < 16; ++q) lg[q] = 0.f;
            float s2 = 0.f;
#pragma unroll
            for (int k4 = 0; k4 < 4; ++k4) { const int ww = k4 * 2 + tile;
#pragma unroll
                for (int q = 0; q < 4; ++q) { const f32x4 p = *(const LAS f32x4*)(part + (ww * 64 + lane) * 16 + 4 * q); lg[4 * q] += p[0]; lg[4 * q + 1] += p[1]; lg[4 * q + 2] += p[2]; lg[4 * q + 3] += p[3]; }
                s2 += ssqp[ww * 64 + lane] + ssqp[ww * 64 + (lane ^ 32)]; }
            const float rstd = rsqrtf(s2 * (1.f / DM) + EPS);
#pragma unroll
            for (int q = 0; q < 16; ++q) lg[q] = lg[q] * rstd + F.router_b[crow(q, h)];
            float cv[8]; int ci[8];
#pragma unroll
            for (int k = 0; k < TOPK; ++k) {
                float bv = -INFINITY; int bi = 1 << 20;
#pragma unroll
                for (int q = 0; q < 16; ++q) { const int e = crow(q, h); const bool better = (lg[q] > bv) || (lg[q] == bv && e < bi); bv = better ? lg[q] : bv; bi = better ? e : bi; }
#pragma unroll
                for (int q = 0; q < 16; ++q) if (crow(q, h) == bi) lg[q] = -INFINITY;
                cv[k] = bv; ci[k] = bi;
            }
#pragma unroll
            for (int k = 0; k < TOPK; ++k) { cv[4 + k] = __shfl_xor(cv[k], 32); ci[4 + k] = __shfl_xor(ci[k], 32); }
            float tv[TOPK]; int te[TOPK];
#pragma unroll
            for (int k = 0; k < TOPK; ++k) {
                float bv = -INFINITY; int bi = 1 << 20;
#pragma unroll
                for (int q = 0; q < 8; ++q) { const bool better = (cv[q] > bv) || (cv[q] == bv && ci[q] < bi); bv = better ? cv[q] : bv; bi = better ? ci[q] : bi; }
#pragma unroll
                for (int q = 0; q < 8; ++q) if (ci[q] == bi) cv[q] = -INFINITY;
                tv[k] = bv; te[k] = bi;
            }
            const float e1 = __expf(tv[1] - tv[0]), e2 = __expf(tv[2] - tv[0]), e3 = __expf(tv[3] - tv[0]), inv = 1.f / (1.f + e1 + e2 + e3);
            if (h == 0) {
                my_rs = rstd; my_g[0] = inv; my_g[1] = e1 * inv; my_g[2] = e2 * inv; my_g[3] = e3 * inv;
#pragma unroll
                for (int k = 0; k < TOPK; ++k) { my_e[k] = te[k]; my_p[k] = __hip_atomic_fetch_add(&lcnt[te[k]], 1, __ATOMIC_RELAXED, __HIP_MEMORY_SCOPE_WORKGROUP); }
            }
        }
        RSTAMP(13);
        __syncthreads();
        if (F.tid < NE) lbase[F.tid] = atomicAdd(&cnt[F.tid * 64], (int)lcnt[F.tid]);
        __syncthreads();
        if (w < 2 && h == 0) {
#pragma unroll
            for (int k = 0; k < TOPK; ++k) { const size_t li = (size_t)my_e[k] * T + lbase[my_e[k]] + my_p[k]; LIST[li] = t * TOPK + k; LRS[li] = my_rs; LGT[li] = my_g[k]; }
        }
        __syncthreads();
        RSTAMP(14);
    }
}
__device__ __forceinline__ void moe_setup(Frame& F) {
    LAS int* pre = (LAS int*)(F.lds + MOE_OFF); LAS int* lc = (LAS int*)(F.lds + MOE_OFF + 256); LAS int* te = (LAS int*)(F.lds + MOE_OFF + 512);
    if (F.tid < 64) {
        const int c = F.lane < NE ? (int)__hip_atomic_load((int*)(F.ctl + CW_CNT) + F.lane * 64, RLX_AGENT) : 0;
        int s = c >> 8;
#pragma unroll
        for (int o = 1; o < 32; o <<= 1) { const int v = __shfl_up(s, o); if ((F.lane & 31) >= o) s += v; }
        const int rem = c & 255; int rank = 0;
#pragma unroll 4
        for (int q = 0; q < NE; ++q) { const int rq = __shfl(rem, q); rank += (rq > rem || (rq == rem && q < F.lane)) ? 1 : 0; }
        const int nt = __builtin_popcountll(__ballot(rem > 0) & 0xffffffffull);
        if (F.lane < NE) { pre[F.lane + 1] = s; lc[F.lane] = c; te[rank] = F.lane; }
        if (F.lane == 0) { pre[0] = 0; te[32] = nt; }
    }
    __syncthreads();
}
__device__ __forceinline__ void p_final(Frame& F) {
    const bf16_t* X1 = WSP(bf16_t, WS_X1); const unsigned char* Y = WSP(unsigned char, WS_Y);
    const int gw = F.vcu * NWAVES + F.wave, NGW = F.G * NWAVES;
    f32x4 gfv[4];
#pragma unroll
    for (int j = 0; j < 4; ++j) gfv[j] = *((const f32x4*)F.final_g + F.lane + 64 * j);
    for (int t = gw; t < T; t += NGW) {
        const GAS u32x2* xr = (const GAS u32x2*)(X1 + (size_t)t * DM) + F.lane;
        f32x4 v[4]; float s = 0.f;
#pragma unroll
        for (int j = 0; j < 4; ++j) {
            { const u32x2 xb = xr[64 * j]; v[j] = (f32x4){bflo(xb.x), bfhi(xb.x), bflo(xb.y), bfhi(xb.y)}; }
#pragma unroll
            for (int k = 0; k < TOPK; ++k) { const int y = *((const GAS int*)(Y + ((size_t)t * TOPK + k) * DM) + F.lane + 64 * j);
                const f32x2 lo = __builtin_amdgcn_cvt_pk_f32_fp8(y, false), hi = __builtin_amdgcn_cvt_pk_f32_fp8(y, true);
                v[j].x += lo[0] * (1.f / pg8::FP8_Y_SCALE); v[j].y += lo[1] * (1.f / pg8::FP8_Y_SCALE); v[j].z += hi[0] * (1.f / pg8::FP8_Y_SCALE); v[j].w += hi[1] * (1.f / pg8::FP8_Y_SCALE); }
            s += (v[j].x * v[j].x + v[j].y * v[j].y) + (v[j].z * v[j].z + v[j].w * v[j].w);
        }
        const float r = rsqrtf(wave_sum(s) * (1.f / DM) + EPS);
        GAS f32x4* o = (GAS f32x4*)(F.out + (size_t)t * DM) + F.lane;
#pragma unroll
        for (int j = 0; j < 4; ++j) { const f32x4 g = gfv[j]; o[64 * j] = (f32x4){v[j].x * r * g.x, v[j].y * r * g.y, v[j].z * r * g.z, v[j].w * r * g.w}; }
    }
}


struct Args { const float* in[18]; float* out; unsigned char* ws; int ph_lo, ph_hi, li, dry; };
__global__ void __launch_bounds__(NWAVES * 64, 2) mega_fwd(Args args) {
    extern __shared__ __attribute__((aligned(16))) unsigned char lds[];
    Frame F;
    F.lds = (LAS unsigned char*)lds; F.MISC = (volatile LAS unsigned*)(F.lds + MISC_OFF);
    F.tid = threadIdx.x; F.lane = F.tid & 63; F.wave = __builtin_amdgcn_readfirstlane(F.tid >> 6);
    F.G = gridDim.x; { const int bx = blockIdx.x; F.vcu = (F.G % 8 == 0) ? (bx % 8) * (F.G / 8) + bx / 8 : bx; }
    F.ws = args.ws; F.ctl = (gu32*)(args.ws + WS_CTL); F.out = args.out; F.probe = args.dry >= 9 ? args.dry : 0;
    F.x = args.in[0]; F.norm1_g = args.in[1]; F.w_in = args.in[2]; F.b_in = args.in[3]; F.sinks = args.in[4]; F.attn_g = args.in[5]; F.lb_logits = args.in[6]; F.hgrn_g = args.in[7];
    F.w_out = args.in[8]; F.b_out = args.in[9]; F.norm2_g = args.in[10]; F.router_w = args.in[11]; F.router_b = args.in[12]; F.w1 = args.in[13]; F.b1 = args.in[14]; F.w2 = args.in[15];
    F.b2 = args.in[16]; F.final_g = args.in[17];
    for (int u = F.tid; u < (LDS_BYTES - LDSCTL_OFF) / 4; u += NWAVES * 64) ((LAS unsigned*)(F.lds + LDSCTL_OFF))[u] = 0u;
    __syncthreads();
    XcdBarrier bar = xcd_barrier_post((unsigned*)(F.ctl + CW_BAR) + args.li * XCD_BAR_WORDS, F.MISC + 8);
    const int lo = args.ph_lo, hi = args.ph_hi;
#ifdef TS_A
    volatile LAS unsigned long long* ts_ = (volatile LAS unsigned long long*)(F.lds + LDSCTL_OFF + 2048);
#ifndef TS_BLK
#define TS_BLK 0
#endif
    const bool stamper = (blockIdx.x == TS_BLK && F.tid == 0);
    if (stamper) ts_[0] = __builtin_amdgcn_s_memrealtime();
#define STAMP(k) do { if (stamper) ts_[(k) + 1] = __builtin_amdgcn_s_memrealtime(); } while (0)
#else
#define STAMP(k) do { } while (0)
#endif
#define IN(k) (lo <= (k) && (k) < hi)
#define SEAM(k) do { if (IN(k) && IN((k) + 1)) xcd_barrier(bar); } while (0)

    if (IN(0)) { p_prologue(F); SEAM(0); } STAMP(0);
    if (IN(1)) {
        pg8::DenseOrder S; S.init(WSP(bf16_t, WS_XN), WSP(bf16_t, WS_WINT), T, INW, DM, F.G, (int)blockIdx.x, FP8_INPROJ ? 1 : 2, INPROJ_PMAP);
        pg8::EpiInProj E{F.b_in, WSP(float, WS_LB), WSP(bf16_t, WS_AQ), WSP(bf16_t, WS_AK), WSP(bf16_t, WS_AV), WSP(bf16_t, WS_HQ), WSP(bf16_t, WS_KK), WSP(bf16_t, WS_HI), WSP(bf16_t, WS_HG), WSP(bf16_t, WS_G), FP8_INPROJ ? 1.f / (FP8_XN_SCALE * pg8::FP8_W_SCALE) : 1.f};
#ifdef PROBE_VARIANTS
        if (args.dry == 2) pg8::gemm_phase<pg8::EpiInProj, pg8::DenseOrder, false, true, 2, 1>(F.lds + RING_OFF, DM, S, E, args.dry);
        else if (args.dry == 3) pg8::gemm_phase<pg8::EpiInProj, pg8::DenseOrder, false, true, 2, 2>(F.lds + RING_OFF, DM, S, E, args.dry);
        else if (args.dry == 4) pg8::gemm_phase<pg8::EpiInProj, pg8::DenseOrder, false, true, 2, 3>(F.lds + RING_OFF, DM, S, E, args.dry);
        else
#endif
        pg8::gemm_phase<pg8::EpiInProj, pg8::DenseOrder, false, true, FP8_INPROJ ? 1 : 2>(F.lds + RING_OFF, DM, S, E, args.dry);
        SEAM(1);
    } STAMP(1);
    if (IN(2)) { p_hgrn_prep(F); SEAM(2); } STAMP(2);
    if (IN(3)) { p_scan_attn(F, args.dry < 5, args.dry < 5, args.dry == 6 ? 1 : args.dry == 7 ? 3 : 0); SEAM(3); } STAMP(3);
    STAMP(4);
    if (IN(5)) {
        pg8::DenseOrder S; S.init(WSP(bf16_t, WS_MIX), WSP(bf16_t, WS_WOUTT), T, DM, MIXW, F.G, (int)blockIdx.x, FP8_OUTPROJ ? 1 : 2);
        pg8::EpiOutProj E{F.b_out, F.x, WSP(bf16_t, WS_X1), FP8_OUTPROJ ? 1.f / (FP8_MIX_SCALE * pg8::FP8_W_SCALE) : 1.f};
        pg8::gemm_phase<pg8::EpiOutProj, pg8::DenseOrder, false, true, FP8_OUTPROJ ? 1 : 2>(F.lds + RING_OFF, MIXW, S, E);
        SEAM(5);
    } STAMP(5);
    if (IN(6)) { p_router(F); SEAM(6); } STAMP(6);
    if (IN(7)) {
        moe_setup(F);
        LAS const int* pre = (LAS const int*)(F.lds + MOE_OFF); LAS const int* lc = (LAS const int*)(F.lds + MOE_OFF + 256);
        LAS const int* te = (LAS const int*)(F.lds + MOE_OFF + 512);
        pg8::MoeOrder<true, 1, BKN_MOE != 0> S{(const char*)WSP(unsigned char, WS_H2), (const char*)WSP(unsigned char, WS_W1T), WSP(int, WS_LIST), pre, lc, te, DM, 2 * FF, 2 * FF / 256, pre[NE], te[32], F.G, (int)blockIdx.x};
        pg8::EpiMoe1 E{F.b1, WSP(unsigned char, WS_ACT), WSP(float, WS_LRS)};
#ifdef PROBE_VARIANTS
        if (args.dry == 2) pg8::gemm_phase<pg8::EpiMoe1, pg8::MoeOrder<true, 1>, true, true, 1, 1>(F.lds + RING_OFF, DM, S, E, args.dry);
        else if (args.dry == 3) pg8::gemm_phase<pg8::EpiMoe1, pg8::MoeOrder<true, 1>, true, true, 1, 2>(F.lds + RING_OFF, DM, S, E, args.dry);
        else if (args.dry == 4) pg8::gemm_phase<pg8::EpiMoe1, pg8::MoeOrder<true, 1>, true, true, 1, 3>(F.lds + RING_OFF, DM, S, E, args.dry);
        else
#endif
        pg8::gemm_phase<pg8::EpiMoe1, pg8::MoeOrder<true, 1, BKN_MOE != 0>, true, true, 1, 0, BKN_MOE != 0>(F.lds + RING_OFF, DM, S, E, args.dry);
        SEAM(7);
    } STAMP(7);
    if (IN(8)) {
        if (!IN(7)) moe_setup(F);
        LAS const int* pre = (LAS const int*)(F.lds + MOE_OFF); LAS const int* lc = (LAS const int*)(F.lds + MOE_OFF + 256);
        LAS const int* te = (LAS const int*)(F.lds + MOE_OFF + 512);
        pg8::MoeOrder<false, 1, BKN_MOE != 0> S{(const char*)WSP(unsigned char, WS_ACT), (const char*)WSP(unsigned char, WS_W2T), WSP(int, WS_LIST), pre, lc, te, FF, DM, DM / 256, pre[NE], te[32], F.G, (int)blockIdx.x};
        pg8::EpiMoe2 E{F.b2, WSP(int, WS_LIST), WSP(float, WS_LGT), WSP(unsigned char, WS_Y)};
        pg8::gemm_phase<pg8::EpiMoe2, pg8::MoeOrder<false, 1, BKN_MOE != 0>, false, true, 1, 0, BKN_MOE != 0>(F.lds + RING_OFF, FF, S, E, args.dry);
        SEAM(8);
    } STAMP(8);
    if (IN(9)) p_final(F);
    STAMP(9);
#ifdef BW_PROBE
    if (IN(10)) {
        const f32x4* src = (const f32x4*)F.w1; constexpr size_t N4 = (size_t)NE * DM * 2 * FF / 4;
        f32x4 s = {0.f, 0.f, 0.f, 0.f};
        const size_t per = N4 / gridDim.x;
#if BW_PROBE == 1
        const f32x4* p = src + (size_t)blockIdx.x * per + F.tid;
        for (size_t i = 0; i < per; i += 512 * 8) {
            f32x4 v[8];
#pragma unroll
            for (int j = 0; j < 8; ++j) v[j] = p[i + 512 * j];
#pragma unroll
            for (int j = 0; j < 8; ++j) s += v[j];
        }
#else
        const f32x4* p = src + (size_t)F.tid;
        for (size_t i = (size_t)blockIdx.x * 512 * 8; i < N4; i += (size_t)gridDim.x * 512 * 8) {
            f32x4 v[8];
#pragma unroll
            for (int j = 0; j < 8; ++j) v[j] = p[i + 512 * j];
#pragma unroll
            for (int j = 0; j < 8; ++j) s += v[j];
        }
#endif
        if (s[0] + s[1] + s[2] + s[3] == 12345.678f) WSP(float, WS_ACT)[F.tid] = s[0];
    }
#endif
#ifdef TS_A
#ifndef TS_LI
#define TS_LI 0
#endif
    if (stamper && args.li == TS_LI) { const unsigned long long t_end = ts_[10], dly = (unsigned long long)(TS_MULT) * (ts_[TS_B] - ts_[TS_A]); while (__builtin_amdgcn_s_memrealtime() - t_end < dly) __builtin_amdgcn_s_sleep(4); }
#endif
#undef IN
#undef SEAM
}

static int mega_grid() {
    static int grid = 0;
    if (grid == 0) {
        int dev = 0, cus = 0;
        if (hipGetDevice(&dev) != hipSuccess || hipDeviceGetAttribute(&cus, hipDeviceAttributeMultiprocessorCount, dev) != hipSuccess) { grid = -1; return grid; }
        if (hipFuncSetAttribute((const void*)mega_fwd, hipFuncAttributeMaxDynamicSharedMemorySize, LDS_BYTES) != hipSuccess) { grid = -1; return grid; }
        (void)hipGetLastError();
        grid = cus;
    }
    return grid;
}
extern "C" void kernel_launch(void* const* d_in, const int* in_sizes, int n_in, void* d_out, int out_size, void* d_ws, size_t ws_size, hipStream_t stream) {
#ifndef PLAN
#define PLAN {{0, N_PHASES, 0}}
#endif
    if (n_in != 18 || ws_size < WS_END) return;
    const int grid = mega_grid(); if (grid <= 0) return;
    unsigned char* ws = (unsigned char*)d_ws;
    static const int plan[][3] = PLAN;
    constexpr int n_launch = (int)(sizeof(plan) / sizeof(plan[0]));
    (void)hipMemsetAsync(ws + WS_CTL, 0, (size_t)(CW_BAR + n_launch * XCD_BAR_WORDS) * 4, stream);
    Args a{};
    for (int i = 0; i < 18; ++i) a.in[i] = (const float*)d_in[i];
    a.out = (float*)d_out; a.ws = ws;
    for (int li = 0; li < (int)(sizeof(plan) / sizeof(plan[0])); ++li) {
        a.ph_lo = plan[li][0]; a.ph_hi = plan[li][1]; a.li = li; a.dry = plan[li][2];
        hipLaunchKernelGGL(mega_fwd, dim3(grid), dim3(NWAVES * 64), LDS_BYTES, stream, a);
    }
}
```
